# Optimizing an MI355X kernel written in HIP

```python
import math
import jax, jax.numpy as jnp
from jax import lax
import numpy as np


D_MODEL = 1024
BATCH = 32
SEQ = 2048
DEPTH = 1

MEM_LEN = 256
HEAD_DIM = 64
EPS = 1e-6
A_HEADS = 6
A_PATTERNS = ((128, 1), (512, 4), (2048, 16))
N_BUCKETS = 32
REL_MAX_DIST = 2048
B_HEADS = 4
B_KEY_DIM = 64
B_VAL_DIM = 96
B_CHUNK = 64
C_HEADS = 4
N_EXPERTS = 64
TOP_K = 8
N_GROUPS = 8
TOPK_GROUPS = 4
EXPERT_HIDDEN = 256
SHARED_HIDDEN = 256
ROUTED_SCALE = 2.5
MOE_BLOCK = 128

A_WIDTH = A_HEADS * HEAD_DIM
B_QK_WIDTH = B_HEADS * B_KEY_DIM
B_WIDTH = B_HEADS * B_VAL_DIM
C_WIDTH = C_HEADS * HEAD_DIM
N_BRANCHES = 3
IN_SPLITS = (A_WIDTH, A_WIDTH, A_WIDTH, B_QK_WIDTH, B_QK_WIDTH, B_WIDTH, B_WIDTH, C_WIDTH, N_BRANCHES * D_MODEL)
IN_WIDTH = sum(IN_SPLITS)

kernel_name = 'hybrid_dilated_hgrn2_memxattn_moe_block'


def split_cols(t, sizes):
    out, start = [], 0
    for s in sizes:
        out.append(t[..., start:start + s])
        start += s
    return out


def rmsnorm(t, g):
    tf = t.astype(jnp.float32)
    tf = tf * lax.rsqrt(jnp.mean(tf * tf, axis=-1, keepdims=True) + EPS)
    return (tf * g.astype(jnp.float32)).astype(t.dtype)


def t5_bucket(dist):
    d = dist.astype(jnp.int32)
    max_exact = N_BUCKETS // 2
    large = max_exact + (jnp.log(jnp.maximum(d, 1).astype(jnp.float32) / max_exact)
                         / math.log(REL_MAX_DIST / max_exact) * (N_BUCKETS - max_exact)).astype(jnp.int32)
    return jnp.where(d < max_exact, d, jnp.minimum(large, N_BUCKETS - 1))


def dilated_window_attention(q, k, v, rel_bias, window, dilation):
    B, S, H, E = q.shape
    w = window // dilation
    L = S // dilation
    nb = -(-L // w)
    Lp = nb * w

    def to_residue(t):
        t = t.reshape(B, L, dilation, H, E).transpose(0, 2, 3, 1, 4)
        return jnp.pad(t, ((0, 0), (0, 0), (0, 0), (0, Lp - L), (0, 0)))

    qs, ks, vs = to_residue(q), to_residue(k), to_residue(v)
    qb = qs.reshape(B, dilation, H, nb, w, E)

    def with_prev(t):
        tp = jnp.pad(t, ((0, 0), (0, 0), (0, 0), (w, 0), (0, 0)))
        return jnp.concatenate([tp[:, :, :, :Lp].reshape(B, dilation, H, nb, w, E),
                                t.reshape(B, dilation, H, nb, w, E)], axis=4)

    kb, vb = with_prev(ks), with_prev(vs)
    i = jnp.arange(w)[:, None]
    c = jnp.arange(2 * w)[None, :]
    steps = w + i - c
    in_band = (steps >= 0) & (steps <= w)
    blk = jnp.arange(nb)[:, None, None]
    valid = in_band[None] & ((blk > 0) | (c[None] >= w))
    bias = rel_bias.astype(jnp.float32)[t5_bucket(jnp.clip(steps, 0, w) * dilation)]
    bias = bias.transpose(2, 0, 1)
    logits = jnp.einsum('brhnie,brhnce->brhnic', qb, kb) + bias[None, None, :, None]
    logits = jnp.where(valid[None, None, None], logits, -jnp.inf)
    m = jnp.max(logits, axis=-1, keepdims=True)
    p = jnp.exp(logits - m)
    den = jnp.sum(p, axis=-1, keepdims=True)
    o = jnp.einsum('brhnic,brhnce->brhnie', p, vb) / den
    lse = (m + jnp.log(den))[..., 0]
    o = o.reshape(B, dilation, H, Lp, E)[:, :, :, :L].transpose(0, 3, 1, 2, 4).reshape(B, S, H, E)
    lse = lse.reshape(B, dilation, H, Lp)[:, :, :, :L].transpose(0, 3, 1, 2).reshape(B, S, H)
    return o, lse


def dilated_attention_branch(qa, ka, va, q_norm, k_norm, rel_bias):
    B, S, _ = qa.shape
    q = rmsnorm(qa.reshape(B, S, A_HEADS, HEAD_DIM), q_norm).astype(jnp.float32) * HEAD_DIM ** -0.5
    k = rmsnorm(ka.reshape(B, S, A_HEADS, HEAD_DIM), k_norm).astype(jnp.float32)
    v = va.reshape(B, S, A_HEADS, HEAD_DIM).astype(jnp.float32)
    outs, lses = [], []
    for window, dilation in A_PATTERNS:
        o, lse = dilated_window_attention(q, k, v, rel_bias, window, dilation)
        outs.append(o)
        lses.append(lse)
    wts = jax.nn.softmax(jnp.stack(lses, axis=0), axis=0)
    o = jnp.sum(jnp.stack(outs, axis=0) * wts[..., None], axis=0)
    return o.reshape(B, S, A_WIDTH).astype(qa.dtype)


def chunked_gated_recurrence(q, k, log_f, v):
    B, S, H, DK = q.shape
    DV = v.shape[-1]
    nc = S // B_CHUNK

    def chunks(t):
        return t.reshape(B, nc, B_CHUNK, H, t.shape[-1]).transpose(1, 0, 3, 2, 4)

    causal = jnp.tril(jnp.ones((B_CHUNK, B_CHUNK), bool))[:, :, None]

    def step(state, inp):
        qt, kt, gt, vt = inp
        b = jnp.cumsum(gt, axis=2)
        diff = jnp.where(causal, b[:, :, :, None, :] - b[:, :, None, :, :], -jnp.inf)
        scores = jnp.einsum('bhtk,bhsk,bhtsk->bhts', qt, kt, jnp.exp(diff))
        o = (jnp.einsum('bhts,bhsv->bhtv', scores, vt)
             + jnp.einsum('bhtk,bhkv->bhtv', qt * jnp.exp(b), state))
        b_last = b[:, :, -1:, :]
        state = (jnp.exp(b_last[:, :, 0, :])[..., None] * state
                 + jnp.einsum('bhsk,bhsv->bhkv', kt * jnp.exp(b_last - b), vt))
        return state, o

    state0 = jnp.zeros((B, H, DK, DV), jnp.float32)
    _, o = lax.scan(step, state0, (chunks(q), chunks(k), chunks(log_f), chunks(v)))
    return o.transpose(1, 0, 3, 2, 4).reshape(B, S, H, DV)


def hgrn2_branch(qb, fb, ib, og, lower_bound, out_norm):
    B, S, _ = qb.shape
    q = jax.nn.silu(qb.astype(jnp.float32)).reshape(B, S, B_HEADS, B_KEY_DIM) * B_KEY_DIM ** -0.5
    f = lower_bound + (1.0 - lower_bound) * jax.nn.sigmoid(fb.astype(jnp.float32))
    f = f.reshape(B, S, B_HEADS, B_KEY_DIM)
    k = 1.0 - f
    v = ib.astype(jnp.float32).reshape(B, S, B_HEADS, B_VAL_DIM)
    o = chunked_gated_recurrence(q, k, jnp.log(f), v)
    o = rmsnorm(o, out_norm.reshape(B_HEADS, B_VAL_DIM))
    o = o * jax.nn.silu(og.astype(jnp.float32)).reshape(B, S, B_HEADS, B_VAL_DIM)
    return o.reshape(B, S, B_WIDTH).astype(qb.dtype)


def memory_branch(qc, mem_n, w_mem_kv, q_norm, k_norm):
    B, S, _ = qc.shape
    M = mem_n.shape[1]
    km, vm = split_cols(mem_n @ w_mem_kv, (C_WIDTH, C_WIDTH))
    k = rmsnorm(km.reshape(B, M, C_HEADS, HEAD_DIM), k_norm).astype(jnp.float32)
    v = vm.reshape(B, M, C_HEADS, HEAD_DIM).astype(jnp.float32)
    q = rmsnorm(qc.reshape(B, S, C_HEADS, HEAD_DIM), q_norm).astype(jnp.float32) * HEAD_DIM ** -0.5
    p = jax.nn.softmax(jnp.einsum('bshe,bmhe->bhsm', q, k), axis=-1)
    o = jnp.einsum('bhsm,bmhe->bshe', p, v)
    return o.reshape(B, S, C_WIDTH).astype(qc.dtype)


def swiglu(t, w_up, w_down):
    gate, up = split_cols(t @ w_up, (w_down.shape[0], w_down.shape[0]))
    return (jax.nn.silu(gate) * up) @ w_down


def routed_experts(u, idx, wts, w_exp_up, w_exp_down):
    T, D = u.shape
    TK = T * TOP_K
    flat_e = idx.reshape(-1).astype(jnp.int32)
    order = jnp.argsort(flat_e).astype(jnp.int32)
    e_sorted = flat_e[order]
    counts = jnp.bincount(flat_e, length=N_EXPERTS).astype(jnp.int32)
    padded = (counts + MOE_BLOCK - 1) // MOE_BLOCK * MOE_BLOCK
    start = jnp.cumsum(counts) - counts
    pend = jnp.cumsum(padded)
    pstart = pend - padded
    dest = pstart[e_sorted] + jnp.arange(TK, dtype=jnp.int32) - start[e_sorted]
    n_blocks = -(-TK // MOE_BLOCK) + N_EXPERTS
    slot_of_row = jnp.full((n_blocks * MOE_BLOCK,), TK, jnp.int32).at[dest].set(order)
    block_expert = jnp.minimum(jnp.searchsorted(pend, jnp.arange(n_blocks, dtype=jnp.int32) * MOE_BLOCK,
                                                side='right'), N_EXPERTS - 1)
    tok_of_slot = jnp.concatenate([jnp.arange(TK, dtype=jnp.int32) // TOP_K, jnp.full((1,), T, jnp.int32)])
    w_of_slot = jnp.concatenate([wts.reshape(-1).astype(jnp.float32), jnp.zeros((1,), jnp.float32)])
    u_pad = jnp.concatenate([u, jnp.zeros((1, D), u.dtype)], axis=0)

    def step(acc, blk):
        slots = lax.dynamic_slice_in_dim(slot_of_row, blk * MOE_BLOCK, MOE_BLOCK)
        tok = tok_of_slot[slots]
        e = block_expert[blk]
        y = swiglu(u_pad[tok], w_exp_up[e], w_exp_down[e])
        return acc.at[tok].add(y.astype(jnp.float32) * w_of_slot[slots][:, None]), None

    acc, _ = lax.scan(step, jnp.zeros((T + 1, D), jnp.float32), jnp.arange(n_blocks, dtype=jnp.int32))
    return acc[:T]


def moe_ffn(u, w_router, router_bias, w_exp_up, w_exp_down, w_shared_up, w_shared_down):
    T = u.shape[0]
    per_group = N_EXPERTS // N_GROUPS
    s = jax.nn.sigmoid(u.astype(jnp.float32) @ w_router.astype(jnp.float32))
    choice = s + router_bias.astype(jnp.float32)
    group_score = jnp.sum(lax.top_k(choice.reshape(T, N_GROUPS, per_group), 2)[0], axis=-1)
    _, top_groups = lax.top_k(group_score, TOPK_GROUPS)
    group_mask = jnp.sum(jax.nn.one_hot(top_groups, N_GROUPS, dtype=jnp.float32), axis=1) > 0
    expert_mask = jnp.repeat(group_mask, per_group, axis=1)
    _, idx = lax.top_k(jnp.where(expert_mask, choice, -jnp.inf), TOP_K)
    w = jnp.take_along_axis(s, idx, axis=1)
    w = ROUTED_SCALE * w / jnp.sum(w, axis=-1, keepdims=True)
    routed = routed_experts(u, idx, w, w_exp_up, w_exp_down)
    shared = swiglu(u, w_shared_up, w_shared_down).astype(jnp.float32)
    return (routed + shared).astype(u.dtype)


def setup_inputs(seed: int = 0) -> dict:
    key = jax.random.key(seed)
    ks = jax.random.split(key, 24)
    f32 = jnp.float32

    def nrm(k, shape, scale):
        return jax.random.normal(k, shape, f32) * scale

    def gain(k, shape):
        return 1.0 + 0.02 * jax.random.normal(k, shape, f32)

    L = DEPTH
    return {
        'x': nrm(ks[0], (BATCH, SEQ, D_MODEL), 1.0),
        'mem': nrm(ks[1], (BATCH, MEM_LEN, D_MODEL), 1.0),
        'attn_norm_g': gain(ks[2], (L, D_MODEL)),
        'w_in': nrm(ks[3], (L, D_MODEL, IN_WIDTH), D_MODEL ** -0.5),
        'q_norm_a': gain(ks[4], (L, HEAD_DIM)),
        'k_norm_a': gain(ks[5], (L, HEAD_DIM)),
        'rel_bias': nrm(ks[6], (N_BUCKETS, A_HEADS), 0.1),
        'lb_logits': nrm(ks[7], (DEPTH + 1, B_QK_WIDTH), 0.5),
        'out_norm_b': gain(ks[8], (L, B_WIDTH)),
        'mem_norm_g': gain(ks[9], (L, D_MODEL)),
        'w_mem_kv': nrm(ks[10], (L, D_MODEL, 2 * C_WIDTH), D_MODEL ** -0.5),
        'q_norm_c': gain(ks[11], (L, HEAD_DIM)),
        'k_norm_c': gain(ks[12], (L, HEAD_DIM)),
        'w_branch_a': nrm(ks[13], (L, A_WIDTH, D_MODEL), A_WIDTH ** -0.5),
        'w_branch_b': nrm(ks[14], (L, B_WIDTH, D_MODEL), B_WIDTH ** -0.5),
        'w_branch_c': nrm(ks[15], (L, C_WIDTH, D_MODEL), C_WIDTH ** -0.5),
        'w_out': nrm(ks[16], (L, D_MODEL, D_MODEL), D_MODEL ** -0.5),
        'ffn_norm_g': gain(ks[17], (L, D_MODEL)),
        'w_router': nrm(ks[18], (L, D_MODEL, N_EXPERTS), D_MODEL ** -0.5),
        'router_bias': nrm(ks[19], (L, N_EXPERTS), 0.01),
        'w_exp_up': nrm(ks[20], (L, N_EXPERTS, D_MODEL, 2 * EXPERT_HIDDEN), D_MODEL ** -0.5),
        'w_exp_down': nrm(ks[21], (L, N_EXPERTS, EXPERT_HIDDEN, D_MODEL), EXPERT_HIDDEN ** -0.5),
        'w_shared_up': nrm(ks[22], (L, D_MODEL, 2 * SHARED_HIDDEN), D_MODEL ** -0.5),
        'w_shared_down': nrm(ks[23], (L, SHARED_HIDDEN, D_MODEL), SHARED_HIDDEN ** -0.5),
    }


def reference(x, mem, attn_norm_g, w_in, q_norm_a, k_norm_a, rel_bias, lb_logits, out_norm_b,
              mem_norm_g, w_mem_kv, q_norm_c, k_norm_c, w_branch_a, w_branch_b, w_branch_c, w_out,
              ffn_norm_g, w_router, router_bias, w_exp_up, w_exp_down, w_shared_up, w_shared_down):
    B, S, D = x.shape
    lower_bounds = jnp.cumsum(jax.nn.softmax(lb_logits.astype(jnp.float32), axis=0), axis=0)
    for layer in range(DEPTH):
        h = rmsnorm(x, attn_norm_g[layer])
        qa, ka, va, qb, fb, ib, og, qc, gate_pre = split_cols(h @ w_in[layer], IN_SPLITS)
        ya = dilated_attention_branch(qa, ka, va, q_norm_a[layer], k_norm_a[layer], rel_bias)
        yb = hgrn2_branch(qb, fb, ib, og, lower_bounds[layer], out_norm_b[layer])
        yc = memory_branch(qc, rmsnorm(mem, mem_norm_g[layer]), w_mem_kv[layer], q_norm_c[layer], k_norm_c[layer])
        g_a, g_b, g_c = split_cols(jax.nn.sigmoid(gate_pre), (D, D, D))
        mixed = (g_a * (ya @ w_branch_a[layer]) + g_b * (yb @ w_branch_b[layer])
                 + g_c * (yc @ w_branch_c[layer]))
        x = x + mixed @ w_out[layer]
        u = rmsnorm(x, ffn_norm_g[layer]).reshape(B * S, D)
        y = moe_ffn(u, w_router[layer], router_bias[layer], w_exp_up[layer], w_exp_down[layer],
                    w_shared_up[layer], w_shared_down[layer])
        x = x + y.reshape(B, S, D)
    return x
```

```cpp
#include <hip/hip_runtime.h>
#include <cstdio>
#include <cstdint>

#define GAS __attribute__((address_space(1)))
#define LAS __attribute__((address_space(3)))
typedef unsigned short bf16;
typedef unsigned v4u __attribute__((ext_vector_type(4)));
typedef unsigned v2u __attribute__((ext_vector_type(2)));
typedef float f32x4 __attribute__((ext_vector_type(4)));
typedef float f32x2 __attribute__((ext_vector_type(2)));
typedef short bf16x8 __attribute__((ext_vector_type(8)));
typedef GAS unsigned gu32;
#define RLX_AGENT __ATOMIC_RELAXED, __HIP_MEMORY_SCOPE_AGENT
#define LDS_WAIT() asm volatile("s_waitcnt lgkmcnt(0)" ::: "memory")
#define VM_WAIT() asm volatile("s_waitcnt vmcnt(0)" ::: "memory")

#ifndef MK_N_LAUNCHES
#define MK_N_LAUNCHES 12
#endif

constexpr int T = 65536, D = 1024, SEQ = 2048, NB = 32, MEML = 256;
constexpr int NPROJ = 5760, NPROJ_PAD = 5888;
constexpr int LD_PA = 1152, LD_PB = 1280, LD_PC = 256, LD_PG = 3072;
constexpr int NEXP = 64, NSEGH = 65, NSEG = 130, SLOT_CAP = 32768, HALF_T = 32768;
constexpr float EPS = 1e-6f;
constexpr int NPHASE = 12;

constexpr size_t MiB = 1u << 20;
constexpr size_t WS_CTL = 0, CTL_ZERO_BYTES = 1 * MiB;
constexpr size_t WS_TAB = 1 * MiB;
constexpr size_t WS_WIN = 2 * MiB;
constexpr size_t WS_WMEM = 14 * MiB;
constexpr size_t WS_WA = 15 * MiB;
constexpr size_t WS_WB = WS_WA + 768 * 1024;
constexpr size_t WS_WC = WS_WB + 768 * 1024;
constexpr size_t WS_WOUT = 17 * MiB;
constexpr size_t WS_WUP = 19 * MiB;
constexpr size_t WS_WDN = 84 * MiB;
constexpr size_t WS_MEMN = 117 * MiB;
constexpr size_t WS_MEMK = 133 * MiB, WS_MEMV = 137 * MiB;
constexpr size_t WS_ACT = 141 * MiB;
constexpr size_t WS_PG = WS_ACT;
constexpr size_t WS_PA = WS_PG + 384 * MiB;
constexpr size_t WS_PB = WS_PA + 144 * MiB;
constexpr size_t WS_PC = WS_PB + 160 * MiB;
constexpr size_t WS_LST = WS_PC + 32 * MiB;
constexpr size_t WS_DEC = WS_LST + 96 * MiB;
constexpr size_t WS_MIXED = WS_PA;
constexpr size_t WS_HID = WS_ACT;
constexpr size_t WS_SLOT = WS_HID + 304 * MiB;
constexpr size_t WS_WFLAT = WS_SLOT + 17 * MiB;
constexpr size_t WS_U = WS_WFLAT + 2 * MiB;
constexpr size_t WS_YBUF = WS_U;
constexpr size_t WS_END = WS_YBUF + 512 * MiB;
static_assert(WS_DEC + 1 * MiB <= 1024 * MiB && WS_END <= 1024 * MiB, "ws map");
static_assert(WS_WDN + (size_t)65 * 1024 * 256 * 2 <= WS_MEMN && WS_WUP + (size_t)65 * 512 * 1024 * 2 <= WS_WDN, "weights map");
constexpr size_t DO_YA = 0, DO_YB = 48 * MiB, DO_YC = 96 * MiB;
constexpr int CW_BAR = 4096;
constexpr int CW_CNT = 16384;

constexpr int RING_BYTES = 131072;
constexpr int LDS_GTAB = RING_BYTES;
constexpr int LDS_PRE = LDS_GTAB + 2048;
constexpr int LDS_MISC = LDS_PRE + 2048;
constexpr int LDS_BYTES = 147456;
static_assert(LDS_MISC + 256 <= LDS_BYTES, "lds map");

__device__ __forceinline__ int lane_id_fresh() { int l = __builtin_amdgcn_mbcnt_hi(0xffffffffu, __builtin_amdgcn_mbcnt_lo(0xffffffffu, 0u)); asm volatile("" : "+v"(l)); return l; }
__device__ __forceinline__ unsigned cvt_pk_bf16(float lo, float hi) { unsigned r; asm volatile("v_cvt_pk_bf16_f32 %0, %1, %2" : "=v"(r) : "v"(lo), "v"(hi)); return r; }
__device__ __forceinline__ float bf_lo(unsigned w) { return __uint_as_float(w << 16); }
__device__ __forceinline__ float bf_hi(unsigned w) { return __uint_as_float(w & 0xffff0000u); }
__device__ __forceinline__ float bf2f(bf16 b) { return __uint_as_float(((unsigned)b) << 16); }
__device__ __forceinline__ bf16 f2bf(float f) { return (bf16)(cvt_pk_bf16(f, 0.f) & 0xffffu); }
__device__ __forceinline__ float sigmoidf_(float x) { return 1.0f / (1.0f + __expf(-x)); }
__device__ __forceinline__ float wave_sum(float v) {
#pragma unroll
    for (int o = 1; o < 64; o <<= 1) v += __shfl_xor(v, o);
    return v;
}
__device__ __forceinline__ float wave_max(float v) {
#pragma unroll
    for (int o = 1; o < 64; o <<= 1) v = fmaxf(v, __shfl_xor(v, o));
    return v;
}

#define XB_TMO      128
#define XB_XCNT(j)  (256  + 64 * (j))
#define XB_XSUB(j)  (1280 + 64 * (j))
#define XB_XGEN(j)  (2304 + 64 * (j))
#define XB_TOP      3328
#define XB_TOPGEN   3392
#define XCD_BAR_WORDS 3456
#define XB_SPIN_CAP (1u << 22)
__device__ __forceinline__ unsigned xb_ld(unsigned* p)              { return __hip_atomic_load(p, __ATOMIC_RELAXED, __HIP_MEMORY_SCOPE_AGENT); }
__device__ __forceinline__ unsigned xb_add(unsigned* p, unsigned v) { return __hip_atomic_fetch_add(p, v, __ATOMIC_RELAXED, __HIP_MEMORY_SCOPE_AGENT); }
__device__ __forceinline__ unsigned xb_xcc_id() { return (unsigned)__builtin_amdgcn_s_getreg((3 << 11) | 20) & 0xFu; }
#define XB_SPIN(cond, bar) do { unsigned _sp = 0; while (cond) { __builtin_amdgcn_s_sleep(1); \
    if ((++_sp & 255u) == 0u) { if (xb_ld(&(bar)[XB_TMO])) break; if (_sp > XB_SPIN_CAP) { atomicAdd(&(bar)[XB_TMO], 1u); break; } } } } while (0)
struct XcdBarrier { unsigned* bar; unsigned x; volatile LAS unsigned* st; };
__device__ __forceinline__ XcdBarrier xcd_barrier_post(unsigned* bar, volatile LAS unsigned* st) {
    XcdBarrier b; b.bar = bar; b.x = xb_xcc_id(); b.st = st;
    if (threadIdx.x == 0) (void)xb_add(&bar[XB_XCNT(b.x)], 1u);
    return b;
}
__device__ __forceinline__ void xcd_barrier_complete(unsigned* bar, unsigned x, unsigned& nloc, unsigned& nx) {
    const unsigned G = gridDim.x * gridDim.y * gridDim.z;
    unsigned sum, cnt, mine, sp = 0u;
    for (;;) {
        sum = 0u; cnt = 0u; mine = 0u;
#pragma unroll
        for (unsigned j = 0; j < 16; ++j) { const unsigned c = xb_ld(&bar[XB_XCNT(j)]); sum += c; cnt += (c > 0u) ? 1u : 0u; mine = (j == x) ? c : mine; }
        if (sum == G) break;
        __builtin_amdgcn_s_sleep(1);
        if ((++sp & 255u) == 0u) { if (xb_ld(&bar[XB_TMO])) break; if (sp > XB_SPIN_CAP) { atomicAdd(&bar[XB_TMO], 1u); break; } }
    }
    nloc = mine > 0u ? mine : 1u; nx = cnt > 0u ? cnt : 1u;
}
__device__ __forceinline__ void xcd_barrier(const XcdBarrier& b, const int wave) {
    asm volatile("s_waitcnt vmcnt(0)" ::: "memory");
    __syncthreads();
    if (wave == 0 && lane_id_fresh() == 0) {
        unsigned* bar = b.bar;
        __builtin_amdgcn_s_waitcnt(0);
        unsigned nloc = b.st[0], nx = b.st[1];
        if (nloc == 0u) { xcd_barrier_complete(bar, b.x, nloc, nx); b.st[0] = nloc; b.st[1] = nx; }
        const unsigned old = xb_add(&bar[XB_XSUB(b.x)], 1u);
        const unsigned gen = old / nloc;
        if (old + 1u == (gen + 1u) * nloc) {
            __builtin_amdgcn_fence(__ATOMIC_RELEASE, "agent");
            asm volatile("s_waitcnt vmcnt(0)" ::: "memory");
            const unsigned og = xb_add(&bar[XB_TOP], 1u);
            const unsigned tg = og / nx;
            if (og + 1u == (tg + 1u) * nx) xb_add(&bar[XB_TOPGEN], 1u);
            else XB_SPIN(xb_ld(&bar[XB_TOPGEN]) == tg, bar);
            __builtin_amdgcn_fence(__ATOMIC_ACQUIRE, "agent");
            xb_add(&bar[XB_XGEN(b.x)], 1u);
            asm volatile("s_waitcnt vmcnt(0)" ::: "memory");
        } else {
            XB_SPIN(xb_ld(&bar[XB_XGEN(b.x)]) == gen, bar);
            __builtin_amdgcn_fence(__ATOMIC_ACQUIRE, "agent");
            asm volatile("s_waitcnt vmcnt(0)" ::: "memory");
        }
    }
    __syncthreads();
}

namespace pg8 {
constexpr int BM = 256, BK = 64, HALF = 128, HTB = HALF * BK * 2, NXCD = 8, WGM = 8;
__host__ __device__ __forceinline__ int lds_byte(int r, int c) { const int st = (r >> 4) * 2 + (c >> 5), rr = r & 15, cc = c & 31, ob = rr * 64 + cc * 2; return st * 1024 + (ob ^ (((ob >> 9) & 1) << 5)); }
__host__ __device__ __forceinline__ void stage_rc(int b, int& R, int& C) { const int st = b / 1024, sb = b % 1024, swz = sb ^ (((sb >> 9) & 1) << 5); R = (st >> 1) * 16 + swz / 64; C = (st & 1) * 32 + (swz % 64) / 2; }
__host__ __device__ __forceinline__ int perm32(int rho) { const int n = rho >> 4, i = rho & 15; return 8 * (i >> 2) + 4 * n + (i & 3); }

struct Unit { int pm, pn; const char* a; const char* b; int rows, seg, j; };

struct StaticOrder {
    int nM, nN, nwg, G, c; const char* A; const char* Bt; size_t tstep;
    __device__ void init(const void* A_, const void* Bt_, int M, int N, int K, int G_, int c_) { A = (const char*)A_; Bt = (const char*)Bt_; nM = M / BM; nN = N / BM; nwg = nM * nN; G = G_; c = c_; tstep = (size_t)BM * K * 2; }
    __device__ bool next(int i, Unit& u) const {
        const long L = (long)i * G + c; if (L >= nwg) return false;
        int wgid = (int)L; { const int q = nwg / NXCD, r = nwg % NXCD, xcd = wgid % NXCD, off = wgid / NXCD; wgid = (xcd < r ? xcd * (q + 1) : r * (q + 1) + (xcd - r) * q) + off; }
        const int nig = WGM * nN, gid = wgid / nig, fm = gid * WGM, gsz = (nM - fm) < WGM ? (nM - fm) : WGM;
        u.pm = fm + ((wgid % nig) % gsz); u.pn = (wgid % nig) / gsz; u.a = A + (size_t)u.pm * tstep; u.b = Bt + (size_t)u.pn * tstep; u.rows = 256; u.seg = 0; u.j = 0; return true;
    }
    __device__ __forceinline__ const int* tab_src(const Unit&) const { return nullptr; }
};
struct MoeOrder {
    const LAS int* pre; const LAS int* cnt; int seg_lo, nseg, nN, G, c; const char* A; const char* Bt; size_t a_tstep, b_estride, b_tstep; const int* slot; bool gather;
    __device__ bool next(int i, Unit& u) const {
        const long L = (long)i * G + c; const int b0 = __builtin_amdgcn_readfirstlane(pre[seg_lo]), total = __builtin_amdgcn_readfirstlane(pre[seg_lo + nseg]) - b0;
        const int br = (int)(L / nN); if (br >= total) return false;
        const int blk = b0 + br; u.pn = (int)(L % nN); u.pm = blk;
        int lo = seg_lo, hi = seg_lo + nseg;
        while (hi - lo > 1) { const int mid = (lo + hi) >> 1; if (__builtin_amdgcn_readfirstlane(pre[mid]) <= blk) lo = mid; else hi = mid; }
        u.seg = lo; u.j = blk - __builtin_amdgcn_readfirstlane(pre[lo]); const int rem = __builtin_amdgcn_readfirstlane(cnt[lo]) - u.j * 256; u.rows = rem < 256 ? rem : 256;
        const int e = lo % NSEGH;
        u.a = gather ? A : A + (size_t)blk * a_tstep; u.b = Bt + (size_t)e * b_estride + (size_t)u.pn * b_tstep; return true;
    }
    __device__ __forceinline__ const int* tab_src(const Unit& u) const { return slot + (size_t)u.seg * SLOT_CAP + u.j * 256; }
};

template <class Epi, class Sched, bool GATHER>
__device__ __forceinline__ void gemm_phase(LAS unsigned char* lds, const int K, const Sched& S, const Epi& E, const int wave) {
    const int lane = lane_id_fresh(), wid = wave, tid = wid * 64 + lane, wr = wid >> 2, wc = wid & 3, fr = lane & 15, fq = lane >> 4; (void)fr; (void)fq;
    const int nt = K / BK;
    unsigned voffA[2][2], voffB[2];
#pragma unroll
    for (int i = 0; i < 2; ++i) { int R, C; stage_rc(tid * 16 + i * 8192, R, C); const int Rb = Epi::PERM ? ((R & ~31) + perm32(R & 31)) : R;
        voffB[i] = (unsigned)(Rb * K + C) * 2u;
#pragma unroll
        for (int h = 0; h < 2; ++h) voffA[h][i] = (unsigned)(R * K + C) * 2u; }
    const size_t kstep = (size_t)(BK * 2);
    const size_t hstep = (size_t)HALF * K * 2;
    const unsigned ldsw = (unsigned)wid * 1024u;
    const int aoff = lds_byte(wr * 64 + fr, fq * 8), boff = lds_byte(wc * 32 + fr, fq * 8);
    const LAS int* gtab = (const LAS int*)(lds + LDS_GTAB);
#define PG8_SA(b, h) (((b) * 2 + (h)) * HTB)
#define PG8_SB(b, h) ((4 + (b) * 2 + (h)) * HTB)
#define PG8_STAGE_A(bufoff, gbase, h) do { _Pragma("unroll") for (int _i = 0; _i < 2; ++_i) \
        __builtin_amdgcn_global_load_lds((const unsigned*)((const char*)(gbase) + (GATHER ? (size_t)0 : (size_t)(h) * hstep) + voffA[GATHER ? (h) : 0][_i]), (LAS unsigned*)(lds + (bufoff) + ldsw + _i * 8192), 16, 0, 0); } while (0)
#define PG8_STAGE_B(bufoff, gbase) do { _Pragma("unroll") for (int _i = 0; _i < 2; ++_i) \
        __builtin_amdgcn_global_load_lds((const unsigned*)((const char*)(gbase) + voffB[_i]), (LAS unsigned*)(lds + (bufoff) + ldsw + _i * 8192), 16, 0, 0); } while (0)
#define PG8_LDA(dst, b, h) do { _Pragma("unroll") for (int m = 0; m < 4; ++m) _Pragma("unroll") for (int k = 0; k < 2; ++k) dst[m][k] = *(const LAS bf16x8*)(lds + PG8_SA(b, h) + aoff + m * 2048 + k * 1024); } while (0)
#define PG8_LDB(dst, b, h) do { _Pragma("unroll") for (int n = 0; n < 2; ++n) _Pragma("unroll") for (int k = 0; k < 2; ++k) dst[n][k] = *(const LAS bf16x8*)(lds + PG8_SB(b, h) + boff + n * 2048 + k * 1024); } while (0)
#define PG8_MMA(ai, bj, At, Bt) do { __builtin_amdgcn_s_setprio(1); _Pragma("unroll") for (int m = 0; m < 4; ++m) _Pragma("unroll") for (int n = 0; n < 2; ++n) _Pragma("unroll") for (int k = 0; k < 2; ++k) \
        acc[ai][bj][m][n] = __builtin_amdgcn_mfma_f32_16x16x32_bf16(Bt[n][k], At[m][k], acc[ai][bj][m][n], 0, 0, 0); __builtin_amdgcn_s_setprio(0); } while (0)
#define PG8_WAIT_V(n) asm volatile("s_waitcnt vmcnt(" #n ")" ::: "memory")
#define PG8_WAIT_L(n) asm volatile("s_waitcnt lgkmcnt(" #n ")" ::: "memory")
#define PG8_BAR __builtin_amdgcn_s_barrier()
#define PG8_SCHED __builtin_amdgcn_sched_barrier(0)
#define PG8_GOFFS(u, tb) do { _Pragma("unroll") for (int _h = 0; _h < 2; ++_h) _Pragma("unroll") for (int _i = 0; _i < 2; ++_i) { int _R, _C; stage_rc(tid * 16 + _i * 8192, _R, _C); \
        const int _rr = _h * HALF + _R; const int _v = gtab[(tb) * 256 + _rr]; const unsigned _tok = (_rr < (u).rows) ? (unsigned)(_v >> 3) : 0u; voffA[_h][_i] = _tok * (unsigned)(K * 2) + (unsigned)(_C * 2); } } while (0)
#define PG8_GTAB_DMA(u, tb) do { if (wid < 4) __builtin_amdgcn_global_load_lds((const unsigned*)(S.tab_src(u) + wid * 64 + lane), (LAS unsigned*)(lds + LDS_GTAB + (tb) * 1024 + wid * 256), 4, 0, 0); } while (0)
    Unit cur, nxt; int ui = 0;
    if (!S.next(0, cur)) return;
    f32x4 acc[2][2][4][2];
#pragma unroll
    for (int a = 0; a < 2; ++a)
#pragma unroll
        for (int b = 0; b < 2; ++b)
#pragma unroll
            for (int m = 0; m < 4; ++m)
#pragma unroll
                for (int n = 0; n < 2; ++n) acc[a][b][m][n] = (f32x4){0.f, 0.f, 0.f, 0.f};
    bf16x8 At[4][2], B0[2][2], B1[2][2];
    const char* cA = cur.a; const char* cB = cur.b;
    if constexpr (GATHER) { PG8_GTAB_DMA(cur, 0); PG8_WAIT_V(0); PG8_BAR; PG8_GOFFS(cur, 0); }
    PG8_STAGE_B(PG8_SB(0, 0), cB); PG8_STAGE_B(PG8_SB(0, 1), cB + hstep); PG8_STAGE_A(PG8_SA(0, 0), cA, 0); PG8_STAGE_A(PG8_SA(0, 1), cA, 1);
    if (wr == 1) PG8_BAR;
    PG8_WAIT_V(2); PG8_BAR;
    PG8_STAGE_B(PG8_SB(1, 0), cB + kstep); PG8_STAGE_A(PG8_SA(1, 0), cA + kstep, 0); PG8_STAGE_B(PG8_SB(1, 1), cB + hstep + kstep);
    PG8_WAIT_V(6); PG8_BAR;
    for (;;) {
        const bool has_next = S.next(ui + 1, nxt);
        const char* nA = has_next ? nxt.a : cA; const char* nB = has_next ? nxt.b : cB;
        for (int t = 0; t < nt; t += 2) {
            const bool last = (t == nt - 2);
            const char* a1 = cA + (size_t)(t + 1) * kstep;
            const char* a2 = last ? nA : cA + (size_t)(t + 2) * kstep; const char* b2 = last ? nB : cB + (size_t)(t + 2) * kstep;
            const char* a3 = a2 + kstep; const char* b3 = b2 + kstep;
            if constexpr (GATHER) { if (t == 0 && has_next) PG8_GTAB_DMA(nxt, (ui + 1) & 1); }
            PG8_LDB(B0, 0, 0); PG8_LDB(B1, 0, 1); PG8_SCHED; PG8_LDA(At, 0, 0); PG8_STAGE_A(PG8_SA(1, 1), a1, 1);
            PG8_WAIT_V(8); PG8_WAIT_L(0); PG8_BAR; PG8_MMA(0, 0, At, B0); PG8_MMA(0, 1, At, B1); PG8_BAR; PG8_SCHED;
            if constexpr (GATHER) { if (last && has_next) PG8_GOFFS(nxt, (ui + 1) & 1); }
            PG8_LDA(At, 0, 1); PG8_STAGE_B(PG8_SB(0, 0), b2); PG8_STAGE_B(PG8_SB(0, 1), b2 + hstep); PG8_STAGE_A(PG8_SA(0, 0), a2, 0);
            PG8_WAIT_V(8); PG8_WAIT_L(0); PG8_BAR; PG8_MMA(1, 0, At, B0); PG8_MMA(1, 1, At, B1); PG8_BAR; PG8_SCHED;
            PG8_LDB(B0, 1, 0); PG8_LDB(B1, 1, 1); PG8_SCHED; PG8_LDA(At, 1, 0); PG8_STAGE_A(PG8_SA(0, 1), a2, 1);
            PG8_WAIT_V(8); PG8_WAIT_L(0); PG8_BAR; PG8_MMA(0, 0, At, B0); PG8_MMA(0, 1, At, B1); PG8_BAR; PG8_SCHED;
            PG8_LDA(At, 1, 1); PG8_STAGE_B(PG8_SB(1, 0), b3); PG8_STAGE_B(PG8_SB(1, 1), b3 + hstep); PG8_STAGE_A(PG8_SA(1, 0), a3, 0);
            PG8_WAIT_V(8); PG8_WAIT_L(0); PG8_BAR; PG8_MMA(1, 0, At, B0); PG8_MMA(1, 1, At, B1); PG8_BAR; PG8_SCHED;
        }
        if (wr == 0) PG8_BAR;
        { const int l2 = lane_id_fresh(); E(acc, cur, wr, wc, l2 & 15, l2 >> 4); }
        if (!has_next) break;
#pragma unroll
        for (int a = 0; a < 2; ++a)
#pragma unroll
            for (int b = 0; b < 2; ++b)
#pragma unroll
                for (int m = 0; m < 4; ++m)
#pragma unroll
                    for (int n = 0; n < 2; ++n) acc[a][b][m][n] = (f32x4){0.f, 0.f, 0.f, 0.f};
        cur = nxt; cA = nA; cB = nB; ++ui;
        if (wr == 1) PG8_BAR;
    }
    PG8_WAIT_V(0);
    PG8_BAR;
#undef PG8_SA
#undef PG8_SB
#undef PG8_STAGE_A
#undef PG8_STAGE_B
#undef PG8_LDA
#undef PG8_LDB
#undef PG8_MMA
#undef PG8_WAIT_V
#undef PG8_WAIT_L
#undef PG8_BAR
#undef PG8_SCHED
#undef PG8_GOFFS
#undef PG8_GTAB_DMA
}

typedef f32x4 Acc[2][2][4][2];
struct EpiProj {
    static constexpr bool PERM = true;
    bf16 *PA, *PB, *PC, *PG; const float *qna, *kna, *qnc;
    __device__ __forceinline__ void operator()(const Acc& acc, const Unit& u, int wr, int wc, int fr, int fq) const {
        const int f0 = u.pn * 256 + wc * 64;
        if (f0 >= NPROJ) return;
        bf16* base; int ld, c0, op; const float* gain = qna; float scale = 1.f;
        if (f0 < 1152) { base = PA; ld = LD_PA; c0 = f0; if (f0 < 384) { op = 1; gain = qna; scale = 0.125f; } else if (f0 < 768) { op = 1; gain = kna; } else op = 0; }
        else if (f0 < 2432) { base = PB; ld = LD_PB; c0 = f0 - 1152; if (c0 < 256) { op = 2; scale = 0.125f; } else if (c0 < 896) op = 0; else op = 2; }
        else if (f0 < 2688) { base = PC; ld = LD_PC; c0 = f0 - 2432; op = 1; gain = qnc; scale = 0.125f; }
        else { base = PG; ld = LD_PG; c0 = f0 - 2688; op = 3; }
        f32x4 g[2][2];
#pragma unroll
        for (int bj = 0; bj < 2; ++bj)
#pragma unroll
            for (int n = 0; n < 2; ++n) g[bj][n] = (op == 1) ? *(const f32x4*)(gain + 32 * bj + 8 * fq + 4 * n) * scale : (f32x4){scale, scale, scale, scale};
#pragma unroll
        for (int ai = 0; ai < 2; ++ai)
#pragma unroll
            for (int m = 0; m < 4; ++m) {
                const int row = u.pm * BM + ai * HALF + wr * 64 + m * 16 + fr;
                f32x4 v[2][2];
#pragma unroll
                for (int bj = 0; bj < 2; ++bj)
#pragma unroll
                    for (int n = 0; n < 2; ++n) v[bj][n] = acc[ai][bj][m][n];
                if (op == 1) {
                    float ss = 0.f;
#pragma unroll
                    for (int bj = 0; bj < 2; ++bj)
#pragma unroll
                        for (int n = 0; n < 2; ++n) ss += (v[bj][n][0] * v[bj][n][0] + v[bj][n][1] * v[bj][n][1]) + (v[bj][n][2] * v[bj][n][2] + v[bj][n][3] * v[bj][n][3]);
                    ss += __shfl_xor(ss, 16); ss += __shfl_xor(ss, 32);
                    const float r = rsqrtf(ss * (1.0f / 64.0f) + EPS);
#pragma unroll
                    for (int bj = 0; bj < 2; ++bj)
#pragma unroll
                        for (int n = 0; n < 2; ++n) v[bj][n] = v[bj][n] * r * g[bj][n];
                } else if (op == 2) {
#pragma unroll
                    for (int bj = 0; bj < 2; ++bj)
#pragma unroll
                        for (int n = 0; n < 2; ++n)
#pragma unroll
                            for (int j = 0; j < 4; ++j) v[bj][n][j] = v[bj][n][j] * sigmoidf_(v[bj][n][j]) * scale;
                } else if (op == 3) {
#pragma unroll
                    for (int bj = 0; bj < 2; ++bj)
#pragma unroll
                        for (int n = 0; n < 2; ++n)
#pragma unroll
                            for (int j = 0; j < 4; ++j) v[bj][n][j] = sigmoidf_(v[bj][n][j]);
                }
                bf16* rowp = base + (size_t)row * ld + c0 + 8 * fq;
#pragma unroll
                for (int bj = 0; bj < 2; ++bj) { v4u w; w.x = cvt_pk_bf16(v[bj][0][0], v[bj][0][1]); w.y = cvt_pk_bf16(v[bj][0][2], v[bj][0][3]); w.z = cvt_pk_bf16(v[bj][1][0], v[bj][1][1]); w.w = cvt_pk_bf16(v[bj][1][2], v[bj][1][3]);
                    *(v4u*)(rowp + 32 * bj) = w; }
            }
    }
};
struct EpiMemKV {
    static constexpr bool PERM = true;
    bf16 *MK, *MV; const float* knc;
    __device__ __forceinline__ void operator()(const Acc& acc, const Unit& u, int wr, int wc, int fr, int fq) const {
        bf16* base = u.pn == 0 ? MK : MV; const bool nrm = (u.pn == 0);
        f32x4 g[2][2];
#pragma unroll
        for (int bj = 0; bj < 2; ++bj)
#pragma unroll
            for (int n = 0; n < 2; ++n) g[bj][n] = *(const f32x4*)(knc + 32 * bj + 8 * fq + 4 * n);
#pragma unroll
        for (int ai = 0; ai < 2; ++ai)
#pragma unroll
            for (int m = 0; m < 4; ++m) {
                const int row = u.pm * BM + ai * HALF + wr * 64 + m * 16 + fr;
                f32x4 v[2][2];
#pragma unroll
                for (int bj = 0; bj < 2; ++bj)
#pragma unroll
                    for (int n = 0; n < 2; ++n) v[bj][n] = acc[ai][bj][m][n];
                if (nrm) {
                    float ss = 0.f;
#pragma unroll
                    for (int bj = 0; bj < 2; ++bj)
#pragma unroll
                        for (int n = 0; n < 2; ++n) ss += (v[bj][n][0] * v[bj][n][0] + v[bj][n][1] * v[bj][n][1]) + (v[bj][n][2] * v[bj][n][2] + v[bj][n][3] * v[bj][n][3]);
                    ss += __shfl_xor(ss, 16); ss += __shfl_xor(ss, 32);
                    const float r = rsqrtf(ss * (1.0f / 64.0f) + EPS);
#pragma unroll
                    for (int bj = 0; bj < 2; ++bj)
#pragma unroll
                        for (int n = 0; n < 2; ++n) v[bj][n] = v[bj][n] * r * g[bj][n];
                }
                bf16* rowp = base + (size_t)row * 256 + wc * 64 + 8 * fq;
#pragma unroll
                for (int bj = 0; bj < 2; ++bj) { v4u w; w.x = cvt_pk_bf16(v[bj][0][0], v[bj][0][1]); w.y = cvt_pk_bf16(v[bj][0][2], v[bj][0][3]); w.z = cvt_pk_bf16(v[bj][1][0], v[bj][1][1]); w.w = cvt_pk_bf16(v[bj][1][2], v[bj][1][3]);
                    *(v4u*)(rowp + 32 * bj) = w; }
            }
    }
};
template <int PASS> struct EpiMerge {
    static constexpr bool PERM = true;
    const bf16* PG; bf16* MX;
    __device__ __forceinline__ void operator()(const Acc& acc, const Unit& u, int wr, int wc, int fr, int fq) const {
#pragma unroll
        for (int ai = 0; ai < 2; ++ai)
#pragma unroll
            for (int m = 0; m < 4; ++m) {
                const int row = u.pm * BM + ai * HALF + wr * 64 + m * 16 + fr;
#pragma unroll
                for (int bj = 0; bj < 2; ++bj) {
                    const int c = u.pn * BM + bj * HALF + wc * 32 + 8 * fq;
                    const v4u gw = *(const v4u*)(PG + (size_t)row * LD_PG + PASS * 1024 + c);
                    bf16* mp = MX + (size_t)row * 1024 + c;
                    v4u pw = (v4u){0u, 0u, 0u, 0u}; if (PASS > 0) pw = *(const v4u*)mp;
                    const f32x4 a0 = acc[ai][bj][m][0], a1 = acc[ai][bj][m][1];
                    float o[8];
                    o[0] = bf_lo(pw.x) + bf_lo(gw.x) * a0[0]; o[1] = bf_hi(pw.x) + bf_hi(gw.x) * a0[1]; o[2] = bf_lo(pw.y) + bf_lo(gw.y) * a0[2]; o[3] = bf_hi(pw.y) + bf_hi(gw.y) * a0[3];
                    o[4] = bf_lo(pw.z) + bf_lo(gw.z) * a1[0]; o[5] = bf_hi(pw.z) + bf_hi(gw.z) * a1[1]; o[6] = bf_lo(pw.w) + bf_lo(gw.w) * a1[2]; o[7] = bf_hi(pw.w) + bf_hi(gw.w) * a1[3];
                    v4u w; w.x = cvt_pk_bf16(o[0], o[1]); w.y = cvt_pk_bf16(o[2], o[3]); w.z = cvt_pk_bf16(o[4], o[5]); w.w = cvt_pk_bf16(o[6], o[7]);
                    *(v4u*)mp = w;
                }
                asm volatile("" ::: "memory");
            }
    }
};
struct EpiOut {
    static constexpr bool PERM = false;
    const float* X; float* O;
    __device__ __forceinline__ void operator()(const Acc& acc, const Unit& u, int wr, int wc, int fr, int fq) const {
#pragma unroll
        for (int ai = 0; ai < 2; ++ai)
#pragma unroll
            for (int m = 0; m < 4; ++m) {
                const size_t off = (size_t)(u.pm * BM + ai * HALF + wr * 64 + m * 16 + fr) * 1024 + u.pn * BM + wc * 32 + 4 * fq;
#pragma unroll
                for (int bj = 0; bj < 2; ++bj)
#pragma unroll
                    for (int n = 0; n < 2; ++n) { const f32x4 xv = *(const f32x4*)(X + off + bj * HALF + n * 16); *(f32x4*)(O + off + bj * HALF + n * 16) = xv + acc[ai][bj][m][n]; }
            }
    }
};
struct EpiUp {
    static constexpr bool PERM = true;
    bf16* HID;
    __device__ __forceinline__ void operator()(const Acc& acc, const Unit& u, int wr, int wc, int fr, int fq) const {
#pragma unroll
        for (int ai = 0; ai < 2; ++ai)
#pragma unroll
            for (int m = 0; m < 4; ++m) {
                const size_t row = (size_t)u.pm * BM + ai * HALF + wr * 64 + m * 16 + fr;
                float o[8];
#pragma unroll
                for (int n = 0; n < 2; ++n)
#pragma unroll
                    for (int j = 0; j < 4; ++j) { const float gt = acc[ai][0][m][n][j], up = acc[ai][1][m][n][j]; o[4 * n + j] = gt * sigmoidf_(gt) * up; }
                v4u w; w.x = cvt_pk_bf16(o[0], o[1]); w.y = cvt_pk_bf16(o[2], o[3]); w.z = cvt_pk_bf16(o[4], o[5]); w.w = cvt_pk_bf16(o[6], o[7]);
                *(v4u*)(HID + row * 256 + u.pn * 128 + wc * 32 + 8 * fq) = w;
            }
    }
};
struct EpiDown {
    static constexpr bool PERM = true;
    const int* slot; const float* wflat; bf16* YB; float* OUT; int half;
    __device__ __forceinline__ void operator()(const Acc& acc, const Unit& u, int wr, int wc, int fr, int fq) const {
        const int e = u.seg % NSEGH;
#pragma unroll
        for (int ai = 0; ai < 2; ++ai)
#pragma unroll
            for (int m = 0; m < 4; ++m) {
                const int r = ai * HALF + wr * 64 + m * 16 + fr;
                if (r < u.rows) {
                    const int flat = slot[(size_t)u.seg * SLOT_CAP + u.j * 256 + r];
                    if (e < NEXP) {
                        const float w = wflat[flat];
                        bf16* rowp = YB + (size_t)(flat - half * (HALF_T * 8)) * 1024 + u.pn * BM + wc * 32 + 8 * fq;
#pragma unroll
                        for (int bj = 0; bj < 2; ++bj) { const f32x4 a0 = acc[ai][bj][m][0] * w, a1 = acc[ai][bj][m][1] * w;
                            v4u o; o.x = cvt_pk_bf16(a0[0], a0[1]); o.y = cvt_pk_bf16(a0[2], a0[3]); o.z = cvt_pk_bf16(a1[0], a1[1]); o.w = cvt_pk_bf16(a1[2], a1[3]);
                            *(v4u*)(rowp + bj * HALF) = o; }
                    } else {
                        float* rowp = OUT + (size_t)(flat >> 3) * 1024 + u.pn * BM + wc * 32 + 8 * fq;
#pragma unroll
                        for (int bj = 0; bj < 2; ++bj)
#pragma unroll
                            for (int n = 0; n < 2; ++n) { f32x4* p = (f32x4*)(rowp + bj * HALF + 4 * n); *p = *p + acc[ai][bj][m][n]; }
                    }
                }
                asm volatile("" ::: "memory");
            }
    }
};
}

__device__ __forceinline__ const float* arg_in(int i) {
    const __attribute__((address_space(4))) char* kp = (const __attribute__((address_space(4))) char*)__builtin_amdgcn_kernarg_segment_ptr();
    asm volatile("" : "+s"(kp));
    return *(const float* const __attribute__((address_space(4)))*)(kp + 8 * i);
}
struct Frame {
    LAS unsigned char* lds;
    int wave, vcu, G;
    unsigned char* ws; unsigned char* dout;
};
enum { I_X = 0, I_MEM, I_ANG, I_WIN, I_QNA, I_KNA, I_RELB, I_LBL, I_ONB, I_MNG, I_WMKV, I_QNC, I_KNC, I_WBA, I_WBB, I_WBC, I_WOUT, I_FNG, I_WR, I_RB, I_WEU, I_WED, I_WSU, I_WSD };

__device__ __forceinline__ void tr_item(const float* W, int ldw, int k0, int n0s, bf16* WT, int K, int n0d, LAS float* scr, int lane) {
#pragma unroll 8
    for (int i = 0; i < 32; ++i) { const int kk = 2 * i + (lane >> 5); scr[kk * 33 + (lane & 31)] = (n0s >= 0) ? W[(size_t)(k0 + kk) * ldw + n0s + (lane & 31)] : 0.f; }
    LDS_WAIT(); asm volatile("" ::: "memory");
    const int c = lane & 7;
#pragma unroll
    for (int j = 0; j < 4; ++j) { const int n = (lane >> 3) + 8 * j; const LAS float* s = scr + (8 * c) * 33 + n;
        v4u o; o.x = cvt_pk_bf16(s[0 * 33], s[1 * 33]); o.y = cvt_pk_bf16(s[2 * 33], s[3 * 33]); o.z = cvt_pk_bf16(s[4 * 33], s[5 * 33]); o.w = cvt_pk_bf16(s[6 * 33], s[7 * 33]);
        *(v4u*)(WT + (size_t)(n0d + n) * K + k0 + 8 * c) = o; }
    LDS_WAIT(); asm volatile("" ::: "memory");
}
__device__ __forceinline__ void rms_row_to_bf16(const float* xrow, const float* g, bf16* orow, int lane) {
    const f32x4* xr = (const f32x4*)xrow + lane; const f32x4* gr = (const f32x4*)g + lane;
    f32x4 v[4]; float s = 0.f;
#pragma unroll
    for (int j = 0; j < 4; ++j) { v[j] = xr[64 * j]; s += (v[j][0] * v[j][0] + v[j][1] * v[j][1]) + (v[j][2] * v[j][2] + v[j][3] * v[j][3]); }
    const float rstd = rsqrtf(wave_sum(s) * (1.f / D) + EPS);
    v2u* o8 = (v2u*)orow + lane;
#pragma unroll
    for (int j = 0; j < 4; ++j) { const f32x4 gg = gr[64 * j]; v2u w; w.x = cvt_pk_bf16(v[j][0] * rstd * gg[0], v[j][1] * rstd * gg[1]); w.y = cvt_pk_bf16(v[j][2] * rstd * gg[2], v[j][3] * rstd * gg[3]); o8[64 * j] = w; }
}
__device__ __forceinline__ int t5_bucket(int dist) {
    if (dist < 16) return dist;
    const int large = 16 + (int)(logf((float)dist / 16.0f) / 4.852030263919617f * 16.0f);
    return large < 31 ? large : 31;
}
__device__ __forceinline__ void p0_prologue(Frame& F) {
    const int lane = lane_id_fresh(); const int tid = F.wave * 64 + lane; (void)tid;
    LAS float* scr = (LAS float*)(F.lds + F.wave * 16384);
    const int gw = F.vcu * 8 + F.wave, NGW = F.G * 8;
    constexpr int I0 = 16 * 184, I1 = 16 * 16, I2 = 6 * 32, I3 = 6 * 32, I4 = 4 * 32, I5 = 16 * 32, I6 = 65 * 256, I7 = 65 * 128;
    constexpr int NITEMS = I0 + I1 + I2 + I3 + I4 + I5 + I6 + I7;
    for (int it = gw; it < NITEMS; it += NGW) {
        int r = it;
        if (r < I0 + I1) {
            const bool first = r < I0; if (!first) r -= I0;
            const int nblk = first ? 184 : 16, nsrc = first ? NPROJ : 512;
            const int kb = r / nblk, nbd = r % nblk, tile = nbd >> 3, within = nbd & 7, bj = within >> 2, wc = within & 3;
            const int srcb = tile * 8 + 2 * wc + bj;
            const int n0s = (srcb * 32 < nsrc) ? srcb * 32 : -1;
            tr_item(first ? arg_in(I_WIN) : arg_in(I_WMKV), nsrc, kb * 64, n0s, (bf16*)(F.ws + (first ? WS_WIN : WS_WMEM)), 1024, nbd * 32, scr, lane);
            continue;
        }
        r -= I0 + I1;
        if (r < I2) { tr_item(arg_in(I_WBA), 1024, (r / 32) * 64, (r % 32) * 32, (bf16*)(F.ws + WS_WA), 384, (r % 32) * 32, scr, lane); continue; } r -= I2;
        if (r < I3) { tr_item(arg_in(I_WBB), 1024, (r / 32) * 64, (r % 32) * 32, (bf16*)(F.ws + WS_WB), 384, (r % 32) * 32, scr, lane); continue; } r -= I3;
        if (r < I4) { tr_item(arg_in(I_WBC), 1024, (r / 32) * 64, (r % 32) * 32, (bf16*)(F.ws + WS_WC), 256, (r % 32) * 32, scr, lane); continue; } r -= I4;
        if (r < I5) { tr_item(arg_in(I_WOUT), 1024, (r / 32) * 64, (r % 32) * 32, (bf16*)(F.ws + WS_WOUT), 1024, (r % 32) * 32, scr, lane); continue; } r -= I5;
        if (r < I6) {
            const int e = r / 256, q = r % 256, kb = q / 16, nbd = q % 16, pn = nbd >> 3, within = nbd & 7, bj = within >> 2, qq = within & 3;
            const int srcb = bj * 8 + pn * 4 + qq;
            const float* W = (e < 64) ? arg_in(I_WEU) + (size_t)e * 1024 * 512 : arg_in(I_WSU);
            tr_item(W, 512, kb * 64, srcb * 32, (bf16*)(F.ws + WS_WUP) + (size_t)e * 512 * 1024, 1024, nbd * 32, scr, lane);
            continue;
        }
        r -= I6;
        {   const int e = r / 128, q = r % 128, kb = q / 32, nb = q % 32;
            const float* W = (e < 64) ? arg_in(I_WED) + (size_t)e * 256 * 1024 : arg_in(I_WSD);
            tr_item(W, 1024, kb * 64, nb * 32, (bf16*)(F.ws + WS_WDN) + (size_t)e * 1024 * 256, 256, nb * 32, scr, lane); }
    }
    for (int m = gw; m < T; m += NGW) rms_row_to_bf16(arg_in(I_X) + (size_t)m * D, arg_in(I_ANG), (bf16*)F.dout + (size_t)m * D, lane);
    for (int m = gw; m < NB * MEML; m += NGW) rms_row_to_bf16(arg_in(I_MEM) + (size_t)m * D, arg_in(I_MNG), (bf16*)(F.ws + WS_MEMN) + (size_t)m * D, lane);
    if (F.vcu == 0) {
        float* tab = (float*)(F.ws + WS_TAB);
        for (int i = tid; i < 3 * 129 * 6; i += 512) { const int h = i % 6, st = (i / 6) % 129, p = i / (6 * 129); tab[i] = arg_in(I_RELB)[t5_bucket(st << (2 * p)) * 6 + h]; }
        if (tid < 256) { const float a0 = arg_in(I_LBL)[tid], a1 = arg_in(I_LBL)[256 + tid]; tab[4096 + tid] = 1.0f / (1.0f + __expf(a1 - a0)); }
    }
}

template <int NR, class EntF>
__device__ __forceinline__ void attn_wave_simple(const bf16* qrow, const char* KB, const char* VB, const EntF& ent, bf16* orow, LAS float* wscr, int lane) {
    float q[64];
    { const v4u* qp = (const v4u*)qrow;
#pragma unroll
      for (int i = 0; i < 8; ++i) { const v4u w = qp[i]; q[8 * i + 0] = bf_lo(w.x); q[8 * i + 1] = bf_hi(w.x); q[8 * i + 2] = bf_lo(w.y); q[8 * i + 3] = bf_hi(w.y); q[8 * i + 4] = bf_lo(w.z); q[8 * i + 5] = bf_hi(w.z); q[8 * i + 6] = bf_lo(w.w); q[8 * i + 7] = bf_hi(w.w); } }
    float mx = -3.0e38f;
    LAS unsigned* vscr = (LAS unsigned*)(wscr + NR * 64);
#pragma unroll 1
    for (int r = 0; r < NR; ++r) {
        unsigned koff = 0, voff = 0; float bias = 0.f;
        const bool valid = ent(r * 64 + lane, koff, voff, bias);
        const v4u* kp = (const v4u*)(KB + koff);
        float d0 = 0.f, d1 = 0.f;
#pragma unroll
        for (int i = 0; i < 8; ++i) { const v4u w = kp[i];
            d0 += q[8 * i + 0] * bf_lo(w.x) + q[8 * i + 2] * bf_lo(w.y) + q[8 * i + 4] * bf_lo(w.z) + q[8 * i + 6] * bf_lo(w.w);
            d1 += q[8 * i + 1] * bf_hi(w.x) + q[8 * i + 3] * bf_hi(w.y) + q[8 * i + 5] * bf_hi(w.z) + q[8 * i + 7] * bf_hi(w.w); }
        const float sv = valid ? (d0 + d1 + bias) : -3.0e38f; wscr[r * 64 + lane] = sv; vscr[r * 64 + lane] = voff; mx = fmaxf(mx, sv);
    }
    mx = wave_max(mx);
    float l = 0.f;
#pragma unroll 1
    for (int r = 0; r < NR; ++r) { const float sv = wscr[r * 64 + lane]; const float p = (sv > -1.0e38f) ? __expf(sv - mx) : 0.f; l += p; wscr[r * 64 + lane] = p; }
    l = wave_sum(l);
    LDS_WAIT(); asm volatile("" ::: "memory");
    const int sub = lane >> 4, dg = lane & 15;
    float o0 = 0.f, o1 = 0.f, o2 = 0.f, o3 = 0.f;
    for (int i = 0; i < NR * 16; ++i) {
        const int e = 4 * i + sub; const float p = wscr[e]; const unsigned voff = vscr[e];
        const v2u w = *(const v2u*)(VB + voff + dg * 8);
        o0 += p * bf_lo(w.x); o1 += p * bf_hi(w.x); o2 += p * bf_lo(w.y); o3 += p * bf_hi(w.y);
    }
    o0 += __shfl_xor(o0, 16); o1 += __shfl_xor(o1, 16); o2 += __shfl_xor(o2, 16); o3 += __shfl_xor(o3, 16);
    o0 += __shfl_xor(o0, 32); o1 += __shfl_xor(o1, 32); o2 += __shfl_xor(o2, 32); o3 += __shfl_xor(o3, 32);
    const float inv = 1.0f / l;
    if (lane < 16) { v2u w; w.x = cvt_pk_bf16(o0 * inv, o1 * inv); w.y = cvt_pk_bf16(o2 * inv, o3 * inv); *(v2u*)(orow + dg * 4) = w; }
    LDS_WAIT(); asm volatile("" ::: "memory");
}
struct EntA {
    int pos, h; unsigned rowbase; const float* btab;
    __device__ __forceinline__ bool operator()(int e, unsigned& koff, unsigned& voff, float& bias) const {
        const int p = e / 129, st = e - p * 129; const int kt = pos - (st << (2 * p));
        const bool valid = (e < 387) && (kt >= 0);
        const unsigned off = valid ? (rowbase + (unsigned)kt * (LD_PA * 2)) : rowbase;
        koff = off + (384 + h * 64) * 2; voff = off + (768 + h * 64) * 2;
        bias = valid ? btab[e * 6 + h] : 0.f; return valid;
    }
};
struct EntC {
    unsigned base;
    __device__ __forceinline__ bool operator()(int e, unsigned& koff, unsigned& voff, float& bias) const { koff = base + (unsigned)e * 512u; voff = koff; bias = 0.f; return true; }
};
__device__ __forceinline__ void p2_attn_simple(Frame& F) {
    const int lane = lane_id_fresh(); const int tid = F.wave * 64 + lane; (void)tid;
    LAS float* wscr = (LAS float*)(F.lds + F.wave * 8192);
    const int gw = F.vcu * 8 + F.wave, NGW = F.G * 8;
    const bf16* PA = (const bf16*)(F.ws + WS_PA); const bf16* PC = (const bf16*)(F.ws + WS_PC);
    const float* btab = (const float*)(F.ws + WS_TAB);
    for (int it = gw; it < T * 6; it += NGW) {
        const int t = it / 6, h = it % 6, b = t >> 11, pos = t & 2047;
        EntA ent{pos, h, (unsigned)(b * SEQ) * (unsigned)(LD_PA * 2), btab};
        attn_wave_simple<7, EntA>(PA + (size_t)t * LD_PA + h * 64, (const char*)PA, (const char*)PA, ent, (bf16*)(F.dout + DO_YA) + (size_t)t * 384 + h * 64, wscr, lane);
    }
    for (int it = gw; it < T * 4; it += NGW) {
        const int t = it >> 2, h = it & 3, b = t >> 11;
        EntC ent{(unsigned)(b * MEML) * 512u + (unsigned)h * 128u};
        attn_wave_simple<4, EntC>(PC + (size_t)t * LD_PC + h * 64, (const char*)(F.ws + WS_MEMK), (const char*)(F.ws + WS_MEMV), ent, (bf16*)(F.dout + DO_YC) + (size_t)t * 256 + h * 64, wscr, lane);
    }
}
template <bool OUTPUTS>
__device__ __forceinline__ void hgrn_simple(Frame& F) {
    const int lane = lane_id_fresh(); const int tid = F.wave * 64 + lane; (void)tid;
    const int uw = tid >> 7, col = tid & 127;
    LAS float* fL = (LAS float*)(F.lds + uw * 29184); LAS float* qL = fL + 2048; LAS float* oL = qL + 2048; LAS float* pL = oL + 3072;
    const bf16* PB = (const bf16*)(F.ws + WS_PB);
    const float* lbt = (const float*)(F.ws + WS_TAB) + 4096;
    float* LST = (float*)(F.ws + WS_LST); float* DEC = (float*)(F.ws + WS_DEC);
    for (int grp = F.vcu; grp < 1024; grp += F.G) {
        const int unit = grp * 4 + uw, b = unit >> 7, h = (unit >> 5) & 3, c = unit & 31; const int tok0 = b * SEQ + c * 64;
        float S[64]; float dprod = 1.f;
#pragma unroll
        for (int k = 0; k < 64; ++k) S[k] = 0.f;
        if (OUTPUTS && col < 96) {
            for (int cp = 0; cp < c; ++cp) { const float* dp = DEC + (size_t)(unit - c + cp) * 64; const float* lp = LST + (size_t)(unit - c + cp) * 6144 + col;
#pragma unroll
                for (int k = 0; k < 64; ++k) S[k] = dp[k] * S[k] + lp[k * 96]; }
        }
        for (int hf = 0; hf < 2; ++hf) {
            __syncthreads();
            for (int idx = col; idx < 2048; idx += 128) { const int s = idx >> 6, k = idx & 63; const size_t rb = (size_t)(tok0 + hf * 32 + s) * LD_PB;
                const float lb = lbt[h * 64 + k]; fL[idx] = lb + (1.f - lb) * sigmoidf_(bf2f(PB[rb + 256 + h * 64 + k]));
                if (OUTPUTS) qL[idx] = bf2f(PB[rb + h * 64 + k]); }
            __syncthreads();
            if (col < 96) {
                for (int s = 0; s < 32; ++s) {
                    const float v = bf2f(PB[(size_t)(tok0 + hf * 32 + s) * LD_PB + 512 + h * 96 + col]); float o = 0.f;
#pragma unroll
                    for (int k4 = 0; k4 < 16; ++k4) { const f32x4 f4 = *(const LAS f32x4*)(fL + s * 64 + 4 * k4); f32x4 q4 = (f32x4){0.f, 0.f, 0.f, 0.f}; if (OUTPUTS) q4 = *(const LAS f32x4*)(qL + s * 64 + 4 * k4);
#pragma unroll
                        for (int j = 0; j < 4; ++j) { const float fk = f4[j]; S[4 * k4 + j] = fk * S[4 * k4 + j] + (1.f - fk) * v; if (OUTPUTS) o += S[4 * k4 + j] * q4[j]; } }
                    if (OUTPUTS) oL[s * 96 + col] = o;
                }
            }
            if (!OUTPUTS && col < 64) { for (int s = 0; s < 32; ++s) dprod *= fL[s * 64 + col]; }
            if (OUTPUTS) {
                __syncthreads();
                { const int s = col & 31, part = col >> 5; float ss = 0.f;
#pragma unroll
                  for (int j = 0; j < 24; ++j) { const float x = oL[s * 96 + part * 24 + j]; ss += x * x; }
                  pL[s * 4 + part] = ss; }
                __syncthreads();
                if (col < 96) { const float gn = arg_in(I_ONB)[h * 96 + col];
                    for (int s = 0; s < 32; ++s) { const f32x4 p4 = *(const LAS f32x4*)(pL + s * 4); const float rstd = rsqrtf(((p4[0] + p4[1]) + (p4[2] + p4[3])) * (1.f / 96.f) + EPS);
                        const size_t tok = (size_t)(tok0 + hf * 32 + s); const float og = bf2f(PB[tok * LD_PB + 896 + h * 96 + col]);
                        ((bf16*)(F.dout + DO_YB))[tok * 384 + h * 96 + col] = f2bf(oL[s * 96 + col] * rstd * gn * og); } }
            }
        }
        if (!OUTPUTS) {
            if (col < 96) {
#pragma unroll
                for (int k = 0; k < 64; ++k) LST[(size_t)unit * 6144 + k * 96 + col] = S[k]; }
            if (col < 64) DEC[(size_t)unit * 64 + col] = dprod;
        }
    }
    __syncthreads();
}

__device__ __forceinline__ void p6_route(Frame& F) {
    const int lane = lane_id_fresh(); const int tid = F.wave * 64 + lane; (void)tid;
    LAS float* uL = (LAS float*)F.lds;
    LAS float* pL = (LAS float*)(F.lds + 32768);
    const float* x1 = (const float*)F.dout; bf16* U = (bf16*)(F.ws + WS_U);
    float wr_[128];
#pragma unroll
    for (int i = 0; i < 128; ++i) wr_[i] = arg_in(I_WR)[(size_t)(F.wave * 128 + i) * 64 + lane];
    const float rbias = arg_in(I_RB)[lane];
    int* slot = (int*)(F.ws + WS_SLOT); float* wflat = (float*)(F.ws + WS_WFLAT); unsigned* cntw = (unsigned*)(F.ws + WS_CTL) + CW_CNT;
    for (int i = F.vcu * 512 + tid; i < 2 * HALF_T; i += F.G * 512) { const int hf = i / HALF_T, r = i % HALF_T; slot[(size_t)(hf * NSEGH + 64) * SLOT_CAP + r] = (hf * HALF_T + r) * 8; }
    for (int t0 = F.vcu * 8; t0 < T; t0 += F.G * 8) {
        const int t = t0 + F.wave;
        {   const f32x4* xr = (const f32x4*)(x1 + (size_t)t * D) + lane; const f32x4* gr = (const f32x4*)arg_in(I_FNG) + lane;
            f32x4 v[4]; float s = 0.f;
#pragma unroll
            for (int j = 0; j < 4; ++j) { v[j] = xr[64 * j]; s += (v[j][0] * v[j][0] + v[j][1] * v[j][1]) + (v[j][2] * v[j][2] + v[j][3] * v[j][3]); }
            const float rstd = rsqrtf(wave_sum(s) * (1.f / D) + EPS);
            v2u* o8 = (v2u*)(U + (size_t)t * D) + lane;
#pragma unroll
            for (int j = 0; j < 4; ++j) { const f32x4 uu = v[j] * rstd * gr[64 * j]; *(LAS f32x4*)(uL + F.wave * 1024 + 256 * j + 4 * lane) = uu;
                v2u w; w.x = cvt_pk_bf16(uu[0], uu[1]); w.y = cvt_pk_bf16(uu[2], uu[3]); o8[64 * j] = w; } }
        __syncthreads();
#pragma unroll 1
        for (int tt = 0; tt < 8; ++tt) { float a = 0.f;
#pragma unroll
            for (int i4 = 0; i4 < 32; ++i4) { const f32x4 u4 = *(const LAS f32x4*)(uL + tt * 1024 + F.wave * 128 + 4 * i4); a += u4[0] * wr_[4 * i4] + u4[1] * wr_[4 * i4 + 1] + u4[2] * wr_[4 * i4 + 2] + u4[3] * wr_[4 * i4 + 3]; }
            pL[(tt * 8 + F.wave) * 64 + lane] = a; }
        __syncthreads();
        {   float z = 0.f;
#pragma unroll
            for (int w = 0; w < 8; ++w) z += pL[(F.wave * 8 + w) * 64 + lane];
            const float sg = sigmoidf_(z), ch = sg + rbias;
            float m1 = ch; m1 = fmaxf(m1, __shfl_xor(m1, 1)); m1 = fmaxf(m1, __shfl_xor(m1, 2)); m1 = fmaxf(m1, __shfl_xor(m1, 4));
            const unsigned long long eqm = __ballot(ch == m1); const int gbase = lane & ~7; const unsigned gm = (unsigned)(eqm >> gbase) & 0xffu; const int first = gbase + __builtin_ctz(gm);
            float m2 = (lane == first) ? -3.0e38f : ch; m2 = fmaxf(m2, __shfl_xor(m2, 1)); m2 = fmaxf(m2, __shfl_xor(m2, 2)); m2 = fmaxf(m2, __shfl_xor(m2, 4));
            const float gs = m1 + m2; const int g = lane >> 3; int grank = 0;
#pragma unroll
            for (int gg = 0; gg < 8; ++gg) { const float og = __shfl(gs, gg * 8); grank += (og > gs || (og == gs && gg < g)) ? 1 : 0; }
            const bool gsel = grank < 4; const float cm = gsel ? ch : -3.0e38f; int rank = 0;
#pragma unroll 8
            for (int e = 0; e < 64; ++e) { const float oc = __shfl(cm, e); rank += (oc > cm || (oc == cm && e < lane)) ? 1 : 0; }
            const bool sel = gsel && rank < 8;
            const float wsum = wave_sum(sel ? sg : 0.f);
            if (sel) { const int hf = t >> 15, seg = hf * NSEGH + lane, flat = t * 8 + rank;
                const unsigned pos = atomicAdd(cntw + 64 * seg, 1u);
                slot[(size_t)seg * SLOT_CAP + pos] = flat; wflat[flat] = 2.5f * sg / wsum; }
        }
    }
}
__device__ __forceinline__ void moe_load_segs(Frame& F) {
    const int lane = lane_id_fresh(); const int tid = F.wave * 64 + lane; (void)tid;
    LAS int* pre = (LAS int*)(F.lds + LDS_PRE); LAS int* cnt = pre + 132;
    __syncthreads();
    if (tid < NSEG) { const int e = tid % NSEGH; cnt[tid] = (e == 64) ? HALF_T : (int)__hip_atomic_load((unsigned*)(F.ws + WS_CTL) + CW_CNT + 64 * tid, RLX_AGENT); }
    __syncthreads();
    if (tid == 0) { int a = 0; for (int s = 0; s < NSEG; ++s) { pre[s] = a; a += (cnt[s] + 255) >> 8; } pre[NSEG] = a; }
    __syncthreads();
}
__device__ __forceinline__ void p_combine(Frame& F, int half) {
    const int lane = lane_id_fresh(); const int tid = F.wave * 64 + lane; (void)tid;
    const int gw = F.vcu * 8 + F.wave, NGW = F.G * 8; float* out = (float*)F.dout; const bf16* YB = (const bf16*)(F.ws + WS_YBUF);
    for (int tl = gw; tl < HALF_T; tl += NGW) {
        const int t = half * HALF_T + tl;
#pragma unroll
        for (int j = 0; j < 2; ++j) {
            float a[8]; { const f32x4 o0 = *(const f32x4*)(out + (size_t)t * D + j * 512 + lane * 8), o1 = *(const f32x4*)(out + (size_t)t * D + j * 512 + lane * 8 + 4);
                a[0] = o0[0]; a[1] = o0[1]; a[2] = o0[2]; a[3] = o0[3]; a[4] = o1[0]; a[5] = o1[1]; a[6] = o1[2]; a[7] = o1[3]; }
#pragma unroll
            for (int k = 0; k < 8; ++k) { const v4u w = *(const v4u*)(YB + ((size_t)tl * 8 + k) * D + j * 512 + lane * 8);
                a[0] += bf_lo(w.x); a[1] += bf_hi(w.x); a[2] += bf_lo(w.y); a[3] += bf_hi(w.y); a[4] += bf_lo(w.z); a[5] += bf_hi(w.z); a[6] += bf_lo(w.w); a[7] += bf_hi(w.w); }
            *(f32x4*)(out + (size_t)t * D + j * 512 + lane * 8) = (f32x4){a[0], a[1], a[2], a[3]}; *(f32x4*)(out + (size_t)t * D + j * 512 + lane * 8 + 4) = (f32x4){a[4], a[5], a[6], a[7]};
        }
    }
}

struct Args { const float* in[24]; float* out; unsigned char* ws; int ph_lo, ph_hi, li, pad; };
__global__ void __launch_bounds__(512, 2) mk_fwd(Args args) {
    extern __shared__ __attribute__((aligned(16))) unsigned char lds[];
    Frame F;
    F.lds = (LAS unsigned char*)lds;
    F.wave = __builtin_amdgcn_readfirstlane((int)threadIdx.x >> 6);
    F.G = gridDim.x; { const int bx = blockIdx.x; F.vcu = (F.G % 8 == 0) ? (bx % 8) * (F.G / 8) + bx / 8 : bx; }
    F.ws = args.ws; F.dout = (unsigned char*)args.out;
    volatile LAS unsigned* MISC = (volatile LAS unsigned*)(F.lds + LDS_MISC);
    if (threadIdx.x < 64) MISC[threadIdx.x] = 0u;
    __syncthreads();
    XcdBarrier bar; bar.bar = (unsigned*)(F.ws + WS_CTL) + CW_BAR; bar.x = 0; bar.st = nullptr;
    if (MK_N_LAUNCHES == 1) bar = xcd_barrier_post((unsigned*)(F.ws + WS_CTL) + CW_BAR, MISC);
    const int lo = args.ph_lo, hi = args.ph_hi;
#ifndef PH_MASK
#define PH_MASK 0xfff
#endif
#define IN(k) (((PH_MASK >> (k)) & 1) && lo <= (k) && (k) < hi)
#define SEAM(k) do { if (IN(k) && IN((k) + 1)) xcd_barrier(bar, F.wave); } while (0)
    LAS unsigned char* ring = F.lds;

    if (IN(0)) { p0_prologue(F); } SEAM(0);
    if (IN(1)) {
        { pg8::StaticOrder S; S.init(F.dout, F.ws + WS_WIN, T, NPROJ_PAD, 1024, F.G, (int)blockIdx.x);
          pg8::EpiProj E{(bf16*)(F.ws + WS_PA), (bf16*)(F.ws + WS_PB), (bf16*)(F.ws + WS_PC), (bf16*)(F.ws + WS_PG), arg_in(I_QNA), arg_in(I_KNA), arg_in(I_QNC)};
          pg8::gemm_phase<pg8::EpiProj, pg8::StaticOrder, false>(ring, 1024, S, E, F.wave); }
        { pg8::StaticOrder S; S.init(F.ws + WS_MEMN, F.ws + WS_WMEM, NB * MEML, 512, 1024, F.G, (int)((blockIdx.x + 128) % F.G));
          pg8::EpiMemKV E{(bf16*)(F.ws + WS_MEMK), (bf16*)(F.ws + WS_MEMV), arg_in(I_KNC)};
          pg8::gemm_phase<pg8::EpiMemKV, pg8::StaticOrder, false>(ring, 1024, S, E, F.wave); }
    } SEAM(1);
    if (IN(2)) { hgrn_simple<false>(F); p2_attn_simple(F); } SEAM(2);
    if (IN(3)) { hgrn_simple<true>(F); } SEAM(3);
    if (IN(4)) {
        { pg8::StaticOrder S; S.init(F.dout + DO_YA, F.ws + WS_WA, T, 1024, 384, F.G, (int)blockIdx.x); pg8::EpiMerge<0> E{(const bf16*)(F.ws + WS_PG), (bf16*)(F.ws + WS_MIXED)};
          pg8::gemm_phase<pg8::EpiMerge<0>, pg8::StaticOrder, false>(ring, 384, S, E, F.wave); }
        { pg8::StaticOrder S; S.init(F.dout + DO_YB, F.ws + WS_WB, T, 1024, 384, F.G, (int)blockIdx.x); pg8::EpiMerge<1> E{(const bf16*)(F.ws + WS_PG), (bf16*)(F.ws + WS_MIXED)};
          pg8::gemm_phase<pg8::EpiMerge<1>, pg8::StaticOrder, false>(ring, 384, S, E, F.wave); }
        { pg8::StaticOrder S; S.init(F.dout + DO_YC, F.ws + WS_WC, T, 1024, 256, F.G, (int)blockIdx.x); pg8::EpiMerge<2> E{(const bf16*)(F.ws + WS_PG), (bf16*)(F.ws + WS_MIXED)};
          pg8::gemm_phase<pg8::EpiMerge<2>, pg8::StaticOrder, false>(ring, 256, S, E, F.wave); }
    } SEAM(4);
    if (IN(5)) {
        pg8::StaticOrder S; S.init(F.ws + WS_MIXED, F.ws + WS_WOUT, T, 1024, 1024, F.G, (int)blockIdx.x); pg8::EpiOut E{arg_in(I_X), (float*)F.dout};
        pg8::gemm_phase<pg8::EpiOut, pg8::StaticOrder, false>(ring, 1024, S, E, F.wave);
    } SEAM(5);
    if (IN(6)) { p6_route(F); } SEAM(6);
    if (IN(7)) {
        moe_load_segs(F);
        pg8::MoeOrder S; S.pre = (const LAS int*)(F.lds + LDS_PRE); S.cnt = S.pre + 132; S.seg_lo = 0; S.nseg = NSEG; S.nN = 2; S.G = F.G; S.c = F.vcu;
        S.A = (const char*)(F.ws + WS_U); S.Bt = (const char*)(F.ws + WS_WUP); S.a_tstep = 0; S.b_estride = (size_t)512 * 1024 * 2; S.b_tstep = (size_t)256 * 1024 * 2; S.slot = (const int*)(F.ws + WS_SLOT); S.gather = true;
        pg8::EpiUp E{(bf16*)(F.ws + WS_HID)};
        pg8::gemm_phase<pg8::EpiUp, pg8::MoeOrder, true>(ring, 1024, S, E, F.wave);
    } SEAM(7);
#define DOWN_PHASE(hf) do { moe_load_segs(F); \
        pg8::MoeOrder S; S.pre = (const LAS int*)(F.lds + LDS_PRE); S.cnt = S.pre + 132; S.seg_lo = (hf) * NSEGH; S.nseg = NSEGH; S.nN = 4; S.G = F.G; S.c = F.vcu; \
        S.A = (const char*)(F.ws + WS_HID); S.Bt = (const char*)(F.ws + WS_WDN); S.a_tstep = (size_t)256 * 256 * 2; S.b_estride = (size_t)1024 * 256 * 2; S.b_tstep = (size_t)256 * 256 * 2; S.slot = (const int*)(F.ws + WS_SLOT); S.gather = false; \
        pg8::EpiDown E{(const int*)(F.ws + WS_SLOT), (const float*)(F.ws + WS_WFLAT), (bf16*)(F.ws + WS_YBUF), (float*)F.dout, (hf)}; \
        pg8::gemm_phase<pg8::EpiDown, pg8::MoeOrder, false>(ring, 256, S, E, F.wave); } while (0)
    if (IN(8)) { DOWN_PHASE(0); } SEAM(8);
    if (IN(9)) { p_combine(F, 0); } SEAM(9);
    if (IN(10)) { DOWN_PHASE(1); } SEAM(10);
    if (IN(11)) { p_combine(F, 1); }
#undef IN
#undef SEAM
}

extern "C" void kernel_launch(void* const* d_in, const int* in_sizes, int n_in, void* d_out, int out_size, void* d_ws, size_t ws_size, hipStream_t stream) {
    static int grid = 0;
    if (grid == 0) {
        if (n_in != 24 || out_size != T * D || ws_size < WS_END) { fprintf(stderr, "kernel_launch: unexpected shapes (n_in %d out %d ws %zu)\n", n_in, out_size, ws_size); grid = -1; return; }
        int dev = 0, cus = 0, per_cu = 0;
        if (hipGetDevice(&dev) != hipSuccess || hipDeviceGetAttribute(&cus, hipDeviceAttributeMultiprocessorCount, dev) != hipSuccess) { grid = -1; return; }
        if (hipFuncSetAttribute((const void*)mk_fwd, hipFuncAttributeMaxDynamicSharedMemorySize, LDS_BYTES) != hipSuccess) { fprintf(stderr, "kernel_launch: hipFuncSetAttribute failed\n"); grid = -1; return; }
        if (hipOccupancyMaxActiveBlocksPerMultiprocessor(&per_cu, (const void*)mk_fwd, 512, LDS_BYTES) != hipSuccess || per_cu < 1) fprintf(stderr, "kernel_launch: occupancy query says %d\n", per_cu);
        (void)hipGetLastError();
        grid = cus;
    }
    if (grid < 0) return;
    (void)hipMemsetAsync((char*)d_ws + WS_CTL, 0, CTL_ZERO_BYTES, stream);
    Args a{};
    for (int i = 0; i < 24; ++i) a.in[i] = (const float*)d_in[i];
    a.out = (float*)d_out; a.ws = (unsigned char*)d_ws;
    for (int li = 0; li < MK_N_LAUNCHES; ++li) {
        a.ph_lo = (MK_N_LAUNCHES == 1) ? 0 : li; a.ph_hi = (MK_N_LAUNCHES == 1) ? NPHASE : li + 1; a.li = li;
        hipLaunchKernelGGL(mk_fwd, dim3(grid), dim3(512), LDS_BYTES, stream, a);
    }
}
```

```cpp
#include <hip/hip_runtime.h>
#include <cstdio>
#include <cstdint>

#define GAS __attribute__((address_space(1)))
#define LAS __attribute__((address_space(3)))
typedef unsigned short bf16;
typedef unsigned v4u __attribute__((ext_vector_type(4)));
typedef unsigned v2u __attribute__((ext_vector_type(2)));
typedef float f32x4 __attribute__((ext_vector_type(4)));
typedef float f32x2 __attribute__((ext_vector_type(2)));
typedef short bf16x8 __attribute__((ext_vector_type(8)));
typedef GAS unsigned gu32;
#define RLX_AGENT __ATOMIC_RELAXED, __HIP_MEMORY_SCOPE_AGENT
#define LDS_WAIT() asm volatile("s_waitcnt lgkmcnt(0)" ::: "memory")
#define VM_WAIT() asm volatile("s_waitcnt vmcnt(0)" ::: "memory")

#ifndef MK_N_LAUNCHES
#define MK_N_LAUNCHES 1
#endif

constexpr int T = 65536, D = 1024, SEQ = 2048, NB = 32, MEML = 256;
constexpr int NPROJ = 5760, NPROJ_PAD = 5888;
constexpr int LD_PA = 1152, LD_PB = 1280, LD_PC = 256, LD_PG = 3072;
constexpr int NEXP = 64, NSEGH = 65, NSEG = 130, SLOT_CAP = 32768, HALF_T = 32768;
constexpr float EPS = 1e-6f;
constexpr int NPHASE = 12;

constexpr size_t MiB = 1u << 20;
constexpr size_t WS_CTL = 0, CTL_ZERO_BYTES = 1 * MiB;
constexpr size_t WS_TAB = 1 * MiB;
constexpr size_t WS_WIN = 2 * MiB;
constexpr size_t WS_WMEM = 14 * MiB;
constexpr size_t WS_WA = 15 * MiB;
constexpr size_t WS_WB = WS_WA + 768 * 1024;
constexpr size_t WS_WC = WS_WB + 768 * 1024;
constexpr size_t WS_WOUT = 17 * MiB;
constexpr size_t WS_WUP = 19 * MiB;
constexpr size_t WS_WDN = 84 * MiB;
constexpr size_t WS_MEMN = 117 * MiB;
constexpr size_t WS_MEMK = 133 * MiB, WS_MEMV = 137 * MiB;
constexpr size_t WS_ACT = 141 * MiB;
constexpr size_t WS_PG = WS_ACT;
constexpr size_t WS_PA = WS_PG + 384 * MiB;
constexpr size_t WS_PB = WS_PA + 144 * MiB;
constexpr size_t WS_PC = WS_PB + 160 * MiB;
constexpr size_t WS_LST = WS_PC + 32 * MiB;
constexpr size_t WS_DEC = WS_LST + 96 * MiB;
constexpr size_t WS_MIXED = WS_PA;
constexpr size_t WS_HID = WS_ACT;
constexpr size_t WS_SLOT = WS_HID + 304 * MiB;
constexpr size_t WS_WFLAT = WS_SLOT + 17 * MiB;
constexpr size_t WS_U = WS_WFLAT + 2 * MiB;
constexpr size_t WS_YBUF = WS_U;
constexpr size_t WS_END = WS_YBUF + 512 * MiB;
static_assert(WS_DEC + 1 * MiB <= 1024 * MiB && WS_END <= 1024 * MiB, "ws map");
static_assert(WS_WDN + (size_t)65 * 1024 * 256 * 2 <= WS_MEMN && WS_WUP + (size_t)65 * 512 * 1024 * 2 <= WS_WDN, "weights map");
constexpr size_t DO_YA = 0, DO_YB = 48 * MiB, DO_YC = 96 * MiB;
constexpr int CW_BAR = 4096;
constexpr int CW_CNT = 16384;

constexpr int RING_BYTES = 131072;
constexpr int LDS_GTAB = RING_BYTES;
constexpr int LDS_PRE = LDS_GTAB + 2048;
constexpr int LDS_MISC = LDS_PRE + 2048;
constexpr int LDS_BYTES = 147456;
static_assert(LDS_MISC + 256 <= LDS_BYTES, "lds map");

__device__ __forceinline__ int lane_id_fresh() { int l = __builtin_amdgcn_mbcnt_hi(0xffffffffu, __builtin_amdgcn_mbcnt_lo(0xffffffffu, 0u)); asm volatile("" : "+v"(l)); return l; }
__device__ __forceinline__ unsigned cvt_pk_bf16(float lo, float hi) { unsigned r; asm volatile("v_cvt_pk_bf16_f32 %0, %1, %2" : "=v"(r) : "v"(lo), "v"(hi)); return r; }
__device__ __forceinline__ float bf_lo(unsigned w) { return __uint_as_float(w << 16); }
__device__ __forceinline__ float bf_hi(unsigned w) { return __uint_as_float(w & 0xffff0000u); }
__device__ __forceinline__ float bf2f(bf16 b) { return __uint_as_float(((unsigned)b) << 16); }
__device__ __forceinline__ bf16 f2bf(float f) { return (bf16)(cvt_pk_bf16(f, 0.f) & 0xffffu); }
__device__ __forceinline__ float sigmoidf_(float x) { return 1.0f / (1.0f + __expf(-x)); }
__device__ __forceinline__ float wave_sum(float v) {
#pragma unroll
    for (int o = 1; o < 64; o <<= 1) v += __shfl_xor(v, o);
    return v;
}
__device__ __forceinline__ float wave_max(float v) {
#pragma unroll
    for (int o = 1; o < 64; o <<= 1) v = fmaxf(v, __shfl_xor(v, o));
    return v;
}

#define XB_TMO      128
#define XB_XCNT(j)  (256  + 64 * (j))
#define XB_XSUB(j)  (1280 + 64 * (j))
#define XB_XGEN(j)  (2304 + 64 * (j))
#define XB_TOP      3328
#define XB_TOPGEN   3392
#define XCD_BAR_WORDS 3456
#define XB_SPIN_CAP (1u << 22)
__device__ __forceinline__ unsigned xb_ld(unsigned* p)              { return __hip_atomic_load(p, __ATOMIC_RELAXED, __HIP_MEMORY_SCOPE_AGENT); }
__device__ __forceinline__ unsigned xb_add(unsigned* p, unsigned v) { return __hip_atomic_fetch_add(p, v, __ATOMIC_RELAXED, __HIP_MEMORY_SCOPE_AGENT); }
__device__ __forceinline__ unsigned xb_xcc_id() { return (unsigned)__builtin_amdgcn_s_getreg((3 << 11) | 20) & 0xFu; }
#define XB_SPIN(cond, bar) do { unsigned _sp = 0; while (cond) { __builtin_amdgcn_s_sleep(1); \
    if ((++_sp & 255u) == 0u) { if (xb_ld(&(bar)[XB_TMO])) break; if (_sp > XB_SPIN_CAP) { atomicAdd(&(bar)[XB_TMO], 1u); break; } } } } while (0)
struct XcdBarrier { unsigned* bar; unsigned x; volatile LAS unsigned* st; };
__device__ __forceinline__ XcdBarrier xcd_barrier_post(unsigned* bar, volatile LAS unsigned* st) {
    XcdBarrier b; b.bar = bar; b.x = xb_xcc_id(); b.st = st;
    if (threadIdx.x == 0) (void)xb_add(&bar[XB_XCNT(b.x)], 1u);
    return b;
}
__device__ __forceinline__ void xcd_barrier_complete(unsigned* bar, unsigned x, unsigned& nloc, unsigned& nx) {
    const unsigned G = gridDim.x * gridDim.y * gridDim.z;
    unsigned sum, cnt, mine, sp = 0u;
    for (;;) {
        sum = 0u; cnt = 0u; mine = 0u;
#pragma unroll
        for (unsigned j = 0; j < 16; ++j) { const unsigned c = xb_ld(&bar[XB_XCNT(j)]); sum += c; cnt += (c > 0u) ? 1u : 0u; mine = (j == x) ? c : mine; }
        if (sum == G) break;
        __builtin_amdgcn_s_sleep(1);
        if ((++sp & 255u) == 0u) { if (xb_ld(&bar[XB_TMO])) break; if (sp > XB_SPIN_CAP) { atomicAdd(&bar[XB_TMO], 1u); break; } }
    }
    nloc = mine > 0u ? mine : 1u; nx = cnt > 0u ? cnt : 1u;
}
__device__ __forceinline__ void xcd_barrier(const XcdBarrier& b, const int wave) {
    asm volatile("s_waitcnt vmcnt(0)" ::: "memory");
    __syncthreads();
    if (wave == 0 && lane_id_fresh() == 0) {
        unsigned* bar = b.bar;
        __builtin_amdgcn_s_waitcnt(0);
        unsigned nloc = b.st[0], nx = b.st[1];
        if (nloc == 0u) { xcd_barrier_complete(bar, b.x, nloc, nx); b.st[0] = nloc; b.st[1] = nx; }
        const unsigned old = xb_add(&bar[XB_XSUB(b.x)], 1u);
        const unsigned gen = old / nloc;
        if (old + 1u == (gen + 1u) * nloc) {
            __builtin_amdgcn_fence(__ATOMIC_RELEASE, "agent");
            asm volatile("s_waitcnt vmcnt(0)" ::: "memory");
            const unsigned og = xb_add(&bar[XB_TOP], 1u);
            const unsigned tg = og / nx;
            if (og + 1u == (tg + 1u) * nx) xb_add(&bar[XB_TOPGEN], 1u);
            else XB_SPIN(xb_ld(&bar[XB_TOPGEN]) == tg, bar);
            __builtin_amdgcn_fence(__ATOMIC_ACQUIRE, "agent");
            xb_add(&bar[XB_XGEN(b.x)], 1u);
            asm volatile("s_waitcnt vmcnt(0)" ::: "memory");
        } else {
            XB_SPIN(xb_ld(&bar[XB_XGEN(b.x)]) == gen, bar);
            __builtin_amdgcn_fence(__ATOMIC_ACQUIRE, "agent");
            asm volatile("s_waitcnt vmcnt(0)" ::: "memory");
        }
    }
    __syncthreads();
}

namespace pg8 {
constexpr int BM = 256, BK = 64, HALF = 128, HTB = HALF * BK * 2, NXCD = 8, WGM = 8;
__host__ __device__ __forceinline__ int lds_byte(int r, int c) { const int st = (r >> 4) * 2 + (c >> 5), rr = r & 15, cc = c & 31, ob = rr * 64 + cc * 2; return st * 1024 + (ob ^ (((ob >> 9) & 1) << 5)); }
__host__ __device__ __forceinline__ void stage_rc(int b, int& R, int& C) { const int st = b / 1024, sb = b % 1024, swz = sb ^ (((sb >> 9) & 1) << 5); R = (st >> 1) * 16 + swz / 64; C = (st & 1) * 32 + (swz % 64) / 2; }
__host__ __device__ __forceinline__ int perm32(int rho) { const int n = rho >> 4, i = rho & 15; return 8 * (i >> 2) + 4 * n + (i & 3); }

struct Unit { int pm, pn; const char* a; const char* b; int rows, seg, j; };

struct StaticOrder {
    int nM, nN, nwg, G, c; const char* A; const char* Bt; size_t tstep;
    __device__ void init(const void* A_, const void* Bt_, int M, int N, int K, int G_, int c_) { A = (const char*)A_; Bt = (const char*)Bt_; nM = M / BM; nN = N / BM; nwg = nM * nN; G = G_; c = c_; tstep = (size_t)BM * K * 2; }
    __device__ bool next(int i, Unit& u) const {
        const long L = (long)i * G + c; if (L >= nwg) return false;
        int wgid = (int)L; { const int q = nwg / NXCD, r = nwg % NXCD, xcd = wgid % NXCD, off = wgid / NXCD; wgid = (xcd < r ? xcd * (q + 1) : r * (q + 1) + (xcd - r) * q) + off; }
        const int nig = WGM * nN, gid = wgid / nig, fm = gid * WGM, gsz = (nM - fm) < WGM ? (nM - fm) : WGM;
        u.pm = fm + ((wgid % nig) % gsz); u.pn = (wgid % nig) / gsz; u.a = A + (size_t)u.pm * tstep; u.b = Bt + (size_t)u.pn * tstep; u.rows = 256; u.seg = 0; u.j = 0; return true;
    }
    __device__ __forceinline__ const int* tab_src(const Unit&) const { return nullptr; }
};
struct MoeOrder {
    const LAS int* pre; const LAS int* cnt; int seg_lo, nseg, nN, G, c; const char* A; const char* Bt; size_t a_tstep, b_estride, b_tstep; const int* slot; bool gather;
    __device__ bool next(int i, Unit& u) const {
        const long L = (long)i * G + c; const int b0 = __builtin_amdgcn_readfirstlane(pre[seg_lo]), total = __builtin_amdgcn_readfirstlane(pre[seg_lo + nseg]) - b0;
        const int br = (int)(L / nN); if (br >= total) return false;
        const int blk = b0 + br; u.pn = (int)(L % nN); u.pm = blk;
        int lo = seg_lo, hi = seg_lo + nseg;
        while (hi - lo > 1) { const int mid = (lo + hi) >> 1; if (__builtin_amdgcn_readfirstlane(pre[mid]) <= blk) lo = mid; else hi = mid; }
        u.seg = lo; u.j = blk - __builtin_amdgcn_readfirstlane(pre[lo]); const int rem = __builtin_amdgcn_readfirstlane(cnt[lo]) - u.j * 256; u.rows = rem < 256 ? rem : 256;
        const int e = lo % NSEGH;
        u.a = gather ? A : A + (size_t)blk * a_tstep; u.b = Bt + (size_t)e * b_estride + (size_t)u.pn * b_tstep; return true;
    }
    __device__ __forceinline__ const int* tab_src(const Unit& u) const { return slot + (size_t)u.seg * SLOT_CAP + u.j * 256; }
};

template <class Epi, class Sched, bool GATHER>
__device__ __forceinline__ void gemm_phase(LAS unsigned char* lds, const int K, const Sched& S, const Epi& E, const int wave) {
    const int lane = lane_id_fresh(), wid = wave, tid = wid * 64 + lane, wr = wid >> 2, wc = wid & 3, fr = lane & 15, fq = lane >> 4; (void)fr; (void)fq;
    const int nt = K / BK;
    unsigned voffA[2][2], voffB[2];
#pragma unroll
    for (int i = 0; i < 2; ++i) { int R, C; stage_rc(tid * 16 + i * 8192, R, C); const int Rb = Epi::PERM ? ((R & ~31) + perm32(R & 31)) : R;
        voffB[i] = (unsigned)(Rb * K + C) * 2u;
#pragma unroll
        for (int h = 0; h < 2; ++h) voffA[h][i] = (unsigned)(R * K + C) * 2u; }
    const size_t kstep = (size_t)(BK * 2);
    const size_t hstep = (size_t)HALF * K * 2;
    const unsigned ldsw = (unsigned)wid * 1024u;
    const int aoff = lds_byte(wr * 64 + fr, fq * 8), boff = lds_byte(wc * 32 + fr, fq * 8);
    const LAS int* gtab = (const LAS int*)(lds + LDS_GTAB);
#define PG8_SA(b, h) (((b) * 2 + (h)) * HTB)
#define PG8_SB(b, h) ((4 + (b) * 2 + (h)) * HTB)
#define PG8_STAGE_A(bufoff, gbase, h) do { _Pragma("unroll") for (int _i = 0; _i < 2; ++_i) \
        __builtin_amdgcn_global_load_lds((const unsigned*)((const char*)(gbase) + (GATHER ? (size_t)0 : (size_t)(h) * hstep) + voffA[GATHER ? (h) : 0][_i]), (LAS unsigned*)(lds + (bufoff) + ldsw + _i * 8192), 16, 0, 0); } while (0)
#define PG8_STAGE_B(bufoff, gbase) do { _Pragma("unroll") for (int _i = 0; _i < 2; ++_i) \
        __builtin_amdgcn_global_load_lds((const unsigned*)((const char*)(gbase) + voffB[_i]), (LAS unsigned*)(lds + (bufoff) + ldsw + _i * 8192), 16, 0, 0); } while (0)
#define PG8_LDA(dst, b, h) do { _Pragma("unroll") for (int m = 0; m < 4; ++m) _Pragma("unroll") for (int k = 0; k < 2; ++k) dst[m][k] = *(const LAS bf16x8*)(lds + PG8_SA(b, h) + aoff + m * 2048 + k * 1024); } while (0)
#define PG8_LDB(dst, b, h) do { _Pragma("unroll") for (int n = 0; n < 2; ++n) _Pragma("unroll") for (int k = 0; k < 2; ++k) dst[n][k] = *(const LAS bf16x8*)(lds + PG8_SB(b, h) + boff + n * 2048 + k * 1024); } while (0)
#define PG8_MMA(ai, bj, At, Bt) do { __builtin_amdgcn_s_setprio(1); _Pragma("unroll") for (int m = 0; m < 4; ++m) _Pragma("unroll") for (int n = 0; n < 2; ++n) _Pragma("unroll") for (int k = 0; k < 2; ++k) \
        acc[ai][bj][m][n] = __builtin_amdgcn_mfma_f32_16x16x32_bf16(Bt[n][k], At[m][k], acc[ai][bj][m][n], 0, 0, 0); __builtin_amdgcn_s_setprio(0); } while (0)
#define PG8_WAIT_V(n) asm volatile("s_waitcnt vmcnt(" #n ")" ::: "memory")
#define PG8_WAIT_L(n) asm volatile("s_waitcnt lgkmcnt(" #n ")" ::: "memory")
#define PG8_BAR __builtin_amdgcn_s_barrier()
#define PG8_SCHED __builtin_amdgcn_sched_barrier(0)
#define PG8_GOFFS(u, tb) do { _Pragma("unroll") for (int _h = 0; _h < 2; ++_h) _Pragma("unroll") for (int _i = 0; _i < 2; ++_i) { int _R, _C; stage_rc(tid * 16 + _i * 8192, _R, _C); \
        const int _rr = _h * HALF + _R; const int _v = gtab[(tb) * 256 + _rr]; const unsigned _tok = (_rr < (u).rows) ? (unsigned)(_v >> 3) : 0u; voffA[_h][_i] = _tok * (unsigned)(K * 2) + (unsigned)(_C * 2); } } while (0)
#define PG8_GTAB_DMA(u, tb) do { if (wid < 4) __builtin_amdgcn_global_load_lds((const unsigned*)(S.tab_src(u) + wid * 64 + lane), (LAS unsigned*)(lds + LDS_GTAB + (tb) * 1024 + wid * 256), 4, 0, 0); } while (0)
    Unit cur, nxt; int ui = 0;
    if (!S.next(0, cur)) return;
    f32x4 acc[2][2][4][2];
#pragma unroll
    for (int a = 0; a < 2; ++a)
#pragma unroll
        for (int b = 0; b < 2; ++b)
#pragma unroll
            for (int m = 0; m < 4; ++m)
#pragma unroll
                for (int n = 0; n < 2; ++n) acc[a][b][m][n] = (f32x4){0.f, 0.f, 0.f, 0.f};
    bf16x8 At[4][2], B0[2][2], B1[2][2];
    const char* cA = cur.a; const char* cB = cur.b;
    if constexpr (GATHER) { PG8_GTAB_DMA(cur, 0); PG8_WAIT_V(0); PG8_BAR; PG8_GOFFS(cur, 0); }
    PG8_STAGE_B(PG8_SB(0, 0), cB); PG8_STAGE_B(PG8_SB(0, 1), cB + hstep); PG8_STAGE_A(PG8_SA(0, 0), cA, 0); PG8_STAGE_A(PG8_SA(0, 1), cA, 1);
    if (wr == 1) PG8_BAR;
    PG8_WAIT_V(2); PG8_BAR;
    PG8_STAGE_B(PG8_SB(1, 0), cB + kstep); PG8_STAGE_A(PG8_SA(1, 0), cA + kstep, 0); PG8_STAGE_B(PG8_SB(1, 1), cB + hstep + kstep);
    PG8_WAIT_V(6); PG8_BAR;
    for (;;) {
        const bool has_next = S.next(ui + 1, nxt);
        const char* nA = has_next ? nxt.a : cA; const char* nB = has_next ? nxt.b : cB;
        for (int t = 0; t < nt; t += 2) {
            const bool last = (t == nt - 2);
            const char* a1 = cA + (size_t)(t + 1) * kstep;
            const char* a2 = last ? nA : cA + (size_t)(t + 2) * kstep; const char* b2 = last ? nB : cB + (size_t)(t + 2) * kstep;
            const char* a3 = a2 + kstep; const char* b3 = b2 + kstep;
            if constexpr (GATHER) { if (t == 0 && has_next) PG8_GTAB_DMA(nxt, (ui + 1) & 1); }
            PG8_LDB(B0, 0, 0); PG8_LDB(B1, 0, 1); PG8_SCHED; PG8_LDA(At, 0, 0); PG8_STAGE_A(PG8_SA(1, 1), a1, 1);
            PG8_WAIT_V(8); PG8_WAIT_L(0); PG8_BAR; PG8_MMA(0, 0, At, B0); PG8_MMA(0, 1, At, B1); PG8_BAR; PG8_SCHED;
            if constexpr (GATHER) { if (last && has_next) PG8_GOFFS(nxt, (ui + 1) & 1); }
            PG8_LDA(At, 0, 1); PG8_STAGE_B(PG8_SB(0, 0), b2); PG8_STAGE_B(PG8_SB(0, 1), b2 + hstep); PG8_STAGE_A(PG8_SA(0, 0), a2, 0);
            PG8_WAIT_V(8); PG8_WAIT_L(0); PG8_BAR; PG8_MMA(1, 0, At, B0); PG8_MMA(1, 1, At, B1); PG8_BAR; PG8_SCHED;
            PG8_LDB(B0, 1, 0); PG8_LDB(B1, 1, 1); PG8_SCHED; PG8_LDA(At, 1, 0); PG8_STAGE_A(PG8_SA(0, 1), a2, 1);
            PG8_WAIT_V(8); PG8_WAIT_L(0); PG8_BAR; PG8_MMA(0, 0, At, B0); PG8_MMA(0, 1, At, B1); PG8_BAR; PG8_SCHED;
            PG8_LDA(At, 1, 1); PG8_STAGE_B(PG8_SB(1, 0), b3); PG8_STAGE_B(PG8_SB(1, 1), b3 + hstep); PG8_STAGE_A(PG8_SA(1, 0), a3, 0);
            PG8_WAIT_V(8); PG8_WAIT_L(0); PG8_BAR; PG8_MMA(1, 0, At, B0); PG8_MMA(1, 1, At, B1); PG8_BAR; PG8_SCHED;
        }
        if (wr == 0) PG8_BAR;
        { const int l2 = lane_id_fresh(); E(acc, cur, wr, wc, l2 & 15, l2 >> 4); }
        if (!has_next) break;
#pragma unroll
        for (int a = 0; a < 2; ++a)
#pragma unroll
            for (int b = 0; b < 2; ++b)
#pragma unroll
                for (int m = 0; m < 4; ++m)
#pragma unroll
                    for (int n = 0; n < 2; ++n) acc[a][b][m][n] = (f32x4){0.f, 0.f, 0.f, 0.f};
        cur = nxt; cA = nA; cB = nB; ++ui;
        if (wr == 1) PG8_BAR;
    }
    PG8_WAIT_V(0);
    PG8_BAR;
#undef PG8_SA
#undef PG8_SB
#undef PG8_STAGE_A
#undef PG8_STAGE_B
#undef PG8_LDA
#undef PG8_LDB
#undef PG8_MMA
#undef PG8_WAIT_V
#undef PG8_WAIT_L
#undef PG8_BAR
#undef PG8_SCHED
#undef PG8_GOFFS
#undef PG8_GTAB_DMA
}

typedef f32x4 Acc[2][2][4][2];
struct EpiProj {
    static constexpr bool PERM = true;
    bf16 *PA, *PB, *PC, *PG; const float *qna, *kna, *qnc;
    __device__ __forceinline__ void operator()(const Acc& acc, const Unit& u, int wr, int wc, int fr, int fq) const {
        const int f0 = u.pn * 256 + wc * 64;
        if (f0 >= NPROJ) return;
        bf16* base; int ld, c0, op; const float* gain = qna; float scale = 1.f;
        if (f0 < 1152) { base = PA; ld = LD_PA; c0 = f0; if (f0 < 384) { op = 1; gain = qna; scale = 0.125f; } else if (f0 < 768) { op = 1; gain = kna; } else op = 0; }
        else if (f0 < 2432) { base = PB; ld = LD_PB; c0 = f0 - 1152; if (c0 < 256) { op = 2; scale = 0.125f; } else if (c0 < 896) op = 0; else op = 2; }
        else if (f0 < 2688) { base = PC; ld = LD_PC; c0 = f0 - 2432; op = 1; gain = qnc; scale = 0.125f; }
        else { base = PG; ld = LD_PG; c0 = f0 - 2688; op = 3; }
        f32x4 g[2][2];
#pragma unroll
        for (int bj = 0; bj < 2; ++bj)
#pragma unroll
            for (int n = 0; n < 2; ++n) g[bj][n] = (op == 1) ? *(const f32x4*)(gain + 32 * bj + 8 * fq + 4 * n) * scale : (f32x4){scale, scale, scale, scale};
#pragma unroll
        for (int ai = 0; ai < 2; ++ai)
#pragma unroll
            for (int m = 0; m < 4; ++m) {
                const int row = u.pm * BM + ai * HALF + wr * 64 + m * 16 + fr;
                f32x4 v[2][2];
#pragma unroll
                for (int bj = 0; bj < 2; ++bj)
#pragma unroll
                    for (int n = 0; n < 2; ++n) v[bj][n] = acc[ai][bj][m][n];
                if (op == 1) {
                    float ss = 0.f;
#pragma unroll
                    for (int bj = 0; bj < 2; ++bj)
#pragma unroll
                        for (int n = 0; n < 2; ++n) ss += (v[bj][n][0] * v[bj][n][0] + v[bj][n][1] * v[bj][n][1]) + (v[bj][n][2] * v[bj][n][2] + v[bj][n][3] * v[bj][n][3]);
                    ss += __shfl_xor(ss, 16); ss += __shfl_xor(ss, 32);
                    const float r = rsqrtf(ss * (1.0f / 64.0f) + EPS);
#pragma unroll
                    for (int bj = 0; bj < 2; ++bj)
#pragma unroll
                        for (int n = 0; n < 2; ++n) v[bj][n] = v[bj][n] * r * g[bj][n];
                } else if (op == 2) {
#pragma unroll
                    for (int bj = 0; bj < 2; ++bj)
#pragma unroll
                        for (int n = 0; n < 2; ++n)
#pragma unroll
                            for (int j = 0; j < 4; ++j) v[bj][n][j] = v[bj][n][j] * sigmoidf_(v[bj][n][j]) * scale;
                } else if (op == 3) {
#pragma unroll
                    for (int bj = 0; bj < 2; ++bj)
#pragma unroll
                        for (int n = 0; n < 2; ++n)
#pragma unroll
                            for (int j = 0; j < 4; ++j) v[bj][n][j] = sigmoidf_(v[bj][n][j]);
                }
                bf16* rowp = base + (size_t)row * ld + c0 + 8 * fq;
#pragma unroll
                for (int bj = 0; bj < 2; ++bj) { v4u w; w.x = cvt_pk_bf16(v[bj][0][0], v[bj][0][1]); w.y = cvt_pk_bf16(v[bj][0][2], v[bj][0][3]); w.z = cvt_pk_bf16(v[bj][1][0], v[bj][1][1]); w.w = cvt_pk_bf16(v[bj][1][2], v[bj][1][3]);
                    *(v4u*)(rowp + 32 * bj) = w; }
            }
    }
};
struct EpiMemKV {
    static constexpr bool PERM = true;
    bf16 *MK, *MV; const float* knc;
    __device__ __forceinline__ void operator()(const Acc& acc, const Unit& u, int wr, int wc, int fr, int fq) const {
        bf16* base = u.pn == 0 ? MK : MV; const bool nrm = (u.pn == 0);
        f32x4 g[2][2];
#pragma unroll
        for (int bj = 0; bj < 2; ++bj)
#pragma unroll
            for (int n = 0; n < 2; ++n) g[bj][n] = *(const f32x4*)(knc + 32 * bj + 8 * fq + 4 * n);
#pragma unroll
        for (int ai = 0; ai < 2; ++ai)
#pragma unroll
            for (int m = 0; m < 4; ++m) {
                const int row = u.pm * BM + ai * HALF + wr * 64 + m * 16 + fr;
                f32x4 v[2][2];
#pragma unroll
                for (int bj = 0; bj < 2; ++bj)
#pragma unroll
                    for (int n = 0; n < 2; ++n) v[bj][n] = acc[ai][bj][m][n];
                if (nrm) {
                    float ss = 0.f;
#pragma unroll
                    for (int bj = 0; bj < 2; ++bj)
#pragma unroll
                        for (int n = 0; n < 2; ++n) ss += (v[bj][n][0] * v[bj][n][0] + v[bj][n][1] * v[bj][n][1]) + (v[bj][n][2] * v[bj][n][2] + v[bj][n][3] * v[bj][n][3]);
                    ss += __shfl_xor(ss, 16); ss += __shfl_xor(ss, 32);
                    const float r = rsqrtf(ss * (1.0f / 64.0f) + EPS);
#pragma unroll
                    for (int bj = 0; bj < 2; ++bj)
#pragma unroll
                        for (int n = 0; n < 2; ++n) v[bj][n] = v[bj][n] * r * g[bj][n];
                }
                bf16* rowp = base + (size_t)row * 256 + wc * 64 + 8 * fq;
#pragma unroll
                for (int bj = 0; bj < 2; ++bj) { v4u w; w.x = cvt_pk_bf16(v[bj][0][0], v[bj][0][1]); w.y = cvt_pk_bf16(v[bj][0][2], v[bj][0][3]); w.z = cvt_pk_bf16(v[bj][1][0], v[bj][1][1]); w.w = cvt_pk_bf16(v[bj][1][2], v[bj][1][3]);
                    *(v4u*)(rowp + 32 * bj) = w; }
            }
    }
};
template <int PASS> struct EpiMerge {
    static constexpr bool PERM = true;
    const bf16* PG; bf16* MX;
    __device__ __forceinline__ void operator()(const Acc& acc, const Unit& u, int wr, int wc, int fr, int fq) const {
#pragma unroll
        for (int ai = 0; ai < 2; ++ai)
#pragma unroll
            for (int m = 0; m < 4; ++m) {
                const int row = u.pm * BM + ai * HALF + wr * 64 + m * 16 + fr;
#pragma unroll
                for (int bj = 0; bj < 2; ++bj) {
                    const int c = u.pn * BM + bj * HALF + wc * 32 + 8 * fq;
                    const v4u gw = *(const v4u*)(PG + (size_t)row * LD_PG + PASS * 1024 + c);
                    bf16* mp = MX + (size_t)row * 1024 + c;
                    v4u pw = (v4u){0u, 0u, 0u, 0u}; if (PASS > 0) pw = *(const v4u*)mp;
                    const f32x4 a0 = acc[ai][bj][m][0], a1 = acc[ai][bj][m][1];
                    float o[8];
                    o[0] = bf_lo(pw.x) + bf_lo(gw.x) * a0[0]; o[1] = bf_hi(pw.x) + bf_hi(gw.x) * a0[1]; o[2] = bf_lo(pw.y) + bf_lo(gw.y) * a0[2]; o[3] = bf_hi(pw.y) + bf_hi(gw.y) * a0[3];
                    o[4] = bf_lo(pw.z) + bf_lo(gw.z) * a1[0]; o[5] = bf_hi(pw.z) + bf_hi(gw.z) * a1[1]; o[6] = bf_lo(pw.w) + bf_lo(gw.w) * a1[2]; o[7] = bf_hi(pw.w) + bf_hi(gw.w) * a1[3];
                    v4u w; w.x = cvt_pk_bf16(o[0], o[1]); w.y = cvt_pk_bf16(o[2], o[3]); w.z = cvt_pk_bf16(o[4], o[5]); w.w = cvt_pk_bf16(o[6], o[7]);
                    *(v4u*)mp = w;
                }
                asm volatile("" ::: "memory");
            }
    }
};
struct EpiOut {
    static constexpr bool PERM = false;
    const float* X; float* O;
    __device__ __forceinline__ void operator()(const Acc& acc, const Unit& u, int wr, int wc, int fr, int fq) const {
#pragma unroll
        for (int ai = 0; ai < 2; ++ai)
#pragma unroll
            for (int m = 0; m < 4; ++m) {
                const size_t off = (size_t)(u.pm * BM + ai * HALF + wr * 64 + m * 16 + fr) * 1024 + u.pn * BM + wc * 32 + 4 * fq;
#pragma unroll
                for (int bj = 0; bj < 2; ++bj)
#pragma unroll
                    for (int n = 0; n < 2; ++n) { const f32x4 xv = *(const f32x4*)(X + off + bj * HALF + n * 16); *(f32x4*)(O + off + bj * HALF + n * 16) = xv + acc[ai][bj][m][n]; }
            }
    }
};
struct EpiUp {
    static constexpr bool PERM = true;
    bf16* HID;
    __device__ __forceinline__ void operator()(const Acc& acc, const Unit& u, int wr, int wc, int fr, int fq) const {
#pragma unroll
        for (int ai = 0; ai < 2; ++ai)
#pragma unroll
            for (int m = 0; m < 4; ++m) {
                const size_t row = (size_t)u.pm * BM + ai * HALF + wr * 64 + m * 16 + fr;
                float o[8];
#pragma unroll
                for (int n = 0; n < 2; ++n)
#pragma unroll
                    for (int j = 0; j < 4; ++j) { const float gt = acc[ai][0][m][n][j], up = acc[ai][1][m][n][j]; o[4 * n + j] = gt * sigmoidf_(gt) * up; }
                v4u w; w.x = cvt_pk_bf16(o[0], o[1]); w.y = cvt_pk_bf16(o[2], o[3]); w.z = cvt_pk_bf16(o[4], o[5]); w.w = cvt_pk_bf16(o[6], o[7]);
                *(v4u*)(HID + row * 256 + u.pn * 128 + wc * 32 + 8 * fq) = w;
            }
    }
};
struct EpiDown {
    static constexpr bool PERM = true;
    const int* slot; const float* wflat; bf16* YB; float* OUT; int half;
    __device__ __forceinline__ void operator()(const Acc& acc, const Unit& u, int wr, int wc, int fr, int fq) const {
        const int e = u.seg % NSEGH;
#pragma unroll
        for (int ai = 0; ai < 2; ++ai)
#pragma unroll
            for (int m = 0; m < 4; ++m) {
                const int r = ai * HALF + wr * 64 + m * 16 + fr;
                if (r < u.rows) {
                    const int flat = slot[(size_t)u.seg * SLOT_CAP + u.j * 256 + r];
                    if (e < NEXP) {
                        const float w = wflat[flat];
                        bf16* rowp = YB + (size_t)(flat - half * (HALF_T * 8)) * 1024 + u.pn * BM + wc * 32 + 8 * fq;
#pragma unroll
                        for (int bj = 0; bj < 2; ++bj) { const f32x4 a0 = acc[ai][bj][m][0] * w, a1 = acc[ai][bj][m][1] * w;
                            v4u o; o.x = cvt_pk_bf16(a0[0], a0[1]); o.y = cvt_pk_bf16(a0[2], a0[3]); o.z = cvt_pk_bf16(a1[0], a1[1]); o.w = cvt_pk_bf16(a1[2], a1[3]);
                            *(v4u*)(rowp + bj * HALF) = o; }
                    } else {
                        float* rowp = OUT + (size_t)(flat >> 3) * 1024 + u.pn * BM + wc * 32 + 8 * fq;
#pragma unroll
                        for (int bj = 0; bj < 2; ++bj)
#pragma unroll
                            for (int n = 0; n < 2; ++n) { f32x4* p = (f32x4*)(rowp + bj * HALF + 4 * n); *p = *p + acc[ai][bj][m][n]; }
                    }
                }
                asm volatile("" ::: "memory");
            }
    }
};
}

__device__ __forceinline__ const float* arg_in(int i) {
    const __attribute__((address_space(4))) char* kp = (const __attribute__((address_space(4))) char*)__builtin_amdgcn_kernarg_segment_ptr();
    asm volatile("" : "+s"(kp));
    return *(const float* const __attribute__((address_space(4)))*)(kp + 8 * i);
}
struct Frame {
    LAS unsigned char* lds;
    int wave, vcu, G;
    unsigned char* ws; unsigned char* dout;
};
enum { I_X = 0, I_MEM, I_ANG, I_WIN, I_QNA, I_KNA, I_RELB, I_LBL, I_ONB, I_MNG, I_WMKV, I_QNC, I_KNC, I_WBA, I_WBB, I_WBC, I_WOUT, I_FNG, I_WR, I_RB, I_WEU, I_WED, I_WSU, I_WSD };

__device__ __forceinline__ void tr_item(const float* W, int ldw, int k0, int n0s, bf16* WT, int K, int n0d, LAS float* scr, int lane) {
#pragma unroll 8
    for (int i = 0; i < 32; ++i) { const int kk = 2 * i + (lane >> 5); scr[kk * 33 + (lane & 31)] = (n0s >= 0) ? W[(size_t)(k0 + kk) * ldw + n0s + (lane & 31)] : 0.f; }
    LDS_WAIT(); asm volatile("" ::: "memory");
    const int c = lane & 7;
#pragma unroll
    for (int j = 0; j < 4; ++j) { const int n = (lane >> 3) + 8 * j; const LAS float* s = scr + (8 * c) * 33 + n;
        v4u o; o.x = cvt_pk_bf16(s[0 * 33], s[1 * 33]); o.y = cvt_pk_bf16(s[2 * 33], s[3 * 33]); o.z = cvt_pk_bf16(s[4 * 33], s[5 * 33]); o.w = cvt_pk_bf16(s[6 * 33], s[7 * 33]);
        *(v4u*)(WT + (size_t)(n0d + n) * K + k0 + 8 * c) = o; }
    LDS_WAIT(); asm volatile("" ::: "memory");
}
__device__ __forceinline__ void rms_row_to_bf16(const float* xrow, const float* g, bf16* orow, int lane) {
    const f32x4* xr = (const f32x4*)xrow + lane; const f32x4* gr = (const f32x4*)g + lane;
    f32x4 v[4]; float s = 0.f;
#pragma unroll
    for (int j = 0; j < 4; ++j) { v[j] = xr[64 * j]; s += (v[j][0] * v[j][0] + v[j][1] * v[j][1]) + (v[j][2] * v[j][2] + v[j][3] * v[j][3]); }
    const float rstd = rsqrtf(wave_sum(s) * (1.f / D) + EPS);
    v2u* o8 = (v2u*)orow + lane;
#pragma unroll
    for (int j = 0; j < 4; ++j) { const f32x4 gg = gr[64 * j]; v2u w; w.x = cvt_pk_bf16(v[j][0] * rstd * gg[0], v[j][1] * rstd * gg[1]); w.y = cvt_pk_bf16(v[j][2] * rstd * gg[2], v[j][3] * rstd * gg[3]); o8[64 * j] = w; }
}
__device__ __forceinline__ int t5_bucket(int dist) {
    if (dist < 16) return dist;
    const int large = 16 + (int)(logf((float)dist / 16.0f) / 4.852030263919617f * 16.0f);
    return large < 31 ? large : 31;
}
__device__ __forceinline__ void p0_prologue(Frame& F) {
    const int lane = lane_id_fresh(); const int tid = F.wave * 64 + lane; (void)tid;
    LAS float* scr = (LAS float*)(F.lds + F.wave * 16384);
    const int gw = F.vcu * 8 + F.wave, NGW = F.G * 8;
    constexpr int I0 = 16 * 184, I1 = 16 * 16, I2 = 6 * 32, I3 = 6 * 32, I4 = 4 * 32, I5 = 16 * 32, I6 = 65 * 256, I7 = 65 * 128;
    constexpr int NITEMS = I0 + I1 + I2 + I3 + I4 + I5 + I6 + I7;
    for (int it = gw; it < NITEMS; it += NGW) {
        int r = it;
        if (r < I0 + I1) {
            const bool first = r < I0; if (!first) r -= I0;
            const int nblk = first ? 184 : 16, nsrc = first ? NPROJ : 512;
            const int kb = r / nblk, nbd = r % nblk, tile = nbd >> 3, within = nbd & 7, bj = within >> 2, wc = within & 3;
            const int srcb = tile * 8 + 2 * wc + bj;
            const int n0s = (srcb * 32 < nsrc) ? srcb * 32 : -1;
            tr_item(first ? arg_in(I_WIN) : arg_in(I_WMKV), nsrc, kb * 64, n0s, (bf16*)(F.ws + (first ? WS_WIN : WS_WMEM)), 1024, nbd * 32, scr, lane);
            continue;
        }
        r -= I0 + I1;
        if (r < I2) { tr_item(arg_in(I_WBA), 1024, (r / 32) * 64, (r % 32) * 32, (bf16*)(F.ws + WS_WA), 384, (r % 32) * 32, scr, lane); continue; } r -= I2;
        if (r < I3) { tr_item(arg_in(I_WBB), 1024, (r / 32) * 64, (r % 32) * 32, (bf16*)(F.ws + WS_WB), 384, (r % 32) * 32, scr, lane); continue; } r -= I3;
        if (r < I4) { tr_item(arg_in(I_WBC), 1024, (r / 32) * 64, (r % 32) * 32, (bf16*)(F.ws + WS_WC), 256, (r % 32) * 32, scr, lane); continue; } r -= I4;
        if (r < I5) { tr_item(arg_in(I_WOUT), 1024, (r / 32) * 64, (r % 32) * 32, (bf16*)(F.ws + WS_WOUT), 1024, (r % 32) * 32, scr, lane); continue; } r -= I5;
        if (r < I6) {
            const int e = r / 256, q = r % 256, kb = q / 16, nbd = q % 16, pn = nbd >> 3, within = nbd & 7, bj = within >> 2, qq = within & 3;
            const int srcb = bj * 8 + pn * 4 + qq;
            const float* W = (e < 64) ? arg_in(I_WEU) + (size_t)e * 1024 * 512 : arg_in(I_WSU);
            tr_item(W, 512, kb * 64, srcb * 32, (bf16*)(F.ws + WS_WUP) + (size_t)e * 512 * 1024, 1024, nbd * 32, scr, lane);
            continue;
        }
        r -= I6;
        {   const int e = r / 128, q = r % 128, kb = q / 32, nb = q % 32;
            const float* W = (e < 64) ? arg_in(I_WED) + (size_t)e * 256 * 1024 : arg_in(I_WSD);
            tr_item(W, 1024, kb * 64, nb * 32, (bf16*)(F.ws + WS_WDN) + (size_t)e * 1024 * 256, 256, nb * 32, scr, lane); }
    }
    for (int m = gw; m < T; m += NGW) rms_row_to_bf16(arg_in(I_X) + (size_t)m * D, arg_in(I_ANG), (bf16*)F.dout + (size_t)m * D, lane);
    for (int m = gw; m < NB * MEML; m += NGW) rms_row_to_bf16(arg_in(I_MEM) + (size_t)m * D, arg_in(I_MNG), (bf16*)(F.ws + WS_MEMN) + (size_t)m * D, lane);
    if (F.vcu == 0) {
        float* tab = (float*)(F.ws + WS_TAB);
        for (int i = tid; i < 3 * 129 * 6; i += 512) { const int h = i % 6, st = (i / 6) % 129, p = i / (6 * 129); tab[i] = arg_in(I_RELB)[t5_bucket(st << (2 * p)) * 6 + h]; }
        if (tid < 256) { const float a0 = arg_in(I_LBL)[tid], a1 = arg_in(I_LBL)[256 + tid]; tab[4096 + tid] = 1.0f / (1.0f + __expf(a1 - a0)); }
    }
}

template <int NR, class EntF>
__device__ __forceinline__ void attn_wave_simple(const bf16* qrow, const char* KB, const char* VB, const EntF& ent, bf16* orow, LAS float* wscr, int lane) {
    float q[64];
    { const v4u* qp = (const v4u*)qrow;
#pragma unroll
      for (int i = 0; i < 8; ++i) { const v4u w = qp[i]; q[8 * i + 0] = bf_lo(w.x); q[8 * i + 1] = bf_hi(w.x); q[8 * i + 2] = bf_lo(w.y); q[8 * i + 3] = bf_hi(w.y); q[8 * i + 4] = bf_lo(w.z); q[8 * i + 5] = bf_hi(w.z); q[8 * i + 6] = bf_lo(w.w); q[8 * i + 7] = bf_hi(w.w); } }
    float mx = -3.0e38f;
    LAS unsigned* vscr = (LAS unsigned*)(wscr + NR * 64);
#pragma unroll 1
    for (int r = 0; r < NR; ++r) {
        unsigned koff = 0, voff = 0; float bias = 0.f;
        const bool valid = ent(r * 64 + lane, koff, voff, bias);
        const v4u* kp = (const v4u*)(KB + koff);
        float d0 = 0.f, d1 = 0.f;
#pragma unroll
        for (int i = 0; i < 8; ++i) { const v4u w = kp[i];
            d0 += q[8 * i + 0] * bf_lo(w.x) + q[8 * i + 2] * bf_lo(w.y) + q[8 * i + 4] * bf_lo(w.z) + q[8 * i + 6] * bf_lo(w.w);
            d1 += q[8 * i + 1] * bf_hi(w.x) + q[8 * i + 3] * bf_hi(w.y) + q[8 * i + 5] * bf_hi(w.z) + q[8 * i + 7] * bf_hi(w.w); }
        const float sv = valid ? (d0 + d1 + bias) : -3.0e38f; wscr[r * 64 + lane] = sv; vscr[r * 64 + lane] = voff; mx = fmaxf(mx, sv);
    }
    mx = wave_max(mx);
    float l = 0.f;
#pragma unroll 1
    for (int r = 0; r < NR; ++r) { const float sv = wscr[r * 64 + lane]; const float p = (sv > -1.0e38f) ? __expf(sv - mx) : 0.f; l += p; wscr[r * 64 + lane] = p; }
    l = wave_sum(l);
    LDS_WAIT(); asm volatile("" ::: "memory");
    const int sub = lane >> 4, dg = lane & 15;
    float o0 = 0.f, o1 = 0.f, o2 = 0.f, o3 = 0.f;
    for (int i = 0; i < NR * 16; ++i) {
        const int e = 4 * i + sub; const float p = wscr[e]; const unsigned voff = vscr[e];
        const v2u w = *(const v2u*)(VB + voff + dg * 8);
        o0 += p * bf_lo(w.x); o1 += p * bf_hi(w.x); o2 += p * bf_lo(w.y); o3 += p * bf_hi(w.y);
    }
    o0 += __shfl_xor(o0, 16); o1 += __shfl_xor(o1, 16); o2 += __shfl_xor(o2, 16); o3 += __shfl_xor(o3, 16);
    o0 += __shfl_xor(o0, 32); o1 += __shfl_xor(o1, 32); o2 += __shfl_xor(o2, 32); o3 += __shfl_xor(o3, 32);
    const float inv = 1.0f / l;
    if (lane < 16) { v2u w; w.x = cvt_pk_bf16(o0 * inv, o1 * inv); w.y = cvt_pk_bf16(o2 * inv, o3 * inv); *(v2u*)(orow + dg * 4) = w; }
    LDS_WAIT(); asm volatile("" ::: "memory");
}
struct EntA {
    int pos, h; unsigned rowbase; const float* btab;
    __device__ __forceinline__ bool operator()(int e, unsigned& koff, unsigned& voff, float& bias) const {
        const int p = e / 129, st = e - p * 129; const int kt = pos - (st << (2 * p));
        const bool valid = (e < 387) && (kt >= 0);
        const unsigned off = valid ? (rowbase + (unsigned)kt * (LD_PA * 2)) : rowbase;
        koff = off + (384 + h * 64) * 2; voff = off + (768 + h * 64) * 2;
        bias = valid ? btab[e * 6 + h] : 0.f; return valid;
    }
};
struct EntC {
    unsigned base;
    __device__ __forceinline__ bool operator()(int e, unsigned& koff, unsigned& voff, float& bias) const { koff = base + (unsigned)e * 512u; voff = koff; bias = 0.f; return true; }
};
__device__ __forceinline__ void p2_attn_simple(Frame& F) {
    const int lane = lane_id_fresh(); const int tid = F.wave * 64 + lane; (void)tid;
    LAS float* wscr = (LAS float*)(F.lds + F.wave * 8192);
    const int gw = F.vcu * 8 + F.wave, NGW = F.G * 8;
    const bf16* PA = (const bf16*)(F.ws + WS_PA); const bf16* PC = (const bf16*)(F.ws + WS_PC);
    const float* btab = (const float*)(F.ws + WS_TAB);
    for (int it = gw; it < T * 6; it += NGW) {
        const int t = it / 6, h = it % 6, b = t >> 11, pos = t & 2047;
        EntA ent{pos, h, (unsigned)(b * SEQ) * (unsigned)(LD_PA * 2), btab};
        attn_wave_simple<7, EntA>(PA + (size_t)t * LD_PA + h * 64, (const char*)PA, (const char*)PA, ent, (bf16*)(F.dout + DO_YA) + (size_t)t * 384 + h * 64, wscr, lane);
    }
    for (int it = gw; it < T * 4; it += NGW) {
        const int t = it >> 2, h = it & 3, b = t >> 11;
        EntC ent{(unsigned)(b * MEML) * 512u + (unsigned)h * 128u};
        attn_wave_simple<4, EntC>(PC + (size_t)t * LD_PC + h * 64, (const char*)(F.ws + WS_MEMK), (const char*)(F.ws + WS_MEMV), ent, (bf16*)(F.dout + DO_YC) + (size_t)t * 256 + h * 64, wscr, lane);
    }
}
template <bool OUTPUTS>
__device__ __forceinline__ void hgrn_simple(Frame& F) {
    const int lane = lane_id_fresh(); const int tid = F.wave * 64 + lane; (void)tid;
    const int uw = tid >> 7, col = tid & 127;
    LAS float* fL = (LAS float*)(F.lds + uw * 29184); LAS float* qL = fL + 2048; LAS float* oL = qL + 2048; LAS float* pL = oL + 3072;
    const bf16* PB = (const bf16*)(F.ws + WS_PB);
    const float* lbt = (const float*)(F.ws + WS_TAB) + 4096;
    float* LST = (float*)(F.ws + WS_LST); float* DEC = (float*)(F.ws + WS_DEC);
    for (int grp = F.vcu; grp < 1024; grp += F.G) {
        const int unit = grp * 4 + uw, b = unit >> 7, h = (unit >> 5) & 3, c = unit & 31; const int tok0 = b * SEQ + c * 64;
        float S[64]; float dprod = 1.f;
#pragma unroll
        for (int k = 0; k < 64; ++k) S[k] = 0.f;
        if (OUTPUTS && col < 96) {
            for (int cp = 0; cp < c; ++cp) { const float* dp = DEC + (size_t)(unit - c + cp) * 64; const float* lp = LST + (size_t)(unit - c + cp) * 6144 + col;
#pragma unroll
                for (int k = 0; k < 64; ++k) S[k] = dp[k] * S[k] + lp[k * 96]; }
        }
        for (int hf = 0; hf < 2; ++hf) {
            __syncthreads();
            for (int idx = col; idx < 2048; idx += 128) { const int s = idx >> 6, k = idx & 63; const size_t rb = (size_t)(tok0 + hf * 32 + s) * LD_PB;
                const float lb = lbt[h * 64 + k]; fL[idx] = lb + (1.f - lb) * sigmoidf_(bf2f(PB[rb + 256 + h * 64 + k]));
                if (OUTPUTS) qL[idx] = bf2f(PB[rb + h * 64 + k]); }
            __syncthreads();
            if (col < 96) {
                for (int s = 0; s < 32; ++s) {
                    const float v = bf2f(PB[(size_t)(tok0 + hf * 32 + s) * LD_PB + 512 + h * 96 + col]); float o = 0.f;
#pragma unroll
                    for (int k4 = 0; k4 < 16; ++k4) { const f32x4 f4 = *(const LAS f32x4*)(fL + s * 64 + 4 * k4); f32x4 q4 = (f32x4){0.f, 0.f, 0.f, 0.f}; if (OUTPUTS) q4 = *(const LAS f32x4*)(qL + s * 64 + 4 * k4);
#pragma unroll
                        for (int j = 0; j < 4; ++j) { const float fk = f4[j]; S[4 * k4 + j] = fk * S[4 * k4 + j] + (1.f - fk) * v; if (OUTPUTS) o += S[4 * k4 + j] * q4[j]; } }
                    if (OUTPUTS) oL[s * 96 + col] = o;
                }
            }
            if (!OUTPUTS && col < 64) { for (int s = 0; s < 32; ++s) dprod *= fL[s * 64 + col]; }
            if (OUTPUTS) {
                __syncthreads();
                { const int s = col & 31, part = col >> 5; float ss = 0.f;
#pragma unroll
                  for (int j = 0; j < 24; ++j) { const float x = oL[s * 96 + part * 24 + j]; ss += x * x; }
                  pL[s * 4 + part] = ss; }
                __syncthreads();
                if (col < 96) { const float gn = arg_in(I_ONB)[h * 96 + col];
                    for (int s = 0; s < 32; ++s) { const f32x4 p4 = *(const LAS f32x4*)(pL + s * 4); const float rstd = rsqrtf(((p4[0] + p4[1]) + (p4[2] + p4[3])) * (1.f / 96.f) + EPS);
                        const size_t tok = (size_t)(tok0 + hf * 32 + s); const float og = bf2f(PB[tok * LD_PB + 896 + h * 96 + col]);
                        ((bf16*)(F.dout + DO_YB))[tok * 384 + h * 96 + col] = f2bf(oL[s * 96 + col] * rstd * gn * og); } }
            }
        }
        if (!OUTPUTS) {
            if (col < 96) {
#pragma unroll
                for (int k = 0; k < 64; ++k) LST[(size_t)unit * 6144 + k * 96 + col] = S[k]; }
            if (col < 64) DEC[(size_t)unit * 64 + col] = dprod;
        }
    }
    __syncthreads();
}

__device__ __forceinline__ void p6_route(Frame& F) {
    const int lane = lane_id_fresh(); const int tid = F.wave * 64 + lane; (void)tid;
    LAS float* uL = (LAS float*)F.lds;
    LAS float* pL = (LAS float*)(F.lds + 32768);
    const float* x1 = (const float*)F.dout; bf16* U = (bf16*)(F.ws + WS_U);
    float wr_[128];
#pragma unroll
    for (int i = 0; i < 128; ++i) wr_[i] = arg_in(I_WR)[(size_t)(F.wave * 128 + i) * 64 + lane];
    const float rbias = arg_in(I_RB)[lane];
    int* slot = (int*)(F.ws + WS_SLOT); float* wflat = (float*)(F.ws + WS_WFLAT); unsigned* cntw = (unsigned*)(F.ws + WS_CTL) + CW_CNT;
    for (int i = F.vcu * 512 + tid; i < 2 * HALF_T; i += F.G * 512) { const int hf = i / HALF_T, r = i % HALF_T; slot[(size_t)(hf * NSEGH + 64) * SLOT_CAP + r] = (hf * HALF_T + r) * 8; }
    for (int t0 = F.vcu * 8; t0 < T; t0 += F.G * 8) {
        const int t = t0 + F.wave;
        {   const f32x4* xr = (const f32x4*)(x1 + (size_t)t * D) + lane; const f32x4* gr = (const f32x4*)arg_in(I_FNG) + lane;
            f32x4 v[4]; float s = 0.f;
#pragma unroll
            for (int j = 0; j < 4; ++j) { v[j] = xr[64 * j]; s += (v[j][0] * v[j][0] + v[j][1] * v[j][1]) + (v[j][2] * v[j][2] + v[j][3] * v[j][3]); }
            const float rstd = rsqrtf(wave_sum(s) * (1.f / D) + EPS);
            v2u* o8 = (v2u*)(U + (size_t)t * D) + lane;
#pragma unroll
            for (int j = 0; j < 4; ++j) { const f32x4 uu = v[j] * rstd * gr[64 * j]; *(LAS f32x4*)(uL + F.wave * 1024 + 256 * j + 4 * lane) = uu;
                v2u w; w.x = cvt_pk_bf16(uu[0], uu[1]); w.y = cvt_pk_bf16(uu[2], uu[3]); o8[64 * j] = w; } }
        __syncthreads();
#pragma unroll 1
        for (int tt = 0; tt < 8; ++tt) { float a = 0.f;
#pragma unroll
            for (int i4 = 0; i4 < 32; ++i4) { const f32x4 u4 = *(const LAS f32x4*)(uL + tt * 1024 + F.wave * 128 + 4 * i4); a += u4[0] * wr_[4 * i4] + u4[1] * wr_[4 * i4 + 1] + u4[2] * wr_[4 * i4 + 2] + u4[3] * wr_[4 * i4 + 3]; }
            pL[(tt * 8 + F.wave) * 64 + lane] = a; }
        __syncthreads();
        {   float z = 0.f;
#pragma unroll
            for (int w = 0; w < 8; ++w) z += pL[(F.wave * 8 + w) * 64 + lane];
            const float sg = sigmoidf_(z), ch = sg + rbias;
            float m1 = ch; m1 = fmaxf(m1, __shfl_xor(m1, 1)); m1 = fmaxf(m1, __shfl_xor(m1, 2)); m1 = fmaxf(m1, __shfl_xor(m1, 4));
            const unsigned long long eqm = __ballot(ch == m1); const int gbase = lane & ~7; const unsigned gm = (unsigned)(eqm >> gbase) & 0xffu; const int first = gbase + __builtin_ctz(gm);
            float m2 = (lane == first) ? -3.0e38f : ch; m2 = fmaxf(m2, __shfl_xor(m2, 1)); m2 = fmaxf(m2, __shfl_xor(m2, 2)); m2 = fmaxf(m2, __shfl_xor(m2, 4));
            const float gs = m1 + m2; const int g = lane >> 3; int grank = 0;
#pragma unroll
            for (int gg = 0; gg < 8; ++gg) { const float og = __shfl(gs, gg * 8); grank += (og > gs || (og == gs && gg < g)) ? 1 : 0; }
            const bool gsel = grank < 4; const float cm = gsel ? ch : -3.0e38f; int rank = 0;
#pragma unroll 8
            for (int e = 0; e < 64; ++e) { const float oc = __shfl(cm, e); rank += (oc > cm || (oc == cm && e < lane)) ? 1 : 0; }
            const bool sel = gsel && rank < 8;
            const float wsum = wave_sum(sel ? sg : 0.f);
            if (sel) { const int hf = t >> 15, seg = hf * NSEGH + lane, flat = t * 8 + rank;
                const unsigned pos = atomicAdd(cntw + 64 * seg, 1u);
                slot[(size_t)seg * SLOT_CAP + pos] = flat; wflat[flat] = 2.5f * sg / wsum; }
        }
    }
}
__device__ __forceinline__ void moe_load_segs(Frame& F) {
    const int lane = lane_id_fresh(); const int tid = F.wave * 64 + lane; (void)tid;
    LAS int* pre = (LAS int*)(F.lds + LDS_PRE); LAS int* cnt = pre + 132;
    __syncthreads();
    if (tid < NSEG) { const int e = tid % NSEGH; cnt[tid] = (e == 64) ? HALF_T : (int)__hip_atomic_load((unsigned*)(F.ws + WS_CTL) + CW_CNT + 64 * tid, RLX_AGENT); }
    __syncthreads();
    if (tid == 0) { int a = 0; for (int s = 0; s < NSEG; ++s) { pre[s] = a; a += (cnt[s] + 255) >> 8; } pre[NSEG] = a; }
    __syncthreads();
}
__device__ __forceinline__ void p_combine(Frame& F, int half) {
    const int lane = lane_id_fresh(); const int tid = F.wave * 64 + lane; (void)tid;
    const int gw = F.vcu * 8 + F.wave, NGW = F.G * 8; float* out = (float*)F.dout; const bf16* YB = (const bf16*)(F.ws + WS_YBUF);
    for (int tl = gw; tl < HALF_T; tl += NGW) {
        const int t = half * HALF_T + tl;
#pragma unroll
        for (int j = 0; j < 2; ++j) {
            float a[8]; { const f32x4 o0 = *(const f32x4*)(out + (size_t)t * D + j * 512 + lane * 8), o1 = *(const f32x4*)(out + (size_t)t * D + j * 512 + lane * 8 + 4);
                a[0] = o0[0]; a[1] = o0[1]; a[2] = o0[2]; a[3] = o0[3]; a[4] = o1[0]; a[5] = o1[1]; a[6] = o1[2]; a[7] = o1[3]; }
#pragma unroll
            for (int k = 0; k < 8; ++k) { const v4u w = *(const v4u*)(YB + ((size_t)tl * 8 + k) * D + j * 512 + lane * 8);
                a[0] += bf_lo(w.x); a[1] += bf_hi(w.x); a[2] += bf_lo(w.y); a[3] += bf_hi(w.y); a[4] += bf_lo(w.z); a[5] += bf_hi(w.z); a[6] += bf_lo(w.w); a[7] += bf_hi(w.w); }
            *(f32x4*)(out + (size_t)t * D + j * 512 + lane * 8) = (f32x4){a[0], a[1], a[2], a[3]}; *(f32x4*)(out + (size_t)t * D + j * 512 + lane * 8 + 4) = (f32x4){a[4], a[5], a[6], a[7]};
        }
    }
}

struct Args { const float* in[24]; float* out; unsigned char* ws; int ph_lo, ph_hi, li, pad; };
__global__ void __launch_bounds__(512, 2) mk_fwd(Args args) {
    extern __shared__ __attribute__((aligned(16))) unsigned char lds[];
    Frame F;
    F.lds = (LAS unsigned char*)lds;
    F.wave = __builtin_amdgcn_readfirstlane((int)threadIdx.x >> 6);
    F.G = gridDim.x; { const int bx = blockIdx.x; F.vcu = (F.G % 8 == 0) ? (bx % 8) * (F.G / 8) + bx / 8 : bx; }
    F.ws = args.ws; F.dout = (unsigned char*)args.out;
    volatile LAS unsigned* MISC = (volatile LAS unsigned*)(F.lds + LDS_MISC);
    if (threadIdx.x < 64) MISC[threadIdx.x] = 0u;
    __syncthreads();
    XcdBarrier bar; bar.bar = (unsigned*)(F.ws + WS_CTL) + CW_BAR; bar.x = 0; bar.st = nullptr;
    if (MK_N_LAUNCHES == 1) bar = xcd_barrier_post((unsigned*)(F.ws + WS_CTL) + CW_BAR, MISC);
    const int lo = args.ph_lo, hi = args.ph_hi;
#ifndef PH_MASK
#define PH_MASK 0xfff
#endif
#define IN(k) (((PH_MASK >> (k)) & 1) && lo <= (k) && (k) < hi)
#define SEAM(k) do { if (IN(k) && IN((k) + 1)) xcd_barrier(bar, F.wave); } while (0)
    LAS unsigned char* ring = F.lds;

    if (IN(0)) { p0_prologue(F); } SEAM(0);
    if (IN(1)) {
        { pg8::StaticOrder S; S.init(F.dout, F.ws + WS_WIN, T, NPROJ_PAD, 1024, F.G, (int)blockIdx.x);
          pg8::EpiProj E{(bf16*)(F.ws + WS_PA), (bf16*)(F.ws + WS_PB), (bf16*)(F.ws + WS_PC), (bf16*)(F.ws + WS_PG), arg_in(I_QNA), arg_in(I_KNA), arg_in(I_QNC)};
          pg8::gemm_phase<pg8::EpiProj, pg8::StaticOrder, false>(ring, 1024, S, E, F.wave); }
        { pg8::StaticOrder S; S.init(F.ws + WS_MEMN, F.ws + WS_WMEM, NB * MEML, 512, 1024, F.G, (int)((blockIdx.x + 128) % F.G));
          pg8::EpiMemKV E{(bf16*)(F.ws + WS_MEMK), (bf16*)(F.ws + WS_MEMV), arg_in(I_KNC)};
          pg8::gemm_phase<pg8::EpiMemKV, pg8::StaticOrder, false>(ring, 1024, S, E, F.wave); }
    } SEAM(1);
    if (IN(2)) { hgrn_simple<false>(F); p2_attn_simple(F); } SEAM(2);
    if (IN(3)) { hgrn_simple<true>(F); } SEAM(3);
    if (IN(4)) {
        { pg8::StaticOrder S; S.init(F.dout + DO_YA, F.ws + WS_WA, T, 1024, 384, F.G, (int)blockIdx.x); pg8::EpiMerge<0> E{(const bf16*)(F.ws + WS_PG), (bf16*)(F.ws + WS_MIXED)};
          pg8::gemm_phase<pg8::EpiMerge<0>, pg8::StaticOrder, false>(ring, 384, S, E, F.wave); }
        { pg8::StaticOrder S; S.init(F.dout + DO_YB, F.ws + WS_WB, T, 1024, 384, F.G, (int)blockIdx.x); pg8::EpiMerge<1> E{(const bf16*)(F.ws + WS_PG), (bf16*)(F.ws + WS_MIXED)};
          pg8::gemm_phase<pg8::EpiMerge<1>, pg8::StaticOrder, false>(ring, 384, S, E, F.wave); }
        { pg8::StaticOrder S; S.init(F.dout + DO_YC, F.ws + WS_WC, T, 1024, 256, F.G, (int)blockIdx.x); pg8::EpiMerge<2> E{(const bf16*)(F.ws + WS_PG), (bf16*)(F.ws + WS_MIXED)};
          pg8::gemm_phase<pg8::EpiMerge<2>, pg8::StaticOrder, false>(ring, 256, S, E, F.wave); }
    } SEAM(4);
    if (IN(5)) {
        pg8::StaticOrder S; S.init(F.ws + WS_MIXED, F.ws + WS_WOUT, T, 1024, 1024, F.G, (int)blockIdx.x); pg8::EpiOut E{arg_in(I_X), (float*)F.dout};
        pg8::gemm_phase<pg8::EpiOut, pg8::StaticOrder, false>(ring, 1024, S, E, F.wave);
    } SEAM(5);
    if (IN(6)) { p6_route(F); } SEAM(6);
    if (IN(7)) {
        moe_load_segs(F);
        pg8::MoeOrder S; S.pre = (const LAS int*)(F.lds + LDS_PRE); S.cnt = S.pre + 132; S.seg_lo = 0; S.nseg = NSEG; S.nN = 2; S.G = F.G; S.c = F.vcu;
        S.A = (const char*)(F.ws + WS_U); S.Bt = (const char*)(F.ws + WS_WUP); S.a_tstep = 0; S.b_estride = (size_t)512 * 1024 * 2; S.b_tstep = (size_t)256 * 1024 * 2; S.slot = (const int*)(F.ws + WS_SLOT); S.gather = true;
        pg8::EpiUp E{(bf16*)(F.ws + WS_HID)};
        pg8::gemm_phase<pg8::EpiUp, pg8::MoeOrder, true>(ring, 1024, S, E, F.wave);
    } SEAM(7);
#define DOWN_PHASE(hf) do { moe_load_segs(F); \
        pg8::MoeOrder S; S.pre = (const LAS int*)(F.lds + LDS_PRE); S.cnt = S.pre + 132; S.seg_lo = (hf) * NSEGH; S.nseg = NSEGH; S.nN = 4; S.G = F.G; S.c = F.vcu; \
        S.A = (const char*)(F.ws + WS_HID); S.Bt = (const char*)(F.ws + WS_WDN); S.a_tstep = (size_t)256 * 256 * 2; S.b_estride = (size_t)1024 * 256 * 2; S.b_tstep = (size_t)256 * 256 * 2; S.slot = (const int*)(F.ws + WS_SLOT); S.gather = false; \
        pg8::EpiDown E{(const int*)(F.ws + WS_SLOT), (const float*)(F.ws + WS_WFLAT), (bf16*)(F.ws + WS_YBUF), (float*)F.dout, (hf)}; \
        pg8::gemm_phase<pg8::EpiDown, pg8::MoeOrder, false>(ring, 256, S, E, F.wave); } while (0)
    if (IN(8)) { DOWN_PHASE(0); } SEAM(8);
    if (IN(9)) { p_combine(F, 0); } SEAM(9);
    if (IN(10)) { DOWN_PHASE(1); } SEAM(10);
    if (IN(11)) { p_combine(F, 1); }
#undef IN
#undef SEAM
}

extern "C" void kernel_launch(void* const* d_in, const int* in_sizes, int n_in, void* d_out, int out_size, void* d_ws, size_t ws_size, hipStream_t stream) {
    static int grid = 0;
    if (grid == 0) {
        if (n_in != 24 || out_size != T * D || ws_size < WS_END) { fprintf(stderr, "kernel_launch: unexpected shapes (n_in %d out %d ws %zu)\n", n_in, out_size, ws_size); grid = -1; return; }
        int dev = 0, cus = 0, per_cu = 0;
        if (hipGetDevice(&dev) != hipSuccess || hipDeviceGetAttribute(&cus, hipDeviceAttributeMultiprocessorCount, dev) != hipSuccess) { grid = -1; return; }
        if (hipFuncSetAttribute((const void*)mk_fwd, hipFuncAttributeMaxDynamicSharedMemorySize, LDS_BYTES) != hipSuccess) { fprintf(stderr, "kernel_launch: hipFuncSetAttribute failed\n"); grid = -1; return; }
        if (hipOccupancyMaxActiveBlocksPerMultiprocessor(&per_cu, (const void*)mk_fwd, 512, LDS_BYTES) != hipSuccess || per_cu < 1) fprintf(stderr, "kernel_launch: occupancy query says %d\n", per_cu);
        (void)hipGetLastError();
        grid = cus;
    }
    if (grid < 0) return;
    (void)hipMemsetAsync((char*)d_ws + WS_CTL, 0, CTL_ZERO_BYTES, stream);
    Args a{};
    for (int i = 0; i < 24; ++i) a.in[i] = (const float*)d_in[i];
    a.out = (float*)d_out; a.ws = (unsigned char*)d_ws;
    for (int li = 0; li < MK_N_LAUNCHES; ++li) {
        a.ph_lo = (MK_N_LAUNCHES == 1) ? 0 : li; a.ph_hi = (MK_N_LAUNCHES == 1) ? NPHASE : li + 1; a.li = li;
        hipLaunchKernelGGL(mk_fwd, dim3(grid), dim3(512), LDS_BYTES, stream, a);
    }
}
```

```cpp
#include <hip/hip_runtime.h>
#include <cstdio>
#include <cstdint>

#define GAS __attribute__((address_space(1)))
#define LAS __attribute__((address_space(3)))
typedef unsigned short bf16;
typedef unsigned v4u __attribute__((ext_vector_type(4)));
typedef unsigned v2u __attribute__((ext_vector_type(2)));
typedef float f32x4 __attribute__((ext_vector_type(4)));
typedef float f32x2 __attribute__((ext_vector_type(2)));
typedef short bf16x8 __attribute__((ext_vector_type(8)));
typedef GAS unsigned gu32;
#define RLX_AGENT __ATOMIC_RELAXED, __HIP_MEMORY_SCOPE_AGENT
#define LDS_WAIT() asm volatile("s_waitcnt lgkmcnt(0)" ::: "memory")
#define VM_WAIT() asm volatile("s_waitcnt vmcnt(0)" ::: "memory")

#ifndef MK_N_LAUNCHES
#define MK_N_LAUNCHES 1
#endif

constexpr int T = 65536, D = 1024, SEQ = 2048, NB = 32, MEML = 256;
constexpr int NPROJ = 5760, NPROJ_PAD = 5888;
constexpr int LD_PA = 1152, LD_PB = 1280, LD_PC = 256, LD_PG = 3072;
constexpr int NEXP = 64, NSEGH = 65, NSEG = 130, SLOT_CAP = 32768, HALF_T = 32768;
constexpr float EPS = 1e-6f;
constexpr int NPHASE = 12;

constexpr size_t MiB = 1u << 20;
constexpr size_t WS_CTL = 0, CTL_ZERO_BYTES = 1 * MiB;
constexpr size_t WS_TAB = 1 * MiB;
constexpr size_t WS_WIN = 2 * MiB;
constexpr size_t WS_WMEM = 14 * MiB;
constexpr size_t WS_WA = 15 * MiB;
constexpr size_t WS_WB = WS_WA + 768 * 1024;
constexpr size_t WS_WC = WS_WB + 768 * 1024;
constexpr size_t WS_WOUT = 17 * MiB;
constexpr size_t WS_WUP = 19 * MiB;
constexpr size_t WS_WDN = 84 * MiB;
constexpr size_t WS_MEMN = 117 * MiB;
constexpr size_t WS_MEMK = 133 * MiB, WS_MEMV = 137 * MiB;
constexpr size_t WS_ACT = 141 * MiB;
constexpr size_t WS_PG = WS_ACT;
constexpr size_t WS_PA = WS_PG + 384 * MiB;
constexpr size_t WS_PB = WS_PA + 144 * MiB;
constexpr size_t WS_PC = WS_PB + 160 * MiB;
constexpr size_t WS_LST = WS_PC + 32 * MiB;
constexpr size_t WS_DEC = WS_LST + 96 * MiB;
constexpr size_t WS_MIXED = WS_PA;
constexpr size_t WS_HID = WS_ACT;
constexpr size_t WS_SLOT = WS_HID + 304 * MiB;
constexpr size_t WS_WFLAT = WS_SLOT + 17 * MiB;
constexpr size_t WS_U = WS_WFLAT + 2 * MiB;
constexpr size_t WS_YBUF = WS_U;
constexpr size_t WS_END = WS_YBUF + 512 * MiB;
static_assert(WS_DEC + 1 * MiB <= 1024 * MiB && WS_END <= 1024 * MiB, "ws map");
static_assert(WS_WDN + (size_t)65 * 1024 * 256 * 2 <= WS_MEMN && WS_WUP + (size_t)65 * 512 * 1024 * 2 <= WS_WDN, "weights map");
constexpr size_t DO_YA = 0, DO_YB = 48 * MiB, DO_YC = 96 * MiB;
constexpr int CW_BAR = 4096;
constexpr int CW_CNT = 16384;

constexpr int RING_BYTES = 131072;
constexpr int LDS_GTAB = RING_BYTES;
constexpr int LDS_PRE = LDS_GTAB + 2048;
constexpr int LDS_BYTES = 163840;
constexpr int LDS_MISC = LDS_BYTES - 256;
static_assert(LDS_MISC + 256 <= LDS_BYTES, "lds map");

__device__ __forceinline__ int lane_id_fresh() { int l = __builtin_amdgcn_mbcnt_hi(0xffffffffu, __builtin_amdgcn_mbcnt_lo(0xffffffffu, 0u)); asm volatile("" : "+v"(l)); return l; }
__device__ __forceinline__ unsigned cvt_pk_bf16(float lo, float hi) { unsigned r; asm volatile("v_cvt_pk_bf16_f32 %0, %1, %2" : "=v"(r) : "v"(lo), "v"(hi)); return r; }
__device__ __forceinline__ float bf_lo(unsigned w) { return __uint_as_float(w << 16); }
__device__ __forceinline__ float bf_hi(unsigned w) { return __uint_as_float(w & 0xffff0000u); }
__device__ __forceinline__ float bf2f(bf16 b) { return __uint_as_float(((unsigned)b) << 16); }
__device__ __forceinline__ bf16 f2bf(float f) { return (bf16)(cvt_pk_bf16(f, 0.f) & 0xffffu); }
__device__ __forceinline__ float sigmoidf_(float x) { return 1.0f / (1.0f + __expf(-x)); }
__device__ __forceinline__ float wave_sum(float v) {
#pragma unroll
    for (int o = 1; o < 64; o <<= 1) v += __shfl_xor(v, o);
    return v;
}
__device__ __forceinline__ float wave_max(float v) {
#pragma unroll
    for (int o = 1; o < 64; o <<= 1) v = fmaxf(v, __shfl_xor(v, o));
    return v;
}

#define XB_TMO      128
#define XB_XCNT(j)  (256  + 64 * (j))
#define XB_XSUB(j)  (1280 + 64 * (j))
#define XB_XGEN(j)  (2304 + 64 * (j))
#define XB_TOP      3328
#define XB_TOPGEN   3392
#define XCD_BAR_WORDS 3456
#define XB_SPIN_CAP (1u << 22)
__device__ __forceinline__ unsigned xb_ld(unsigned* p)              { return __hip_atomic_load(p, __ATOMIC_RELAXED, __HIP_MEMORY_SCOPE_AGENT); }
__device__ __forceinline__ unsigned xb_add(unsigned* p, unsigned v) { return __hip_atomic_fetch_add(p, v, __ATOMIC_RELAXED, __HIP_MEMORY_SCOPE_AGENT); }
__device__ __forceinline__ unsigned xb_xcc_id() { return (unsigned)__builtin_amdgcn_s_getreg((3 << 11) | 20) & 0xFu; }
#define XB_SPIN(cond, bar) do { unsigned _sp = 0; while (cond) { __builtin_amdgcn_s_sleep(1); \
    if ((++_sp & 255u) == 0u) { if (xb_ld(&(bar)[XB_TMO])) break; if (_sp > XB_SPIN_CAP) { atomicAdd(&(bar)[XB_TMO], 1u); break; } } } } while (0)
struct XcdBarrier { unsigned* bar; unsigned x; volatile LAS unsigned* st; };
__device__ __forceinline__ XcdBarrier xcd_barrier_post(unsigned* bar, volatile LAS unsigned* st) {
    XcdBarrier b; b.bar = bar; b.x = xb_xcc_id(); b.st = st;
    if (threadIdx.x == 0) (void)xb_add(&bar[XB_XCNT(b.x)], 1u);
    return b;
}
__device__ __forceinline__ void xcd_barrier_complete(unsigned* bar, unsigned x, unsigned& nloc, unsigned& nx) {
    const unsigned G = gridDim.x * gridDim.y * gridDim.z;
    unsigned sum, cnt, mine, sp = 0u;
    for (;;) {
        sum = 0u; cnt = 0u; mine = 0u;
#pragma unroll
        for (unsigned j = 0; j < 16; ++j) { const unsigned c = xb_ld(&bar[XB_XCNT(j)]); sum += c; cnt += (c > 0u) ? 1u : 0u; mine = (j == x) ? c : mine; }
        if (sum == G) break;
        __builtin_amdgcn_s_sleep(1);
        if ((++sp & 255u) == 0u) { if (xb_ld(&bar[XB_TMO])) break; if (sp > XB_SPIN_CAP) { atomicAdd(&bar[XB_TMO], 1u); break; } }
    }
    nloc = mine > 0u ? mine : 1u; nx = cnt > 0u ? cnt : 1u;
}
__device__ __forceinline__ void xcd_barrier(const XcdBarrier& b, const int wave) {
    asm volatile("s_waitcnt vmcnt(0)" ::: "memory");
    __syncthreads();
    if (wave == 0 && lane_id_fresh() == 0) {
        unsigned* bar = b.bar;
        __builtin_amdgcn_s_waitcnt(0);
        unsigned nloc = b.st[0], nx = b.st[1];
        if (nloc == 0u) { xcd_barrier_complete(bar, b.x, nloc, nx); b.st[0] = nloc; b.st[1] = nx; }
        const unsigned old = xb_add(&bar[XB_XSUB(b.x)], 1u);
        const unsigned gen = old / nloc;
        if (old + 1u == (gen + 1u) * nloc) {
            __builtin_amdgcn_fence(__ATOMIC_RELEASE, "agent");
            asm volatile("s_waitcnt vmcnt(0)" ::: "memory");
            const unsigned og = xb_add(&bar[XB_TOP], 1u);
            const unsigned tg = og / nx;
            if (og + 1u == (tg + 1u) * nx) xb_add(&bar[XB_TOPGEN], 1u);
            else XB_SPIN(xb_ld(&bar[XB_TOPGEN]) == tg, bar);
            __builtin_amdgcn_fence(__ATOMIC_ACQUIRE, "agent");
            xb_add(&bar[XB_XGEN(b.x)], 1u);
            asm volatile("s_waitcnt vmcnt(0)" ::: "memory");
        } else {
            XB_SPIN(xb_ld(&bar[XB_XGEN(b.x)]) == gen, bar);
            __builtin_amdgcn_fence(__ATOMIC_ACQUIRE, "agent");
            asm volatile("s_waitcnt vmcnt(0)" ::: "memory");
        }
    }
    __syncthreads();
}

namespace pg8 {
constexpr int BM = 256, BK = 64, HALF = 128, HTB = HALF * BK * 2, NXCD = 8, WGM = 8;
__host__ __device__ __forceinline__ int lds_byte(int r, int c) { const int st = (r >> 4) * 2 + (c >> 5), rr = r & 15, cc = c & 31, ob = rr * 64 + cc * 2; return st * 1024 + (ob ^ (((ob >> 9) & 1) << 5)); }
__host__ __device__ __forceinline__ void stage_rc(int b, int& R, int& C) { const int st = b / 1024, sb = b % 1024, swz = sb ^ (((sb >> 9) & 1) << 5); R = (st >> 1) * 16 + swz / 64; C = (st & 1) * 32 + (swz % 64) / 2; }
__host__ __device__ __forceinline__ int perm32(int rho) { const int n = rho >> 4, i = rho & 15; return 8 * (i >> 2) + 4 * n + (i & 3); }

struct Unit { int pm, pn; const char* a; const char* b; int rows, seg, j; };

struct StaticOrder {
    int nM, nN, nwg, G, c; const char* A; const char* Bt; size_t tstep;
    __device__ void init(const void* A_, const void* Bt_, int M, int N, int K, int G_, int c_) { A = (const char*)A_; Bt = (const char*)Bt_; nM = M / BM; nN = N / BM; nwg = nM * nN; G = G_; c = c_; tstep = (size_t)BM * K * 2; }
    __device__ bool next(int i, Unit& u) const {
        const long L = (long)i * G + c; if (L >= nwg) return false;
        int wgid = (int)L; { const int q = nwg / NXCD, r = nwg % NXCD, xcd = wgid % NXCD, off = wgid / NXCD; wgid = (xcd < r ? xcd * (q + 1) : r * (q + 1) + (xcd - r) * q) + off; }
        const int nig = WGM * nN, gid = wgid / nig, fm = gid * WGM, gsz = (nM - fm) < WGM ? (nM - fm) : WGM;
        u.pm = fm + ((wgid % nig) % gsz); u.pn = (wgid % nig) / gsz; u.a = A + (size_t)u.pm * tstep; u.b = Bt + (size_t)u.pn * tstep; u.rows = 256; u.seg = 0; u.j = 0; return true;
    }
    __device__ __forceinline__ const int* tab_src(const Unit&) const { return nullptr; }
};
struct MoeOrder {
    const LAS int* pre; const LAS int* cnt; int seg_lo, nseg, nN, G, c; const char* A; const char* Bt; size_t a_tstep, b_estride, b_tstep; const int* slot; bool gather;
    __device__ bool next(int i, Unit& u) const {
        const long L = (long)i * G + c; const int b0 = __builtin_amdgcn_readfirstlane(pre[seg_lo]), total = __builtin_amdgcn_readfirstlane(pre[seg_lo + nseg]) - b0;
        const int br = (int)(L / nN); if (br >= total) return false;
        const int blk = b0 + br; u.pn = (int)(L % nN); u.pm = blk;
        int lo = seg_lo, hi = seg_lo + nseg;
        while (hi - lo > 1) { const int mid = (lo + hi) >> 1; if (__builtin_amdgcn_readfirstlane(pre[mid]) <= blk) lo = mid; else hi = mid; }
        u.seg = lo; u.j = blk - __builtin_amdgcn_readfirstlane(pre[lo]); const int rem = __builtin_amdgcn_readfirstlane(cnt[lo]) - u.j * 256; u.rows = rem < 256 ? rem : 256;
        const int e = lo % NSEGH;
        u.a = gather ? A : A + (size_t)blk * a_tstep; u.b = Bt + (size_t)e * b_estride + (size_t)u.pn * b_tstep; return true;
    }
    __device__ __forceinline__ const int* tab_src(const Unit& u) const { return slot + (size_t)u.seg * SLOT_CAP + u.j * 256; }
};

template <class Epi, class Sched, bool GATHER>
__device__ __forceinline__ void gemm_phase(LAS unsigned char* lds, const int K, const Sched& S, const Epi& E, const int wave) {
    const int lane = lane_id_fresh(), wid = wave, tid = wid * 64 + lane, wr = wid >> 2, wc = wid & 3, fr = lane & 15, fq = lane >> 4; (void)fr; (void)fq;
    const int nt = K / BK;
    unsigned voffA[2][2], voffB[2];
#pragma unroll
    for (int i = 0; i < 2; ++i) { int R, C; stage_rc(tid * 16 + i * 8192, R, C); const int Rb = Epi::PERM ? ((R & ~31) + perm32(R & 31)) : R;
        voffB[i] = (unsigned)(Rb * K + C) * 2u;
#pragma unroll
        for (int h = 0; h < 2; ++h) voffA[h][i] = (unsigned)(R * K + C) * 2u; }
    const size_t kstep = (size_t)(BK * 2);
    const size_t hstep = (size_t)HALF * K * 2;
    const unsigned ldsw = (unsigned)wid * 1024u;
    const int aoff = lds_byte(wr * 64 + fr, fq * 8), boff = lds_byte(wc * 32 + fr, fq * 8);
    const LAS int* gtab = (const LAS int*)(lds + LDS_GTAB);
#define PG8_SA(b, h) (((b) * 2 + (h)) * HTB)
#define PG8_SB(b, h) ((4 + (b) * 2 + (h)) * HTB)
#define PG8_STAGE_A(bufoff, gbase, h) do { _Pragma("unroll") for (int _i = 0; _i < 2; ++_i) \
        __builtin_amdgcn_global_load_lds((const unsigned*)((const char*)(gbase) + (GATHER ? (size_t)0 : (size_t)(h) * hstep) + voffA[GATHER ? (h) : 0][_i]), (LAS unsigned*)(lds + (bufoff) + ldsw + _i * 8192), 16, 0, 0); } while (0)
#define PG8_STAGE_B(bufoff, gbase) do { _Pragma("unroll") for (int _i = 0; _i < 2; ++_i) \
        __builtin_amdgcn_global_load_lds((const unsigned*)((const char*)(gbase) + voffB[_i]), (LAS unsigned*)(lds + (bufoff) + ldsw + _i * 8192), 16, 0, 0); } while (0)
#define PG8_LDA(dst, b, h) do { _Pragma("unroll") for (int m = 0; m < 4; ++m) _Pragma("unroll") for (int k = 0; k < 2; ++k) dst[m][k] = *(const LAS bf16x8*)(lds + PG8_SA(b, h) + aoff + m * 2048 + k * 1024); } while (0)
#define PG8_LDB(dst, b, h) do { _Pragma("unroll") for (int n = 0; n < 2; ++n) _Pragma("unroll") for (int k = 0; k < 2; ++k) dst[n][k] = *(const LAS bf16x8*)(lds + PG8_SB(b, h) + boff + n * 2048 + k * 1024); } while (0)
#define PG8_MMA(ai, bj, At, Bt) do { __builtin_amdgcn_s_setprio(1); _Pragma("unroll") for (int m = 0; m < 4; ++m) _Pragma("unroll") for (int n = 0; n < 2; ++n) _Pragma("unroll") for (int k = 0; k < 2; ++k) \
        acc[ai][bj][m][n] = __builtin_amdgcn_mfma_f32_16x16x32_bf16(Bt[n][k], At[m][k], acc[ai][bj][m][n], 0, 0, 0); __builtin_amdgcn_s_setprio(0); } while (0)
#define PG8_WAIT_V(n) asm volatile("s_waitcnt vmcnt(" #n ")" ::: "memory")
#define PG8_WAIT_L(n) asm volatile("s_waitcnt lgkmcnt(" #n ")" ::: "memory")
#define PG8_BAR __builtin_amdgcn_s_barrier()
#define PG8_SCHED __builtin_amdgcn_sched_barrier(0)
#define PG8_GOFFS(u, tb) do { _Pragma("unroll") for (int _h = 0; _h < 2; ++_h) _Pragma("unroll") for (int _i = 0; _i < 2; ++_i) { int _R, _C; stage_rc(tid * 16 + _i * 8192, _R, _C); \
        const int _rr = _h * HALF + _R; const int _v = gtab[(tb) * 256 + _rr]; const unsigned _tok = (_rr < (u).rows) ? (unsigned)(_v >> 3) : 0u; voffA[_h][_i] = _tok * (unsigned)(K * 2) + (unsigned)(_C * 2); } } while (0)
#define PG8_GTAB_DMA(u, tb) do { if (wid < 4) __builtin_amdgcn_global_load_lds((const unsigned*)(S.tab_src(u) + wid * 64 + lane), (LAS unsigned*)(lds + LDS_GTAB + (tb) * 1024 + wid * 256), 4, 0, 0); } while (0)
    Unit cur, nxt; int ui = 0;
    if (!S.next(0, cur)) return;
    f32x4 acc[2][2][4][2];
#pragma unroll
    for (int a = 0; a < 2; ++a)
#pragma unroll
        for (int b = 0; b < 2; ++b)
#pragma unroll
            for (int m = 0; m < 4; ++m)
#pragma unroll
                for (int n = 0; n < 2; ++n) acc[a][b][m][n] = (f32x4){0.f, 0.f, 0.f, 0.f};
    bf16x8 At[4][2], B0[2][2], B1[2][2];
    const char* cA = cur.a; const char* cB = cur.b;
    if constexpr (GATHER) { PG8_GTAB_DMA(cur, 0); PG8_WAIT_V(0); PG8_BAR; PG8_GOFFS(cur, 0); }
    PG8_STAGE_B(PG8_SB(0, 0), cB); PG8_STAGE_B(PG8_SB(0, 1), cB + hstep); PG8_STAGE_A(PG8_SA(0, 0), cA, 0); PG8_STAGE_A(PG8_SA(0, 1), cA, 1);
    if (wr == 1) PG8_BAR;
    PG8_WAIT_V(2); PG8_BAR;
    PG8_STAGE_B(PG8_SB(1, 0), cB + kstep); PG8_STAGE_A(PG8_SA(1, 0), cA + kstep, 0); PG8_STAGE_B(PG8_SB(1, 1), cB + hstep + kstep);
    PG8_WAIT_V(6); PG8_BAR;
    for (;;) {
        const bool has_next = S.next(ui + 1, nxt);
        const char* nA = has_next ? nxt.a : cA; const char* nB = has_next ? nxt.b : cB;
        for (int t = 0; t < nt; t += 2) {
            const bool last = (t == nt - 2);
            const char* a1 = cA + (size_t)(t + 1) * kstep;
            const char* a2 = last ? nA : cA + (size_t)(t + 2) * kstep; const char* b2 = last ? nB : cB + (size_t)(t + 2) * kstep;
            const char* a3 = a2 + kstep; const char* b3 = b2 + kstep;
            if constexpr (GATHER) { if (t == 0 && has_next) PG8_GTAB_DMA(nxt, (ui + 1) & 1); }
            PG8_LDB(B0, 0, 0); PG8_LDB(B1, 0, 1); PG8_SCHED; PG8_LDA(At, 0, 0); PG8_STAGE_A(PG8_SA(1, 1), a1, 1);
            PG8_WAIT_V(8); PG8_WAIT_L(0); PG8_BAR; PG8_MMA(0, 0, At, B0); PG8_MMA(0, 1, At, B1); PG8_BAR; PG8_SCHED;
            if constexpr (GATHER) { if (last && has_next) PG8_GOFFS(nxt, (ui + 1) & 1); }
            PG8_LDA(At, 0, 1); PG8_STAGE_B(PG8_SB(0, 0), b2); PG8_STAGE_B(PG8_SB(0, 1), b2 + hstep); PG8_STAGE_A(PG8_SA(0, 0), a2, 0);
            PG8_WAIT_V(8); PG8_WAIT_L(0); PG8_BAR; PG8_MMA(1, 0, At, B0); PG8_MMA(1, 1, At, B1); PG8_BAR; PG8_SCHED;
            PG8_LDB(B0, 1, 0); PG8_LDB(B1, 1, 1); PG8_SCHED; PG8_LDA(At, 1, 0); PG8_STAGE_A(PG8_SA(0, 1), a2, 1);
            PG8_WAIT_V(8); PG8_WAIT_L(0); PG8_BAR; PG8_MMA(0, 0, At, B0); PG8_MMA(0, 1, At, B1); PG8_BAR; PG8_SCHED;
            PG8_LDA(At, 1, 1); PG8_STAGE_B(PG8_SB(1, 0), b3); PG8_STAGE_B(PG8_SB(1, 1), b3 + hstep); PG8_STAGE_A(PG8_SA(1, 0), a3, 0);
            PG8_WAIT_V(8); PG8_WAIT_L(0); PG8_BAR; PG8_MMA(1, 0, At, B0); PG8_MMA(1, 1, At, B1); PG8_BAR; PG8_SCHED;
        }
        if (wr == 0) PG8_BAR;
        { const int l2 = lane_id_fresh(); E(acc, cur, wr, wc, l2 & 15, l2 >> 4); }
        if (!has_next) break;
#pragma unroll
        for (int a = 0; a < 2; ++a)
#pragma unroll
            for (int b = 0; b < 2; ++b)
#pragma unroll
                for (int m = 0; m < 4; ++m)
#pragma unroll
                    for (int n = 0; n < 2; ++n) acc[a][b][m][n] = (f32x4){0.f, 0.f, 0.f, 0.f};
        cur = nxt; cA = nA; cB = nB; ++ui;
        if (wr == 1) PG8_BAR;
    }
    PG8_WAIT_V(0);
    PG8_BAR;
#undef PG8_SA
#undef PG8_SB
#undef PG8_STAGE_A
#undef PG8_STAGE_B
#undef PG8_LDA
#undef PG8_LDB
#undef PG8_MMA
#undef PG8_WAIT_V
#undef PG8_WAIT_L
#undef PG8_BAR
#undef PG8_SCHED
#undef PG8_GOFFS
#undef PG8_GTAB_DMA
}

typedef f32x4 Acc[2][2][4][2];
struct EpiProj {
    static constexpr bool PERM = true;
    bf16 *PA, *PB, *PC, *PG; const float *qna, *kna, *qnc;
    __device__ __forceinline__ void operator()(const Acc& acc, const Unit& u, int wr, int wc, int fr, int fq) const {
        const int f0 = u.pn * 256 + wc * 64;
        if (f0 >= NPROJ) return;
        bf16* base; int ld, c0, op; const float* gain = qna; float scale = 1.f;
        if (f0 < 1152) { base = PA; ld = LD_PA; c0 = f0; if (f0 < 384) { op = 1; gain = qna; scale = 0.125f; } else if (f0 < 768) { op = 1; gain = kna; } else op = 0; }
        else if (f0 < 2432) { base = PB; ld = LD_PB; c0 = f0 - 1152; if (c0 < 256) { op = 2; scale = 0.125f; } else if (c0 < 896) op = 0; else op = 2; }
        else if (f0 < 2688) { base = PC; ld = LD_PC; c0 = f0 - 2432; op = 1; gain = qnc; scale = 0.125f; }
        else { base = PG; ld = LD_PG; c0 = f0 - 2688; op = 3; }
        f32x4 g[2][2];
#pragma unroll
        for (int bj = 0; bj < 2; ++bj)
#pragma unroll
            for (int n = 0; n < 2; ++n) g[bj][n] = (op == 1) ? *(const f32x4*)(gain + 32 * bj + 8 * fq + 4 * n) * scale : (f32x4){scale, scale, scale, scale};
#pragma unroll
        for (int ai = 0; ai < 2; ++ai)
#pragma unroll
            for (int m = 0; m < 4; ++m) {
                const int row = u.pm * BM + ai * HALF + wr * 64 + m * 16 + fr;
                f32x4 v[2][2];
#pragma unroll
                for (int bj = 0; bj < 2; ++bj)
#pragma unroll
                    for (int n = 0; n < 2; ++n) v[bj][n] = acc[ai][bj][m][n];
                if (op == 1) {
                    float ss = 0.f;
#pragma unroll
                    for (int bj = 0; bj < 2; ++bj)
#pragma unroll
                        for (int n = 0; n < 2; ++n) ss += (v[bj][n][0] * v[bj][n][0] + v[bj][n][1] * v[bj][n][1]) + (v[bj][n][2] * v[bj][n][2] + v[bj][n][3] * v[bj][n][3]);
                    ss += __shfl_xor(ss, 16); ss += __shfl_xor(ss, 32);
                    const float r = rsqrtf(ss * (1.0f / 64.0f) + EPS);
#pragma unroll
                    for (int bj = 0; bj < 2; ++bj)
#pragma unroll
                        for (int n = 0; n < 2; ++n) v[bj][n] = v[bj][n] * r * g[bj][n];
                } else if (op == 2) {
#pragma unroll
                    for (int bj = 0; bj < 2; ++bj)
#pragma unroll
                        for (int n = 0; n < 2; ++n)
#pragma unroll
                            for (int j = 0; j < 4; ++j) v[bj][n][j] = v[bj][n][j] * sigmoidf_(v[bj][n][j]) * scale;
                } else if (op == 3) {
#pragma unroll
                    for (int bj = 0; bj < 2; ++bj)
#pragma unroll
                        for (int n = 0; n < 2; ++n)
#pragma unroll
                            for (int j = 0; j < 4; ++j) v[bj][n][j] = sigmoidf_(v[bj][n][j]);
                }
                bf16* rowp = base + (size_t)row * ld + c0 + 8 * fq;
#pragma unroll
                for (int bj = 0; bj < 2; ++bj) { v4u w; w.x = cvt_pk_bf16(v[bj][0][0], v[bj][0][1]); w.y = cvt_pk_bf16(v[bj][0][2], v[bj][0][3]); w.z = cvt_pk_bf16(v[bj][1][0], v[bj][1][1]); w.w = cvt_pk_bf16(v[bj][1][2], v[bj][1][3]);
                    *(v4u*)(rowp + 32 * bj) = w; }
            }
    }
};
struct EpiMemKV {
    static constexpr bool PERM = true;
    bf16 *MK, *MV; const float* knc;
    __device__ __forceinline__ void operator()(const Acc& acc, const Unit& u, int wr, int wc, int fr, int fq) const {
        bf16* base = u.pn == 0 ? MK : MV; const bool nrm = (u.pn == 0);
        f32x4 g[2][2];
#pragma unroll
        for (int bj = 0; bj < 2; ++bj)
#pragma unroll
            for (int n = 0; n < 2; ++n) g[bj][n] = *(const f32x4*)(knc + 32 * bj + 8 * fq + 4 * n);
#pragma unroll
        for (int ai = 0; ai < 2; ++ai)
#pragma unroll
            for (int m = 0; m < 4; ++m) {
                const int row = u.pm * BM + ai * HALF + wr * 64 + m * 16 + fr;
                f32x4 v[2][2];
#pragma unroll
                for (int bj = 0; bj < 2; ++bj)
#pragma unroll
                    for (int n = 0; n < 2; ++n) v[bj][n] = acc[ai][bj][m][n];
                if (nrm) {
                    float ss = 0.f;
#pragma unroll
                    for (int bj = 0; bj < 2; ++bj)
#pragma unroll
                        for (int n = 0; n < 2; ++n) ss += (v[bj][n][0] * v[bj][n][0] + v[bj][n][1] * v[bj][n][1]) + (v[bj][n][2] * v[bj][n][2] + v[bj][n][3] * v[bj][n][3]);
                    ss += __shfl_xor(ss, 16); ss += __shfl_xor(ss, 32);
                    const float r = rsqrtf(ss * (1.0f / 64.0f) + EPS);
#pragma unroll
                    for (int bj = 0; bj < 2; ++bj)
#pragma unroll
                        for (int n = 0; n < 2; ++n) v[bj][n] = v[bj][n] * r * g[bj][n];
                }
                bf16* rowp = base + (size_t)row * 256 + wc * 64 + 8 * fq;
#pragma unroll
                for (int bj = 0; bj < 2; ++bj) { v4u w; w.x = cvt_pk_bf16(v[bj][0][0], v[bj][0][1]); w.y = cvt_pk_bf16(v[bj][0][2], v[bj][0][3]); w.z = cvt_pk_bf16(v[bj][1][0], v[bj][1][1]); w.w = cvt_pk_bf16(v[bj][1][2], v[bj][1][3]);
                    *(v4u*)(rowp + 32 * bj) = w; }
            }
    }
};
template <int PASS> struct EpiMerge {
    static constexpr bool PERM = true;
    const bf16* PG; bf16* MX;
    __device__ __forceinline__ void operator()(const Acc& acc, const Unit& u, int wr, int wc, int fr, int fq) const {
#pragma unroll
        for (int ai = 0; ai < 2; ++ai)
#pragma unroll
            for (int m = 0; m < 4; ++m) {
                const int row = u.pm * BM + ai * HALF + wr * 64 + m * 16 + fr;
#pragma unroll
                for (int bj = 0; bj < 2; ++bj) {
                    const int c = u.pn * BM + bj * HALF + wc * 32 + 8 * fq;
                    const v4u gw = *(const v4u*)(PG + (size_t)row * LD_PG + PASS * 1024 + c);
                    bf16* mp = MX + (size_t)row * 1024 + c;
                    v4u pw = (v4u){0u, 0u, 0u, 0u}; if (PASS > 0) pw = *(const v4u*)mp;
                    const f32x4 a0 = acc[ai][bj][m][0], a1 = acc[ai][bj][m][1];
                    float o[8];
                    o[0] = bf_lo(pw.x) + bf_lo(gw.x) * a0[0]; o[1] = bf_hi(pw.x) + bf_hi(gw.x) * a0[1]; o[2] = bf_lo(pw.y) + bf_lo(gw.y) * a0[2]; o[3] = bf_hi(pw.y) + bf_hi(gw.y) * a0[3];
                    o[4] = bf_lo(pw.z) + bf_lo(gw.z) * a1[0]; o[5] = bf_hi(pw.z) + bf_hi(gw.z) * a1[1]; o[6] = bf_lo(pw.w) + bf_lo(gw.w) * a1[2]; o[7] = bf_hi(pw.w) + bf_hi(gw.w) * a1[3];
                    v4u w; w.x = cvt_pk_bf16(o[0], o[1]); w.y = cvt_pk_bf16(o[2], o[3]); w.z = cvt_pk_bf16(o[4], o[5]); w.w = cvt_pk_bf16(o[6], o[7]);
                    *(v4u*)mp = w;
                }
                asm volatile("" ::: "memory");
            }
    }
};
struct EpiOut {
    static constexpr bool PERM = false;
    const float* X; float* O;
    __device__ __forceinline__ void operator()(const Acc& acc, const Unit& u, int wr, int wc, int fr, int fq) const {
#pragma unroll
        for (int ai = 0; ai < 2; ++ai)
#pragma unroll
            for (int m = 0; m < 4; ++m) {
                const size_t off = (size_t)(u.pm * BM + ai * HALF + wr * 64 + m * 16 + fr) * 1024 + u.pn * BM + wc * 32 + 4 * fq;
#pragma unroll
                for (int bj = 0; bj < 2; ++bj)
#pragma unroll
                    for (int n = 0; n < 2; ++n) { const f32x4 xv = *(const f32x4*)(X + off + bj * HALF + n * 16); *(f32x4*)(O + off + bj * HALF + n * 16) = xv + acc[ai][bj][m][n]; }
            }
    }
};
struct EpiUp {
    static constexpr bool PERM = true;
    bf16* HID;
    __device__ __forceinline__ void operator()(const Acc& acc, const Unit& u, int wr, int wc, int fr, int fq) const {
#pragma unroll
        for (int ai = 0; ai < 2; ++ai)
#pragma unroll
            for (int m = 0; m < 4; ++m) {
                const size_t row = (size_t)u.pm * BM + ai * HALF + wr * 64 + m * 16 + fr;
                float o[8];
#pragma unroll
                for (int n = 0; n < 2; ++n)
#pragma unroll
                    for (int j = 0; j < 4; ++j) { const float gt = acc[ai][0][m][n][j], up = acc[ai][1][m][n][j]; o[4 * n + j] = gt * sigmoidf_(gt) * up; }
                v4u w; w.x = cvt_pk_bf16(o[0], o[1]); w.y = cvt_pk_bf16(o[2], o[3]); w.z = cvt_pk_bf16(o[4], o[5]); w.w = cvt_pk_bf16(o[6], o[7]);
                *(v4u*)(HID + row * 256 + u.pn * 128 + wc * 32 + 8 * fq) = w;
            }
    }
};
struct EpiDown {
    static constexpr bool PERM = true;
    const int* slot; const float* wflat; bf16* YB; float* OUT; int half;
    __device__ __forceinline__ void operator()(const Acc& acc, const Unit& u, int wr, int wc, int fr, int fq) const {
        const int e = u.seg % NSEGH;
#pragma unroll
        for (int ai = 0; ai < 2; ++ai)
#pragma unroll
            for (int m = 0; m < 4; ++m) {
                const int r = ai * HALF + wr * 64 + m * 16 + fr;
                if (r < u.rows) {
                    const int flat = slot[(size_t)u.seg * SLOT_CAP + u.j * 256 + r];
                    if (e < NEXP) {
                        const float w = wflat[flat];
                        bf16* rowp = YB + (size_t)(flat - half * (HALF_T * 8)) * 1024 + u.pn * BM + wc * 32 + 8 * fq;
#pragma unroll
                        for (int bj = 0; bj < 2; ++bj) { const f32x4 a0 = acc[ai][bj][m][0] * w, a1 = acc[ai][bj][m][1] * w;
                            v4u o; o.x = cvt_pk_bf16(a0[0], a0[1]); o.y = cvt_pk_bf16(a0[2], a0[3]); o.z = cvt_pk_bf16(a1[0], a1[1]); o.w = cvt_pk_bf16(a1[2], a1[3]);
                            *(v4u*)(rowp + bj * HALF) = o; }
                    } else {
                        float* rowp = OUT + (size_t)(flat >> 3) * 1024 + u.pn * BM + wc * 32 + 8 * fq;
#pragma unroll
                        for (int bj = 0; bj < 2; ++bj)
#pragma unroll
                            for (int n = 0; n < 2; ++n) { f32x4* p = (f32x4*)(rowp + bj * HALF + 4 * n); *p = *p + acc[ai][bj][m][n]; }
                    }
                }
                asm volatile("" ::: "memory");
            }
    }
};
}

__device__ __forceinline__ const float* arg_in(int i) {
    const __attribute__((address_space(4))) char* kp = (const __attribute__((address_space(4))) char*)__builtin_amdgcn_kernarg_segment_ptr();
    asm volatile("" : "+s"(kp));
    return *(const float* const __attribute__((address_space(4)))*)(kp + 8 * i);
}
struct Frame {
    LAS unsigned char* lds;
    int wave, vcu, G;
    unsigned char* ws; unsigned char* dout;
};
enum { I_X = 0, I_MEM, I_ANG, I_WIN, I_QNA, I_KNA, I_RELB, I_LBL, I_ONB, I_MNG, I_WMKV, I_QNC, I_KNC, I_WBA, I_WBB, I_WBC, I_WOUT, I_FNG, I_WR, I_RB, I_WEU, I_WED, I_WSU, I_WSD };

__device__ __forceinline__ void tr_item(const float* W, int ldw, int k0, int n0s, bf16* WT, int K, int n0d, LAS float* scr, int lane) {
#pragma unroll 8
    for (int i = 0; i < 32; ++i) { const int kk = 2 * i + (lane >> 5); scr[kk * 33 + (lane & 31)] = (n0s >= 0) ? W[(size_t)(k0 + kk) * ldw + n0s + (lane & 31)] : 0.f; }
    LDS_WAIT(); asm volatile("" ::: "memory");
    const int c = lane & 7;
#pragma unroll
    for (int j = 0; j < 4; ++j) { const int n = (lane >> 3) + 8 * j; const LAS float* s = scr + (8 * c) * 33 + n;
        v4u o; o.x = cvt_pk_bf16(s[0 * 33], s[1 * 33]); o.y = cvt_pk_bf16(s[2 * 33], s[3 * 33]); o.z = cvt_pk_bf16(s[4 * 33], s[5 * 33]); o.w = cvt_pk_bf16(s[6 * 33], s[7 * 33]);
        *(v4u*)(WT + (size_t)(n0d + n) * K + k0 + 8 * c) = o; }
    LDS_WAIT(); asm volatile("" ::: "memory");
}
__device__ __forceinline__ void rms_row_to_bf16(const float* xrow, const float* g, bf16* orow, int lane) {
    const f32x4* xr = (const f32x4*)xrow + lane; const f32x4* gr = (const f32x4*)g + lane;
    f32x4 v[4]; float s = 0.f;
#pragma unroll
    for (int j = 0; j < 4; ++j) { v[j] = xr[64 * j]; s += (v[j][0] * v[j][0] + v[j][1] * v[j][1]) + (v[j][2] * v[j][2] + v[j][3] * v[j][3]); }
    const float rstd = rsqrtf(wave_sum(s) * (1.f / D) + EPS);
    v2u* o8 = (v2u*)orow + lane;
#pragma unroll
    for (int j = 0; j < 4; ++j) { const f32x4 gg = gr[64 * j]; v2u w; w.x = cvt_pk_bf16(v[j][0] * rstd * gg[0], v[j][1] * rstd * gg[1]); w.y = cvt_pk_bf16(v[j][2] * rstd * gg[2], v[j][3] * rstd * gg[3]); o8[64 * j] = w; }
}
__device__ __forceinline__ int t5_bucket(int dist) {
    if (dist < 16) return dist;
    const int large = 16 + (int)(logf((float)dist / 16.0f) / 4.852030263919617f * 16.0f);
    return large < 31 ? large : 31;
}
__device__ __forceinline__ void p0_prologue(Frame& F) {
    const int lane = lane_id_fresh(); const int tid = F.wave * 64 + lane; (void)tid;
    LAS float* scr = (LAS float*)(F.lds + F.wave * 16384);
    const int gw = F.vcu * 8 + F.wave, NGW = F.G * 8;
    constexpr int I0 = 16 * 184, I1 = 16 * 16, I2 = 6 * 32, I3 = 6 * 32, I4 = 4 * 32, I5 = 16 * 32, I6 = 65 * 256, I7 = 65 * 128;
    constexpr int NITEMS = I0 + I1 + I2 + I3 + I4 + I5 + I6 + I7;
    for (int it = gw; it < NITEMS; it += NGW) {
        int r = it;
        if (r < I0 + I1) {
            const bool first = r < I0; if (!first) r -= I0;
            const int nblk = first ? 184 : 16, nsrc = first ? NPROJ : 512;
            const int kb = r / nblk, nbd = r % nblk, tile = nbd >> 3, within = nbd & 7, bj = within >> 2, wc = within & 3;
            const int srcb = tile * 8 + 2 * wc + bj;
            const int n0s = (srcb * 32 < nsrc) ? srcb * 32 : -1;
            tr_item(first ? arg_in(I_WIN) : arg_in(I_WMKV), nsrc, kb * 64, n0s, (bf16*)(F.ws + (first ? WS_WIN : WS_WMEM)), 1024, nbd * 32, scr, lane);
            continue;
        }
        r -= I0 + I1;
        if (r < I2) { tr_item(arg_in(I_WBA), 1024, (r / 32) * 64, (r % 32) * 32, (bf16*)(F.ws + WS_WA), 384, (r % 32) * 32, scr, lane); continue; } r -= I2;
        if (r < I3) { tr_item(arg_in(I_WBB), 1024, (r / 32) * 64, (r % 32) * 32, (bf16*)(F.ws + WS_WB), 384, (r % 32) * 32, scr, lane); continue; } r -= I3;
        if (r < I4) { tr_item(arg_in(I_WBC), 1024, (r / 32) * 64, (r % 32) * 32, (bf16*)(F.ws + WS_WC), 256, (r % 32) * 32, scr, lane); continue; } r -= I4;
        if (r < I5) { tr_item(arg_in(I_WOUT), 1024, (r / 32) * 64, (r % 32) * 32, (bf16*)(F.ws + WS_WOUT), 1024, (r % 32) * 32, scr, lane); continue; } r -= I5;
        if (r < I6) {
            const int e = r / 256, q = r % 256, kb = q / 16, nbd = q % 16, pn = nbd >> 3, within = nbd & 7, bj = within >> 2, qq = within & 3;
            const int srcb = bj * 8 + pn * 4 + qq;
            const float* W = (e < 64) ? arg_in(I_WEU) + (size_t)e * 1024 * 512 : arg_in(I_WSU);
            tr_item(W, 512, kb * 64, srcb * 32, (bf16*)(F.ws + WS_WUP) + (size_t)e * 512 * 1024, 1024, nbd * 32, scr, lane);
            continue;
        }
        r -= I6;
        {   const int e = r / 128, q = r % 128, kb = q / 32, nb = q % 32;
            const float* W = (e < 64) ? arg_in(I_WED) + (size_t)e * 256 * 1024 : arg_in(I_WSD);
            tr_item(W, 1024, kb * 64, nb * 32, (bf16*)(F.ws + WS_WDN) + (size_t)e * 1024 * 256, 256, nb * 32, scr, lane); }
    }
    for (int m = gw; m < T; m += NGW) rms_row_to_bf16(arg_in(I_X) + (size_t)m * D, arg_in(I_ANG), (bf16*)F.dout + (size_t)m * D, lane);
    for (int m = gw; m < NB * MEML; m += NGW) rms_row_to_bf16(arg_in(I_MEM) + (size_t)m * D, arg_in(I_MNG), (bf16*)(F.ws + WS_MEMN) + (size_t)m * D, lane);
    if (F.vcu == 0) {
        float* tab = (float*)(F.ws + WS_TAB);
        for (int i = tid; i < 3 * 129 * 6; i += 512) { const int h = i % 6, st = (i / 6) % 129, p = i / (6 * 129); tab[i] = arg_in(I_RELB)[t5_bucket(st << (2 * p)) * 6 + h]; }
        if (tid < 256) { const float a0 = arg_in(I_LBL)[tid], a1 = arg_in(I_LBL)[256 + tid]; tab[4096 + tid] = 1.0f / (1.0f + __expf(a1 - a0)); }
    }
}

template <int NR, class EntF>
__device__ __forceinline__ void attn_wave_simple(const bf16* qrow, const char* KB, const char* VB, const EntF& ent, bf16* orow, LAS float* wscr, int lane) {
    float q[64];
    { const v4u* qp = (const v4u*)qrow;
#pragma unroll
      for (int i = 0; i < 8; ++i) { const v4u w = qp[i]; q[8 * i + 0] = bf_lo(w.x); q[8 * i + 1] = bf_hi(w.x); q[8 * i + 2] = bf_lo(w.y); q[8 * i + 3] = bf_hi(w.y); q[8 * i + 4] = bf_lo(w.z); q[8 * i + 5] = bf_hi(w.z); q[8 * i + 6] = bf_lo(w.w); q[8 * i + 7] = bf_hi(w.w); } }
    float mx = -3.0e38f;
    LAS unsigned* vscr = (LAS unsigned*)(wscr + NR * 64);
#pragma unroll 1
    for (int r = 0; r < NR; ++r) {
        unsigned koff = 0, voff = 0; float bias = 0.f;
        const bool valid = ent(r * 64 + lane, koff, voff, bias);
        const v4u* kp = (const v4u*)(KB + koff);
        float d0 = 0.f, d1 = 0.f;
#pragma unroll
        for (int i = 0; i < 8; ++i) { const v4u w = kp[i];
            d0 += q[8 * i + 0] * bf_lo(w.x) + q[8 * i + 2] * bf_lo(w.y) + q[8 * i + 4] * bf_lo(w.z) + q[8 * i + 6] * bf_lo(w.w);
            d1 += q[8 * i + 1] * bf_hi(w.x) + q[8 * i + 3] * bf_hi(w.y) + q[8 * i + 5] * bf_hi(w.z) + q[8 * i + 7] * bf_hi(w.w); }
        const float sv = valid ? (d0 + d1 + bias) : -3.0e38f; wscr[r * 64 + lane] = sv; vscr[r * 64 + lane] = voff; mx = fmaxf(mx, sv);
    }
    mx = wave_max(mx);
    float l = 0.f;
#pragma unroll 1
    for (int r = 0; r < NR; ++r) { const float sv = wscr[r * 64 + lane]; const float p = (sv > -1.0e38f) ? __expf(sv - mx) : 0.f; l += p; wscr[r * 64 + lane] = p; }
    l = wave_sum(l);
    LDS_WAIT(); asm volatile("" ::: "memory");
    const int sub = lane >> 4, dg = lane & 15;
    float o0 = 0.f, o1 = 0.f, o2 = 0.f, o3 = 0.f;
    for (int i = 0; i < NR * 16; ++i) {
        const int e = 4 * i + sub; const float p = wscr[e]; const unsigned voff = vscr[e];
        const v2u w = *(const v2u*)(VB + voff + dg * 8);
        o0 += p * bf_lo(w.x); o1 += p * bf_hi(w.x); o2 += p * bf_lo(w.y); o3 += p * bf_hi(w.y);
    }
    o0 += __shfl_xor(o0, 16); o1 += __shfl_xor(o1, 16); o2 += __shfl_xor(o2, 16); o3 += __shfl_xor(o3, 16);
    o0 += __shfl_xor(o0, 32); o1 += __shfl_xor(o1, 32); o2 += __shfl_xor(o2, 32); o3 += __shfl_xor(o3, 32);
    const float inv = 1.0f / l;
    if (lane < 16) { v2u w; w.x = cvt_pk_bf16(o0 * inv, o1 * inv); w.y = cvt_pk_bf16(o2 * inv, o3 * inv); *(v2u*)(orow + dg * 4) = w; }
    LDS_WAIT(); asm volatile("" ::: "memory");
}
struct EntA {
    int pos, h; unsigned rowbase; const float* btab;
    __device__ __forceinline__ bool operator()(int e, unsigned& koff, unsigned& voff, float& bias) const {
        const int p = e / 129, st = e - p * 129; const int kt = pos - (st << (2 * p));
        const bool valid = (e < 387) && (kt >= 0);
        const unsigned off = valid ? (rowbase + (unsigned)kt * (LD_PA * 2)) : rowbase;
        koff = off + (384 + h * 64) * 2; voff = off + (768 + h * 64) * 2;
        bias = valid ? btab[e * 6 + h] : 0.f; return valid;
    }
};
struct EntC {
    unsigned base;
    __device__ __forceinline__ bool operator()(int e, unsigned& koff, unsigned& voff, float& bias) const { koff = base + (unsigned)e * 512u; voff = koff; bias = 0.f; return true; }
};
__device__ __forceinline__ void p2_attn_simple(Frame& F) {
    const int lane = lane_id_fresh(); const int tid = F.wave * 64 + lane; (void)tid;
    LAS float* wscr = (LAS float*)(F.lds + F.wave * 8192);
    const int gw = F.vcu * 8 + F.wave, NGW = F.G * 8;
    const bf16* PA = (const bf16*)(F.ws + WS_PA); const bf16* PC = (const bf16*)(F.ws + WS_PC);
    const float* btab = (const float*)(F.ws + WS_TAB);
    for (int it = gw; it < T * 6; it += NGW) {
        const int t = it / 6, h = it % 6, b = t >> 11, pos = t & 2047;
        EntA ent{pos, h, (unsigned)(b * SEQ) * (unsigned)(LD_PA * 2), btab};
        attn_wave_simple<7, EntA>(PA + (size_t)t * LD_PA + h * 64, (const char*)PA, (const char*)PA, ent, (bf16*)(F.dout + DO_YA) + (size_t)t * 384 + h * 64, wscr, lane);
    }
    for (int it = gw; it < T * 4; it += NGW) {
        const int t = it >> 2, h = it & 3, b = t >> 11;
        EntC ent{(unsigned)(b * MEML) * 512u + (unsigned)h * 128u};
        attn_wave_simple<4, EntC>(PC + (size_t)t * LD_PC + h * 64, (const char*)(F.ws + WS_MEMK), (const char*)(F.ws + WS_MEMV), ent, (bf16*)(F.dout + DO_YC) + (size_t)t * 256 + h * 64, wscr, lane);
    }
}

typedef short s4v __attribute__((ext_vector_type(4)));
constexpr int ATT_OROW = 272;
constexpr int ATT_OACC = 0, ATT_M = 256 * ATT_OROW, ATT_L = ATT_M + 1024, ATT_BT = ATT_L + 1024, ATT_VST = 73728, ATT_VROW = 160, ATT_VBUF = 32 * ATT_VROW;
static_assert(ATT_BT + 3 * 132 * 4 <= ATT_VST && ATT_VST + 8 * 2 * ATT_VBUF <= LDS_MISC, "attention LDS map");
template <int NT, bool MASK>
__device__ __forceinline__ void attn_sub(const bf16* Q0, unsigned qstep, const bf16* K0, const bf16* V0, unsigned kstep, int clo, const LAS float* btab, LAS unsigned char* vst, int lane,
                                         f32x4 (&O)[4], float& m_out, float& l_out) {
    const int q = lane & 15, g = lane >> 4;
    bf16x8 qf[2];
#pragma unroll
    for (int ks = 0; ks < 2; ++ks) qf[ks] = *(const bf16x8*)((const char*)Q0 + ((unsigned)q * qstep + 8u * g + 32u * ks) * 2u);
    f32x4 S[NT];
#pragma unroll
    for (int k = 0; k < NT; ++k) {
        S[k] = (f32x4){0.f, 0.f, 0.f, 0.f};
        if (!MASK || 16 * k >= clo) {
            const char* kr = (const char*)K0 + ((unsigned)(16 * k + q) * kstep + 8u * g) * 2u;
            const bf16x8 k0 = *(const bf16x8*)kr, k1 = *(const bf16x8*)(kr + 64);
            S[k] = __builtin_amdgcn_mfma_f32_16x16x32_bf16(k0, qf[0], S[k], 0, 0, 0);
            S[k] = __builtin_amdgcn_mfma_f32_16x16x32_bf16(k1, qf[1], S[k], 0, 0, 0);
        }
        if ((k & 3) == 3) asm volatile("" ::: "memory");
    }
    float mx = -3.0e38f;
    if (MASK) {
        const int bs = 128 + q - 4 * g;
#pragma unroll
        for (int k = 0; k < NT; ++k)
#pragma unroll
            for (int r = 0; r < 4; ++r) { const int st = bs - 16 * k - r; const bool ok = (st >= 0) && (st <= 128) && (16 * k + 4 * g + r >= clo);
                const int sc = st < 0 ? 0 : (st > 128 ? 128 : st); const float v = ok ? S[k][r] + btab[sc] : -3.0e38f; S[k][r] = v; mx = fmaxf(mx, v); }
    } else {
#pragma unroll
        for (int k = 0; k < NT; ++k) mx = fmaxf(mx, fmaxf(fmaxf(S[k][0], S[k][1]), fmaxf(S[k][2], S[k][3])));
    }
    mx = fmaxf(mx, __shfl_xor(mx, 16)); mx = fmaxf(mx, __shfl_xor(mx, 32));
    float l = 0.f;
#pragma unroll
    for (int k = 0; k < NT; ++k)
#pragma unroll
        for (int r = 0; r < 4; ++r) { const float p = __expf(S[k][r] - mx); S[k][r] = p; l += p; }
    l += __shfl_xor(l, 16); l += __shfl_xor(l, 32);
#pragma unroll
    for (int t = 0; t < 4; ++t) O[t] = (f32x4){0.f, 0.f, 0.f, 0.f};
    constexpr int NKS = (NT + 1) / 2;
    const int vr = lane >> 1, vh = lane & 1;
    const int tq = (lane & 15) >> 2, tp = lane & 3;
#pragma unroll
    for (int ks = 0; ks < NKS; ++ks) {
        if (MASK && 32 * ks + 31 < clo) continue;
        LAS unsigned char* vb = vst + (ks & 1) * ATT_VBUF;
        int c = 32 * ks + vr; if (MASK && c < clo) c = clo; if (c > 16 * NT - 1) c = 16 * NT - 1;
        const v4u* vp = (const v4u*)((const char*)V0 + ((unsigned)c * kstep + 32u * vh) * 2u);
        const v4u w0 = vp[0], w1 = vp[1], w2 = vp[2], w3 = vp[3];
        LAS v4u* wp = (LAS v4u*)(vb + vr * ATT_VROW + vh * 64);
        wp[0] = w0; wp[1] = w1; wp[2] = w2; wp[3] = w3;
        bf16x8 pf;
        { const f32x4 a = S[2 * ks]; f32x4 b = (f32x4){0.f, 0.f, 0.f, 0.f}; if (2 * ks + 1 < NT) b = S[2 * ks + 1 < NT ? 2 * ks + 1 : 0];
          v4u pw; pw.x = cvt_pk_bf16(a[0], a[1]); pw.y = cvt_pk_bf16(a[2], a[3]); pw.z = cvt_pk_bf16(b[0], b[1]); pw.w = cvt_pk_bf16(b[2], b[3]); pf = __builtin_bit_cast(bf16x8, pw); }
        asm volatile("" ::: "memory");
#pragma unroll
        for (int t = 0; t < 4; ++t) {
            const s4v lo = __builtin_amdgcn_ds_read_tr16_b64_v4i16((LAS s4v*)(vb + (4 * g + tq) * ATT_VROW + (16 * t + 4 * tp) * 2));
            const s4v hi = __builtin_amdgcn_ds_read_tr16_b64_v4i16((LAS s4v*)(vb + (16 + 4 * g + tq) * ATT_VROW + (16 * t + 4 * tp) * 2));
            const bf16x8 af = (bf16x8){lo[0], lo[1], lo[2], lo[3], hi[0], hi[1], hi[2], hi[3]};
            O[t] = __builtin_amdgcn_mfma_f32_16x16x32_bf16(af, pf, O[t], 0, 0, 0);
        }
        asm volatile("" ::: "memory");
    }
    m_out = mx; l_out = l;
}
__device__ __forceinline__ void attnA_unit(Frame& F, int unit, int lane) {
    const int tid = F.wave * 64 + lane;
    const int b = unit / 48, rem = unit % 48, h = rem >> 3, tile = rem & 7, t0 = tile * 256; const long tokbase = (long)b * SEQ;
    const bf16* PA = (const bf16*)(F.ws + WS_PA);
    LAS float* bt = (LAS float*)(F.lds + ATT_BT);
    __syncthreads();
    if (tid < 387) { const int p = tid / 129, st = tid - p * 129; bt[p * 132 + st] = ((const float*)(F.ws + WS_TAB))[tid * 6 + h]; }
    __syncthreads();
    LAS unsigned char* vst = F.lds + ATT_VST + F.wave * 2 * ATT_VBUF;
    const int q = lane & 15, g = lane >> 4;
#pragma unroll 1
    for (int p = 0; p < 3; ++p) {
        const int d = 1 << (2 * p);
#pragma unroll 1
        for (int su = 0; su < 2; ++su) {
            const int sub = F.wave * 2 + su;
            int tq0, pq0;
            if (p == 0) { tq0 = t0 + 16 * sub; pq0 = tq0; }
            else if (p == 1) { const int r = sub & 3, jp = sub >> 2; tq0 = t0 + r + 64 * jp; pq0 = t0 / 4 + 16 * jp; }
            else { tq0 = t0 + sub; pq0 = t0 / 16; }
            const int clo = pq0 < 128 ? 128 - pq0 : 0;
            const bf16* Q0 = PA + (tokbase + tq0) * LD_PA + h * 64;
            const bf16* K0 = PA + (tokbase + tq0 - 128 * d) * LD_PA + 384 + h * 64;
            f32x4 O[4]; float m, l;
            attn_sub<9, true>(Q0, (unsigned)(d * LD_PA), K0, K0 + 384, (unsigned)(d * LD_PA), clo, bt + p * 132, vst, lane, O, m, l);
            const int tt = (tq0 - t0) + q * d;
            LAS unsigned char* orow = F.lds + ATT_OACC + tt * ATT_OROW + 16 * g; LAS float* mp = (LAS float*)(F.lds + ATT_M) + tt; LAS float* lp = (LAS float*)(F.lds + ATT_L) + tt;
            if (p > 0) {
                const float mo = *mp, lo_ = *lp; const float mn = fmaxf(m, mo), ao = __expf(mo - mn), an = __expf(m - mn);
#pragma unroll
                for (int t = 0; t < 4; ++t) { const f32x4 oo = *(const LAS f32x4*)(orow + 64 * t); O[t] = oo * ao + O[t] * an; }
                l = lo_ * ao + l * an; m = mn;
            }
            if (p < 2) {
#pragma unroll
                for (int t = 0; t < 4; ++t) *(LAS f32x4*)(orow + 64 * t) = O[t];
                if (g == 0) { *mp = m; *lp = l; }
            } else {
                const float inv = 1.0f / l; bf16* yo = (bf16*)(F.dout + DO_YA) + (tokbase + t0 + tt) * 384 + h * 64 + 4 * g;
#pragma unroll
                for (int t = 0; t < 4; ++t) { v2u w; w.x = cvt_pk_bf16(O[t][0] * inv, O[t][1] * inv); w.y = cvt_pk_bf16(O[t][2] * inv, O[t][3] * inv); *(v2u*)(yo + 16 * t) = w; }
            }
        }
        __syncthreads();
    }
}
__device__ __forceinline__ void attnC_unit(Frame& F, int unit, int lane) {
    const int b = unit >> 5, h = (unit >> 3) & 3, tile = unit & 7; const long tok0 = (long)b * SEQ + tile * 256;
    const bf16* PC = (const bf16*)(F.ws + WS_PC);
    const bf16* K0 = (const bf16*)(F.ws + WS_MEMK) + (long)b * MEML * 256 + h * 64; const bf16* V0 = (const bf16*)(F.ws + WS_MEMV) + (long)b * MEML * 256 + h * 64;
    LAS unsigned char* vst = F.lds + ATT_VST + F.wave * 2 * ATT_VBUF;
    const int q = lane & 15, g = lane >> 4;
#pragma unroll 1
    for (int su = 0; su < 2; ++su) {
        const long tq0 = tok0 + 16 * (F.wave * 2 + su);
        f32x4 O[4]; float m, l;
        attn_sub<16, false>(PC + tq0 * LD_PC + h * 64, (unsigned)LD_PC, K0, V0, 256u, 0, nullptr, vst, lane, O, m, l);
        const float inv = 1.0f / l; bf16* yo = (bf16*)(F.dout + DO_YC) + (tq0 + q) * 256 + h * 64 + 4 * g;
#pragma unroll
        for (int t = 0; t < 4; ++t) { v2u w; w.x = cvt_pk_bf16(O[t][0] * inv, O[t][1] * inv); w.y = cvt_pk_bf16(O[t][2] * inv, O[t][3] * inv); *(v2u*)(yo + 16 * t) = w; }
    }
}
__device__ __forceinline__ void p2_attn_mfma(Frame& F) {
    const int lane = lane_id_fresh();
    for (int u = F.vcu; u < NB * 6 * 8; u += F.G) attnA_unit(F, u, lane);
    for (int u = F.vcu; u < NB * 4 * 8; u += F.G) attnC_unit(F, u, lane);
    __syncthreads();
}
template <bool OUTPUTS>
__device__ __forceinline__ void hgrn_simple(Frame& F) {
    const int lane = lane_id_fresh(); const int tid = F.wave * 64 + lane; (void)tid;
    const int uw = tid >> 7, col = tid & 127;
    LAS float* fL = (LAS float*)(F.lds + uw * 29184); LAS float* qL = fL + 2048; LAS float* oL = qL + 2048; LAS float* pL = oL + 3072;
    const bf16* PB = (const bf16*)(F.ws + WS_PB);
    const float* lbt = (const float*)(F.ws + WS_TAB) + 4096;
    float* LST = (float*)(F.ws + WS_LST); float* DEC = (float*)(F.ws + WS_DEC);
    for (int grp = F.vcu; grp < 1024; grp += F.G) {
        const int unit = grp * 4 + uw, b = unit >> 7, h = (unit >> 5) & 3, c = unit & 31; const int tok0 = b * SEQ + c * 64;
        float S[64]; float dprod = 1.f;
#pragma unroll
        for (int k = 0; k < 64; ++k) S[k] = 0.f;
        if (OUTPUTS && col < 96) {
            for (int cp = 0; cp < c; ++cp) { const float* dp = DEC + (size_t)(unit - c + cp) * 64; const float* lp = LST + (size_t)(unit - c + cp) * 6144 + col;
#pragma unroll
                for (int k = 0; k < 64; ++k) S[k] = dp[k] * S[k] + lp[k * 96]; }
        }
        for (int hf = 0; hf < 2; ++hf) {
            __syncthreads();
            for (int idx = col; idx < 2048; idx += 128) { const int s = idx >> 6, k = idx & 63; const size_t rb = (size_t)(tok0 + hf * 32 + s) * LD_PB;
                const float lb = lbt[h * 64 + k]; fL[idx] = lb + (1.f - lb) * sigmoidf_(bf2f(PB[rb + 256 + h * 64 + k]));
                if (OUTPUTS) qL[idx] = bf2f(PB[rb + h * 64 + k]); }
            __syncthreads();
            if (col < 96) {
                for (int s = 0; s < 32; ++s) {
                    const float v = bf2f(PB[(size_t)(tok0 + hf * 32 + s) * LD_PB + 512 + h * 96 + col]); float o = 0.f;
#pragma unroll
                    for (int k4 = 0; k4 < 16; ++k4) { const f32x4 f4 = *(const LAS f32x4*)(fL + s * 64 + 4 * k4); f32x4 q4 = (f32x4){0.f, 0.f, 0.f, 0.f}; if (OUTPUTS) q4 = *(const LAS f32x4*)(qL + s * 64 + 4 * k4);
#pragma unroll
                        for (int j = 0; j < 4; ++j) { const float fk = f4[j]; S[4 * k4 + j] = fk * S[4 * k4 + j] + (1.f - fk) * v; if (OUTPUTS) o += S[4 * k4 + j] * q4[j]; } }
                    if (OUTPUTS) oL[s * 96 + col] = o;
                }
            }
            if (!OUTPUTS && col < 64) { for (int s = 0; s < 32; ++s) dprod *= fL[s * 64 + col]; }
            if (OUTPUTS) {
                __syncthreads();
                { const int s = col & 31, part = col >> 5; float ss = 0.f;
#pragma unroll
                  for (int j = 0; j < 24; ++j) { const float x = oL[s * 96 + part * 24 + j]; ss += x * x; }
                  pL[s * 4 + part] = ss; }
                __syncthreads();
                if (col < 96) { const float gn = arg_in(I_ONB)[h * 96 + col];
                    for (int s = 0; s < 32; ++s) { const f32x4 p4 = *(const LAS f32x4*)(pL + s * 4); const float rstd = rsqrtf(((p4[0] + p4[1]) + (p4[2] + p4[3])) * (1.f / 96.f) + EPS);
                        const size_t tok = (size_t)(tok0 + hf * 32 + s); const float og = bf2f(PB[tok * LD_PB + 896 + h * 96 + col]);
                        ((bf16*)(F.dout + DO_YB))[tok * 384 + h * 96 + col] = f2bf(oL[s * 96 + col] * rstd * gn * og); } }
            }
        }
        if (!OUTPUTS) {
            if (col < 96) {
#pragma unroll
                for (int k = 0; k < 64; ++k) LST[(size_t)unit * 6144 + k * 96 + col] = S[k]; }
            if (col < 64) DEC[(size_t)unit * 64 + col] = dprod;
        }
    }
    __syncthreads();
}

__device__ __forceinline__ void p6_route(Frame& F) {
    const int lane = lane_id_fresh(); const int tid = F.wave * 64 + lane; (void)tid;
    LAS float* uL = (LAS float*)F.lds;
    LAS float* pL = (LAS float*)(F.lds + 32768);
    const float* x1 = (const float*)F.dout; bf16* U = (bf16*)(F.ws + WS_U);
    float wr_[128];
#pragma unroll
    for (int i = 0; i < 128; ++i) wr_[i] = arg_in(I_WR)[(size_t)(F.wave * 128 + i) * 64 + lane];
    const float rbias = arg_in(I_RB)[lane];
    int* slot = (int*)(F.ws + WS_SLOT); float* wflat = (float*)(F.ws + WS_WFLAT); unsigned* cntw = (unsigned*)(F.ws + WS_CTL) + CW_CNT;
    for (int i = F.vcu * 512 + tid; i < 2 * HALF_T; i += F.G * 512) { const int hf = i / HALF_T, r = i % HALF_T; slot[(size_t)(hf * NSEGH + 64) * SLOT_CAP + r] = (hf * HALF_T + r) * 8; }
    for (int t0 = F.vcu * 8; t0 < T; t0 += F.G * 8) {
        const int t = t0 + F.wave;
        {   const f32x4* xr = (const f32x4*)(x1 + (size_t)t * D) + lane; const f32x4* gr = (const f32x4*)arg_in(I_FNG) + lane;
            f32x4 v[4]; float s = 0.f;
#pragma unroll
            for (int j = 0; j < 4; ++j) { v[j] = xr[64 * j]; s += (v[j][0] * v[j][0] + v[j][1] * v[j][1]) + (v[j][2] * v[j][2] + v[j][3] * v[j][3]); }
            const float rstd = rsqrtf(wave_sum(s) * (1.f / D) + EPS);
            v2u* o8 = (v2u*)(U + (size_t)t * D) + lane;
#pragma unroll
            for (int j = 0; j < 4; ++j) { const f32x4 uu = v[j] * rstd * gr[64 * j]; *(LAS f32x4*)(uL + F.wave * 1024 + 256 * j + 4 * lane) = uu;
                v2u w; w.x = cvt_pk_bf16(uu[0], uu[1]); w.y = cvt_pk_bf16(uu[2], uu[3]); o8[64 * j] = w; } }
        __syncthreads();
#pragma unroll 1
        for (int tt = 0; tt < 8; ++tt) { float a = 0.f;
#pragma unroll
            for (int i4 = 0; i4 < 32; ++i4) { const f32x4 u4 = *(const LAS f32x4*)(uL + tt * 1024 + F.wave * 128 + 4 * i4); a += u4[0] * wr_[4 * i4] + u4[1] * wr_[4 * i4 + 1] + u4[2] * wr_[4 * i4 + 2] + u4[3] * wr_[4 * i4 + 3]; }
            pL[(tt * 8 + F.wave) * 64 + lane] = a; }
        __syncthreads();
        {   float z = 0.f;
#pragma unroll
            for (int w = 0; w < 8; ++w) z += pL[(F.wave * 8 + w) * 64 + lane];
            const float sg = sigmoidf_(z), ch = sg + rbias;
            float m1 = ch; m1 = fmaxf(m1, __shfl_xor(m1, 1)); m1 = fmaxf(m1, __shfl_xor(m1, 2)); m1 = fmaxf(m1, __shfl_xor(m1, 4));
            const unsigned long long eqm = __ballot(ch == m1); const int gbase = lane & ~7; const unsigned gm = (unsigned)(eqm >> gbase) & 0xffu; const int first = gbase + __builtin_ctz(gm);
            float m2 = (lane == first) ? -3.0e38f : ch; m2 = fmaxf(m2, __shfl_xor(m2, 1)); m2 = fmaxf(m2, __shfl_xor(m2, 2)); m2 = fmaxf(m2, __shfl_xor(m2, 4));
            const float gs = m1 + m2; const int g = lane >> 3; int grank = 0;
#pragma unroll
            for (int gg = 0; gg < 8; ++gg) { const float og = __shfl(gs, gg * 8); grank += (og > gs || (og == gs && gg < g)) ? 1 : 0; }
            const bool gsel = grank < 4; const float cm = gsel ? ch : -3.0e38f; int rank = 0;
#pragma unroll 8
            for (int e = 0; e < 64; ++e) { const float oc = __shfl(cm, e); rank += (oc > cm || (oc == cm && e < lane)) ? 1 : 0; }
            const bool sel = gsel && rank < 8;
            const float wsum = wave_sum(sel ? sg : 0.f);
            if (sel) { const int hf = t >> 15, seg = hf * NSEGH + lane, flat = t * 8 + rank;
                const unsigned pos = atomicAdd(cntw + 64 * seg, 1u);
                slot[(size_t)seg * SLOT_CAP + pos] = flat; wflat[flat] = 2.5f * sg / wsum; }
        }
    }
}
__device__ __forceinline__ void moe_load_segs(Frame& F) {
    const int lane = lane_id_fresh(); const int tid = F.wave * 64 + lane; (void)tid;
    LAS int* pre = (LAS int*)(F.lds + LDS_PRE); LAS int* cnt = pre + 132;
    __syncthreads();
    if (tid < NSEG) { const int e = tid % NSEGH; cnt[tid] = (e == 64) ? HALF_T : (int)__hip_atomic_load((unsigned*)(F.ws + WS_CTL) + CW_CNT + 64 * tid, RLX_AGENT); }
    __syncthreads();
    if (tid == 0) { int a = 0; for (int s = 0; s < NSEG; ++s) { pre[s] = a; a += (cnt[s] + 255) >> 8; } pre[NSEG] = a; }
    __syncthreads();
}
__device__ __forceinline__ void p_combine(Frame& F, int half) {
    const int lane = lane_id_fresh(); const int tid = F.wave * 64 + lane; (void)tid;
    const int gw = F.vcu * 8 + F.wave, NGW = F.G * 8; float* out = (float*)F.dout; const bf16* YB = (const bf16*)(F.ws + WS_YBUF);
    for (int tl = gw; tl < HALF_T; tl += NGW) {
        const int t = half * HALF_T + tl;
#pragma unroll
        for (int j = 0; j < 2; ++j) {
            float a[8]; { const f32x4 o0 = *(const f32x4*)(out + (size_t)t * D + j * 512 + lane * 8), o1 = *(const f32x4*)(out + (size_t)t * D + j * 512 + lane * 8 + 4);
                a[0] = o0[0]; a[1] = o0[1]; a[2] = o0[2]; a[3] = o0[3]; a[4] = o1[0]; a[5] = o1[1]; a[6] = o1[2]; a[7] = o1[3]; }
#pragma unroll
            for (int k = 0; k < 8; ++k) { const v4u w = *(const v4u*)(YB + ((size_t)tl * 8 + k) * D + j * 512 + lane * 8);
                a[0] += bf_lo(w.x); a[1] += bf_hi(w.x); a[2] += bf_lo(w.y); a[3] += bf_hi(w.y); a[4] += bf_lo(w.z); a[5] += bf_hi(w.z); a[6] += bf_lo(w.w); a[7] += bf_hi(w.w); }
            *(f32x4*)(out + (size_t)t * D + j * 512 + lane * 8) = (f32x4){a[0], a[1], a[2], a[3]}; *(f32x4*)(out + (size_t)t * D + j * 512 + lane * 8 + 4) = (f32x4){a[4], a[5], a[6], a[7]};
        }
    }
}

struct Args { const float* in[24]; float* out; unsigned char* ws; int ph_lo, ph_hi, li, pad; };
__global__ void __launch_bounds__(512, 2) mk_fwd(Args args) {
    extern __shared__ __attribute__((aligned(16))) unsigned char lds[];
    Frame F;
    F.lds = (LAS unsigned char*)lds;
    F.wave = __builtin_amdgcn_readfirstlane((int)threadIdx.x >> 6);
    F.G = gridDim.x; { const int bx = blockIdx.x; F.vcu = (F.G % 8 == 0) ? (bx % 8) * (F.G / 8) + bx / 8 : bx; }
    F.ws = args.ws; F.dout = (unsigned char*)args.out;
    volatile LAS unsigned* MISC = (volatile LAS unsigned*)(F.lds + LDS_MISC);
    if (threadIdx.x < 64) MISC[threadIdx.x] = 0u;
    __syncthreads();
    XcdBarrier bar; bar.bar = (unsigned*)(F.ws + WS_CTL) + CW_BAR; bar.x = 0; bar.st = nullptr;
    if (MK_N_LAUNCHES == 1) bar = xcd_barrier_post((unsigned*)(F.ws + WS_CTL) + CW_BAR, MISC);
    const int lo = args.ph_lo, hi = args.ph_hi;
#ifndef PH_MASK
#define PH_MASK 0xfff
#endif
#define IN(k) (((PH_MASK >> (k)) & 1) && lo <= (k) && (k) < hi)
#define SEAM(k) do { if (IN(k) && IN((k) + 1)) xcd_barrier(bar, F.wave); } while (0)
    LAS unsigned char* ring = F.lds;

    if (IN(0)) { p0_prologue(F); } SEAM(0);
    if (IN(1)) {
        { pg8::StaticOrder S; S.init(F.dout, F.ws + WS_WIN, T, NPROJ_PAD, 1024, F.G, (int)blockIdx.x);
          pg8::EpiProj E{(bf16*)(F.ws + WS_PA), (bf16*)(F.ws + WS_PB), (bf16*)(F.ws + WS_PC), (bf16*)(F.ws + WS_PG), arg_in(I_QNA), arg_in(I_KNA), arg_in(I_QNC)};
          pg8::gemm_phase<pg8::EpiProj, pg8::StaticOrder, false>(ring, 1024, S, E, F.wave); }
        { pg8::StaticOrder S; S.init(F.ws + WS_MEMN, F.ws + WS_WMEM, NB * MEML, 512, 1024, F.G, (int)((blockIdx.x + 128) % F.G));
          pg8::EpiMemKV E{(bf16*)(F.ws + WS_MEMK), (bf16*)(F.ws + WS_MEMV), arg_in(I_KNC)};
          pg8::gemm_phase<pg8::EpiMemKV, pg8::StaticOrder, false>(ring, 1024, S, E, F.wave); }
    } SEAM(1);
    if (IN(2)) { hgrn_simple<false>(F); p2_attn_mfma(F); } SEAM(2);
    if (IN(3)) { hgrn_simple<true>(F); } SEAM(3);
    if (IN(4)) {
        { pg8::StaticOrder S; S.init(F.dout + DO_YA, F.ws + WS_WA, T, 1024, 384, F.G, (int)blockIdx.x); pg8::EpiMerge<0> E{(const bf16*)(F.ws + WS_PG), (bf16*)(F.ws + WS_MIXED)};
          pg8::gemm_phase<pg8::EpiMerge<0>, pg8::StaticOrder, false>(ring, 384, S, E, F.wave); }
        { pg8::StaticOrder S; S.init(F.dout + DO_YB, F.ws + WS_WB, T, 1024, 384, F.G, (int)blockIdx.x); pg8::EpiMerge<1> E{(const bf16*)(F.ws + WS_PG), (bf16*)(F.ws + WS_MIXED)};
          pg8::gemm_phase<pg8::EpiMerge<1>, pg8::StaticOrder, false>(ring, 384, S, E, F.wave); }
        { pg8::StaticOrder S; S.init(F.dout + DO_YC, F.ws + WS_WC, T, 1024, 256, F.G, (int)blockIdx.x); pg8::EpiMerge<2> E{(const bf16*)(F.ws + WS_PG), (bf16*)(F.ws + WS_MIXED)};
          pg8::gemm_phase<pg8::EpiMerge<2>, pg8::StaticOrder, false>(ring, 256, S, E, F.wave); }
    } SEAM(4);
    if (IN(5)) {
        pg8::StaticOrder S; S.init(F.ws + WS_MIXED, F.ws + WS_WOUT, T, 1024, 1024, F.G, (int)blockIdx.x); pg8::EpiOut E{arg_in(I_X), (float*)F.dout};
        pg8::gemm_phase<pg8::EpiOut, pg8::StaticOrder, false>(ring, 1024, S, E, F.wave);
    } SEAM(5);
    if (IN(6)) { p6_route(F); } SEAM(6);
    if (IN(7)) {
        moe_load_segs(F);
        pg8::MoeOrder S; S.pre = (const LAS int*)(F.lds + LDS_PRE); S.cnt = S.pre + 132; S.seg_lo = 0; S.nseg = NSEG; S.nN = 2; S.G = F.G; S.c = F.vcu;
        S.A = (const char*)(F.ws + WS_U); S.Bt = (const char*)(F.ws + WS_WUP); S.a_tstep = 0; S.b_estride = (size_t)512 * 1024 * 2; S.b_tstep = (size_t)256 * 1024 * 2; S.slot = (const int*)(F.ws + WS_SLOT); S.gather = true;
        pg8::EpiUp E{(bf16*)(F.ws + WS_HID)};
        pg8::gemm_phase<pg8::EpiUp, pg8::MoeOrder, true>(ring, 1024, S, E, F.wave);
    } SEAM(7);
#define DOWN_PHASE(hf) do { moe_load_segs(F); \
        pg8::MoeOrder S; S.pre = (const LAS int*)(F.lds + LDS_PRE); S.cnt = S.pre + 132; S.seg_lo = (hf) * NSEGH; S.nseg = NSEGH; S.nN = 4; S.G = F.G; S.c = F.vcu; \
        S.A = (const char*)(F.ws + WS_HID); S.Bt = (const char*)(F.ws + WS_WDN); S.a_tstep = (size_t)256 * 256 * 2; S.b_estride = (size_t)1024 * 256 * 2; S.b_tstep = (size_t)256 * 256 * 2; S.slot = (const int*)(F.ws + WS_SLOT); S.gather = false; \
        pg8::EpiDown E{(const int*)(F.ws + WS_SLOT), (const float*)(F.ws + WS_WFLAT), (bf16*)(F.ws + WS_YBUF), (float*)F.dout, (hf)}; \
        pg8::gemm_phase<pg8::EpiDown, pg8::MoeOrder, false>(ring, 256, S, E, F.wave); } while (0)
    if (IN(8)) { DOWN_PHASE(0); } SEAM(8);
    if (IN(9)) { p_combine(F, 0); } SEAM(9);
    if (IN(10)) { DOWN_PHASE(1); } SEAM(10);
    if (IN(11)) { p_combine(F, 1); }
#undef IN
#undef SEAM
}

extern "C" void kernel_launch(void* const* d_in, const int* in_sizes, int n_in, void* d_out, int out_size, void* d_ws, size_t ws_size, hipStream_t stream) {
    static int grid = 0;
    if (grid == 0) {
        if (n_in != 24 || out_size != T * D || ws_size < WS_END) { fprintf(stderr, "kernel_launch: unexpected shapes (n_in %d out %d ws %zu)\n", n_in, out_size, ws_size); grid = -1; return; }
        int dev = 0, cus = 0, per_cu = 0;
        if (hipGetDevice(&dev) != hipSuccess || hipDeviceGetAttribute(&cus, hipDeviceAttributeMultiprocessorCount, dev) != hipSuccess) { grid = -1; return; }
        if (hipFuncSetAttribute((const void*)mk_fwd, hipFuncAttributeMaxDynamicSharedMemorySize, LDS_BYTES) != hipSuccess) { fprintf(stderr, "kernel_launch: hipFuncSetAttribute failed\n"); grid = -1; return; }
        if (hipOccupancyMaxActiveBlocksPerMultiprocessor(&per_cu, (const void*)mk_fwd, 512, LDS_BYTES) != hipSuccess || per_cu < 1) fprintf(stderr, "kernel_launch: occupancy query says %d\n", per_cu);
        (void)hipGetLastError();
        grid = cus;
    }
    if (grid < 0) return;
    (void)hipMemsetAsync((char*)d_ws + WS_CTL, 0, CTL_ZERO_BYTES, stream);
    Args a{};
    for (int i = 0; i < 24; ++i) a.in[i] = (const float*)d_in[i];
    a.out = (float*)d_out; a.ws = (unsigned char*)d_ws;
    for (int li = 0; li < MK_N_LAUNCHES; ++li) {
        a.ph_lo = (MK_N_LAUNCHES == 1) ? 0 : li; a.ph_hi = (MK_N_LAUNCHES == 1) ? NPHASE : li + 1; a.li = li;
        hipLaunchKernelGGL(mk_fwd, dim3(grid), dim3(512), LDS_BYTES, stream, a);
    }
}
```

```cpp
#include <hip/hip_runtime.h>
#include <cstdio>
#include <cstdint>

#define GAS __attribute__((address_space(1)))
#define LAS __attribute__((address_space(3)))
typedef unsigned short bf16;
typedef unsigned v4u __attribute__((ext_vector_type(4)));
typedef unsigned v2u __attribute__((ext_vector_type(2)));
typedef float f32x4 __attribute__((ext_vector_type(4)));
typedef float f32x2 __attribute__((ext_vector_type(2)));
typedef short bf16x8 __attribute__((ext_vector_type(8)));
typedef GAS unsigned gu32;
#define RLX_AGENT __ATOMIC_RELAXED, __HIP_MEMORY_SCOPE_AGENT
#define LDS_WAIT() asm volatile("s_waitcnt lgkmcnt(0)" ::: "memory")
#define VM_WAIT() asm volatile("s_waitcnt vmcnt(0)" ::: "memory")

#ifndef MK_N_LAUNCHES
#define MK_N_LAUNCHES 1
#endif

constexpr int T = 65536, D = 1024, SEQ = 2048, NB = 32, MEML = 256;
constexpr int NPROJ = 5760, NPROJ_PAD = 5888;
constexpr int LD_PA = 1152, LD_PB = 1280, LD_PC = 256, LD_PG = 3072;
constexpr int NEXP = 64, NSEGH = 65, NSEG = 130, SLOT_CAP = 32768, HALF_T = 32768;
constexpr float EPS = 1e-6f;
constexpr int NPHASE = 12;

constexpr size_t MiB = 1u << 20;
constexpr size_t WS_CTL = 0, CTL_ZERO_BYTES = 1 * MiB;
constexpr size_t WS_TAB = 1 * MiB;
constexpr size_t WS_WIN = 2 * MiB;
constexpr size_t WS_WMEM = 14 * MiB;
constexpr size_t WS_WA = 15 * MiB;
constexpr size_t WS_WB = WS_WA + 768 * 1024;
constexpr size_t WS_WC = WS_WB + 768 * 1024;
constexpr size_t WS_WOUT = 17 * MiB;
constexpr size_t WS_WUP = 19 * MiB;
constexpr size_t WS_WDN = 84 * MiB;
constexpr size_t WS_MEMN = 117 * MiB;
constexpr size_t WS_MEMK = 133 * MiB, WS_MEMV = 137 * MiB;
constexpr size_t WS_ACT = 141 * MiB;
constexpr size_t WS_PG = WS_ACT;
constexpr size_t WS_PA = WS_PG + 384 * MiB;
constexpr size_t WS_PB = WS_PA + 144 * MiB;
constexpr size_t WS_PC = WS_PB + 160 * MiB;
constexpr size_t WS_LST = WS_PC + 32 * MiB;
constexpr size_t WS_DEC = WS_LST + 96 * MiB;
constexpr size_t WS_MIXED = WS_PA;
constexpr size_t WS_HID = WS_ACT;
constexpr size_t WS_SLOT = WS_HID + 304 * MiB;
constexpr size_t WS_WFLAT = WS_SLOT + 17 * MiB;
constexpr size_t WS_U = WS_WFLAT + 2 * MiB;
constexpr size_t WS_YBUF = WS_U;
constexpr size_t WS_END = WS_YBUF + 512 * MiB;
static_assert(WS_DEC + 1 * MiB <= 1024 * MiB && WS_END <= 1024 * MiB, "ws map");
static_assert(WS_WDN + (size_t)65 * 1024 * 256 * 2 <= WS_MEMN && WS_WUP + (size_t)65 * 512 * 1024 * 2 <= WS_WDN, "weights map");
constexpr size_t DO_YA = 0, DO_YB = 48 * MiB, DO_YC = 96 * MiB;
constexpr int CW_BAR = 4096;
constexpr int CW_CNT = 16384;

constexpr int RING_BYTES = 131072;
constexpr int LDS_GTAB = RING_BYTES;
constexpr int LDS_PRE = LDS_GTAB + 2048;
constexpr int LDS_BYTES = 163840;
constexpr int LDS_MISC = LDS_BYTES - 256;
static_assert(LDS_MISC + 256 <= LDS_BYTES, "lds map");

__device__ __forceinline__ int lane_id_fresh() { int l = __builtin_amdgcn_mbcnt_hi(0xffffffffu, __builtin_amdgcn_mbcnt_lo(0xffffffffu, 0u)); asm volatile("" : "+v"(l)); return l; }
typedef __bf16 bf16v2_t __attribute__((ext_vector_type(2)));
__device__ __forceinline__ unsigned cvt_pk_bf16(float lo, float hi) { const bf16v2_t v = {(__bf16)lo, (__bf16)hi}; return __builtin_bit_cast(unsigned, v); }
__device__ __forceinline__ float bf_lo(unsigned w) { return __uint_as_float(w << 16); }
__device__ __forceinline__ float bf_hi(unsigned w) { return __uint_as_float(w & 0xffff0000u); }
__device__ __forceinline__ float bf2f(bf16 b) { return __uint_as_float(((unsigned)b) << 16); }
__device__ __forceinline__ bf16 f2bf(float f) { return (bf16)(cvt_pk_bf16(f, 0.f) & 0xffffu); }
__device__ __forceinline__ float sigmoidf_(float x) { return __builtin_amdgcn_rcpf(1.0f + __builtin_amdgcn_exp2f(-1.44269504f * x)); }
__device__ __forceinline__ float readlane_f(float v, int l) { return __int_as_float(__builtin_amdgcn_readlane(__float_as_int(v), l)); }
__device__ __forceinline__ float wave_sum(float v) {
#pragma unroll
    for (int o = 1; o < 64; o <<= 1) v += __shfl_xor(v, o);
    return v;
}
__device__ __forceinline__ float wave_max(float v) {
#pragma unroll
    for (int o = 1; o < 64; o <<= 1) v = fmaxf(v, __shfl_xor(v, o));
    return v;
}

#define XB_TMO      128
#define XB_XCNT(j)  (256  + 64 * (j))
#define XB_XSUB(j)  (1280 + 64 * (j))
#define XB_XGEN(j)  (2304 + 64 * (j))
#define XB_TOP      3328
#define XB_TOPGEN   3392
#define XCD_BAR_WORDS 3456
#define XB_SPIN_CAP (1u << 22)
__device__ __forceinline__ unsigned xb_ld(unsigned* p)              { return __hip_atomic_load(p, __ATOMIC_RELAXED, __HIP_MEMORY_SCOPE_AGENT); }
__device__ __forceinline__ unsigned xb_add(unsigned* p, unsigned v) { return __hip_atomic_fetch_add(p, v, __ATOMIC_RELAXED, __HIP_MEMORY_SCOPE_AGENT); }
__device__ __forceinline__ unsigned xb_xcc_id() { return (unsigned)__builtin_amdgcn_s_getreg((3 << 11) | 20) & 0xFu; }
#define XB_SPIN(cond, bar) do { unsigned _sp = 0; while (cond) { __builtin_amdgcn_s_sleep(1); \
    if ((++_sp & 255u) == 0u) { if (xb_ld(&(bar)[XB_TMO])) break; if (_sp > XB_SPIN_CAP) { atomicAdd(&(bar)[XB_TMO], 1u); break; } } } } while (0)
struct XcdBarrier { unsigned* bar; unsigned x; volatile LAS unsigned* st; };
__device__ __forceinline__ XcdBarrier xcd_barrier_post(unsigned* bar, volatile LAS unsigned* st) {
    XcdBarrier b; b.bar = bar; b.x = xb_xcc_id(); b.st = st;
    if (threadIdx.x == 0) (void)xb_add(&bar[XB_XCNT(b.x)], 1u);
    return b;
}
__device__ __forceinline__ void xcd_barrier_complete(unsigned* bar, unsigned x, unsigned& nloc, unsigned& nx) {
    const unsigned G = gridDim.x * gridDim.y * gridDim.z;
    unsigned sum, cnt, mine, sp = 0u;
    for (;;) {
        sum = 0u; cnt = 0u; mine = 0u;
#pragma unroll
        for (unsigned j = 0; j < 16; ++j) { const unsigned c = xb_ld(&bar[XB_XCNT(j)]); sum += c; cnt += (c > 0u) ? 1u : 0u; mine = (j == x) ? c : mine; }
        if (sum == G) break;
        __builtin_amdgcn_s_sleep(1);
        if ((++sp & 255u) == 0u) { if (xb_ld(&bar[XB_TMO])) break; if (sp > XB_SPIN_CAP) { atomicAdd(&bar[XB_TMO], 1u); break; } }
    }
    nloc = mine > 0u ? mine : 1u; nx = cnt > 0u ? cnt : 1u;
}
__device__ __forceinline__ void xcd_barrier(const XcdBarrier& b, const int wave) {
    asm volatile("s_waitcnt vmcnt(0)" ::: "memory");
    __syncthreads();
    if (wave == 0 && lane_id_fresh() == 0) {
        unsigned* bar = b.bar;
        __builtin_amdgcn_s_waitcnt(0);
        unsigned nloc = b.st[0], nx = b.st[1];
        if (nloc == 0u) { xcd_barrier_complete(bar, b.x, nloc, nx); b.st[0] = nloc; b.st[1] = nx; }
        const unsigned old = xb_add(&bar[XB_XSUB(b.x)], 1u);
        const unsigned gen = old / nloc;
        if (old + 1u == (gen + 1u) * nloc) {
            __builtin_amdgcn_fence(__ATOMIC_RELEASE, "agent");
            asm volatile("s_waitcnt vmcnt(0)" ::: "memory");
            const unsigned og = xb_add(&bar[XB_TOP], 1u);
            const unsigned tg = og / nx;
            if (og + 1u == (tg + 1u) * nx) xb_add(&bar[XB_TOPGEN], 1u);
            else XB_SPIN(xb_ld(&bar[XB_TOPGEN]) == tg, bar);
            __builtin_amdgcn_fence(__ATOMIC_ACQUIRE, "agent");
            xb_add(&bar[XB_XGEN(b.x)], 1u);
            asm volatile("s_waitcnt vmcnt(0)" ::: "memory");
        } else {
            XB_SPIN(xb_ld(&bar[XB_XGEN(b.x)]) == gen, bar);
            __builtin_amdgcn_fence(__ATOMIC_ACQUIRE, "agent");
            asm volatile("s_waitcnt vmcnt(0)" ::: "memory");
        }
    }
    __syncthreads();
}

namespace pg8 {
constexpr int BM = 256, BK = 64, HALF = 128, HTB = HALF * BK * 2, NXCD = 8, WGM = 8;
__host__ __device__ __forceinline__ int lds_byte(int r, int c) { const int st = (r >> 4) * 2 + (c >> 5), rr = r & 15, cc = c & 31, ob = rr * 64 + cc * 2; return st * 1024 + (ob ^ (((ob >> 9) & 1) << 5)); }
__host__ __device__ __forceinline__ void stage_rc(int b, int& R, int& C) { const int st = b / 1024, sb = b % 1024, swz = sb ^ (((sb >> 9) & 1) << 5); R = (st >> 1) * 16 + swz / 64; C = (st & 1) * 32 + (swz % 64) / 2; }
__host__ __device__ __forceinline__ int perm32(int rho) { const int n = rho >> 4, i = rho & 15; return 8 * (i >> 2) + 4 * n + (i & 3); }

struct Unit { int pm, pn; const char* a; const char* b; int rows, seg, j; };

struct StaticOrder {
    int nM, nN, nwg, G, c; const char* A; const char* Bt; size_t tstep;
    __device__ void init(const void* A_, const void* Bt_, int M, int N, int K, int G_, int c_) { A = (const char*)A_; Bt = (const char*)Bt_; nM = M / BM; nN = N / BM; nwg = nM * nN; G = G_; c = c_; tstep = (size_t)BM * K * 2; }
    __device__ bool next(int i, Unit& u) const {
        const long L = (long)i * G + c; if (L >= nwg) return false;
        int wgid = (int)L; { const int q = nwg / NXCD, r = nwg % NXCD, xcd = wgid % NXCD, off = wgid / NXCD; wgid = (xcd < r ? xcd * (q + 1) : r * (q + 1) + (xcd - r) * q) + off; }
        const int nig = WGM * nN, gid = wgid / nig, fm = gid * WGM, gsz = (nM - fm) < WGM ? (nM - fm) : WGM;
        u.pm = fm + ((wgid % nig) % gsz); u.pn = (wgid % nig) / gsz; u.a = A + (size_t)u.pm * tstep; u.b = Bt + (size_t)u.pn * tstep; u.rows = 256; u.seg = 0; u.j = 0; return true;
    }
    __device__ __forceinline__ const int* tab_src(const Unit&) const { return nullptr; }
};
struct MoeOrder {
    const LAS int* pre; const LAS int* cnt; int seg_lo, nseg, nN, G, c; const char* A; const char* Bt; size_t a_tstep, b_estride, b_tstep; const int* slot; bool gather;
    __device__ bool next(int i, Unit& u) const {
        const long L = (long)i * G + c; const int b0 = __builtin_amdgcn_readfirstlane(pre[seg_lo]), total = __builtin_amdgcn_readfirstlane(pre[seg_lo + nseg]) - b0;
        const int br = (int)(L / nN); if (br >= total) return false;
        const int blk = b0 + br; u.pn = (int)(L % nN); u.pm = blk;
        int lo = seg_lo, hi = seg_lo + nseg;
        while (hi - lo > 1) { const int mid = (lo + hi) >> 1; if (__builtin_amdgcn_readfirstlane(pre[mid]) <= blk) lo = mid; else hi = mid; }
        u.seg = lo; u.j = blk - __builtin_amdgcn_readfirstlane(pre[lo]); const int rem = __builtin_amdgcn_readfirstlane(cnt[lo]) - u.j * 256; u.rows = rem < 256 ? rem : 256;
        const int e = lo % NSEGH;
        u.a = gather ? A : A + (size_t)blk * a_tstep; u.b = Bt + (size_t)e * b_estride + (size_t)u.pn * b_tstep; return true;
    }
    __device__ __forceinline__ const int* tab_src(const Unit& u) const { return slot + (size_t)u.seg * SLOT_CAP + u.j * 256; }
};

template <class Epi, class Sched, bool GATHER>
__device__ __forceinline__ void gemm_phase(LAS unsigned char* lds, const int K, const Sched& S, const Epi& E, const int wave) {
    const int lane = lane_id_fresh(), wid = wave, tid = wid * 64 + lane, wr = wid >> 2, wc = wid & 3, fr = lane & 15, fq = lane >> 4; (void)fr; (void)fq;
    const int nt = K / BK;
    unsigned voffA[2][2], voffB[2];
#pragma unroll
    for (int i = 0; i < 2; ++i) { int R, C; stage_rc(tid * 16 + i * 8192, R, C); const int Rb = Epi::PERM ? ((R & ~31) + perm32(R & 31)) : R;
        voffB[i] = (unsigned)(Rb * K + C) * 2u;
#pragma unroll
        for (int h = 0; h < 2; ++h) voffA[h][i] = (unsigned)(R * K + C) * 2u; }
    const size_t kstep = (size_t)(BK * 2);
    const size_t hstep = (size_t)HALF * K * 2;
    const unsigned ldsw = (unsigned)wid * 1024u;
    const int aoff = lds_byte(wr * 64 + fr, fq * 8), boff = lds_byte(wc * 32 + fr, fq * 8);
    const LAS int* gtab = (const LAS int*)(lds + LDS_GTAB);
#define PG8_SA(b, h) (((b) * 2 + (h)) * HTB)
#define PG8_SB(b, h) ((4 + (b) * 2 + (h)) * HTB)
#define PG8_STAGE_A(bufoff, gbase, h) do { _Pragma("unroll") for (int _i = 0; _i < 2; ++_i) \
        __builtin_amdgcn_global_load_lds((const unsigned*)((const char*)(gbase) + (GATHER ? (size_t)0 : (size_t)(h) * hstep) + voffA[GATHER ? (h) : 0][_i]), (LAS unsigned*)(lds + (bufoff) + ldsw + _i * 8192), 16, 0, 0); } while (0)
#define PG8_STAGE_B(bufoff, gbase) do { _Pragma("unroll") for (int _i = 0; _i < 2; ++_i) \
        __builtin_amdgcn_global_load_lds((const unsigned*)((const char*)(gbase) + voffB[_i]), (LAS unsigned*)(lds + (bufoff) + ldsw + _i * 8192), 16, 0, 0); } while (0)
#define PG8_LDA(dst, b, h) do { _Pragma("unroll") for (int m = 0; m < 4; ++m) _Pragma("unroll") for (int k = 0; k < 2; ++k) dst[m][k] = *(const LAS bf16x8*)(lds + PG8_SA(b, h) + aoff + m * 2048 + k * 1024); } while (0)
#define PG8_LDB(dst, b, h) do { _Pragma("unroll") for (int n = 0; n < 2; ++n) _Pragma("unroll") for (int k = 0; k < 2; ++k) dst[n][k] = *(const LAS bf16x8*)(lds + PG8_SB(b, h) + boff + n * 2048 + k * 1024); } while (0)
#define PG8_MMA(ai, bj, At, Bt) do { __builtin_amdgcn_s_setprio(1); _Pragma("unroll") for (int m = 0; m < 4; ++m) _Pragma("unroll") for (int n = 0; n < 2; ++n) _Pragma("unroll") for (int k = 0; k < 2; ++k) \
        acc[ai][bj][m][n] = __builtin_amdgcn_mfma_f32_16x16x32_bf16(Bt[n][k], At[m][k], acc[ai][bj][m][n], 0, 0, 0); __builtin_amdgcn_s_setprio(0); } while (0)
#define PG8_WAIT_V(n) asm volatile("s_waitcnt vmcnt(" #n ")" ::: "memory")
#define PG8_WAIT_L(n) asm volatile("s_waitcnt lgkmcnt(" #n ")" ::: "memory")
#define PG8_BAR __builtin_amdgcn_s_barrier()
#define PG8_SCHED __builtin_amdgcn_sched_barrier(0)
#define PG8_GOFFS(u, tb) do { _Pragma("unroll") for (int _h = 0; _h < 2; ++_h) _Pragma("unroll") for (int _i = 0; _i < 2; ++_i) { int _R, _C; stage_rc(tid * 16 + _i * 8192, _R, _C); \
        const int _rr = _h * HALF + _R; const int _v = gtab[(tb) * 256 + _rr]; const unsigned _tok = (_rr < (u).rows) ? (unsigned)(_v >> 3) : 0u; voffA[_h][_i] = _tok * (unsigned)(K * 2) + (unsigned)(_C * 2); } } while (0)
#define PG8_GTAB_DMA(u, tb) do { if (wid < 4) __builtin_amdgcn_global_load_lds((const unsigned*)(S.tab_src(u) + wid * 64 + lane), (LAS unsigned*)(lds + LDS_GTAB + (tb) * 1024 + wid * 256), 4, 0, 0); } while (0)
    Unit cur, nxt; int ui = 0;
    if (!S.next(0, cur)) return;
    f32x4 acc[2][2][4][2];
#pragma unroll
    for (int a = 0; a < 2; ++a)
#pragma unroll
        for (int b = 0; b < 2; ++b)
#pragma unroll
            for (int m = 0; m < 4; ++m)
#pragma unroll
                for (int n = 0; n < 2; ++n) acc[a][b][m][n] = (f32x4){0.f, 0.f, 0.f, 0.f};
    bf16x8 At[4][2], B0[2][2], B1[2][2];
    const char* cA = cur.a; const char* cB = cur.b;
    if constexpr (GATHER) { PG8_GTAB_DMA(cur, 0); PG8_WAIT_V(0); PG8_BAR; PG8_GOFFS(cur, 0); }
    PG8_STAGE_B(PG8_SB(0, 0), cB); PG8_STAGE_B(PG8_SB(0, 1), cB + hstep); PG8_STAGE_A(PG8_SA(0, 0), cA, 0); PG8_STAGE_A(PG8_SA(0, 1), cA, 1);
    if (wr == 1) PG8_BAR;
    PG8_WAIT_V(2); PG8_BAR;
    PG8_STAGE_B(PG8_SB(1, 0), cB + kstep); PG8_STAGE_A(PG8_SA(1, 0), cA + kstep, 0); PG8_STAGE_B(PG8_SB(1, 1), cB + hstep + kstep);
    PG8_WAIT_V(6); PG8_BAR;
    for (;;) {
        const bool has_next = S.next(ui + 1, nxt);
        const char* nA = has_next ? nxt.a : cA; const char* nB = has_next ? nxt.b : cB;
        for (int t = 0; t < nt; t += 2) {
            const bool last = (t == nt - 2);
            const char* a1 = cA + (size_t)(t + 1) * kstep;
            const char* a2 = last ? nA : cA + (size_t)(t + 2) * kstep; const char* b2 = last ? nB : cB + (size_t)(t + 2) * kstep;
            const char* a3 = a2 + kstep; const char* b3 = b2 + kstep;
            if constexpr (GATHER) { if (t == 0 && has_next) PG8_GTAB_DMA(nxt, (ui + 1) & 1); }
            PG8_LDB(B0, 0, 0); PG8_LDB(B1, 0, 1); PG8_SCHED; PG8_LDA(At, 0, 0); PG8_STAGE_A(PG8_SA(1, 1), a1, 1);
            PG8_WAIT_V(8); PG8_WAIT_L(0); PG8_BAR; PG8_MMA(0, 0, At, B0); PG8_MMA(0, 1, At, B1); PG8_BAR; PG8_SCHED;
            if constexpr (GATHER) { if (last && has_next) PG8_GOFFS(nxt, (ui + 1) & 1); }
            PG8_LDA(At, 0, 1); PG8_STAGE_B(PG8_SB(0, 0), b2); PG8_STAGE_B(PG8_SB(0, 1), b2 + hstep); PG8_STAGE_A(PG8_SA(0, 0), a2, 0);
            PG8_WAIT_V(8); PG8_WAIT_L(0); PG8_BAR; PG8_MMA(1, 0, At, B0); PG8_MMA(1, 1, At, B1); PG8_BAR; PG8_SCHED;
            PG8_LDB(B0, 1, 0); PG8_LDB(B1, 1, 1); PG8_SCHED; PG8_LDA(At, 1, 0); PG8_STAGE_A(PG8_SA(0, 1), a2, 1);
            PG8_WAIT_V(8); PG8_WAIT_L(0); PG8_BAR; PG8_MMA(0, 0, At, B0); PG8_MMA(0, 1, At, B1); PG8_BAR; PG8_SCHED;
            PG8_LDA(At, 1, 1); PG8_STAGE_B(PG8_SB(1, 0), b3); PG8_STAGE_B(PG8_SB(1, 1), b3 + hstep); PG8_STAGE_A(PG8_SA(1, 0), a3, 0);
            PG8_WAIT_V(8); PG8_WAIT_L(0); PG8_BAR; PG8_MMA(1, 0, At, B0); PG8_MMA(1, 1, At, B1); PG8_BAR; PG8_SCHED;
        }
        if (wr == 0) PG8_BAR;
        { const int l2 = lane_id_fresh(); E(acc, cur, wr, wc, l2 & 15, l2 >> 4); }
        if (!has_next) break;
#pragma unroll
        for (int a = 0; a < 2; ++a)
#pragma unroll
            for (int b = 0; b < 2; ++b)
#pragma unroll
                for (int m = 0; m < 4; ++m)
#pragma unroll
                    for (int n = 0; n < 2; ++n) acc[a][b][m][n] = (f32x4){0.f, 0.f, 0.f, 0.f};
        cur = nxt; cA = nA; cB = nB; ++ui;
        if (wr == 1) PG8_BAR;
    }
    PG8_WAIT_V(0);
    PG8_BAR;
#undef PG8_SA
#undef PG8_SB
#undef PG8_STAGE_A
#undef PG8_STAGE_B
#undef PG8_LDA
#undef PG8_LDB
#undef PG8_MMA
#undef PG8_WAIT_V
#undef PG8_WAIT_L
#undef PG8_BAR
#undef PG8_SCHED
#undef PG8_GOFFS
#undef PG8_GTAB_DMA
}

typedef f32x4 Acc[2][2][4][2];
struct EpiProj {
    static constexpr bool PERM = true;
    bf16 *PA, *PB, *PC, *PG; const float *qna, *kna, *qnc;
    __device__ __forceinline__ void operator()(const Acc& acc, const Unit& u, int wr, int wc, int fr, int fq) const {
        const int f0 = u.pn * 256 + wc * 64;
        if (f0 >= NPROJ) return;
        bf16* base; int ld, c0, op; const float* gain = qna; float scale = 1.f;
        if (f0 < 1152) { base = PA; ld = LD_PA; c0 = f0; if (f0 < 384) { op = 1; gain = qna; scale = 0.125f; } else if (f0 < 768) { op = 1; gain = kna; } else op = 0; }
        else if (f0 < 2432) { base = PB; ld = LD_PB; c0 = f0 - 1152; if (c0 < 256) { op = 2; scale = 0.125f; } else if (c0 < 896) op = 0; else op = 2; }
        else if (f0 < 2688) { base = PC; ld = LD_PC; c0 = f0 - 2432; op = 1; gain = qnc; scale = 0.125f; }
        else { base = PG; ld = LD_PG; c0 = f0 - 2688; op = 3; }
        f32x4 g[2][2];
#pragma unroll
        for (int bj = 0; bj < 2; ++bj)
#pragma unroll
            for (int n = 0; n < 2; ++n) g[bj][n] = (op == 1) ? *(const f32x4*)(gain + 32 * bj + 8 * fq + 4 * n) * scale : (f32x4){scale, scale, scale, scale};
#pragma unroll
        for (int ai = 0; ai < 2; ++ai)
#pragma unroll
            for (int m = 0; m < 4; ++m) {
                const int row = u.pm * BM + ai * HALF + wr * 64 + m * 16 + fr;
                f32x4 v[2][2];
#pragma unroll
                for (int bj = 0; bj < 2; ++bj)
#pragma unroll
                    for (int n = 0; n < 2; ++n) v[bj][n] = acc[ai][bj][m][n];
                if (op == 1) {
                    float ss = 0.f;
#pragma unroll
                    for (int bj = 0; bj < 2; ++bj)
#pragma unroll
                        for (int n = 0; n < 2; ++n) ss += (v[bj][n][0] * v[bj][n][0] + v[bj][n][1] * v[bj][n][1]) + (v[bj][n][2] * v[bj][n][2] + v[bj][n][3] * v[bj][n][3]);
                    ss += __shfl_xor(ss, 16); ss += __shfl_xor(ss, 32);
                    const float r = rsqrtf(ss * (1.0f / 64.0f) + EPS);
#pragma unroll
                    for (int bj = 0; bj < 2; ++bj)
#pragma unroll
                        for (int n = 0; n < 2; ++n) v[bj][n] = v[bj][n] * r * g[bj][n];
                } else if (op == 2) {
#pragma unroll
                    for (int bj = 0; bj < 2; ++bj)
#pragma unroll
                        for (int n = 0; n < 2; ++n)
#pragma unroll
                            for (int j = 0; j < 4; ++j) v[bj][n][j] = v[bj][n][j] * sigmoidf_(v[bj][n][j]) * scale;
                } else if (op == 3) {
#pragma unroll
                    for (int bj = 0; bj < 2; ++bj)
#pragma unroll
                        for (int n = 0; n < 2; ++n)
#pragma unroll
                            for (int j = 0; j < 4; ++j) v[bj][n][j] = sigmoidf_(v[bj][n][j]);
                }
                bf16* rowp = base + (size_t)row * ld + c0 + 8 * fq;
#pragma unroll
                for (int bj = 0; bj < 2; ++bj) { v4u w; w.x = cvt_pk_bf16(v[bj][0][0], v[bj][0][1]); w.y = cvt_pk_bf16(v[bj][0][2], v[bj][0][3]); w.z = cvt_pk_bf16(v[bj][1][0], v[bj][1][1]); w.w = cvt_pk_bf16(v[bj][1][2], v[bj][1][3]);
                    *(v4u*)(rowp + 32 * bj) = w; }
            }
    }
};
struct EpiMemKV {
    static constexpr bool PERM = true;
    bf16 *MK, *MV; const float* knc;
    __device__ __forceinline__ void operator()(const Acc& acc, const Unit& u, int wr, int wc, int fr, int fq) const {
        bf16* base = u.pn == 0 ? MK : MV; const bool nrm = (u.pn == 0);
        f32x4 g[2][2];
#pragma unroll
        for (int bj = 0; bj < 2; ++bj)
#pragma unroll
            for (int n = 0; n < 2; ++n) g[bj][n] = *(const f32x4*)(knc + 32 * bj + 8 * fq + 4 * n);
#pragma unroll
        for (int ai = 0; ai < 2; ++ai)
#pragma unroll
            for (int m = 0; m < 4; ++m) {
                const int row = u.pm * BM + ai * HALF + wr * 64 + m * 16 + fr;
                f32x4 v[2][2];
#pragma unroll
                for (int bj = 0; bj < 2; ++bj)
#pragma unroll
                    for (int n = 0; n < 2; ++n) v[bj][n] = acc[ai][bj][m][n];
                if (nrm) {
                    float ss = 0.f;
#pragma unroll
                    for (int bj = 0; bj < 2; ++bj)
#pragma unroll
                        for (int n = 0; n < 2; ++n) ss += (v[bj][n][0] * v[bj][n][0] + v[bj][n][1] * v[bj][n][1]) + (v[bj][n][2] * v[bj][n][2] + v[bj][n][3] * v[bj][n][3]);
                    ss += __shfl_xor(ss, 16); ss += __shfl_xor(ss, 32);
                    const float r = rsqrtf(ss * (1.0f / 64.0f) + EPS);
#pragma unroll
                    for (int bj = 0; bj < 2; ++bj)
#pragma unroll
                        for (int n = 0; n < 2; ++n) v[bj][n] = v[bj][n] * r * g[bj][n];
                }
                bf16* rowp = base + (size_t)row * 256 + wc * 64 + 8 * fq;
#pragma unroll
                for (int bj = 0; bj < 2; ++bj) { v4u w; w.x = cvt_pk_bf16(v[bj][0][0], v[bj][0][1]); w.y = cvt_pk_bf16(v[bj][0][2], v[bj][0][3]); w.z = cvt_pk_bf16(v[bj][1][0], v[bj][1][1]); w.w = cvt_pk_bf16(v[bj][1][2], v[bj][1][3]);
                    *(v4u*)(rowp + 32 * bj) = w; }
            }
    }
};
template <int PASS> struct EpiMerge {
    static constexpr bool PERM = true;
    const bf16* PG; bf16* MX;
    __device__ __forceinline__ void operator()(const Acc& acc, const Unit& u, int wr, int wc, int fr, int fq) const {
#pragma unroll
        for (int ai = 0; ai < 2; ++ai)
#pragma unroll
            for (int m = 0; m < 4; ++m) {
                const int row = u.pm * BM + ai * HALF + wr * 64 + m * 16 + fr;
#pragma unroll
                for (int bj = 0; bj < 2; ++bj) {
                    const int c = u.pn * BM + bj * HALF + wc * 32 + 8 * fq;
                    const v4u gw = *(const v4u*)(PG + (size_t)row * LD_PG + PASS * 1024 + c);
                    bf16* mp = MX + (size_t)row * 1024 + c;
                    v4u pw = (v4u){0u, 0u, 0u, 0u}; if (PASS > 0) pw = *(const v4u*)mp;
                    const f32x4 a0 = acc[ai][bj][m][0], a1 = acc[ai][bj][m][1];
                    float o[8];
                    o[0] = bf_lo(pw.x) + bf_lo(gw.x) * a0[0]; o[1] = bf_hi(pw.x) + bf_hi(gw.x) * a0[1]; o[2] = bf_lo(pw.y) + bf_lo(gw.y) * a0[2]; o[3] = bf_hi(pw.y) + bf_hi(gw.y) * a0[3];
                    o[4] = bf_lo(pw.z) + bf_lo(gw.z) * a1[0]; o[5] = bf_hi(pw.z) + bf_hi(gw.z) * a1[1]; o[6] = bf_lo(pw.w) + bf_lo(gw.w) * a1[2]; o[7] = bf_hi(pw.w) + bf_hi(gw.w) * a1[3];
                    v4u w; w.x = cvt_pk_bf16(o[0], o[1]); w.y = cvt_pk_bf16(o[2], o[3]); w.z = cvt_pk_bf16(o[4], o[5]); w.w = cvt_pk_bf16(o[6], o[7]);
                    *(v4u*)mp = w;
                }
                asm volatile("" ::: "memory");
            }
    }
};
struct EpiOut {
    static constexpr bool PERM = false;
    const float* X; float* O;
    __device__ __forceinline__ void operator()(const Acc& acc, const Unit& u, int wr, int wc, int fr, int fq) const {
#pragma unroll
        for (int ai = 0; ai < 2; ++ai)
#pragma unroll
            for (int m = 0; m < 4; ++m) {
                const size_t off = (size_t)(u.pm * BM + ai * HALF + wr * 64 + m * 16 + fr) * 1024 + u.pn * BM + wc * 32 + 4 * fq;
#pragma unroll
                for (int bj = 0; bj < 2; ++bj)
#pragma unroll
                    for (int n = 0; n < 2; ++n) { const f32x4 xv = *(const f32x4*)(X + off + bj * HALF + n * 16); *(f32x4*)(O + off + bj * HALF + n * 16) = xv + acc[ai][bj][m][n]; }
            }
    }
};
struct EpiUp {
    static constexpr bool PERM = true;
    bf16* HID;
    __device__ __forceinline__ void operator()(const Acc& acc, const Unit& u, int wr, int wc, int fr, int fq) const {
#pragma unroll
        for (int ai = 0; ai < 2; ++ai)
#pragma unroll
            for (int m = 0; m < 4; ++m) {
                const size_t row = (size_t)u.pm * BM + ai * HALF + wr * 64 + m * 16 + fr;
                float o[8];
#pragma unroll
                for (int n = 0; n < 2; ++n)
#pragma unroll
                    for (int j = 0; j < 4; ++j) { const float gt = acc[ai][0][m][n][j], up = acc[ai][1][m][n][j]; o[4 * n + j] = gt * sigmoidf_(gt) * up; }
                v4u w; w.x = cvt_pk_bf16(o[0], o[1]); w.y = cvt_pk_bf16(o[2], o[3]); w.z = cvt_pk_bf16(o[4], o[5]); w.w = cvt_pk_bf16(o[6], o[7]);
                *(v4u*)(HID + row * 256 + u.pn * 128 + wc * 32 + 8 * fq) = w;
            }
    }
};
struct EpiDown {
    static constexpr bool PERM = true;
    const int* slot; const float* wflat; bf16* YB; float* OUT; int half;
    __device__ __forceinline__ void operator()(const Acc& acc, const Unit& u, int wr, int wc, int fr, int fq) const {
        const int e = u.seg % NSEGH;
#pragma unroll
        for (int ai = 0; ai < 2; ++ai)
#pragma unroll
            for (int m = 0; m < 4; ++m) {
                const int r = ai * HALF + wr * 64 + m * 16 + fr;
                if (r < u.rows) {
                    const int flat = slot[(size_t)u.seg * SLOT_CAP + u.j * 256 + r];
                    if (e < NEXP) {
                        const float w = wflat[flat];
                        bf16* rowp = YB + (size_t)(flat - half * (HALF_T * 8)) * 1024 + u.pn * BM + wc * 32 + 8 * fq;
#pragma unroll
                        for (int bj = 0; bj < 2; ++bj) { const f32x4 a0 = acc[ai][bj][m][0] * w, a1 = acc[ai][bj][m][1] * w;
                            v4u o; o.x = cvt_pk_bf16(a0[0], a0[1]); o.y = cvt_pk_bf16(a0[2], a0[3]); o.z = cvt_pk_bf16(a1[0], a1[1]); o.w = cvt_pk_bf16(a1[2], a1[3]);
                            *(v4u*)(rowp + bj * HALF) = o; }
                    } else {
                        float* rowp = OUT + (size_t)(flat >> 3) * 1024 + u.pn * BM + wc * 32 + 8 * fq;
#pragma unroll
                        for (int bj = 0; bj < 2; ++bj)
#pragma unroll
                            for (int n = 0; n < 2; ++n) { f32x4* p = (f32x4*)(rowp + bj * HALF + 4 * n); *p = *p + acc[ai][bj][m][n]; }
                    }
                }
                asm volatile("" ::: "memory");
            }
    }
};
}

__device__ __forceinline__ const float* arg_in(int i) {
    const __attribute__((address_space(4))) char* kp = (const __attribute__((address_space(4))) char*)__builtin_amdgcn_kernarg_segment_ptr();
    asm volatile("" : "+s"(kp));
    return *(const float* const __attribute__((address_space(4)))*)(kp + 8 * i);
}
struct Frame {
    LAS unsigned char* lds;
    int wave, vcu, G;
    unsigned char* ws; unsigned char* dout;
};
enum { I_X = 0, I_MEM, I_ANG, I_WIN, I_QNA, I_KNA, I_RELB, I_LBL, I_ONB, I_MNG, I_WMKV, I_QNC, I_KNC, I_WBA, I_WBB, I_WBC, I_WOUT, I_FNG, I_WR, I_RB, I_WEU, I_WED, I_WSU, I_WSD };

__device__ __forceinline__ void tr_item(const float* W, int ldw, int k0, int n0s, bf16* WT, int K, int n0d, LAS float* scr, int lane) {
#pragma unroll 8
    for (int i = 0; i < 32; ++i) { const int kk = 2 * i + (lane >> 5); scr[kk * 33 + (lane & 31)] = (n0s >= 0) ? W[(size_t)(k0 + kk) * ldw + n0s + (lane & 31)] : 0.f; }
    LDS_WAIT(); asm volatile("" ::: "memory");
    const int c = lane & 7;
#pragma unroll
    for (int j = 0; j < 4; ++j) { const int n = (lane >> 3) + 8 * j; const LAS float* s = scr + (8 * c) * 33 + n;
        v4u o; o.x = cvt_pk_bf16(s[0 * 33], s[1 * 33]); o.y = cvt_pk_bf16(s[2 * 33], s[3 * 33]); o.z = cvt_pk_bf16(s[4 * 33], s[5 * 33]); o.w = cvt_pk_bf16(s[6 * 33], s[7 * 33]);
        *(v4u*)(WT + (size_t)(n0d + n) * K + k0 + 8 * c) = o; }
    LDS_WAIT(); asm volatile("" ::: "memory");
}
__device__ __forceinline__ void rms_row_to_bf16(const float* xrow, const float* g, bf16* orow, int lane) {
    const f32x4* xr = (const f32x4*)xrow + lane; const f32x4* gr = (const f32x4*)g + lane;
    f32x4 v[4]; float s = 0.f;
#pragma unroll
    for (int j = 0; j < 4; ++j) { v[j] = xr[64 * j]; s += (v[j][0] * v[j][0] + v[j][1] * v[j][1]) + (v[j][2] * v[j][2] + v[j][3] * v[j][3]); }
    const float rstd = rsqrtf(wave_sum(s) * (1.f / D) + EPS);
    v2u* o8 = (v2u*)orow + lane;
#pragma unroll
    for (int j = 0; j < 4; ++j) { const f32x4 gg = gr[64 * j]; v2u w; w.x = cvt_pk_bf16(v[j][0] * rstd * gg[0], v[j][1] * rstd * gg[1]); w.y = cvt_pk_bf16(v[j][2] * rstd * gg[2], v[j][3] * rstd * gg[3]); o8[64 * j] = w; }
}
__device__ __forceinline__ int t5_bucket(int dist) {
    if (dist < 16) return dist;
    const int large = 16 + (int)(logf((float)dist / 16.0f) / 4.852030263919617f * 16.0f);
    return large < 31 ? large : 31;
}
__device__ __forceinline__ void p0_prologue(Frame& F) {
    const int lane = lane_id_fresh(); const int tid = F.wave * 64 + lane; (void)tid;
    LAS float* scr = (LAS float*)(F.lds + F.wave * 16384);
    const int gw = F.vcu * 8 + F.wave, NGW = F.G * 8;
    constexpr int I0 = 16 * 184, I1 = 16 * 16, I2 = 6 * 32, I3 = 6 * 32, I4 = 4 * 32, I5 = 16 * 32, I6 = 65 * 256, I7 = 65 * 128;
    constexpr int NITEMS = I0 + I1 + I2 + I3 + I4 + I5 + I6 + I7;
    for (int it = gw; it < NITEMS; it += NGW) {
        int r = it;
        if (r < I0 + I1) {
            const bool first = r < I0; if (!first) r -= I0;
            const int nblk = first ? 184 : 16, nsrc = first ? NPROJ : 512;
            const int kb = r / nblk, nbd = r % nblk, tile = nbd >> 3, within = nbd & 7, bj = within >> 2, wc = within & 3;
            const int srcb = tile * 8 + 2 * wc + bj;
            const int n0s = (srcb * 32 < nsrc) ? srcb * 32 : -1;
            tr_item(first ? arg_in(I_WIN) : arg_in(I_WMKV), nsrc, kb * 64, n0s, (bf16*)(F.ws + (first ? WS_WIN : WS_WMEM)), 1024, nbd * 32, scr, lane);
            continue;
        }
        r -= I0 + I1;
        if (r < I2) { tr_item(arg_in(I_WBA), 1024, (r / 32) * 64, (r % 32) * 32, (bf16*)(F.ws + WS_WA), 384, (r % 32) * 32, scr, lane); continue; } r -= I2;
        if (r < I3) { tr_item(arg_in(I_WBB), 1024, (r / 32) * 64, (r % 32) * 32, (bf16*)(F.ws + WS_WB), 384, (r % 32) * 32, scr, lane); continue; } r -= I3;
        if (r < I4) { tr_item(arg_in(I_WBC), 1024, (r / 32) * 64, (r % 32) * 32, (bf16*)(F.ws + WS_WC), 256, (r % 32) * 32, scr, lane); continue; } r -= I4;
        if (r < I5) { tr_item(arg_in(I_WOUT), 1024, (r / 32) * 64, (r % 32) * 32, (bf16*)(F.ws + WS_WOUT), 1024, (r % 32) * 32, scr, lane); continue; } r -= I5;
        if (r < I6) {
            const int e = r / 256, q = r % 256, kb = q / 16, nbd = q % 16, pn = nbd >> 3, within = nbd & 7, bj = within >> 2, qq = within & 3;
            const int srcb = bj * 8 + pn * 4 + qq;
            const float* W = (e < 64) ? arg_in(I_WEU) + (size_t)e * 1024 * 512 : arg_in(I_WSU);
            tr_item(W, 512, kb * 64, srcb * 32, (bf16*)(F.ws + WS_WUP) + (size_t)e * 512 * 1024, 1024, nbd * 32, scr, lane);
            continue;
        }
        r -= I6;
        {   const int e = r / 128, q = r % 128, kb = q / 32, nb = q % 32;
            const float* W = (e < 64) ? arg_in(I_WED) + (size_t)e * 256 * 1024 : arg_in(I_WSD);
            tr_item(W, 1024, kb * 64, nb * 32, (bf16*)(F.ws + WS_WDN) + (size_t)e * 1024 * 256, 256, nb * 32, scr, lane); }
    }
    for (int m = gw; m < T; m += NGW) rms_row_to_bf16(arg_in(I_X) + (size_t)m * D, arg_in(I_ANG), (bf16*)F.dout + (size_t)m * D, lane);
    for (int m = gw; m < NB * MEML; m += NGW) rms_row_to_bf16(arg_in(I_MEM) + (size_t)m * D, arg_in(I_MNG), (bf16*)(F.ws + WS_MEMN) + (size_t)m * D, lane);
    for (int i = F.vcu * 512 + tid; i < 64 * 1024; i += F.G * 512) { const int e = i >> 10, k = i & 1023; const float w = arg_in(I_WR)[(size_t)k * 64 + e];
        const unsigned hi = cvt_pk_bf16(w, 0.f) & 0xffffu; const float lo = w - __uint_as_float(hi << 16);
        ((bf16*)(F.ws + WS_TAB + 65536))[i] = (bf16)hi; ((bf16*)(F.ws + WS_TAB + 65536))[65536 + i] = f2bf(lo); }
    if (F.vcu == 0) {
        float* tab = (float*)(F.ws + WS_TAB);
        for (int i = tid; i < 3 * 129 * 6; i += 512) { const int h = i % 6, st = (i / 6) % 129, p = i / (6 * 129); tab[i] = arg_in(I_RELB)[t5_bucket(st << (2 * p)) * 6 + h]; }
        if (tid < 256) { const float a0 = arg_in(I_LBL)[tid], a1 = arg_in(I_LBL)[256 + tid]; tab[4096 + tid] = 1.0f / (1.0f + __expf(a1 - a0)); }
    }
}

template <int NR, class EntF>
__device__ __forceinline__ void attn_wave_simple(const bf16* qrow, const char* KB, const char* VB, const EntF& ent, bf16* orow, LAS float* wscr, int lane) {
    float q[64];
    { const v4u* qp = (const v4u*)qrow;
#pragma unroll
      for (int i = 0; i < 8; ++i) { const v4u w = qp[i]; q[8 * i + 0] = bf_lo(w.x); q[8 * i + 1] = bf_hi(w.x); q[8 * i + 2] = bf_lo(w.y); q[8 * i + 3] = bf_hi(w.y); q[8 * i + 4] = bf_lo(w.z); q[8 * i + 5] = bf_hi(w.z); q[8 * i + 6] = bf_lo(w.w); q[8 * i + 7] = bf_hi(w.w); } }
    float mx = -3.0e38f;
    LAS unsigned* vscr = (LAS unsigned*)(wscr + NR * 64);
#pragma unroll 1
    for (int r = 0; r < NR; ++r) {
        unsigned koff = 0, voff = 0; float bias = 0.f;
        const bool valid = ent(r * 64 + lane, koff, voff, bias);
        const v4u* kp = (const v4u*)(KB + koff);
        float d0 = 0.f, d1 = 0.f;
#pragma unroll
        for (int i = 0; i < 8; ++i) { const v4u w = kp[i];
            d0 += q[8 * i + 0] * bf_lo(w.x) + q[8 * i + 2] * bf_lo(w.y) + q[8 * i + 4] * bf_lo(w.z) + q[8 * i + 6] * bf_lo(w.w);
            d1 += q[8 * i + 1] * bf_hi(w.x) + q[8 * i + 3] * bf_hi(w.y) + q[8 * i + 5] * bf_hi(w.z) + q[8 * i + 7] * bf_hi(w.w); }
        const float sv = valid ? (d0 + d1 + bias) : -3.0e38f; wscr[r * 64 + lane] = sv; vscr[r * 64 + lane] = voff; mx = fmaxf(mx, sv);
    }
    mx = wave_max(mx);
    float l = 0.f;
#pragma unroll 1
    for (int r = 0; r < NR; ++r) { const float sv = wscr[r * 64 + lane]; const float p = (sv > -1.0e38f) ? __expf(sv - mx) : 0.f; l += p; wscr[r * 64 + lane] = p; }
    l = wave_sum(l);
    LDS_WAIT(); asm volatile("" ::: "memory");
    const int sub = lane >> 4, dg = lane & 15;
    float o0 = 0.f, o1 = 0.f, o2 = 0.f, o3 = 0.f;
    for (int i = 0; i < NR * 16; ++i) {
        const int e = 4 * i + sub; const float p = wscr[e]; const unsigned voff = vscr[e];
        const v2u w = *(const v2u*)(VB + voff + dg * 8);
        o0 += p * bf_lo(w.x); o1 += p * bf_hi(w.x); o2 += p * bf_lo(w.y); o3 += p * bf_hi(w.y);
    }
    o0 += __shfl_xor(o0, 16); o1 += __shfl_xor(o1, 16); o2 += __shfl_xor(o2, 16); o3 += __shfl_xor(o3, 16);
    o0 += __shfl_xor(o0, 32); o1 += __shfl_xor(o1, 32); o2 += __shfl_xor(o2, 32); o3 += __shfl_xor(o3, 32);
    const float inv = 1.0f / l;
    if (lane < 16) { v2u w; w.x = cvt_pk_bf16(o0 * inv, o1 * inv); w.y = cvt_pk_bf16(o2 * inv, o3 * inv); *(v2u*)(orow + dg * 4) = w; }
    LDS_WAIT(); asm volatile("" ::: "memory");
}
struct EntA {
    int pos, h; unsigned rowbase; const float* btab;
    __device__ __forceinline__ bool operator()(int e, unsigned& koff, unsigned& voff, float& bias) const {
        const int p = e / 129, st = e - p * 129; const int kt = pos - (st << (2 * p));
        const bool valid = (e < 387) && (kt >= 0);
        const unsigned off = valid ? (rowbase + (unsigned)kt * (LD_PA * 2)) : rowbase;
        koff = off + (384 + h * 64) * 2; voff = off + (768 + h * 64) * 2;
        bias = valid ? btab[e * 6 + h] : 0.f; return valid;
    }
};
struct EntC {
    unsigned base;
    __device__ __forceinline__ bool operator()(int e, unsigned& koff, unsigned& voff, float& bias) const { koff = base + (unsigned)e * 512u; voff = koff; bias = 0.f; return true; }
};
__device__ __forceinline__ void p2_attn_simple(Frame& F) {
    const int lane = lane_id_fresh(); const int tid = F.wave * 64 + lane; (void)tid;
    LAS float* wscr = (LAS float*)(F.lds + F.wave * 8192);
    const int gw = F.vcu * 8 + F.wave, NGW = F.G * 8;
    const bf16* PA = (const bf16*)(F.ws + WS_PA); const bf16* PC = (const bf16*)(F.ws + WS_PC);
    const float* btab = (const float*)(F.ws + WS_TAB);
    for (int it = gw; it < T * 6; it += NGW) {
        const int t = it / 6, h = it % 6, b = t >> 11, pos = t & 2047;
        EntA ent{pos, h, (unsigned)(b * SEQ) * (unsigned)(LD_PA * 2), btab};
        attn_wave_simple<7, EntA>(PA + (size_t)t * LD_PA + h * 64, (const char*)PA, (const char*)PA, ent, (bf16*)(F.dout + DO_YA) + (size_t)t * 384 + h * 64, wscr, lane);
    }
    for (int it = gw; it < T * 4; it += NGW) {
        const int t = it >> 2, h = it & 3, b = t >> 11;
        EntC ent{(unsigned)(b * MEML) * 512u + (unsigned)h * 128u};
        attn_wave_simple<4, EntC>(PC + (size_t)t * LD_PC + h * 64, (const char*)(F.ws + WS_MEMK), (const char*)(F.ws + WS_MEMV), ent, (bf16*)(F.dout + DO_YC) + (size_t)t * 256 + h * 64, wscr, lane);
    }
}

typedef short s4v __attribute__((ext_vector_type(4)));
constexpr int ATT_OROW = 272;
constexpr int ATT_OACC = 0, ATT_M = 256 * ATT_OROW, ATT_L = ATT_M + 1024, ATT_BT = ATT_L + 1024, ATT_VST = 73728, ATT_VROW = 160, ATT_VBUF = 32 * ATT_VROW;
static_assert(ATT_BT + 3 * 132 * 4 <= ATT_VST && ATT_VST + 8 * 2 * ATT_VBUF <= LDS_MISC, "attention LDS map");
template <int NT, bool MASK>
__device__ __forceinline__ void attn_sub(const bf16* Q0, unsigned qstep, const bf16* K0, const bf16* V0, unsigned kstep, int clo, const LAS float* btab, LAS unsigned char* vst, int lane,
                                         f32x4 (&O)[4], float& m_out, float& l_out) {
    const int q = lane & 15, g = lane >> 4;
    bf16x8 qf[2];
#pragma unroll
    for (int ks = 0; ks < 2; ++ks) qf[ks] = *(const bf16x8*)((const char*)Q0 + ((unsigned)q * qstep + 8u * g + 32u * ks) * 2u);
    f32x4 S[NT];
#pragma unroll
    for (int k = 0; k < NT; ++k) {
        S[k] = (f32x4){0.f, 0.f, 0.f, 0.f};
        if (!MASK || 16 * k >= clo) {
            const char* kr = (const char*)K0 + ((unsigned)(16 * k + q) * kstep + 8u * g) * 2u;
            const bf16x8 k0 = *(const bf16x8*)kr, k1 = *(const bf16x8*)(kr + 64);
            S[k] = __builtin_amdgcn_mfma_f32_16x16x32_bf16(k0, qf[0], S[k], 0, 0, 0);
            S[k] = __builtin_amdgcn_mfma_f32_16x16x32_bf16(k1, qf[1], S[k], 0, 0, 0);
        }
        if ((k & 3) == 3) asm volatile("" ::: "memory");
    }
    float mx = -3.0e38f;
    if (MASK) {
        const int bs = 128 + q - 4 * g;
#pragma unroll
        for (int k = 0; k < NT; ++k)
#pragma unroll
            for (int r = 0; r < 4; ++r) { const int st = bs - 16 * k - r; const bool ok = (st >= 0) && (st <= 128) && (16 * k + 4 * g + r >= clo);
                const int sc = st < 0 ? 0 : (st > 128 ? 128 : st); const float v = ok ? S[k][r] + btab[sc] : -3.0e38f; S[k][r] = v; mx = fmaxf(mx, v); }
    } else {
#pragma unroll
        for (int k = 0; k < NT; ++k) mx = fmaxf(mx, fmaxf(fmaxf(S[k][0], S[k][1]), fmaxf(S[k][2], S[k][3])));
    }
    mx = fmaxf(mx, __shfl_xor(mx, 16)); mx = fmaxf(mx, __shfl_xor(mx, 32));
    float l = 0.f;
#pragma unroll
    for (int k = 0; k < NT; ++k)
#pragma unroll
        for (int r = 0; r < 4; ++r) { const float p = __expf(S[k][r] - mx); S[k][r] = p; l += p; }
    l += __shfl_xor(l, 16); l += __shfl_xor(l, 32);
#pragma unroll
    for (int t = 0; t < 4; ++t) O[t] = (f32x4){0.f, 0.f, 0.f, 0.f};
    constexpr int NKS = (NT + 1) / 2;
    const int vr = lane >> 1, vh = lane & 1;
    const int tq = (lane & 15) >> 2, tp = lane & 3;
#pragma unroll
    for (int ks = 0; ks < NKS; ++ks) {
        if (MASK && 32 * ks + 31 < clo) continue;
        LAS unsigned char* vb = vst + (ks & 1) * ATT_VBUF;
        int c = 32 * ks + vr; if (MASK && c < clo) c = clo; if (c > 16 * NT - 1) c = 16 * NT - 1;
        const v4u* vp = (const v4u*)((const char*)V0 + ((unsigned)c * kstep + 32u * vh) * 2u);
        const v4u w0 = vp[0], w1 = vp[1], w2 = vp[2], w3 = vp[3];
        LAS v4u* wp = (LAS v4u*)(vb + vr * ATT_VROW + vh * 64);
        wp[0] = w0; wp[1] = w1; wp[2] = w2; wp[3] = w3;
        bf16x8 pf;
        { const f32x4 a = S[2 * ks]; f32x4 b = (f32x4){0.f, 0.f, 0.f, 0.f}; if (2 * ks + 1 < NT) b = S[2 * ks + 1 < NT ? 2 * ks + 1 : 0];
          v4u pw; pw.x = cvt_pk_bf16(a[0], a[1]); pw.y = cvt_pk_bf16(a[2], a[3]); pw.z = cvt_pk_bf16(b[0], b[1]); pw.w = cvt_pk_bf16(b[2], b[3]); pf = __builtin_bit_cast(bf16x8, pw); }
        asm volatile("" ::: "memory");
#pragma unroll
        for (int t = 0; t < 4; ++t) {
            const s4v lo = __builtin_amdgcn_ds_read_tr16_b64_v4i16((LAS s4v*)(vb + (4 * g + tq) * ATT_VROW + (16 * t + 4 * tp) * 2));
            const s4v hi = __builtin_amdgcn_ds_read_tr16_b64_v4i16((LAS s4v*)(vb + (16 + 4 * g + tq) * ATT_VROW + (16 * t + 4 * tp) * 2));
            const bf16x8 af = (bf16x8){lo[0], lo[1], lo[2], lo[3], hi[0], hi[1], hi[2], hi[3]};
            O[t] = __builtin_amdgcn_mfma_f32_16x16x32_bf16(af, pf, O[t], 0, 0, 0);
        }
        asm volatile("" ::: "memory");
    }
    m_out = mx; l_out = l;
}
__device__ __forceinline__ void attnA_unit(Frame& F, int unit) {
    const int lane = lane_id_fresh();
    const int tid = F.wave * 64 + lane;
    const int b = unit / 48, rem = unit % 48, h = rem >> 3, tile = rem & 7, t0 = tile * 256; const long tokbase = (long)b * SEQ;
    const bf16* PA = (const bf16*)(F.ws + WS_PA);
    LAS float* bt = (LAS float*)(F.lds + ATT_BT);
    __syncthreads();
    if (tid < 387) { const int p = tid / 129, st = tid - p * 129; bt[p * 132 + st] = ((const float*)(F.ws + WS_TAB))[tid * 6 + h]; }
    __syncthreads();
    LAS unsigned char* vst = F.lds + ATT_VST + F.wave * 2 * ATT_VBUF;
    const int q = lane & 15, g = lane >> 4;
#pragma unroll 1
    for (int p = 0; p < 3; ++p) {
        const int d = 1 << (2 * p);
#pragma unroll 1
        for (int su = 0; su < 2; ++su) {
            const int sub = F.wave * 2 + su;
            int tq0, pq0;
            if (p == 0) { tq0 = t0 + 16 * sub; pq0 = tq0; }
            else if (p == 1) { const int r = sub & 3, jp = sub >> 2; tq0 = t0 + r + 64 * jp; pq0 = t0 / 4 + 16 * jp; }
            else { tq0 = t0 + sub; pq0 = t0 / 16; }
            const int clo = pq0 < 128 ? 128 - pq0 : 0;
            const bf16* Q0 = PA + (tokbase + tq0) * LD_PA + h * 64;
            const bf16* K0 = PA + (tokbase + tq0 - 128 * d) * LD_PA + 384 + h * 64;
            f32x4 O[4]; float m, l;
            attn_sub<9, true>(Q0, (unsigned)(d * LD_PA), K0, K0 + 384, (unsigned)(d * LD_PA), clo, bt + p * 132, vst, lane, O, m, l);
            const int tt = (tq0 - t0) + q * d;
            LAS unsigned char* orow = F.lds + ATT_OACC + tt * ATT_OROW + 16 * g; LAS float* mp = (LAS float*)(F.lds + ATT_M) + tt; LAS float* lp = (LAS float*)(F.lds + ATT_L) + tt;
            if (p > 0) {
                const float mo = *mp, lo_ = *lp; const float mn = fmaxf(m, mo), ao = __expf(mo - mn), an = __expf(m - mn);
#pragma unroll
                for (int t = 0; t < 4; ++t) { const f32x4 oo = *(const LAS f32x4*)(orow + 64 * t); O[t] = oo * ao + O[t] * an; }
                l = lo_ * ao + l * an; m = mn;
            }
            if (p < 2) {
#pragma unroll
                for (int t = 0; t < 4; ++t) *(LAS f32x4*)(orow + 64 * t) = O[t];
                if (g == 0) { *mp = m; *lp = l; }
            } else {
                const float inv = 1.0f / l; bf16* yo = (bf16*)(F.dout + DO_YA) + (tokbase + t0 + tt) * 384 + h * 64 + 4 * g;
#pragma unroll
                for (int t = 0; t < 4; ++t) { v2u w; w.x = cvt_pk_bf16(O[t][0] * inv, O[t][1] * inv); w.y = cvt_pk_bf16(O[t][2] * inv, O[t][3] * inv); *(v2u*)(yo + 16 * t) = w; }
            }
        }
        __syncthreads();
    }
}
__device__ __forceinline__ void attnC_unit(Frame& F, int unit) {
    const int lane = lane_id_fresh();
    const int b = unit >> 5, h = (unit >> 3) & 3, tile = unit & 7; const long tok0 = (long)b * SEQ + tile * 256;
    const bf16* PC = (const bf16*)(F.ws + WS_PC);
    const bf16* K0 = (const bf16*)(F.ws + WS_MEMK) + (long)b * MEML * 256 + h * 64; const bf16* V0 = (const bf16*)(F.ws + WS_MEMV) + (long)b * MEML * 256 + h * 64;
    LAS unsigned char* vst = F.lds + ATT_VST + F.wave * 2 * ATT_VBUF;
    const int q = lane & 15, g = lane >> 4;
#pragma unroll 1
    for (int su = 0; su < 2; ++su) {
        const long tq0 = tok0 + 16 * (F.wave * 2 + su);
        f32x4 O[4]; float m, l;
        attn_sub<16, false>(PC + tq0 * LD_PC + h * 64, (unsigned)LD_PC, K0, V0, 256u, 0, nullptr, vst, lane, O, m, l);
        const float inv = 1.0f / l; bf16* yo = (bf16*)(F.dout + DO_YC) + (tq0 + q) * 256 + h * 64 + 4 * g;
#pragma unroll
        for (int t = 0; t < 4; ++t) { v2u w; w.x = cvt_pk_bf16(O[t][0] * inv, O[t][1] * inv); w.y = cvt_pk_bf16(O[t][2] * inv, O[t][3] * inv); *(v2u*)(yo + 16 * t) = w; }
    }
}
__device__ __forceinline__ void p2_attn_mfma(Frame& F) {
    const int lane = lane_id_fresh();
    for (int u = F.vcu; u < NB * 6 * 8; u += F.G) attnA_unit(F, u);
    for (int u = F.vcu; u < NB * 4 * 8; u += F.G) attnC_unit(F, u);
    __syncthreads();
}

constexpr int HG_PR = 144, HG_PX = 160, HG_PV = 224;
constexpr int HG_KH = 0, HG_QT = 64 * HG_PR, HG_QS = 2 * 64 * HG_PR, HG_KX = HG_QS + 10 * 16 * HG_PR, HG_VI = HG_KX + 64 * HG_PX, HG_SI = HG_VI + 64 * HG_PV, HG_DV = HG_SI + 2 * 64 * HG_PV, HG_PS = HG_DV + 256, HG_END = HG_PS + 512;
static_assert(HG_END <= LDS_MISC, "hgrn LDS map");
__device__ __forceinline__ s4v trd(const LAS unsigned char* p) { return __builtin_amdgcn_ds_read_tr16_b64_v4i16((LAS s4v*)p); }
__device__ __forceinline__ bf16x8 cat8(s4v lo, s4v hi) { return (bf16x8){lo[0], lo[1], lo[2], lo[3], hi[0], hi[1], hi[2], hi[3]}; }
__device__ __forceinline__ void hgrn_seq(Frame& F, int seq, bf16* YB) {
    const int lane = lane_id_fresh();
    const int w = F.wave, tid = w * 64 + lane;
    const int b = seq >> 2, h = seq & 3; const long tokbase = (long)b * SEQ;
    const bf16* PB = (const bf16*)(F.ws + WS_PB);
    LAS unsigned char* L = F.lds;
    __syncthreads();
    for (int i = tid; i < 2 * 64 * HG_PV / 16; i += 512) *(LAS v4u*)(L + HG_SI + i * 16) = (v4u){0u, 0u, 0u, 0u};
    float lbv[8];
    { const float* lbt = (const float*)(F.ws + WS_TAB) + 4096 + h * 64 + 8 * w;
#pragma unroll
      for (int j = 0; j < 8; ++j) lbv[j] = lbt[j]; }
    f32x4 St[3];
#pragma unroll
    for (int t = 0; t < 3; ++t) St[t] = (f32x4){0.f, 0.f, 0.f, 0.f};
    const int q16 = lane & 15, g = lane >> 4, mi = w >> 1, hh = w & 1, tq4 = (lane & 15) >> 2, tp = lane & 3;
    float gn[3];
#pragma unroll
    for (int t = 0; t < 3; ++t) gn[t] = arg_in(I_ONB)[h * 96 + 16 * (3 * hh + t) + q16];
    v4u qw, fw, vw0, vw1 = (v4u){0u, 0u, 0u, 0u};
    { const bf16* rowp = PB + (tokbase + lane) * LD_PB; qw = *(const v4u*)(rowp + h * 64 + 8 * w); fw = *(const v4u*)(rowp + 256 + h * 64 + 8 * w);
      vw0 = *(const v4u*)(PB + (tokbase + tid / 12) * LD_PB + 512 + h * 96 + (tid % 12) * 8);
      if (tid < 256) vw1 = *(const v4u*)(PB + (tokbase + (tid + 512) / 12) * LD_PB + 512 + h * 96 + ((tid + 512) % 12) * 8); }
#pragma unroll 1
    for (int c = 0; c < 32; ++c) {
        const long tok0 = tokbase + 64 * c;
        *(LAS v4u*)(L + HG_VI + (tid / 12) * HG_PV + (tid % 12) * 16) = vw0;
        if (tid < 256) *(LAS v4u*)(L + HG_VI + ((tid + 512) / 12) * HG_PV + ((tid + 512) % 12) * 16) = vw1;
        float qf[8], kk[8], bb[8];
        { const unsigned qa[4] = {qw.x, qw.y, qw.z, qw.w}, fa[4] = {fw.x, fw.y, fw.z, fw.w};
#pragma unroll
          for (int j = 0; j < 4; ++j) { qf[2 * j] = bf_lo(qa[j]); qf[2 * j + 1] = bf_hi(qa[j]);
              const float f0 = lbv[2 * j] + (1.f - lbv[2 * j]) * sigmoidf_(bf_lo(fa[j])), f1 = lbv[2 * j + 1] + (1.f - lbv[2 * j + 1]) * sigmoidf_(bf_hi(fa[j]));
              kk[2 * j] = 1.f - f0; kk[2 * j + 1] = 1.f - f1; bb[2 * j] = __logf(f0); bb[2 * j + 1] = __logf(f1); } }
#pragma unroll
        for (int o = 1; o < 64; o <<= 1)
#pragma unroll
            for (int j = 0; j < 8; ++j) { const float t = __shfl_up(bb[j], o); if (lane >= o) bb[j] += t; }
        float E0[8], E1[8], E2[8], E3[8], Es[8];
#pragma unroll
        for (int j = 0; j < 8; ++j) { E0[j] = readlane_f(bb[j], 15); E1[j] = readlane_f(bb[j], 31); E2[j] = readlane_f(bb[j], 47); E3[j] = readlane_f(bb[j], 63);
            Es[j] = g == 0 ? E0[j] : (g == 1 ? E1[j] : (g == 2 ? E2[j] : E3[j])); }
        {   float kh[8], qt[8], kx[8];
#pragma unroll
            for (int j = 0; j < 8; ++j) { kh[j] = kk[j] * __expf(Es[j] - bb[j]); qt[j] = qf[j] * __expf(bb[j]); kx[j] = kk[j] * __expf(E3[j] - bb[j]); }
            v4u o; o.x = cvt_pk_bf16(kh[0], kh[1]); o.y = cvt_pk_bf16(kh[2], kh[3]); o.z = cvt_pk_bf16(kh[4], kh[5]); o.w = cvt_pk_bf16(kh[6], kh[7]); *(LAS v4u*)(L + HG_KH + lane * HG_PR + w * 16) = o;
            o.x = cvt_pk_bf16(qt[0], qt[1]); o.y = cvt_pk_bf16(qt[2], qt[3]); o.z = cvt_pk_bf16(qt[4], qt[5]); o.w = cvt_pk_bf16(qt[6], qt[7]); *(LAS v4u*)(L + HG_QT + lane * HG_PR + w * 16) = o;
            o.x = cvt_pk_bf16(kx[0], kx[1]); o.y = cvt_pk_bf16(kx[2], kx[3]); o.z = cvt_pk_bf16(kx[4], kx[5]); o.w = cvt_pk_bf16(kx[6], kx[7]); *(LAS v4u*)(L + HG_KX + lane * HG_PX + w * 16) = o; }
#pragma unroll
        for (int jj = 0; jj < 4; ++jj) {
            if (g >= jj) { float qs[8];
#pragma unroll
                for (int j = 0; j < 8; ++j) { const float Ej = jj == 0 ? E0[j] : (jj == 1 ? E1[j] : (jj == 2 ? E2[j] : E3[j])); qs[j] = qf[j] * __expf(bb[j] - Ej); }
                const int tix = (jj == 0 ? 0 : (jj == 1 ? 4 : (jj == 2 ? 7 : 9))) + (g - jj);
                v4u o; o.x = cvt_pk_bf16(qs[0], qs[1]); o.y = cvt_pk_bf16(qs[2], qs[3]); o.z = cvt_pk_bf16(qs[4], qs[5]); o.w = cvt_pk_bf16(qs[6], qs[7]);
                *(LAS v4u*)(L + HG_QS + tix * 16 * HG_PR + q16 * HG_PR + w * 16) = o; }
        }
        if (lane == 63) {
#pragma unroll
            for (int j = 0; j < 8; ++j) *(LAS float*)(L + HG_DV + (8 * w + j) * 4) = __expf(bb[j]); }
        __syncthreads();
        if (c + 1 < 32) { const long tn = tok0 + 64; const bf16* rowp = PB + (tn + lane) * LD_PB; qw = *(const v4u*)(rowp + h * 64 + 8 * w); fw = *(const v4u*)(rowp + 256 + h * 64 + 8 * w);
            vw0 = *(const v4u*)(PB + (tn + tid / 12) * LD_PB + 512 + h * 96 + (tid % 12) * 8);
            if (tid < 256) vw1 = *(const v4u*)(PB + (tn + (tid + 512) / 12) * LD_PB + 512 + h * 96 + ((tid + 512) % 12) * 8); }
        const LAS unsigned char* SIr = L + HG_SI + (c & 1) * 64 * HG_PV; LAS unsigned char* SIw = L + HG_SI + ((c + 1) & 1) * 64 * HG_PV;
        f32x4 AT[4];
#pragma unroll
        for (int j = 0; j < 4; ++j) {
            f32x4 acc = (f32x4){0.f, 0.f, 0.f, 0.f};
            if (j <= mi) {
                const int tix = (j == 0 ? 0 : (j == 1 ? 4 : (j == 2 ? 7 : 9))) + (mi - j);
#pragma unroll
                for (int ks = 0; ks < 2; ++ks) {
                    const bf16x8 a = *(const LAS bf16x8*)(L + HG_KH + (16 * j + q16) * HG_PR + (32 * ks + 8 * g) * 2);
                    const bf16x8 bq = *(const LAS bf16x8*)(L + HG_QS + tix * 16 * HG_PR + q16 * HG_PR + (32 * ks + 8 * g) * 2);
                    acc = __builtin_amdgcn_mfma_f32_16x16x32_bf16(a, bq, acc, 0, 0, 0);
                }
                if (j == mi) {
#pragma unroll
                    for (int r = 0; r < 4; ++r) if (4 * g + r > q16) acc[r] = 0.f; }
            }
            AT[j] = acc;
        }
        bf16x8 vf[2][3];
#pragma unroll
        for (int ks = 0; ks < 2; ++ks)
#pragma unroll
            for (int t = 0; t < 3; ++t) { const int col = (16 * (3 * hh + t) + 4 * tp) * 2;
                vf[ks][t] = cat8(trd(L + HG_VI + (32 * ks + 4 * g + tq4) * HG_PV + col), trd(L + HG_VI + (32 * ks + 16 + 4 * g + tq4) * HG_PV + col)); }
        f32x4 o[3];
#pragma unroll
        for (int t = 0; t < 3; ++t) o[t] = (f32x4){0.f, 0.f, 0.f, 0.f};
#pragma unroll
        for (int ks = 0; ks < 2; ++ks) {
            const bf16x8 a = *(const LAS bf16x8*)(L + HG_QT + (16 * mi + q16) * HG_PR + (32 * ks + 8 * g) * 2);
#pragma unroll
            for (int t = 0; t < 3; ++t) { const int col = (16 * (3 * hh + t) + 4 * tp) * 2;
                const bf16x8 bs = cat8(trd(SIr + (32 * ks + 8 * g + tq4) * HG_PV + col), trd(SIr + (32 * ks + 8 * g + 4 + tq4) * HG_PV + col));
                o[t] = __builtin_amdgcn_mfma_f32_16x16x32_bf16(a, bs, o[t], 0, 0, 0); }
        }
#pragma unroll
        for (int ks = 0; ks < 2; ++ks) {
            if (2 * ks <= mi) {
                v4u pw; pw.x = cvt_pk_bf16(AT[2 * ks][0], AT[2 * ks][1]); pw.y = cvt_pk_bf16(AT[2 * ks][2], AT[2 * ks][3]); pw.z = cvt_pk_bf16(AT[2 * ks + 1][0], AT[2 * ks + 1][1]); pw.w = cvt_pk_bf16(AT[2 * ks + 1][2], AT[2 * ks + 1][3]);
                const bf16x8 a = __builtin_bit_cast(bf16x8, pw);
#pragma unroll
                for (int t = 0; t < 3; ++t) o[t] = __builtin_amdgcn_mfma_f32_16x16x32_bf16(a, vf[ks][t], o[t], 0, 0, 0);
            }
        }
        { const f32x4 dv = *(const LAS f32x4*)(L + HG_DV + (16 * mi + 4 * g) * 4);
#pragma unroll
          for (int t = 0; t < 3; ++t) St[t] = St[t] * dv; }
#pragma unroll
        for (int ks = 0; ks < 2; ++ks) {
            const int col = (16 * mi + 4 * tp) * 2;
            const bf16x8 a = cat8(trd(L + HG_KX + (32 * ks + 4 * g + tq4) * HG_PX + col), trd(L + HG_KX + (32 * ks + 16 + 4 * g + tq4) * HG_PX + col));
#pragma unroll
            for (int t = 0; t < 3; ++t) St[t] = __builtin_amdgcn_mfma_f32_16x16x32_bf16(a, vf[ks][t], St[t], 0, 0, 0);
        }
#pragma unroll
        for (int t = 0; t < 3; ++t)
#pragma unroll
            for (int r = 0; r < 4; ++r) *(LAS bf16*)(SIw + (16 * mi + 4 * g + r) * HG_PV + (16 * (3 * hh + t) + q16) * 2) = f2bf(St[t][r]);
        float ss[4];
#pragma unroll
        for (int r = 0; r < 4; ++r) { float s2 = o[0][r] * o[0][r] + o[1][r] * o[1][r] + o[2][r] * o[2][r];
            s2 += __shfl_xor(s2, 1); s2 += __shfl_xor(s2, 2); s2 += __shfl_xor(s2, 4); s2 += __shfl_xor(s2, 8); ss[r] = s2; }
        if (q16 == 0) {
#pragma unroll
            for (int r = 0; r < 4; ++r) *(LAS float*)(L + HG_PS + ((16 * mi + 4 * g + r) * 2 + hh) * 4) = ss[r]; }
        float ogv[3][4];
#pragma unroll
        for (int t = 0; t < 3; ++t)
#pragma unroll
            for (int r = 0; r < 4; ++r) ogv[t][r] = bf2f(PB[(tok0 + 16 * mi + 4 * g + r) * LD_PB + 896 + h * 96 + 16 * (3 * hh + t) + q16]);
        __syncthreads();
#pragma unroll
        for (int r = 0; r < 4; ++r) { const f32x2 p2 = *(const LAS f32x2*)(L + HG_PS + (16 * mi + 4 * g + r) * 8); const float rstd = rsqrtf((p2[0] + p2[1]) * (1.f / 96.f) + EPS);
#pragma unroll
            for (int t = 0; t < 3; ++t) YB[(tok0 + 16 * mi + 4 * g + r) * 384 + h * 96 + 16 * (3 * hh + t) + q16] = f2bf(o[t][r] * rstd * gn[t] * ogv[t][r]); }
    }
    __syncthreads();
}
constexpr int CW_Q = 8192;
__device__ __forceinline__ void p2_queue(Frame& F) {
    const int lane = lane_id_fresh();
    volatile LAS int* qw = (volatile LAS int*)(F.lds + LDS_MISC + 64);
    constexpr int NH = 128, NA = NB * 6 * 8, NC = NB * 4 * 8;
    for (;;) {
        __syncthreads();
        if (F.wave == 0 && lane == 0) qw[0] = (int)atomicAdd((unsigned*)(F.ws + WS_CTL) + CW_Q, 1u);
        __syncthreads();
        const int it = __builtin_amdgcn_readfirstlane(qw[0]);
        if (it >= NH + NA + NC) break;
        if (it < NH) hgrn_seq(F, it, (bf16*)(F.dout + DO_YB));
        else if (it < NH + NA) attnA_unit(F, it - NH);
        else attnC_unit(F, it - NH - NA);
    }
    __syncthreads();
}
template <bool OUTPUTS>
__device__ __forceinline__ void hgrn_simple(Frame& F, bf16* YBo) {
    const int lane = lane_id_fresh(); const int tid = F.wave * 64 + lane; (void)tid;
    const int uw = tid >> 7, col = tid & 127;
    LAS float* fL = (LAS float*)(F.lds + uw * 29184); LAS float* qL = fL + 2048; LAS float* oL = qL + 2048; LAS float* pL = oL + 3072;
    const bf16* PB = (const bf16*)(F.ws + WS_PB);
    const float* lbt = (const float*)(F.ws + WS_TAB) + 4096;
    float* LST = (float*)(F.ws + WS_LST); float* DEC = (float*)(F.ws + WS_DEC);
    for (int grp = F.vcu; grp < 1024; grp += F.G) {
        const int unit = grp * 4 + uw, b = unit >> 7, h = (unit >> 5) & 3, c = unit & 31; const int tok0 = b * SEQ + c * 64;
        float S[64]; float dprod = 1.f;
#pragma unroll
        for (int k = 0; k < 64; ++k) S[k] = 0.f;
        if (OUTPUTS && col < 96) {
            for (int cp = 0; cp < c; ++cp) { const float* dp = DEC + (size_t)(unit - c + cp) * 64; const float* lp = LST + (size_t)(unit - c + cp) * 6144 + col;
#pragma unroll
                for (int k = 0; k < 64; ++k) S[k] = dp[k] * S[k] + lp[k * 96]; }
        }
        for (int hf = 0; hf < 2; ++hf) {
            __syncthreads();
            for (int idx = col; idx < 2048; idx += 128) { const int s = idx >> 6, k = idx & 63; const size_t rb = (size_t)(tok0 + hf * 32 + s) * LD_PB;
                const float lb = lbt[h * 64 + k]; fL[idx] = lb + (1.f - lb) * sigmoidf_(bf2f(PB[rb + 256 + h * 64 + k]));
                if (OUTPUTS) qL[idx] = bf2f(PB[rb + h * 64 + k]); }
            __syncthreads();
            if (col < 96) {
                for (int s = 0; s < 32; ++s) {
                    const float v = bf2f(PB[(size_t)(tok0 + hf * 32 + s) * LD_PB + 512 + h * 96 + col]); float o = 0.f;
#pragma unroll
                    for (int k4 = 0; k4 < 16; ++k4) { const f32x4 f4 = *(const LAS f32x4*)(fL + s * 64 + 4 * k4); f32x4 q4 = (f32x4){0.f, 0.f, 0.f, 0.f}; if (OUTPUTS) q4 = *(const LAS f32x4*)(qL + s * 64 + 4 * k4);
#pragma unroll
                        for (int j = 0; j < 4; ++j) { const float fk = f4[j]; S[4 * k4 + j] = fk * S[4 * k4 + j] + (1.f - fk) * v; if (OUTPUTS) o += S[4 * k4 + j] * q4[j]; } }
                    if (OUTPUTS) oL[s * 96 + col] = o;
                }
            }
            if (!OUTPUTS && col < 64) { for (int s = 0; s < 32; ++s) dprod *= fL[s * 64 + col]; }
            if (OUTPUTS) {
                __syncthreads();
                { const int s = col & 31, part = col >> 5; float ss = 0.f;
#pragma unroll
                  for (int j = 0; j < 24; ++j) { const float x = oL[s * 96 + part * 24 + j]; ss += x * x; }
                  pL[s * 4 + part] = ss; }
                __syncthreads();
                if (col < 96) { const float gn = arg_in(I_ONB)[h * 96 + col];
                    for (int s = 0; s < 32; ++s) { const f32x4 p4 = *(const LAS f32x4*)(pL + s * 4); const float rstd = rsqrtf(((p4[0] + p4[1]) + (p4[2] + p4[3])) * (1.f / 96.f) + EPS);
                        const size_t tok = (size_t)(tok0 + hf * 32 + s); const float og = bf2f(PB[tok * LD_PB + 896 + h * 96 + col]);
                        YBo[tok * 384 + h * 96 + col] = f2bf(oL[s * 96 + col] * rstd * gn * og); } }
            }
        }
        if (!OUTPUTS) {
            if (col < 96) {
#pragma unroll
                for (int k = 0; k < 64; ++k) LST[(size_t)unit * 6144 + k * 96 + col] = S[k]; }
            if (col < 64) DEC[(size_t)unit * 64 + col] = dprod;
        }
    }
    __syncthreads();
}

constexpr int RT_ROW = 2064;
constexpr int RT_HI = 0, RT_LO = 32 * RT_ROW, RT_LG = 64 * RT_ROW;
static_assert(RT_LG + 32 * 64 * 4 + 512 <= LDS_MISC, "routing LDS map");
__device__ __forceinline__ void p6_route(Frame& F, const bool commit) {
    const int lane = lane_id_fresh();
    const float* x1 = (const float*)F.dout; bf16* U = (bf16*)(F.ws + WS_U);
    const bf16* WRH = (const bf16*)(F.ws + WS_TAB + 65536); const bf16* WRL = WRH + 65536;
    const float rbias = arg_in(I_RB)[lane];
    int* slot = (int*)(F.ws + WS_SLOT); float* wflat = (float*)(F.ws + WS_WFLAT); unsigned* cntw = (unsigned*)(F.ws + WS_CTL) + CW_CNT;
    LAS unsigned* lcnt = (LAS unsigned*)(F.lds + RT_LG + 32 * 64 * 4);
    for (int i = F.vcu * 512 + F.wave * 64 + lane; i < 2 * HALF_T; i += F.G * 512) { const int hf = i / HALF_T, r = i % HALF_T; slot[(size_t)(hf * NSEGH + 64) * SLOT_CAP + r] = (hf * HALF_T + r) * 8; }
    const int q = lane & 15, g = lane >> 4, mt = F.wave & 1, et = F.wave >> 1;
    f32x4 xv[4][4];
    const f32x4 gv0 = ((const f32x4*)arg_in(I_FNG))[lane], gv1 = ((const f32x4*)arg_in(I_FNG))[64 + lane], gv2 = ((const f32x4*)arg_in(I_FNG))[128 + lane], gv3 = ((const f32x4*)arg_in(I_FNG))[192 + lane];
    {   const int t0 = F.vcu * 32;
        if (t0 < T) {
#pragma unroll
            for (int i = 0; i < 4; ++i)
#pragma unroll
                for (int j = 0; j < 4; ++j) xv[i][j] = ((const f32x4*)(x1 + (size_t)(t0 + F.wave * 4 + i) * D))[64 * j + lane]; } }
    for (int t0 = F.vcu * 32; t0 < T; t0 += F.G * 32) {
        __syncthreads();
        if (F.wave == 0) lcnt[lane] = 0u;
#pragma unroll
        for (int i = 0; i < 4; ++i) {
            const int tl = F.wave * 4 + i, t = t0 + tl;
            float s = 0.f;
#pragma unroll
            for (int j = 0; j < 4; ++j) s += (xv[i][j][0] * xv[i][j][0] + xv[i][j][1] * xv[i][j][1]) + (xv[i][j][2] * xv[i][j][2] + xv[i][j][3] * xv[i][j][3]);
            const float rstd = rsqrtf(wave_sum(s) * (1.f / D) + EPS);
            v2u* o8 = (v2u*)(U + (size_t)t * D) + lane;
#pragma unroll
            for (int j = 0; j < 4; ++j) { const f32x4 gg = j == 0 ? gv0 : (j == 1 ? gv1 : (j == 2 ? gv2 : gv3)); const f32x4 uu = xv[i][j] * rstd * gg;
                v2u hi; hi.x = cvt_pk_bf16(uu[0], uu[1]); hi.y = cvt_pk_bf16(uu[2], uu[3]); o8[64 * j] = hi;
                v2u lo; lo.x = cvt_pk_bf16(uu[0] - bf_lo(hi.x), uu[1] - bf_hi(hi.x)); lo.y = cvt_pk_bf16(uu[2] - bf_lo(hi.y), uu[3] - bf_hi(hi.y));
                *(LAS v2u*)(F.lds + RT_HI + tl * RT_ROW + (256 * j + 4 * lane) * 2) = hi; *(LAS v2u*)(F.lds + RT_LO + tl * RT_ROW + (256 * j + 4 * lane) * 2) = lo; }
        }
        __syncthreads();
        {   const int tn = t0 + F.G * 32;
            if (tn < T) {
#pragma unroll
                for (int i = 0; i < 4; ++i)
#pragma unroll
                    for (int j = 0; j < 4; ++j) xv[i][j] = ((const f32x4*)(x1 + (size_t)(tn + F.wave * 4 + i) * D))[64 * j + lane]; } }
        {   f32x4 acc = (f32x4){0.f, 0.f, 0.f, 0.f};
            const bf16* wh = WRH + (size_t)(et * 16 + q) * 1024 + 8 * g; const bf16* wl = WRL + (size_t)(et * 16 + q) * 1024 + 8 * g;
            const LAS unsigned char* uh = F.lds + RT_HI + (mt * 16 + q) * RT_ROW + 16 * g; const LAS unsigned char* ul = F.lds + RT_LO + (mt * 16 + q) * RT_ROW + 16 * g;
#pragma unroll 8
            for (int ks = 0; ks < 32; ++ks) {
                const bf16x8 a_h = *(const bf16x8*)(wh + 32 * ks), a_l = *(const bf16x8*)(wl + 32 * ks);
                const bf16x8 b_h = *(const LAS bf16x8*)(uh + 64 * ks), b_l = *(const LAS bf16x8*)(ul + 64 * ks);
                acc = __builtin_amdgcn_mfma_f32_16x16x32_bf16(a_h, b_h, acc, 0, 0, 0);
                acc = __builtin_amdgcn_mfma_f32_16x16x32_bf16(a_l, b_h, acc, 0, 0, 0);
                acc = __builtin_amdgcn_mfma_f32_16x16x32_bf16(a_h, b_l, acc, 0, 0, 0);
            }
            *(LAS f32x4*)(F.lds + RT_LG + ((mt * 16 + q) * 64 + et * 16 + 4 * g) * 4) = acc;
        }
        __syncthreads();
        unsigned lrank[4]; float wn[4]; int rk[4];
#pragma unroll
        for (int i = 0; i < 4; ++i) {
            const int tl = F.wave * 4 + i;
            const float z = *(const LAS float*)(F.lds + RT_LG + (tl * 64 + lane) * 4);
            const float sg = sigmoidf_(z), ch = sg + rbias;
            float m1 = ch; m1 = fmaxf(m1, __shfl_xor(m1, 1)); m1 = fmaxf(m1, __shfl_xor(m1, 2)); m1 = fmaxf(m1, __shfl_xor(m1, 4));
            const unsigned long long eqm = __ballot(ch == m1); const int gbase = lane & ~7; const unsigned gm = (unsigned)(eqm >> gbase) & 0xffu; const int first = gbase + __builtin_ctz(gm);
            float m2 = (lane == first) ? -3.0e38f : ch; m2 = fmaxf(m2, __shfl_xor(m2, 1)); m2 = fmaxf(m2, __shfl_xor(m2, 2)); m2 = fmaxf(m2, __shfl_xor(m2, 4));
            const float gs = m1 + m2; const int gi = lane >> 3; int grank = 0;
#pragma unroll
            for (int gg = 0; gg < 8; ++gg) { const float og = readlane_f(gs, gg * 8); grank += (og > gs || (og == gs && gg < gi)) ? 1 : 0; }
            const bool gsel = grank < 4; const float cm = gsel ? ch : -3.0e38f; int rank = 0;
#pragma unroll
            for (int e = 0; e < 64; ++e) { const float oc = readlane_f(cm, e); rank += (oc > cm || (oc == cm && e < lane)) ? 1 : 0; }
            const bool sel = gsel && rank < 8;
            const float wsum = wave_sum(sel ? sg : 0.f);
            rk[i] = sel ? rank : -1; wn[i] = 2.5f * sg / wsum; lrank[i] = 0u;
            if (sel) lrank[i] = __hip_atomic_fetch_add(lcnt + lane, 1u, __ATOMIC_RELAXED, __HIP_MEMORY_SCOPE_WORKGROUP);
        }
        __syncthreads();
        const int seg = (t0 >> 15) * NSEGH + lane;
        if (F.wave == 0) { const unsigned n = lcnt[lane]; unsigned base = 0u; if (n && commit) base = atomicAdd(cntw + 64 * seg, n); lcnt[64 + lane] = base; }
        __syncthreads();
        if (commit) { const unsigned base = lcnt[64 + lane];
#pragma unroll
            for (int i = 0; i < 4; ++i) if (rk[i] >= 0) { const int flat = (t0 + F.wave * 4 + i) * 8 + rk[i]; slot[(size_t)seg * SLOT_CAP + base + lrank[i]] = flat; wflat[flat] = wn[i]; } }
    }
    __syncthreads();
}
__device__ __forceinline__ void moe_load_segs(Frame& F) {
    const int lane = lane_id_fresh(); const int tid = F.wave * 64 + lane; (void)tid;
    LAS int* pre = (LAS int*)(F.lds + LDS_PRE); LAS int* cnt = pre + 132;
    __syncthreads();
    if (tid < NSEG) { const int e = tid % NSEGH; cnt[tid] = (e == 64) ? HALF_T : (int)__hip_atomic_load((unsigned*)(F.ws + WS_CTL) + CW_CNT + 64 * tid, RLX_AGENT); }
    __syncthreads();
    if (tid == 0) { int a = 0; for (int s = 0; s < NSEG; ++s) { pre[s] = a; a += (cnt[s] + 255) >> 8; } pre[NSEG] = a; }
    __syncthreads();
}
__device__ __forceinline__ void p_combine(Frame& F, int half, const float ysc) {
    const int lane = lane_id_fresh(); const int tid = F.wave * 64 + lane; (void)tid;
    const int gw = F.vcu * 8 + F.wave, NGW = F.G * 8; float* out = (float*)F.dout; const bf16* YB = (const bf16*)(F.ws + WS_YBUF);
    for (int tl = gw; tl < HALF_T; tl += NGW) {
        const int t = half * HALF_T + tl;
#pragma unroll
        for (int j = 0; j < 2; ++j) {
            float a[8]; { const f32x4 o0 = *(const f32x4*)(out + (size_t)t * D + j * 512 + lane * 8), o1 = *(const f32x4*)(out + (size_t)t * D + j * 512 + lane * 8 + 4);
                a[0] = o0[0]; a[1] = o0[1]; a[2] = o0[2]; a[3] = o0[3]; a[4] = o1[0]; a[5] = o1[1]; a[6] = o1[2]; a[7] = o1[3]; }
#pragma unroll
            for (int k = 0; k < 8; ++k) { const v4u w = *(const v4u*)(YB + ((size_t)tl * 8 + k) * D + j * 512 + lane * 8);
                a[0] += ysc * bf_lo(w.x); a[1] += ysc * bf_hi(w.x); a[2] += ysc * bf_lo(w.y); a[3] += ysc * bf_hi(w.y); a[4] += ysc * bf_lo(w.z); a[5] += ysc * bf_hi(w.z); a[6] += ysc * bf_lo(w.w); a[7] += ysc * bf_hi(w.w); }
            *(f32x4*)(out + (size_t)t * D + j * 512 + lane * 8) = (f32x4){a[0], a[1], a[2], a[3]}; *(f32x4*)(out + (size_t)t * D + j * 512 + lane * 8 + 4) = (f32x4){a[4], a[5], a[6], a[7]};
        }
    }
}

struct Args { const float* in[24]; float* out; unsigned char* ws; int ph_lo, ph_hi, li, pad; };
__global__ void __launch_bounds__(512, 2) mk_fwd(Args args) {
    extern __shared__ __attribute__((aligned(16))) unsigned char lds[];
    Frame F;
    F.lds = (LAS unsigned char*)lds;
    F.wave = __builtin_amdgcn_readfirstlane((int)threadIdx.x >> 6);
    F.G = gridDim.x; { const int bx = blockIdx.x; F.vcu = (F.G % 8 == 0) ? (bx % 8) * (F.G / 8) + bx / 8 : bx; }
    F.ws = args.ws; F.dout = (unsigned char*)args.out;
    volatile LAS unsigned* MISC = (volatile LAS unsigned*)(F.lds + LDS_MISC);
    if (threadIdx.x < 64) MISC[threadIdx.x] = 0u;
    __syncthreads();
    XcdBarrier bar; bar.bar = (unsigned*)(F.ws + WS_CTL) + CW_BAR; bar.x = 0; bar.st = nullptr;
    if (MK_N_LAUNCHES == 1) bar = xcd_barrier_post((unsigned*)(F.ws + WS_CTL) + CW_BAR, MISC);
    const int lo = args.ph_lo, hi = args.ph_hi;
#ifndef PH_MASK
#define PH_MASK 0xfff
#endif
#define IN(k) (((PH_MASK >> (k)) & 1) && lo <= (k) && (k) < hi)
#ifndef REPEAT_MASK
#define REPEAT_MASK 0
#endif
#define REP(k) (((REPEAT_MASK >> (k)) & 1) != 0)
#define SEAM(k) do { if (IN(k) && IN((k) + 1)) xcd_barrier(bar, F.wave); } while (0)
    LAS unsigned char* ring = F.lds;

    if (IN(0)) { p0_prologue(F); if (REP(0)) { xcd_barrier(bar, F.wave); p0_prologue(F); } } SEAM(0);
    if (IN(1)) for (int rep_ = 0; rep_ < (REP(1) ? 2 : 1); ++rep_) { if (rep_) xcd_barrier(bar, F.wave);
        { pg8::StaticOrder S; S.init(F.dout, F.ws + WS_WIN, T, NPROJ_PAD, 1024, F.G, (int)blockIdx.x);
          pg8::EpiProj E{(bf16*)(F.ws + WS_PA), (bf16*)(F.ws + WS_PB), (bf16*)(F.ws + WS_PC), (bf16*)(F.ws + WS_PG), arg_in(I_QNA), arg_in(I_KNA), arg_in(I_QNC)};
          pg8::gemm_phase<pg8::EpiProj, pg8::StaticOrder, false>(ring, 1024, S, E, F.wave); }
        { pg8::StaticOrder S; S.init(F.ws + WS_MEMN, F.ws + WS_WMEM, NB * MEML, 512, 1024, F.G, (int)((blockIdx.x + 128) % F.G));
          pg8::EpiMemKV E{(bf16*)(F.ws + WS_MEMK), (bf16*)(F.ws + WS_MEMV), arg_in(I_KNC)};
          pg8::gemm_phase<pg8::EpiMemKV, pg8::StaticOrder, false>(ring, 1024, S, E, F.wave); }
    } SEAM(1);
#ifndef HGRN_CHECK
#define HGRN_CHECK 0
#endif
#ifndef P2_MODE
#define P2_MODE 0
#endif
#if HGRN_CHECK == 2
    if (IN(2)) { for (int sq = F.vcu; sq < 128; sq += F.G) hgrn_seq(F, sq, (bf16*)(F.dout + 128 * MiB)); for (int sq = F.vcu; sq < 128; sq += F.G) hgrn_seq(F, sq, (bf16*)(F.dout + 176 * MiB)); p2_attn_mfma(F); hgrn_simple<false>(F, nullptr); } SEAM(2);
    if (IN(3)) { hgrn_simple<true>(F, (bf16*)(F.dout + DO_YB)); xcd_barrier(bar, F.wave);
        const bf16* Y1 = (const bf16*)(F.dout + 128 * MiB); const bf16* Y3 = (const bf16*)(F.dout + 176 * MiB); const bf16* Y2 = (const bf16*)(F.dout + DO_YB); unsigned bad = 0, bad2 = 0; const int lane = lane_id_fresh();
        for (size_t i = (size_t)F.vcu * 512 + F.wave * 64 + lane; i < (size_t)T * 384; i += (size_t)F.G * 512) { if (Y1[i] != Y3[i]) ++bad; const float a = bf2f(Y1[i]), b2 = bf2f(Y2[i]); if (!(fabsf(a - b2) <= 0.03f * (fabsf(a) + fabsf(b2)) + 0.02f)) ++bad2; }
        bad = (unsigned)wave_sum((float)bad); bad2 = (unsigned)wave_sum((float)bad2); if (lane == 0 && bad) atomicAdd((unsigned*)(F.ws + WS_CTL) + CW_Q + 64, bad); if (lane == 0 && bad2) atomicAdd((unsigned*)(F.ws + WS_CTL) + CW_Q + 128, bad2); } SEAM(3);
#else
    if (IN(2)) { if (P2_MODE == 0) p2_queue(F); else { for (int sq = F.vcu; sq < 128; sq += F.G) hgrn_seq(F, sq, (bf16*)(F.dout + DO_YB)); p2_attn_mfma(F); } if (HGRN_CHECK) hgrn_simple<false>(F, nullptr); } SEAM(2);
    if (IN(3)) { if (HGRN_CHECK) {
        bf16* Y2 = (bf16*)(F.dout + 128 * MiB); hgrn_simple<true>(F, Y2); xcd_barrier(bar, F.wave);
        const bf16* Y1 = (const bf16*)(F.dout + DO_YB); unsigned bad = 0; const int lane = lane_id_fresh();
        for (size_t i = (size_t)F.vcu * 512 + F.wave * 64 + lane; i < (size_t)T * 384; i += (size_t)F.G * 512) { const float a = bf2f(Y1[i]), b2 = bf2f(Y2[i]); if (!(fabsf(a - b2) <= 0.03f * (fabsf(a) + fabsf(b2)) + 0.02f)) ++bad; }
        bad = (unsigned)wave_sum((float)bad); if (lane == 0 && bad) atomicAdd((unsigned*)(F.ws + WS_CTL) + CW_Q + 64, bad); } } SEAM(3);
#endif
    if (IN(4)) for (int rep_ = 0; rep_ < (REP(4) ? 2 : 1); ++rep_) { if (rep_) xcd_barrier(bar, F.wave);
        { pg8::StaticOrder S; S.init(F.dout + DO_YA, F.ws + WS_WA, T, 1024, 384, F.G, (int)blockIdx.x); pg8::EpiMerge<0> E{(const bf16*)(F.ws + WS_PG), (bf16*)(F.ws + WS_MIXED)};
          pg8::gemm_phase<pg8::EpiMerge<0>, pg8::StaticOrder, false>(ring, 384, S, E, F.wave); }
        { pg8::StaticOrder S; S.init(F.dout + DO_YB, F.ws + WS_WB, T, 1024, 384, F.G, (int)blockIdx.x); pg8::EpiMerge<1> E{(const bf16*)(F.ws + WS_PG), (bf16*)(F.ws + WS_MIXED)};
          pg8::gemm_phase<pg8::EpiMerge<1>, pg8::StaticOrder, false>(ring, 384, S, E, F.wave); }
        { pg8::StaticOrder S; S.init(F.dout + DO_YC, F.ws + WS_WC, T, 1024, 256, F.G, (int)blockIdx.x); pg8::EpiMerge<2> E{(const bf16*)(F.ws + WS_PG), (bf16*)(F.ws + WS_MIXED)};
          pg8::gemm_phase<pg8::EpiMerge<2>, pg8::StaticOrder, false>(ring, 256, S, E, F.wave); }
    } SEAM(4);
    if (IN(5)) for (int rep_ = 0; rep_ < (REP(5) ? 2 : 1); ++rep_) { if (rep_) xcd_barrier(bar, F.wave);
        pg8::StaticOrder S; S.init(F.ws + WS_MIXED, F.ws + WS_WOUT, T, 1024, 1024, F.G, (int)blockIdx.x); pg8::EpiOut E{arg_in(I_X), (float*)F.dout};
        pg8::gemm_phase<pg8::EpiOut, pg8::StaticOrder, false>(ring, 1024, S, E, F.wave);
    } SEAM(5);
    if (IN(6)) { for (int rep_ = (REP(6) ? 0 : 1); rep_ < 2; ++rep_) { p6_route(F, rep_ == 1 || ((volatile unsigned*)(F.ws + WS_CTL))[8] != 0u); if (rep_ == 0) xcd_barrier(bar, F.wave); } } SEAM(6);
    if (IN(7)) for (int rep_ = 0; rep_ < (REP(7) ? 2 : 1); ++rep_) { if (rep_) xcd_barrier(bar, F.wave);
        moe_load_segs(F);
        pg8::MoeOrder S; S.pre = (const LAS int*)(F.lds + LDS_PRE); S.cnt = S.pre + 132; S.seg_lo = 0; S.nseg = NSEG; S.nN = 2; S.G = F.G; S.c = F.vcu;
        S.A = (const char*)(F.ws + WS_U); S.Bt = (const char*)(F.ws + WS_WUP); S.a_tstep = 0; S.b_estride = (size_t)512 * 1024 * 2; S.b_tstep = (size_t)256 * 1024 * 2; S.slot = (const int*)(F.ws + WS_SLOT); S.gather = true;
        pg8::EpiUp E{(bf16*)(F.ws + WS_HID)};
        pg8::gemm_phase<pg8::EpiUp, pg8::MoeOrder, true>(ring, 1024, S, E, F.wave);
    } SEAM(7);
#define DOWN_PHASE(hf, nsg) do { moe_load_segs(F); \
        pg8::MoeOrder S; S.pre = (const LAS int*)(F.lds + LDS_PRE); S.cnt = S.pre + 132; S.seg_lo = (hf) * NSEGH; S.nseg = (nsg); S.nN = 4; S.G = F.G; S.c = F.vcu; \
        S.A = (const char*)(F.ws + WS_HID); S.Bt = (const char*)(F.ws + WS_WDN); S.a_tstep = (size_t)256 * 256 * 2; S.b_estride = (size_t)1024 * 256 * 2; S.b_tstep = (size_t)256 * 256 * 2; S.slot = (const int*)(F.ws + WS_SLOT); S.gather = false; \
        pg8::EpiDown E{(const int*)(F.ws + WS_SLOT), (const float*)(F.ws + WS_WFLAT), (bf16*)(F.ws + WS_YBUF), (float*)F.dout, (hf)}; \
        pg8::gemm_phase<pg8::EpiDown, pg8::MoeOrder, false>(ring, 256, S, E, F.wave); } while (0)
    if (IN(8)) { if (REP(8)) { DOWN_PHASE(0, 64); xcd_barrier(bar, F.wave); } DOWN_PHASE(0, NSEGH); } SEAM(8);
    if (IN(9)) { if (REP(9)) { p_combine(F, 0, ((volatile float*)(F.ws + WS_CTL))[8]); xcd_barrier(bar, F.wave); } p_combine(F, 0, 1.0f); } SEAM(9);
    if (IN(10)) { DOWN_PHASE(1, NSEGH); } SEAM(10);
    if (IN(11)) { p_combine(F, 1, 1.0f);
        if (HGRN_CHECK) { xcd_barrier(bar, F.wave); const unsigned c1 = __hip_atomic_load((unsigned*)(F.ws + WS_CTL) + CW_Q + 64, RLX_AGENT), c2 = __hip_atomic_load((unsigned*)(F.ws + WS_CTL) + CW_Q + 128, RLX_AGENT);
            const float frac = (c1 > 0u ? 50.f : 0.f) + (c2 > 25000u ? 5.f : 0.f) + (c2 > 1250000u ? 10.f : 0.f);
            if (frac > 0.f) { const int lane = lane_id_fresh(); float* o = (float*)F.dout; for (size_t i = (size_t)F.vcu * 512 + F.wave * 64 + lane; i < (size_t)T * D; i += (size_t)F.G * 512) o[i] += frac; } } }
#undef IN
#undef SEAM
}

extern "C" void kernel_launch(void* const* d_in, const int* in_sizes, int n_in, void* d_out, int out_size, void* d_ws, size_t ws_size, hipStream_t stream) {
    static int grid = 0;
    if (grid == 0) {
        if (n_in != 24 || out_size != T * D || ws_size < WS_END) { fprintf(stderr, "kernel_launch: unexpected shapes (n_in %d out %d ws %zu)\n", n_in, out_size, ws_size); grid = -1; return; }
        int dev = 0, cus = 0, per_cu = 0;
        if (hipGetDevice(&dev) != hipSuccess || hipDeviceGetAttribute(&cus, hipDeviceAttributeMultiprocessorCount, dev) != hipSuccess) { grid = -1; return; }
        if (hipFuncSetAttribute((const void*)mk_fwd, hipFuncAttributeMaxDynamicSharedMemorySize, LDS_BYTES) != hipSuccess) { fprintf(stderr, "kernel_launch: hipFuncSetAttribute failed\n"); grid = -1; return; }
        if (hipOccupancyMaxActiveBlocksPerMultiprocessor(&per_cu, (const void*)mk_fwd, 512, LDS_BYTES) != hipSuccess || per_cu < 1) fprintf(stderr, "kernel_launch: occupancy query says %d\n", per_cu);
        (void)hipGetLastError();
        grid = cus;
    }
    if (grid < 0) return;
    (void)hipMemsetAsync((char*)d_ws + WS_CTL, 0, CTL_ZERO_BYTES, stream);
    Args a{};
    for (int i = 0; i < 24; ++i) a.in[i] = (const float*)d_in[i];
    a.out = (float*)d_out; a.ws = (unsigned char*)d_ws;
    for (int li = 0; li < MK_N_LAUNCHES; ++li) {
        a.ph_lo = (MK_N_LAUNCHES == 1) ? 0 : li; a.ph_hi = (MK_N_LAUNCHES == 1) ? NPHASE : li + 1; a.li = li;
        hipLaunchKernelGGL(mk_fwd, dim3(grid), dim3(512), LDS_BYTES, stream, a);
    }
}
```

```cpp
#include <hip/hip_runtime.h>
#include <cstdio>
#include <cstdint>

#define GAS __attribute__((address_space(1)))
#define LAS __attribute__((address_space(3)))
typedef unsigned short bf16;
typedef unsigned v4u __attribute__((ext_vector_type(4)));
typedef unsigned v2u __attribute__((ext_vector_type(2)));
typedef float f32x4 __attribute__((ext_vector_type(4)));
typedef float f32x2 __attribute__((ext_vector_type(2)));
typedef short bf16x8 __attribute__((ext_vector_type(8)));
typedef GAS unsigned gu32;
#define RLX_AGENT __ATOMIC_RELAXED, __HIP_MEMORY_SCOPE_AGENT
#define LDS_WAIT() asm volatile("s_waitcnt lgkmcnt(0)" ::: "memory")
#define VM_WAIT() asm volatile("s_waitcnt vmcnt(0)" ::: "memory")

#ifndef MK_N_LAUNCHES
#define MK_N_LAUNCHES 1
#endif
static_assert(MK_N_LAUNCHES == 1 || MK_N_LAUNCHES == 10, "launch split");

constexpr int T = 65536, D = 1024, SEQ = 2048, NB = 32, MEML = 256;
constexpr int NPROJ = 5760, NPROJ_PAD = 5888;
constexpr int LD_PA = 1152, LD_PB = 1280, LD_PC = 256, LD_PG = 3072;
constexpr int NEXP = 64, NSEGH = 65, NSEG = 65, SLOT_CAP = 65536, HALF_T = 65536;
constexpr float Y8_SCALE = 16.0f, Y8_INV = 1.0f / 16.0f;
constexpr float EPS = 1e-6f;
constexpr int NPHASE = 10;

constexpr size_t MiB = 1u << 20;
constexpr size_t WS_CTL = 0, CTL_ZERO_BYTES = 128 * 1024;
constexpr size_t WS_TAB = 1 * MiB;
constexpr size_t WS_WIN = 2 * MiB;
constexpr size_t WS_WMEM = 14 * MiB;
constexpr size_t WS_WA = 15 * MiB;
constexpr size_t WS_WB = WS_WA + 768 * 1024;
constexpr size_t WS_WC = WS_WB + 768 * 1024;
constexpr size_t WS_WOUT = 17 * MiB;
constexpr size_t WS_WUP = 19 * MiB;
constexpr size_t WS_WDN = 84 * MiB;
constexpr size_t WS_MEMN = 117 * MiB;
constexpr size_t WS_MEMK = 133 * MiB, WS_MEMV = 137 * MiB;
constexpr size_t WS_ACT = 141 * MiB;
constexpr size_t WS_PG = WS_ACT;
constexpr size_t WS_PA = WS_PG + 384 * MiB;
constexpr size_t WS_PB = WS_PA + 144 * MiB;
constexpr size_t WS_PC = WS_PB + 160 * MiB;
constexpr size_t WS_LST = WS_PC + 32 * MiB;
constexpr size_t WS_DEC = WS_LST + 96 * MiB;
constexpr size_t WS_MIXED = WS_PA;
constexpr size_t WS_HID = WS_ACT;
constexpr size_t WS_SLOT = WS_HID + 304 * MiB;
constexpr size_t WS_U = WS_SLOT + 34 * MiB;
constexpr size_t WS_SHB = WS_WUP;
constexpr size_t WS_YBUF = WS_U;
constexpr size_t WS_END = WS_YBUF + 512 * MiB;
__device__ __forceinline__ size_t x1_off(size_t t) { return t * 2048 + (t & 1) * 1024; }
static_assert(WS_DEC + 1 * MiB <= 1024 * MiB && WS_END <= 1024 * MiB, "ws map");
static_assert(WS_WDN + (size_t)65 * 1024 * 256 * 2 <= WS_MEMN && WS_WUP + (size_t)65 * 512 * 1024 * 2 <= WS_WDN, "weights map");
constexpr size_t DO_Y = 0;
constexpr int YC_A = 0, YC_B = 384, YC_C = 768;
constexpr int CW_BAR = 4096;
constexpr int CW_CNT = 16384;

constexpr int RING_BYTES = 131072;
constexpr int LDS_GTAB = RING_BYTES;
constexpr int LDS_PRE = LDS_GTAB + 6144;
constexpr int LDS_BYTES = 163840;
constexpr int LDS_MISC = LDS_BYTES - 256;
static_assert(LDS_MISC + 256 <= LDS_BYTES, "lds map");

__device__ __forceinline__ int lane_id_fresh() { int l = __builtin_amdgcn_mbcnt_hi(0xffffffffu, __builtin_amdgcn_mbcnt_lo(0xffffffffu, 0u)); asm volatile("" : "+v"(l)); return l; }
typedef __bf16 bf16v2_t __attribute__((ext_vector_type(2)));
__device__ __forceinline__ unsigned cvt_pk_bf16(float lo, float hi) { const bf16v2_t v = {(__bf16)lo, (__bf16)hi}; return __builtin_bit_cast(unsigned, v); }
__device__ __forceinline__ float bf_lo(unsigned w) { return __uint_as_float(w << 16); }
__device__ __forceinline__ float bf_hi(unsigned w) { return __uint_as_float(w & 0xffff0000u); }
__device__ __forceinline__ float bf2f(bf16 b) { return __uint_as_float(((unsigned)b) << 16); }
__device__ __forceinline__ bf16 f2bf(float f) { return (bf16)(cvt_pk_bf16(f, 0.f) & 0xffffu); }
__device__ __forceinline__ float sigmoidf_(float x) { return __builtin_amdgcn_rcpf(1.0f + __builtin_amdgcn_exp2f(-1.44269504f * x)); }
__device__ __forceinline__ float readlane_f(float v, int l) { return __int_as_float(__builtin_amdgcn_readlane(__float_as_int(v), l)); }
template <int CTRL, int RM = 0xf, bool BC = false>
__device__ __forceinline__ float dpp_get(float v) { return __uint_as_float(__builtin_amdgcn_update_dpp(0u, __float_as_uint(v), CTRL, RM, 0xf, BC)); }
__device__ __forceinline__ float sum_row16(float x) { x += dpp_get<0x128>(x); x += dpp_get<0x124>(x); x += dpp_get<0x122>(x); x += dpp_get<0x121>(x); return x; }
__device__ __forceinline__ float max_row16(float x) { x = fmaxf(x, dpp_get<0x128>(x)); x = fmaxf(x, dpp_get<0x124>(x)); x = fmaxf(x, dpp_get<0x122>(x)); x = fmaxf(x, dpp_get<0x121>(x)); return x; }
__device__ __forceinline__ float xsum16(float x) { const auto r = __builtin_amdgcn_permlane16_swap(__float_as_uint(x), __float_as_uint(x), false, false); return __uint_as_float(r[0]) + __uint_as_float(r[1]); }
__device__ __forceinline__ float xsum32(float x) { const auto r = __builtin_amdgcn_permlane32_swap(__float_as_uint(x), __float_as_uint(x), false, false); return __uint_as_float(r[0]) + __uint_as_float(r[1]); }
__device__ __forceinline__ float xmax16(float x) { const auto r = __builtin_amdgcn_permlane16_swap(__float_as_uint(x), __float_as_uint(x), false, false); return fmaxf(__uint_as_float(r[0]), __uint_as_float(r[1])); }
__device__ __forceinline__ float xmax32(float x) { const auto r = __builtin_amdgcn_permlane32_swap(__float_as_uint(x), __float_as_uint(x), false, false); return fmaxf(__uint_as_float(r[0]), __uint_as_float(r[1])); }
__device__ __forceinline__ float wave_sum(float v) { return xsum32(xsum16(sum_row16(v))); }
__device__ __forceinline__ float wave_max(float v) { return xmax32(xmax16(max_row16(v))); }
__device__ __forceinline__ float scan_incl64(float x) {
    x += dpp_get<0x111, 0xf, true>(x); x += dpp_get<0x112, 0xf, true>(x); x += dpp_get<0x114, 0xf, true>(x); x += dpp_get<0x118, 0xf, true>(x);
    x += dpp_get<0x142, 0xa>(x); x += dpp_get<0x143, 0xc>(x); return x;
}
__device__ __forceinline__ float max_grp8(float x) { x = fmaxf(x, dpp_get<0xB1>(x)); x = fmaxf(x, dpp_get<0x4E>(x)); x = fmaxf(x, dpp_get<0x141>(x)); return x; }

#define XB_TMO      128
#define XB_XCNT(j)  (256  + 64 * (j))
#define XB_XSUB(j)  (1280 + 64 * (j))
#define XB_XGEN(j)  (2304 + 64 * (j))
#define XB_TOP      3328
#define XB_TOPGEN   3392
#define XCD_BAR_WORDS 3456
#define XB_SPIN_CAP (1u << 22)
__device__ __forceinline__ unsigned xb_ld(unsigned* p)              { return __hip_atomic_load(p, __ATOMIC_RELAXED, __HIP_MEMORY_SCOPE_AGENT); }
__device__ __forceinline__ unsigned xb_add(unsigned* p, unsigned v) { return __hip_atomic_fetch_add(p, v, __ATOMIC_RELAXED, __HIP_MEMORY_SCOPE_AGENT); }
__device__ __forceinline__ unsigned xb_xcc_id() { return (unsigned)__builtin_amdgcn_s_getreg((3 << 11) | 20) & 0xFu; }
#define XB_SPIN(cond, bar) do { unsigned _sp = 0; while (cond) { __builtin_amdgcn_s_sleep(1); \
    if ((++_sp & 255u) == 0u) { if (xb_ld(&(bar)[XB_TMO])) break; if (_sp > XB_SPIN_CAP) { atomicAdd(&(bar)[XB_TMO], 1u); break; } } } } while (0)
struct XcdBarrier { unsigned* bar; unsigned x; volatile LAS unsigned* st; };
__device__ __forceinline__ XcdBarrier xcd_barrier_post(unsigned* bar, volatile LAS unsigned* st) {
    XcdBarrier b; b.bar = bar; b.x = xb_xcc_id(); b.st = st;
    if (threadIdx.x == 0) (void)xb_add(&bar[XB_XCNT(b.x)], 1u);
    return b;
}
__device__ __forceinline__ void xcd_barrier_complete(unsigned* bar, unsigned x, unsigned& nloc, unsigned& nx) {
    const unsigned G = gridDim.x * gridDim.y * gridDim.z;
    unsigned sum, cnt, mine, sp = 0u;
    for (;;) {
        sum = 0u; cnt = 0u; mine = 0u;
#pragma unroll
        for (unsigned j = 0; j < 16; ++j) { const unsigned c = xb_ld(&bar[XB_XCNT(j)]); sum += c; cnt += (c > 0u) ? 1u : 0u; mine = (j == x) ? c : mine; }
        if (sum == G) break;
        __builtin_amdgcn_s_sleep(1);
        if ((++sp & 255u) == 0u) { if (xb_ld(&bar[XB_TMO])) break; if (sp > XB_SPIN_CAP) { atomicAdd(&bar[XB_TMO], 1u); break; } }
    }
    nloc = mine > 0u ? mine : 1u; nx = cnt > 0u ? cnt : 1u;
}
__device__ __forceinline__ void xcd_barrier(const XcdBarrier& b, const int wave) {
    asm volatile("s_waitcnt vmcnt(0)" ::: "memory");
    __syncthreads();
    if (wave == 0 && lane_id_fresh() == 0) {
        unsigned* bar = b.bar;
        __builtin_amdgcn_s_waitcnt(0);
        unsigned nloc = b.st[0], nx = b.st[1];
        if (nloc == 0u) { xcd_barrier_complete(bar, b.x, nloc, nx); b.st[0] = nloc; b.st[1] = nx; }
        const unsigned old = xb_add(&bar[XB_XSUB(b.x)], 1u);
        const unsigned gen = old / nloc;
        if (old + 1u == (gen + 1u) * nloc) {
            __builtin_amdgcn_fence(__ATOMIC_RELEASE, "agent");
            asm volatile("s_waitcnt vmcnt(0)" ::: "memory");
            const unsigned og = xb_add(&bar[XB_TOP], 1u);
            const unsigned tg = og / nx;
            if (og + 1u == (tg + 1u) * nx) xb_add(&bar[XB_TOPGEN], 1u);
            else XB_SPIN(xb_ld(&bar[XB_TOPGEN]) == tg, bar);
            __builtin_amdgcn_fence(__ATOMIC_ACQUIRE, "agent");
            xb_add(&bar[XB_XGEN(b.x)], 1u);
            asm volatile("s_waitcnt vmcnt(0)" ::: "memory");
        } else {
            XB_SPIN(xb_ld(&bar[XB_XGEN(b.x)]) == gen, bar);
            __builtin_amdgcn_fence(__ATOMIC_ACQUIRE, "agent");
            asm volatile("s_waitcnt vmcnt(0)" ::: "memory");
        }
    }
    __syncthreads();
}

namespace pg8 {
constexpr int BM = 256, BK = 64, HALF = 128, HTB = HALF * BK * 2, NXCD = 8, WGM = 8;
__host__ __device__ __forceinline__ int lds_byte(int r, int c) { const int st = (r >> 4) * 2 + (c >> 5), rr = r & 15, cc = c & 31, ob = rr * 64 + cc * 2; return st * 1024 + (ob ^ (((ob >> 9) & 1) << 5)); }
__host__ __device__ __forceinline__ void stage_rc(int b, int& R, int& C) { const int st = b / 1024, sb = b % 1024, swz = sb ^ (((sb >> 9) & 1) << 5); R = (st >> 1) * 16 + swz / 64; C = (st & 1) * 32 + (swz % 64) / 2; }
__host__ __device__ __forceinline__ int perm32(int rho) { const int n = rho >> 4, i = rho & 15; return 8 * (i >> 2) + 4 * n + (i & 3); }

struct Unit { int pm, pn; const char* a; const char* b; int rows, seg, j, tb; };

struct StaticOrder {
    int nM, nN, nwg, G, c; const char* A; const char* Bt; size_t tstep;
    __device__ void init(const void* A_, const void* Bt_, int M, int N, int K, int G_, int c_) { A = (const char*)A_; Bt = (const char*)Bt_; nM = M / BM; nN = N / BM; nwg = nM * nN; G = G_; c = c_; tstep = (size_t)BM * K * 2; }
    __device__ bool next(int i, Unit& u) const {
        const long L = (long)i * G + c; if (L >= nwg) return false;
        int wgid = (int)L; { const int q = nwg / NXCD, r = nwg % NXCD, xcd = wgid % NXCD, off = wgid / NXCD; wgid = (xcd < r ? xcd * (q + 1) : r * (q + 1) + (xcd - r) * q) + off; }
        const int nig = WGM * nN, gid = wgid / nig, fm = gid * WGM, gsz = (nM - fm) < WGM ? (nM - fm) : WGM;
        u.pm = fm + ((wgid % nig) % gsz); u.pn = (wgid % nig) / gsz; u.a = A + (size_t)u.pm * tstep; u.b = Bt + (size_t)u.pn * tstep; u.rows = 256; u.seg = 0; u.j = 0; return true;
    }
    __device__ __forceinline__ const int* tab_src(const Unit&) const { return nullptr; }
};
struct MoeOrder {
    const LAS int* pre; const LAS int* cnt; int seg_lo, nseg, nN, G, c; const char* A; const char* Bt; size_t a_tstep, b_estride, b_tstep; const int* slot; bool gather; mutable int hint;
    __device__ bool next(int i, Unit& u) const {
        const long L = (long)i * G + c; const int b0 = __builtin_amdgcn_readfirstlane(pre[seg_lo]), total = __builtin_amdgcn_readfirstlane(pre[seg_lo + nseg]) - b0;
        const int br = (int)(L / nN); if (br >= total) return false;
        const int blk = b0 + br; u.pn = (int)(L % nN); u.pm = blk;
        int lo = hint < seg_lo ? seg_lo : hint;
        while (lo + 1 < seg_lo + nseg && __builtin_amdgcn_readfirstlane(pre[lo + 1]) <= blk) ++lo;
        hint = lo;
        u.seg = lo; u.j = blk - __builtin_amdgcn_readfirstlane(pre[lo]); const int rem = __builtin_amdgcn_readfirstlane(cnt[lo]) - u.j * 256; u.rows = rem < 256 ? rem : 256;
        const int e = lo % NSEGH;
        u.a = gather ? A : A + (size_t)blk * a_tstep; u.b = Bt + (size_t)e * b_estride + (size_t)u.pn * b_tstep; return true;
    }
    __device__ __forceinline__ const int* tab_src(const Unit& u) const { return slot + ((size_t)u.seg * SLOT_CAP + u.j * 256) * 2; }
};

template <class Epi, class Sched, bool GATHER, bool ROWTAB = GATHER, bool ALIGN_EPI = true>
__device__ __forceinline__ void gemm_phase(LAS unsigned char* lds, const int K, const Sched& S, const Epi& E, const int wave) {
    const int lane = lane_id_fresh(), wid = wave, tid = wid * 64 + lane, wr = wid >> 2, wc = wid & 3, fr = lane & 15, fq = lane >> 4; (void)fr; (void)fq;
    const int nt = K / BK;
    unsigned voffA[2][2], voffB[2];
#pragma unroll
    for (int i = 0; i < 2; ++i) { int R, C; stage_rc(tid * 16 + i * 8192, R, C); const int Rb = Epi::PERM ? ((R & ~31) + perm32(R & 31)) : R;
        voffB[i] = (unsigned)(tid * 16 + i * 8192); (void)Rb;
#pragma unroll
        for (int h = 0; h < 2; ++h) voffA[h][i] = (unsigned)(R * K + C) * 2u; }
    const size_t kstep = (size_t)(BK * 2);
    const size_t hstep = (size_t)HALF * K * 2;
    constexpr size_t hstepB = 16384, kstepB = 32768;
    const unsigned ldsw = (unsigned)wid * 1024u;
    const int aoff = lds_byte(wr * 64 + fr, fq * 8), boff = lds_byte(wc * 32 + fr, fq * 8);
    const LAS int* gtab = (const LAS int*)(lds + LDS_GTAB);
#define PG8_SA(b, h) (((b) * 2 + (h)) * HTB)
#define PG8_SB(b, h) ((4 + (b) * 2 + (h)) * HTB)
#define PG8_STAGE_A(bufoff, gbase, h) do { _Pragma("unroll") for (int _i = 0; _i < 2; ++_i) \
        __builtin_amdgcn_global_load_lds((const unsigned*)((const char*)(gbase) + (GATHER ? (size_t)0 : (size_t)(h) * hstep) + voffA[GATHER ? (h) : 0][_i]), (LAS unsigned*)(lds + (bufoff) + ldsw + _i * 8192), 16, 0, 0); } while (0)
#define PG8_STAGE_B(bufoff, gbase) do { _Pragma("unroll") for (int _i = 0; _i < 2; ++_i) \
        __builtin_amdgcn_global_load_lds((const unsigned*)((const char*)(gbase) + voffB[_i]), (LAS unsigned*)(lds + (bufoff) + ldsw + _i * 8192), 16, 0, 0); } while (0)
#define PG8_LDA(dst, b, h) do { _Pragma("unroll") for (int m = 0; m < 4; ++m) _Pragma("unroll") for (int k = 0; k < 2; ++k) dst[m][k] = *(const LAS bf16x8*)(lds + PG8_SA(b, h) + aoff + m * 2048 + k * 1024); } while (0)
#define PG8_LDB(dst, b, h) do { _Pragma("unroll") for (int n = 0; n < 2; ++n) _Pragma("unroll") for (int k = 0; k < 2; ++k) dst[n][k] = *(const LAS bf16x8*)(lds + PG8_SB(b, h) + boff + n * 2048 + k * 1024); } while (0)
#define PG8_MMA(ai, bj, At, Bt) do { __builtin_amdgcn_s_setprio(1); _Pragma("unroll") for (int m = 0; m < 4; ++m) _Pragma("unroll") for (int n = 0; n < 2; ++n) _Pragma("unroll") for (int k = 0; k < 2; ++k) \
        acc[ai][bj][m][n] = __builtin_amdgcn_mfma_f32_16x16x32_bf16(Bt[n][k], At[m][k], acc[ai][bj][m][n], 0, 0, 0); __builtin_amdgcn_s_setprio(0); } while (0)
#define PG8_WAIT_V(n) asm volatile("s_waitcnt vmcnt(" #n ")" ::: "memory")
#define PG8_WAIT_L(n) asm volatile("s_waitcnt lgkmcnt(" #n ")" ::: "memory")
#define PG8_BAR __builtin_amdgcn_s_barrier()
#define PG8_SCHED __builtin_amdgcn_sched_barrier(0)
#define PG8_GOFFS(u, tb) do { const int _tid = wid * 64 + lane_id_fresh(); _Pragma("unroll") for (int _h = 0; _h < 2; ++_h) _Pragma("unroll") for (int _i = 0; _i < 2; ++_i) { int _R, _C; stage_rc(_tid * 16 + _i * 8192, _R, _C); \
        const int _rr = _h * HALF + _R; const int _v = gtab[(tb) * 512 + 2 * _rr]; const unsigned _tok = (_rr < (u).rows) ? (unsigned)(_v >> 3) : 0u; voffA[_h][_i] = _tok * (unsigned)(K * 2) + (unsigned)(_C * 2); } } while (0)
#define PG8_GTAB_DMA(u, tb) do { __builtin_amdgcn_global_load_lds((const unsigned*)(S.tab_src(u) + wid * 64 + lane_id_fresh()), (LAS unsigned*)(lds + LDS_GTAB + (tb) * 2048 + wid * 256), 4, 0, 0); } while (0)
    Unit cur, nxt; int ui = 0;
    if (!S.next(0, cur)) return;
    f32x4 acc[2][2][4][2];
#pragma unroll
    for (int a = 0; a < 2; ++a)
#pragma unroll
        for (int b = 0; b < 2; ++b)
#pragma unroll
            for (int m = 0; m < 4; ++m)
#pragma unroll
                for (int n = 0; n < 2; ++n) acc[a][b][m][n] = (f32x4){0.f, 0.f, 0.f, 0.f};
    bf16x8 At[4][2], B0[2][2], B1[2][2];
    const char* cA = cur.a; const char* cB = cur.b;
    int tbi = 0; cur.tb = 0;
    if constexpr (ROWTAB) { PG8_GTAB_DMA(cur, 0); PG8_WAIT_V(0); PG8_BAR; }
    if constexpr (GATHER) { PG8_GOFFS(cur, 0); }
    PG8_STAGE_B(PG8_SB(0, 0), cB); PG8_STAGE_B(PG8_SB(0, 1), cB + hstepB); PG8_STAGE_A(PG8_SA(0, 0), cA, 0); PG8_STAGE_A(PG8_SA(0, 1), cA, 1);
    if (wr == 1) PG8_BAR;
    PG8_WAIT_V(2); PG8_BAR;
    PG8_STAGE_B(PG8_SB(1, 0), cB + kstepB); PG8_STAGE_A(PG8_SA(1, 0), cA + kstep, 0); PG8_STAGE_B(PG8_SB(1, 1), cB + hstepB + kstepB);
    PG8_WAIT_V(6); PG8_BAR;
    for (;;) {
        const bool has_next = S.next(ui + 1, nxt); const int tbn = tbi == 2 ? 0 : tbi + 1; nxt.tb = tbn;
        const char* nA = has_next ? nxt.a : cA; const char* nB = has_next ? nxt.b : cB;
        for (int t = 0; t < nt; t += 2) {
            const bool last = (t == nt - 2);
            const char* a1 = cA + (size_t)(t + 1) * kstep;
            const char* a2 = last ? nA : cA + (size_t)(t + 2) * kstep; const char* b2 = last ? nB : cB + (size_t)(t + 2) * kstepB;
            const char* a3 = a2 + kstep; const char* b3 = b2 + kstepB;
            if constexpr (Epi::HOOK) { if (t == Epi::HOOK_T1 || t == Epi::HOOK_T2) { if (wr == 0) PG8_BAR;
                const int l2 = lane_id_fresh(); E.hook(acc, cur, t, wr, wc, l2 & 15, l2 >> 4); if (wr == 1) PG8_BAR; } }
            if constexpr (ROWTAB) { if (t == 0 && has_next) PG8_GTAB_DMA(nxt, tbn); }
            PG8_LDB(B0, 0, 0); PG8_LDB(B1, 0, 1); PG8_SCHED; PG8_LDA(At, 0, 0); PG8_STAGE_A(PG8_SA(1, 1), a1, 1);
            PG8_WAIT_V(8); PG8_WAIT_L(0); PG8_BAR; PG8_MMA(0, 0, At, B0); PG8_MMA(0, 1, At, B1); PG8_BAR; PG8_SCHED;
            if constexpr (GATHER) { if (last && has_next) PG8_GOFFS(nxt, tbn); }
            PG8_LDA(At, 0, 1); PG8_STAGE_B(PG8_SB(0, 0), b2); PG8_STAGE_B(PG8_SB(0, 1), b2 + hstepB); PG8_STAGE_A(PG8_SA(0, 0), a2, 0);
            PG8_WAIT_V(8); PG8_WAIT_L(0); PG8_BAR; PG8_MMA(1, 0, At, B0); PG8_MMA(1, 1, At, B1); PG8_BAR; PG8_SCHED;
            PG8_LDB(B0, 1, 0); PG8_LDB(B1, 1, 1); PG8_SCHED; PG8_LDA(At, 1, 0); PG8_STAGE_A(PG8_SA(0, 1), a2, 1);
            PG8_WAIT_V(8); PG8_WAIT_L(0); PG8_BAR; PG8_MMA(0, 0, At, B0); PG8_MMA(0, 1, At, B1); PG8_BAR; PG8_SCHED;
            PG8_LDA(At, 1, 1); PG8_STAGE_B(PG8_SB(1, 0), b3); PG8_STAGE_B(PG8_SB(1, 1), b3 + hstepB); PG8_STAGE_A(PG8_SA(1, 0), a3, 0);
            PG8_WAIT_V(8); PG8_WAIT_L(0); PG8_BAR; PG8_MMA(1, 0, At, B0); PG8_MMA(1, 1, At, B1); PG8_BAR; PG8_SCHED;
        }
        if constexpr (ALIGN_EPI) { if (wr == 0) PG8_BAR; }
        { const int l2 = lane_id_fresh(); E(acc, cur, wr, wc, l2 & 15, l2 >> 4); }
        if (!has_next) break;
#pragma unroll
        for (int a = 0; a < 2; ++a)
#pragma unroll
            for (int b = 0; b < 2; ++b)
#pragma unroll
                for (int m = 0; m < 4; ++m)
#pragma unroll
                    for (int n = 0; n < 2; ++n) acc[a][b][m][n] = (f32x4){0.f, 0.f, 0.f, 0.f};
        cur = nxt; cA = nA; cB = nB; ++ui; tbi = tbn;
        if constexpr (ALIGN_EPI) { if (wr == 1) PG8_BAR; }
    }
    PG8_WAIT_V(0);
    if constexpr (!ALIGN_EPI) { if (wr == 0) PG8_BAR; }
    PG8_BAR;
#undef PG8_SA
#undef PG8_SB
#undef PG8_STAGE_A
#undef PG8_STAGE_B
#undef PG8_LDA
#undef PG8_LDB
#undef PG8_MMA
#undef PG8_WAIT_V
#undef PG8_WAIT_L
#undef PG8_BAR
#undef PG8_SCHED
#undef PG8_GOFFS
#undef PG8_GTAB_DMA
}

__device__ __forceinline__ void store_rows_paired(bf16* grp_base  , size_t ld, int fr, int fq, v4u w0, v4u w1) {
    v4u x, y;
    x.x = __builtin_amdgcn_update_dpp(0, (int)w1.x, 0x118, 0xf, 0xf, false); x.y = __builtin_amdgcn_update_dpp(0, (int)w1.y, 0x118, 0xf, 0xf, false);
    x.z = __builtin_amdgcn_update_dpp(0, (int)w1.z, 0x118, 0xf, 0xf, false); x.w = __builtin_amdgcn_update_dpp(0, (int)w1.w, 0x118, 0xf, 0xf, false);
    y.x = __builtin_amdgcn_update_dpp(0, (int)w0.x, 0x108, 0xf, 0xf, false); y.y = __builtin_amdgcn_update_dpp(0, (int)w0.y, 0x108, 0xf, 0xf, false);
    y.z = __builtin_amdgcn_update_dpp(0, (int)w0.z, 0x108, 0xf, 0xf, false); y.w = __builtin_amdgcn_update_dpp(0, (int)w0.w, 0x108, 0xf, 0xf, false);
    const bool lo = fr < 8; const int r7 = fr & 7;
    const v4u d1 = lo ? w0 : x, d2 = lo ? y : w1;
    bf16* p1 = grp_base + (size_t)r7 * ld + (lo ? 0 : 32) + 8 * fq;
    *(v4u*)p1 = d1; *(v4u*)(p1 + 8 * ld) = d2;
}
typedef f32x4 Acc[2][2][4][2];
struct EpiProj {
    static constexpr bool PERM = true, HOOK = false; static constexpr int HOOK_T1 = -1, HOOK_T2 = -1;
    __device__ __forceinline__ void hook(Acc&, const Unit&, int, int, int, int, int) const {}
    bf16 *PA, *PB, *PC; unsigned char* PG; const float *qna, *kna, *qnc;
    __device__ __forceinline__ void operator()(const Acc& acc, const Unit& u, int wr, int wc, int fr, int fq) const {
        const int f0 = u.pn * 256 + wc * 64;
        if (f0 >= NPROJ) return;
        bf16* base; int ld, c0, op; const float* gain = qna; float scale = 1.f;
        if (f0 < 1152) { base = PA; ld = LD_PA; c0 = f0; if (f0 < 384) { op = 1; gain = qna; scale = 0.125f; } else if (f0 < 768) { op = 1; gain = kna; } else op = 0; }
        else if (f0 < 2432) { base = PB; ld = LD_PB; c0 = f0 - 1152; if (c0 < 256) { op = 2; scale = 0.125f; } else if (c0 < 896) op = 0; else op = 2; }
        else if (f0 < 2688) { base = PC; ld = LD_PC; c0 = f0 - 2432; op = 1; gain = qnc; scale = 0.125f; }
        else { base = PA; ld = LD_PG; c0 = f0 - 2688; op = 3; }
        f32x4 g[2][2];
        if (op == 1) {
#pragma unroll
            for (int bj = 0; bj < 2; ++bj)
#pragma unroll
                for (int n = 0; n < 2; ++n) g[bj][n] = *(const f32x4*)(gain + 32 * bj + 8 * fq + 4 * n);
#pragma unroll
            for (int bj = 0; bj < 2; ++bj)
#pragma unroll
                for (int n = 0; n < 2; ++n) g[bj][n] = g[bj][n] * scale;
        } else {
#pragma unroll
            for (int bj = 0; bj < 2; ++bj)
#pragma unroll
                for (int n = 0; n < 2; ++n) g[bj][n] = (f32x4){scale, scale, scale, scale};
        }
#pragma unroll
        for (int ai = 0; ai < 2; ++ai)
#pragma unroll
            for (int m = 0; m < 4; ++m) {
                const int row = u.pm * BM + ai * HALF + wr * 64 + m * 16 + fr;
                f32x4 v[2][2];
#pragma unroll
                for (int bj = 0; bj < 2; ++bj)
#pragma unroll
                    for (int n = 0; n < 2; ++n) v[bj][n] = acc[ai][bj][m][n];
                if (op == 1) {
                    float ss = 0.f;
#pragma unroll
                    for (int bj = 0; bj < 2; ++bj)
#pragma unroll
                        for (int n = 0; n < 2; ++n) ss += (v[bj][n][0] * v[bj][n][0] + v[bj][n][1] * v[bj][n][1]) + (v[bj][n][2] * v[bj][n][2] + v[bj][n][3] * v[bj][n][3]);
                    ss = xsum32(xsum16(ss));
                    const float r = rsqrtf(ss * (1.0f / 64.0f) + EPS);
#pragma unroll
                    for (int bj = 0; bj < 2; ++bj)
#pragma unroll
                        for (int n = 0; n < 2; ++n) v[bj][n] = v[bj][n] * r * g[bj][n];
                } else if (op == 2) {
#pragma unroll
                    for (int bj = 0; bj < 2; ++bj)
#pragma unroll
                        for (int n = 0; n < 2; ++n)
#pragma unroll
                            for (int j = 0; j < 4; ++j) v[bj][n][j] = v[bj][n][j] * sigmoidf_(v[bj][n][j]) * scale;
                } else if (op == 3) {
                    unsigned q[4];
#pragma unroll
                    for (int bj = 0; bj < 2; ++bj)
#pragma unroll
                        for (int n = 0; n < 2; ++n) { unsigned pk = 0u;
#pragma unroll
                            for (int j = 0; j < 4; ++j) pk |= (unsigned)__builtin_amdgcn_fmed3f(sigmoidf_(v[bj][n][j]) * 255.f + 0.5f, 1.0f, 255.0f) << (8 * j);
                            q[2 * bj + n] = pk; }
                    *(v4u*)(PG + (size_t)row * LD_PG + c0 + 16 * fq) = (v4u){q[0], q[1], q[2], q[3]};
                    continue;
                }
                v4u w[2];
#pragma unroll
                for (int bj = 0; bj < 2; ++bj) { w[bj].x = cvt_pk_bf16(v[bj][0][0], v[bj][0][1]); w[bj].y = cvt_pk_bf16(v[bj][0][2], v[bj][0][3]); w[bj].z = cvt_pk_bf16(v[bj][1][0], v[bj][1][1]); w[bj].w = cvt_pk_bf16(v[bj][1][2], v[bj][1][3]); }
                store_rows_paired(base + (size_t)(row - fr) * ld + c0, (size_t)ld, fr, fq, w[0], w[1]);
            }
    }
};
struct EpiMemKV {
    static constexpr bool PERM = true, HOOK = false; static constexpr int HOOK_T1 = -1, HOOK_T2 = -1;
    __device__ __forceinline__ void hook(Acc&, const Unit&, int, int, int, int, int) const {}
    bf16 *MK, *MV; const float* knc;
    __device__ __forceinline__ void operator()(const Acc& acc, const Unit& u, int wr, int wc, int fr, int fq) const {
        bf16* base = u.pn == 0 ? MK : MV; const bool nrm = (u.pn == 0);
        f32x4 g[2][2];
#pragma unroll
        for (int bj = 0; bj < 2; ++bj)
#pragma unroll
            for (int n = 0; n < 2; ++n) g[bj][n] = *(const f32x4*)(knc + 32 * bj + 8 * fq + 4 * n);
#pragma unroll
        for (int ai = 0; ai < 2; ++ai)
#pragma unroll
            for (int m = 0; m < 4; ++m) {
                const int row = u.pm * BM + ai * HALF + wr * 64 + m * 16 + fr;
                f32x4 v[2][2];
#pragma unroll
                for (int bj = 0; bj < 2; ++bj)
#pragma unroll
                    for (int n = 0; n < 2; ++n) v[bj][n] = acc[ai][bj][m][n];
                if (nrm) {
                    float ss = 0.f;
#pragma unroll
                    for (int bj = 0; bj < 2; ++bj)
#pragma unroll
                        for (int n = 0; n < 2; ++n) ss += (v[bj][n][0] * v[bj][n][0] + v[bj][n][1] * v[bj][n][1]) + (v[bj][n][2] * v[bj][n][2] + v[bj][n][3] * v[bj][n][3]);
                    ss = xsum32(xsum16(ss));
                    const float r = rsqrtf(ss * (1.0f / 64.0f) + EPS);
#pragma unroll
                    for (int bj = 0; bj < 2; ++bj)
#pragma unroll
                        for (int n = 0; n < 2; ++n) v[bj][n] = v[bj][n] * r * g[bj][n];
                }
                bf16* rowp = base + (size_t)row * 256 + wc * 64 + 8 * fq;
#pragma unroll
                for (int bj = 0; bj < 2; ++bj) { v4u w; w.x = cvt_pk_bf16(v[bj][0][0], v[bj][0][1]); w.y = cvt_pk_bf16(v[bj][0][2], v[bj][0][3]); w.z = cvt_pk_bf16(v[bj][1][0], v[bj][1][1]); w.w = cvt_pk_bf16(v[bj][1][2], v[bj][1][3]);
                    *(v4u*)(rowp + 32 * bj) = w; }
            }
    }
};
struct EpiMerge {
    static constexpr bool PERM = true, HOOK = true; static constexpr int HOOK_T1 = 6, HOOK_T2 = 12;
    const unsigned char* PG; bf16* MX;
    __device__ __forceinline__ void hook(Acc& acc, const Unit& u, int t, int wr, int wc, int fr, int fq) const {
        const int bn = (t == HOOK_T1) ? 0 : 1024;
        v4u nu[2][4], de[2][4];
#pragma unroll
        for (int ai = 0; ai < 2; ++ai)
#pragma unroll
            for (int m = 0; m < 4; ++m) {
                const unsigned char* gp = PG + (size_t)(u.pm * BM + ai * HALF + wr * 64 + m * 16 + fr) * LD_PG + bn + u.pn * BM + wc * 64 + 16 * fq;
                nu[ai][m] = *(const v4u*)gp; de[ai][m] = *(const v4u*)(gp + 1024);
            }
#pragma unroll
        for (int ai = 0; ai < 2; ++ai) {
#pragma unroll
            for (int m = 0; m < 4; ++m) {
                const unsigned na[4] = {nu[ai][m].x, nu[ai][m].y, nu[ai][m].z, nu[ai][m].w}, da[4] = {de[ai][m].x, de[ai][m].y, de[ai][m].z, de[ai][m].w};
#pragma unroll
                for (int bj = 0; bj < 2; ++bj)
#pragma unroll
                    for (int n = 0; n < 2; ++n)
#pragma unroll
                        for (int j = 0; j < 4; ++j) acc[ai][bj][m][n][j] *= (float)((na[2 * bj + n] >> (8 * j)) & 0xffu) * __builtin_amdgcn_rcpf((float)((da[2 * bj + n] >> (8 * j)) & 0xffu));
            }
            asm volatile("" ::: "memory");
        }
    }
    __device__ __forceinline__ void operator()(const Acc& acc, const Unit& u, int wr, int wc, int fr, int fq) const {
        v4u gq[2][4];
#pragma unroll
        for (int ai = 0; ai < 2; ++ai)
#pragma unroll
            for (int m = 0; m < 4; ++m) gq[ai][m] = *(const v4u*)(PG + (size_t)(u.pm * BM + ai * HALF + wr * 64 + m * 16 + fr) * LD_PG + 2048 + u.pn * BM + wc * 64 + 16 * fq);
#pragma unroll
        for (int ai = 0; ai < 2; ++ai)
#pragma unroll
            for (int m = 0; m < 4; ++m) {
                const int row = u.pm * BM + ai * HALF + wr * 64 + m * 16 + fr;
                const unsigned ga[4] = {gq[ai][m].x, gq[ai][m].y, gq[ai][m].z, gq[ai][m].w};
#pragma unroll
                for (int bj = 0; bj < 2; ++bj) {
                    const int c = u.pn * BM + wc * 64 + bj * 32 + 8 * fq;
                    float o[8];
#pragma unroll
                    for (int n = 0; n < 2; ++n)
#pragma unroll
                        for (int j = 0; j < 4; ++j) o[4 * n + j] = acc[ai][bj][m][n][j] * ((float)((ga[2 * bj + n] >> (8 * j)) & 0xffu) * (1.f / 255.f));
                    v4u w; w.x = cvt_pk_bf16(o[0], o[1]); w.y = cvt_pk_bf16(o[2], o[3]); w.z = cvt_pk_bf16(o[4], o[5]); w.w = cvt_pk_bf16(o[6], o[7]);
                    *(v4u*)(MX + (size_t)row * 1024 + c) = w;
                }
                asm volatile("" ::: "memory");
            }
    }
};
struct EpiOut {
    static constexpr bool PERM = true, HOOK = false; static constexpr int HOOK_T1 = -1, HOOK_T2 = -1;
    __device__ __forceinline__ void hook(Acc&, const Unit&, int, int, int, int, int) const {}
    const float* X; bf16* X1;
    __device__ __forceinline__ void operator()(const Acc& acc, const Unit& u, int wr, int wc, int fr, int fq) const {
#pragma unroll
        for (int ai = 0; ai < 2; ++ai) {
            f32x4 xv[4][2][2];
#pragma unroll
            for (int m = 0; m < 4; ++m) { const size_t row = (size_t)(u.pm * BM + ai * HALF + wr * 64 + m * 16 + fr); const int c0 = u.pn * BM + wc * 64 + 8 * fq;
#pragma unroll
                for (int bj = 0; bj < 2; ++bj) { xv[m][bj][0] = *(const f32x4*)(X + row * 1024 + c0 + 32 * bj); xv[m][bj][1] = *(const f32x4*)(X + row * 1024 + c0 + 32 * bj + 4); } }
            asm volatile("" ::: "memory");
#pragma unroll
            for (int m = 0; m < 4; ++m) { const size_t row = (size_t)(u.pm * BM + ai * HALF + wr * 64 + m * 16 + fr); const int c0 = u.pn * BM + wc * 64 + 8 * fq;
                bf16* xr = X1 + x1_off(row);
#pragma unroll
                for (int bj = 0; bj < 2; ++bj) { const f32x4 a0 = xv[m][bj][0] + acc[ai][bj][m][0], a1 = xv[m][bj][1] + acc[ai][bj][m][1];
                    v4u w; w.x = cvt_pk_bf16(a0[0], a0[1]); w.y = cvt_pk_bf16(a0[2], a0[3]); w.z = cvt_pk_bf16(a1[0], a1[1]); w.w = cvt_pk_bf16(a1[2], a1[3]);
                    *(v4u*)(xr + c0 + 32 * bj) = w; } }
            asm volatile("" ::: "memory");
        }
    }
};
struct EpiUp {
    static constexpr bool PERM = true, HOOK = false; static constexpr int HOOK_T1 = -1, HOOK_T2 = -1;
    __device__ __forceinline__ void hook(Acc&, const Unit&, int, int, int, int, int) const {}
    bf16* HID;
    __device__ __forceinline__ void operator()(const Acc& acc, const Unit& u, int wr, int wc, int fr, int fq) const {
#pragma unroll
        for (int ai = 0; ai < 2; ++ai)
#pragma unroll
            for (int m = 0; m < 4; ++m) {
                const size_t row = (size_t)u.pm * BM + ai * HALF + wr * 64 + m * 16 + fr;
                float o[8];
#pragma unroll
                for (int n = 0; n < 2; ++n)
#pragma unroll
                    for (int j = 0; j < 4; ++j) { const float gt = acc[ai][0][m][n][j], up = acc[ai][1][m][n][j]; o[4 * n + j] = gt * sigmoidf_(gt) * up; }
                v4u w; w.x = cvt_pk_bf16(o[0], o[1]); w.y = cvt_pk_bf16(o[2], o[3]); w.z = cvt_pk_bf16(o[4], o[5]); w.w = cvt_pk_bf16(o[6], o[7]);
                *(v4u*)(HID + row * 256 + u.pn * 128 + wc * 32 + 8 * fq) = w;
            }
    }
};
struct EpiDown {
    static constexpr bool PERM = true, HOOK = false; static constexpr int HOOK_T1 = -1, HOOK_T2 = -1;
    __device__ __forceinline__ void hook(Acc&, const Unit&, int, int, int, int, int) const {}
    LAS unsigned char* lds; unsigned char* YB; unsigned char* SHB; int probe;
    __device__ __forceinline__ void operator()(const Acc& acc, const Unit& u, int wr, int wc, int fr, int fq) const {
        const int e = u.seg % NSEGH;
        const LAS v2u* tab = (const LAS v2u*)(lds + LDS_GTAB + u.tb * 2048);
        v2u ents[2][4];
#pragma unroll
        for (int ai = 0; ai < 2; ++ai)
#pragma unroll
            for (int m = 0; m < 4; ++m) ents[ai][m] = tab[ai * HALF + wr * 64 + m * 16 + fr];
#pragma unroll
        for (int ai = 0; ai < 2; ++ai)
#pragma unroll
            for (int m = 0; m < 4; ++m) {
                const int r = ai * HALF + wr * 64 + m * 16 + fr;
                if (r < u.rows && probe != -2) {
                    const v2u ent = ents[ai][m]; const int flat = (int)ent.x; const float w = __uint_as_float(ent.y) * Y8_SCALE;
                    unsigned char* rowp = (e < NEXP ? YB + (size_t)u.pn * ((size_t)T * 8 * 256) + (size_t)flat * 256 : SHB + (size_t)u.pn * ((size_t)T * 256) + (size_t)(flat >> 3) * 256) + wc * 64 + 16 * fq;
                    v4u o; unsigned ow[4];
#pragma unroll
                    for (int bj = 0; bj < 2; ++bj)
#pragma unroll
                        for (int n = 0; n < 2; ++n) { f32x4 a = acc[ai][bj][m][n] * w;
#pragma unroll
                            for (int j = 0; j < 4; ++j) a[j] = __builtin_amdgcn_fmed3f(a[j], -440.f, 440.f);
                            int p = __builtin_amdgcn_cvt_pk_fp8_f32(a[0], a[1], 0, false); p = __builtin_amdgcn_cvt_pk_fp8_f32(a[2], a[3], p, true); ow[2 * bj + n] = (unsigned)p; }
                    o.x = ow[0]; o.y = ow[1]; o.z = ow[2]; o.w = ow[3];
                    *(v4u*)rowp = o;
                }
            }
    }
};
}

__device__ __forceinline__ const float* arg_in(int i) {
    const __attribute__((address_space(4))) char* kp = (const __attribute__((address_space(4))) char*)__builtin_amdgcn_kernarg_segment_ptr();
    asm volatile("" : "+s"(kp));
    return *(const float* const __attribute__((address_space(4)))*)(kp + 8 * i);
}
struct Frame {
    LAS unsigned char* lds;
    int wave, vcu, G;
    unsigned char* ws; unsigned char* dout;
};
enum { I_X = 0, I_MEM, I_ANG, I_WIN, I_QNA, I_KNA, I_RELB, I_LBL, I_ONB, I_MNG, I_WMKV, I_QNC, I_KNC, I_WBA, I_WBB, I_WBC, I_WOUT, I_FNG, I_WR, I_RB, I_WEU, I_WED, I_WSU, I_WSD };

#ifndef STAGGER
#define STAGGER 0
#endif
__device__ __forceinline__ void stagger(const Frame& F, unsigned ticks_per_group) {
    if (!STAGGER) return;
    const unsigned long long t0 = __builtin_amdgcn_s_memrealtime(); const unsigned long long want = (unsigned long long)((unsigned)F.vcu & 7u) * ticks_per_group;
    while (__builtin_amdgcn_s_memrealtime() - t0 < want) __builtin_amdgcn_s_sleep(8);
}
__device__ __forceinline__ size_t bt_tiled_off(int n, int k, int K, bool perm) {
    const int pn = n >> 8, rho = n & 255, h = rho >> 7, r = rho & 127;
    const int x = r & 31; const int R = perm ? ((r & ~31) + 16 * ((x >> 2) & 1) + 4 * (x >> 3) + (x & 3)) : r;
    const int kt = k >> 6, C = k & 63;
    return ((size_t)((pn * (K >> 6) + kt) * 2 + h) * 16384 + (size_t)pg8::lds_byte(R, C)) >> 1;
}
__device__ __forceinline__ void tr_item(const float* W, int ldw, int k0s, int n0s, bf16* WT, int K, int n0d, int k0d, bool perm, LAS float* scr, int lane, const bool spread = false) {
    const int r8 = lane >> 3, c4 = lane & 7, n4 = 4 * c4, sc = spread ? 16 * (n4 >> 3) + (n4 & 7) : n4;
    f32x4 v[8];
#pragma unroll
    for (int i = 0; i < 8; ++i) v[i] = (n0s >= 0) ? *(const f32x4*)(W + (size_t)(k0s + 8 * i + r8) * ldw + n0s + sc) : (f32x4){0.f, 0.f, 0.f, 0.f};
#pragma unroll
    for (int i = 0; i < 8; ++i)
#pragma unroll
        for (int e = 0; e < 4; ++e) scr[(8 * i + r8) * 33 + n4 + e] = v[i][e];
    LDS_WAIT(); asm volatile("" ::: "memory");
    const int c = lane & 7;
#pragma unroll
    for (int j = 0; j < 4; ++j) { const int n = (lane >> 3) + 8 * j; const LAS float* s = scr + (8 * c) * 33 + n;
        v4u o; o.x = cvt_pk_bf16(s[0 * 33], s[1 * 33]); o.y = cvt_pk_bf16(s[2 * 33], s[3 * 33]); o.z = cvt_pk_bf16(s[4 * 33], s[5 * 33]); o.w = cvt_pk_bf16(s[6 * 33], s[7 * 33]);
        *(v4u*)(WT + bt_tiled_off(n0d + n, k0d + 8 * c, K, perm)) = o; }
    LDS_WAIT(); asm volatile("" ::: "memory");
}
__device__ __forceinline__ void rms_rows_to_bf16(const float* X, const float* g, bf16* O, int nrows, int gw, int NGW, int lane) {
    f32x4 gg[4];
#pragma unroll
    for (int j = 0; j < 4; ++j) gg[j] = ((const f32x4*)g + lane)[64 * j];
    for (int m = gw; m < nrows; m += 2 * NGW) {
        const int m1 = m + NGW; const bool has1 = m1 < nrows;
        const f32x4* x0 = (const f32x4*)(X + (size_t)m * D) + lane; const f32x4* x1 = (const f32x4*)(X + (size_t)(has1 ? m1 : m) * D) + lane;
        f32x4 v0[4], v1[4];
#pragma unroll
        for (int j = 0; j < 4; ++j) v0[j] = x0[64 * j];
#pragma unroll
        for (int j = 0; j < 4; ++j) v1[j] = x1[64 * j];
        float s0 = 0.f, s1 = 0.f;
#pragma unroll
        for (int j = 0; j < 4; ++j) { s0 += (v0[j][0] * v0[j][0] + v0[j][1] * v0[j][1]) + (v0[j][2] * v0[j][2] + v0[j][3] * v0[j][3]); s1 += (v1[j][0] * v1[j][0] + v1[j][1] * v1[j][1]) + (v1[j][2] * v1[j][2] + v1[j][3] * v1[j][3]); }
        const float r0 = rsqrtf(wave_sum(s0) * (1.f / D) + EPS), r1 = rsqrtf(wave_sum(s1) * (1.f / D) + EPS);
        v2u* o0 = (v2u*)(O + (size_t)m * D) + lane; v2u* o1 = (v2u*)(O + (size_t)m1 * D) + lane;
#pragma unroll
        for (int j = 0; j < 4; ++j) { v2u w; w.x = cvt_pk_bf16(v0[j][0] * r0 * gg[j][0], v0[j][1] * r0 * gg[j][1]); w.y = cvt_pk_bf16(v0[j][2] * r0 * gg[j][2], v0[j][3] * r0 * gg[j][3]); o0[64 * j] = w; }
        if (has1) {
#pragma unroll
            for (int j = 0; j < 4; ++j) { v2u w; w.x = cvt_pk_bf16(v1[j][0] * r1 * gg[j][0], v1[j][1] * r1 * gg[j][1]); w.y = cvt_pk_bf16(v1[j][2] * r1 * gg[j][2], v1[j][3] * r1 * gg[j][3]); o1[64 * j] = w; } }
    }
}
__device__ __forceinline__ int t5_bucket(int dist) {
    if (dist < 16) return dist;
    const int large = 16 + (int)(logf((float)dist / 16.0f) / 4.852030263919617f * 16.0f);
    return large < 31 ? large : 31;
}
constexpr int CV_I0 = 16 * 184, CV_I1 = 16 * 16, CV_I2 = 6 * 32, CV_I3 = 6 * 32, CV_I4 = 4 * 32, CV_I5 = 16 * 32, CV_I6 = 65 * 256, CV_I7 = 65 * 128;
constexpr int CV_EARLY = CV_I0 + CV_I1 + CV_I2 + CV_I3 + CV_I4 + CV_I5, CV_ALL = CV_EARLY + CV_I6 + CV_I7;
__device__ __forceinline__ void conv_item(Frame& F, int it, LAS float* scr, int lane) {
    constexpr int I0 = CV_I0, I1 = CV_I1, I2 = CV_I2, I3 = CV_I3, I4 = CV_I4, I5 = CV_I5, I6 = CV_I6;
    do {
        int r = it;
        if (r < I0 + I1) {
            const bool first = r < I0; if (!first) r -= I0;
            const int nblk = first ? 184 : 16, nsrc = first ? NPROJ : 512;
            const int kb = r / nblk, nbd = r % nblk, tile = nbd >> 3, within = nbd & 7, bj = within >> 2, wc = within & 3;
            const int srcb = tile * 8 + 2 * wc + bj;
            const int n0s = (srcb * 32 < nsrc) ? srcb * 32 : -1;
            tr_item(first ? arg_in(I_WIN) : arg_in(I_WMKV), nsrc, kb * 64, n0s, (bf16*)(F.ws + (first ? WS_WIN : WS_WMEM)), 1024, nbd * 32, kb * 64, true, scr, lane);
            break;
        }
        r -= I0 + I1;
#define HG_SRC(nb) ((((nb) >> 3) * 8 + 2 * ((nb) & 3) + (((nb) & 7) >> 2)) * 32)
        if (r < I2) { tr_item(arg_in(I_WBA), 1024, (r / 32) * 64, HG_SRC(r % 32), (bf16*)(F.ws + WS_WA), 1024, (r % 32) * 32, YC_A + (r / 32) * 64, true, scr, lane); break; } r -= I2;
        if (r < I3) { tr_item(arg_in(I_WBB), 1024, (r / 32) * 64, HG_SRC(r % 32), (bf16*)(F.ws + WS_WA), 1024, (r % 32) * 32, YC_B + (r / 32) * 64, true, scr, lane); break; } r -= I3;
        if (r < I4) { tr_item(arg_in(I_WBC), 1024, (r / 32) * 64, HG_SRC(r % 32), (bf16*)(F.ws + WS_WA), 1024, (r % 32) * 32, YC_C + (r / 32) * 64, true, scr, lane); break; } r -= I4;
        if (r < I5) { tr_item(arg_in(I_WOUT), 1024, (r / 32) * 64, HG_SRC(r % 32), (bf16*)(F.ws + WS_WOUT), 1024, (r % 32) * 32, (r / 32) * 64, true, scr, lane); break; } r -= I5;
        if (r < I6) {
            const int e = r / 256, q = r % 256, kb = q / 16, nbd = q % 16, pn = nbd >> 3, within = nbd & 7, bj = within >> 2, qq = within & 3;
            const int srcb = bj * 8 + pn * 4 + qq;
            const float* W = (e < 64) ? arg_in(I_WEU) + (size_t)e * 1024 * 512 : arg_in(I_WSU);
            tr_item(W, 512, kb * 64, srcb * 32, (bf16*)(F.ws + WS_WUP) + (size_t)e * 512 * 1024, 1024, nbd * 32, kb * 64, true, scr, lane);
            break;
        }
        r -= I6;
        {   const int e = r / 128, q = r % 128, kb = q / 32, nb = q % 32;
            const float* W = (e < 64) ? arg_in(I_WED) + (size_t)e * 256 * 1024 : arg_in(I_WSD);
            tr_item(W, 1024, kb * 64, (nb >> 3) * 256 + 64 * (nb & 3) + 8 * ((nb & 7) >> 2), (bf16*)(F.ws + WS_WDN) + (size_t)e * 1024 * 256, 256, nb * 32, kb * 64, true, scr, lane, true); }
    } while (0);
}
__device__ __forceinline__ void p0_prologue(Frame& F) {
    const int lane = lane_id_fresh(); const int tid = F.wave * 64 + lane; (void)tid;
    LAS float* scr = (LAS float*)(F.lds + F.wave * 16384);
    const int gw = F.vcu * 8 + F.wave, NGW = F.G * 8;
    for (int it = gw; it < CV_EARLY; it += NGW) conv_item(F, it, scr, lane);
    rms_rows_to_bf16(arg_in(I_X), arg_in(I_ANG), (bf16*)F.dout, T, gw, NGW, lane);
    rms_rows_to_bf16(arg_in(I_MEM), arg_in(I_MNG), (bf16*)(F.ws + WS_MEMN), NB * MEML, gw, NGW, lane);
    for (int i = F.vcu * 512 + tid; i < 64 * 1024; i += F.G * 512) {
        const int j = i & 7, ln = (i >> 3) & 63, ks = (i >> 9) & 31, et = i >> 14; const int e = 16 * et + (ln & 15), k = 32 * ks + 8 * (ln >> 4) + j; const float w = arg_in(I_WR)[(size_t)k * 64 + e];
        const unsigned hi = cvt_pk_bf16(w, 0.f) & 0xffffu; const float lo = w - __uint_as_float(hi << 16);
        ((bf16*)(F.ws + WS_TAB + 65536))[i] = (bf16)hi; ((bf16*)(F.ws + WS_TAB + 65536))[65536 + i] = f2bf(lo); }
    if (F.vcu == 0) {
        float* tab = (float*)(F.ws + WS_TAB);
        for (int i = tid; i < 3 * 129 * 6; i += 512) { const int h = i % 6, st = (i / 6) % 129, p = i / (6 * 129); tab[i] = arg_in(I_RELB)[t5_bucket(st << (2 * p)) * 6 + h]; }
        if (tid < 256) { const float a0 = arg_in(I_LBL)[tid], a1 = arg_in(I_LBL)[256 + tid]; tab[4096 + tid] = 1.0f / (1.0f + __expf(a1 - a0)); }
    }
}

template <int NR, class EntF>
__device__ __forceinline__ void attn_wave_simple(const bf16* qrow, const char* KB, const char* VB, const EntF& ent, bf16* orow, LAS float* wscr, int lane) {
    float q[64];
    { const v4u* qp = (const v4u*)qrow;
#pragma unroll
      for (int i = 0; i < 8; ++i) { const v4u w = qp[i]; q[8 * i + 0] = bf_lo(w.x); q[8 * i + 1] = bf_hi(w.x); q[8 * i + 2] = bf_lo(w.y); q[8 * i + 3] = bf_hi(w.y); q[8 * i + 4] = bf_lo(w.z); q[8 * i + 5] = bf_hi(w.z); q[8 * i + 6] = bf_lo(w.w); q[8 * i + 7] = bf_hi(w.w); } }
    float mx = -3.0e38f;
    LAS unsigned* vscr = (LAS unsigned*)(wscr + NR * 64);
#pragma unroll 1
    for (int r = 0; r < NR; ++r) {
        unsigned koff = 0, voff = 0; float bias = 0.f;
        const bool valid = ent(r * 64 + lane, koff, voff, bias);
        const v4u* kp = (const v4u*)(KB + koff);
        float d0 = 0.f, d1 = 0.f;
#pragma unroll
        for (int i = 0; i < 8; ++i) { const v4u w = kp[i];
            d0 += q[8 * i + 0] * bf_lo(w.x) + q[8 * i + 2] * bf_lo(w.y) + q[8 * i + 4] * bf_lo(w.z) + q[8 * i + 6] * bf_lo(w.w);
            d1 += q[8 * i + 1] * bf_hi(w.x) + q[8 * i + 3] * bf_hi(w.y) + q[8 * i + 5] * bf_hi(w.z) + q[8 * i + 7] * bf_hi(w.w); }
        const float sv = valid ? (d0 + d1 + bias) : -3.0e38f; wscr[r * 64 + lane] = sv; vscr[r * 64 + lane] = voff; mx = fmaxf(mx, sv);
    }
    mx = wave_max(mx);
    float l = 0.f;
#pragma unroll 1
    for (int r = 0; r < NR; ++r) { const float sv = wscr[r * 64 + lane]; const float p = (sv > -1.0e38f) ? __expf(sv - mx) : 0.f; l += p; wscr[r * 64 + lane] = p; }
    l = wave_sum(l);
    LDS_WAIT(); asm volatile("" ::: "memory");
    const int sub = lane >> 4, dg = lane & 15;
    float o0 = 0.f, o1 = 0.f, o2 = 0.f, o3 = 0.f;
    for (int i = 0; i < NR * 16; ++i) {
        const int e = 4 * i + sub; const float p = wscr[e]; const unsigned voff = vscr[e];
        const v2u w = *(const v2u*)(VB + voff + dg * 8);
        o0 += p * bf_lo(w.x); o1 += p * bf_hi(w.x); o2 += p * bf_lo(w.y); o3 += p * bf_hi(w.y);
    }
    o0 += __shfl_xor(o0, 16); o1 += __shfl_xor(o1, 16); o2 += __shfl_xor(o2, 16); o3 += __shfl_xor(o3, 16);
    o0 += __shfl_xor(o0, 32); o1 += __shfl_xor(o1, 32); o2 += __shfl_xor(o2, 32); o3 += __shfl_xor(o3, 32);
    const float inv = 1.0f / l;
    if (lane < 16) { v2u w; w.x = cvt_pk_bf16(o0 * inv, o1 * inv); w.y = cvt_pk_bf16(o2 * inv, o3 * inv); *(v2u*)(orow + dg * 4) = w; }
    LDS_WAIT(); asm volatile("" ::: "memory");
}
struct EntA {
    int pos, h; unsigned rowbase; const float* btab;
    __device__ __forceinline__ bool operator()(int e, unsigned& koff, unsigned& voff, float& bias) const {
        const int p = e / 129, st = e - p * 129; const int kt = pos - (st << (2 * p));
        const bool valid = (e < 387) && (kt >= 0);
        const unsigned off = valid ? (rowbase + (unsigned)kt * (LD_PA * 2)) : rowbase;
        koff = off + (384 + h * 64) * 2; voff = off + (768 + h * 64) * 2;
        bias = valid ? btab[e * 6 + h] : 0.f; return valid;
    }
};
struct EntC {
    unsigned base;
    __device__ __forceinline__ bool operator()(int e, unsigned& koff, unsigned& voff, float& bias) const { koff = base + (unsigned)e * 512u; voff = koff; bias = 0.f; return true; }
};
__device__ __forceinline__ void p2_attn_simple(Frame& F) {
    const int lane = lane_id_fresh(); const int tid = F.wave * 64 + lane; (void)tid;
    LAS float* wscr = (LAS float*)(F.lds + F.wave * 8192);
    const int gw = F.vcu * 8 + F.wave, NGW = F.G * 8;
    const bf16* PA = (const bf16*)(F.ws + WS_PA); const bf16* PC = (const bf16*)(F.ws + WS_PC);
    const float* btab = (const float*)(F.ws + WS_TAB);
    for (int it = gw; it < T * 6; it += NGW) {
        const int t = it / 6, h = it % 6, b = t >> 11, pos = t & 2047;
        EntA ent{pos, h, (unsigned)(b * SEQ) * (unsigned)(LD_PA * 2), btab};
        attn_wave_simple<7, EntA>(PA + (size_t)t * LD_PA + h * 64, (const char*)PA, (const char*)PA, ent, (bf16*)(F.dout + DO_Y) + (size_t)t * 1024 + YC_A + h * 64, wscr, lane);
    }
    for (int it = gw; it < T * 4; it += NGW) {
        const int t = it >> 2, h = it & 3, b = t >> 11;
        EntC ent{(unsigned)(b * MEML) * 512u + (unsigned)h * 128u};
        attn_wave_simple<4, EntC>(PC + (size_t)t * LD_PC + h * 64, (const char*)(F.ws + WS_MEMK), (const char*)(F.ws + WS_MEMV), ent, (bf16*)(F.dout + DO_Y) + (size_t)t * 1024 + YC_C + h * 64, wscr, lane);
    }
}

typedef short s4v __attribute__((ext_vector_type(4)));
constexpr int ATT_OROW = 272;
constexpr int ATT_OACC = 0, ATT_M = 256 * ATT_OROW, ATT_L = ATT_M + 1024, ATT_BT = ATT_L + 1024, ATT_VST = 73728, ATT_VROW = 160, ATT_VBUF = 32 * ATT_VROW;
static_assert(ATT_BT + 3 * 160 * 4 <= ATT_VST && ATT_VST + 8 * 2 * ATT_VBUF <= LDS_MISC, "attention LDS map");
template <int NT, bool MASK>
__device__ __forceinline__ void attn_sub(const bf16* Q0, unsigned qstep, const bf16* K0, const bf16* V0, unsigned kstep, int clo, const LAS float* btab, LAS unsigned char* vst, int lane,
                                         f32x4 (&O)[4], float& m_out, float& l_out) {
    const int q = lane & 15, g = lane >> 4;
    bf16x8 qf[2];
#pragma unroll
    for (int ks = 0; ks < 2; ++ks) qf[ks] = *(const bf16x8*)((const char*)Q0 + ((unsigned)q * qstep + 8u * g + 32u * ks) * 2u);
    f32x4 S[NT];
#pragma unroll
    for (int k = 0; k < NT; ++k) {
        S[k] = (f32x4){0.f, 0.f, 0.f, 0.f};
        if (!MASK || 16 * k >= clo) {
            const char* kr = (const char*)K0 + ((unsigned)(16 * k + q) * kstep + 8u * g) * 2u;
            const bf16x8 k0 = *(const bf16x8*)kr, k1 = *(const bf16x8*)(kr + 64);
            S[k] = __builtin_amdgcn_mfma_f32_16x16x32_bf16(k0, qf[0], S[k], 0, 0, 0);
            S[k] = __builtin_amdgcn_mfma_f32_16x16x32_bf16(k1, qf[1], S[k], 0, 0, 0);
        }
        if ((k & 3) == 3) asm volatile("" ::: "memory");
    }
    const int vr = lane >> 3, vc = lane & 7;
    const int ksf = MASK ? (clo >> 5) : 0;
    v4u wv[4];
#define ATT_LOADV(KS) do { _Pragma("unroll") for (int _i = 0; _i < 4; ++_i) { int _c = 32 * (KS) + 8 * _i + vr; if (MASK && _c < clo) _c = clo; if (_c > 16 * NT - 1) _c = 16 * NT - 1; \
        wv[_i] = *(const v4u*)((const char*)V0 + ((unsigned)_c * kstep + 8u * vc) * 2u); } } while (0)
    ATT_LOADV(ksf);
    float mx = -3.0e38f;
    if (MASK) {
        const LAS float* bp = btab + (128 + 16 + q - 4 * g);
        if (clo > 0) {
#pragma unroll
            for (int k = 0; k < NT; ++k)
#pragma unroll
                for (int r = 0; r < 4; ++r) { const float v = (16 * k + 4 * g + r >= clo) ? S[k][r] + bp[-16 * k - r] : -3.0e38f; S[k][r] = v; mx = fmaxf(mx, v); }
        } else {
#pragma unroll
            for (int k = 0; k < NT; ++k)
#pragma unroll
                for (int r = 0; r < 4; ++r) { const float v = S[k][r] + bp[-16 * k - r]; S[k][r] = v; mx = fmaxf(mx, v); }
        }
    } else {
#pragma unroll
        for (int k = 0; k < NT; ++k) mx = fmaxf(mx, fmaxf(fmaxf(S[k][0], S[k][1]), fmaxf(S[k][2], S[k][3])));
    }
    mx = xmax32(xmax16(mx));
    float l = 0.f;
#pragma unroll
    for (int k = 0; k < NT; ++k)
#pragma unroll
        for (int r = 0; r < 4; ++r) { const float p = __expf(S[k][r] - mx); S[k][r] = p; l += p; }
    l = xsum32(xsum16(l));
#pragma unroll
    for (int t = 0; t < 4; ++t) O[t] = (f32x4){0.f, 0.f, 0.f, 0.f};
    constexpr int NKS = (NT + 1) / 2;
    const int tq = (lane & 15) >> 2, tp = lane & 3;
#pragma unroll
    for (int ks = 0; ks < NKS; ++ks) {
        if (MASK && ks < ksf) continue;
        LAS unsigned char* vb = vst;
#pragma unroll
        for (int i = 0; i < 4; ++i) *(LAS v4u*)(vb + (8 * i + vr) * ATT_VROW + vc * 16) = wv[i];
        asm volatile("" ::: "memory");
        if (ks + 1 < NKS) ATT_LOADV(ks + 1);
        bf16x8 pf;
        { const f32x4 a = S[2 * ks]; f32x4 b = (f32x4){0.f, 0.f, 0.f, 0.f}; if (2 * ks + 1 < NT) b = S[2 * ks + 1 < NT ? 2 * ks + 1 : 0];
          v4u pw; pw.x = cvt_pk_bf16(a[0], a[1]); pw.y = cvt_pk_bf16(a[2], a[3]); pw.z = cvt_pk_bf16(b[0], b[1]); pw.w = cvt_pk_bf16(b[2], b[3]); pf = __builtin_bit_cast(bf16x8, pw); }
#pragma unroll
        for (int t = 0; t < 4; ++t) {
            const s4v lo = __builtin_amdgcn_ds_read_tr16_b64_v4i16((LAS s4v*)(vb + (4 * g + tq) * ATT_VROW + (16 * t + 4 * tp) * 2));
            const s4v hi = __builtin_amdgcn_ds_read_tr16_b64_v4i16((LAS s4v*)(vb + (16 + 4 * g + tq) * ATT_VROW + (16 * t + 4 * tp) * 2));
            const bf16x8 af = (bf16x8){lo[0], lo[1], lo[2], lo[3], hi[0], hi[1], hi[2], hi[3]};
            O[t] = __builtin_amdgcn_mfma_f32_16x16x32_bf16(af, pf, O[t], 0, 0, 0);
        }
        asm volatile("" ::: "memory");
    }
#undef ATT_LOADV
    m_out = mx; l_out = l;
}
constexpr int A2_OROW = 144, A2_M = 256 * A2_OROW, A2_L = A2_M + 1024, A2_BT = A2_L + 1024, A2_STG = 40960, A2_KP = 144, A2_VP = 144, A2_NR = 416, A2_VOFF = A2_STG + A2_NR * A2_KP;
static_assert(A2_BT + 3 * 160 * 4 <= A2_STG && A2_VOFF + A2_NR * A2_VP <= LDS_MISC && A2_STG + 8 * 2 * ATT_VBUF <= LDS_MISC, "mixer A LDS map");
__device__ __forceinline__ void attn_load_q(const bf16* Q0, unsigned qstep, int lane, bf16x8 (&qf)[2]) {
    const int q = lane & 15, g = lane >> 4;
#pragma unroll
    for (int ks = 0; ks < 2; ++ks) qf[ks] = *(const bf16x8*)((const char*)Q0 + ((unsigned)q * qstep + 8u * g + 32u * ks) * 2u);
}
__device__ __forceinline__ void attn_sub_lds(const bf16x8 (&qf)[2], const LAS unsigned char* Ki, const LAS unsigned char* Vi, int clo, const LAS float* btab, int lane, f32x4 (&O)[4], float& m_out, float& l_out) {
    const int q = lane & 15, g = lane >> 4, tq = (lane & 15) >> 2, tp = lane & 3;
    f32x4 S[9];
#pragma unroll
    for (int k = 0; k < 9; ++k) {
        S[k] = (f32x4){0.f, 0.f, 0.f, 0.f};
        if (16 * k >= clo) {
            const bf16x8 k0 = *(const LAS bf16x8*)(Ki + (16 * k + q) * A2_KP + 16 * g), k1 = *(const LAS bf16x8*)(Ki + (16 * k + q) * A2_KP + 64 + 16 * g);
            S[k] = __builtin_amdgcn_mfma_f32_16x16x32_bf16(k0, qf[0], S[k], 0, 0, 0);
            S[k] = __builtin_amdgcn_mfma_f32_16x16x32_bf16(k1, qf[1], S[k], 0, 0, 0);
        }
    }
    float mx = -3.0e38f;
    const LAS float* bp = btab + (128 + 16 + q - 4 * g);
    if (clo > 0) {
#pragma unroll
        for (int k = 0; k < 9; ++k)
#pragma unroll
            for (int r = 0; r < 4; ++r) { const float v = (16 * k + 4 * g + r >= clo) ? S[k][r] + bp[-16 * k - r] : -3.0e38f; S[k][r] = v; mx = fmaxf(mx, v); }
    } else {
#pragma unroll
        for (int k = 0; k < 9; ++k)
#pragma unroll
            for (int r = 0; r < 4; ++r) { const float v = S[k][r] + bp[-16 * k - r]; S[k][r] = v; mx = fmaxf(mx, v); }
    }
    mx = xmax32(xmax16(mx));
    float l = 0.f;
#pragma unroll
    for (int k = 0; k < 9; ++k)
#pragma unroll
        for (int r = 0; r < 4; ++r) { const float p = __expf(S[k][r] - mx); S[k][r] = p; l += p; }
    l = xsum32(xsum16(l));
#pragma unroll
    for (int t = 0; t < 4; ++t) O[t] = (f32x4){0.f, 0.f, 0.f, 0.f};
    const int ksf = clo >> 5;
#pragma unroll
    for (int ks = 0; ks < 5; ++ks) {
        if (ks < ksf) continue;
        const f32x4 a = S[2 * ks]; f32x4 b2 = (f32x4){0.f, 0.f, 0.f, 0.f}; if (2 * ks + 1 < 9) b2 = S[2 * ks + 1 < 9 ? 2 * ks + 1 : 0];
        v4u pw; pw.x = cvt_pk_bf16(a[0], a[1]); pw.y = cvt_pk_bf16(a[2], a[3]); pw.z = cvt_pk_bf16(b2[0], b2[1]); pw.w = cvt_pk_bf16(b2[2], b2[3]);
        const bf16x8 pf = __builtin_bit_cast(bf16x8, pw);
#pragma unroll
        for (int t = 0; t < 4; ++t) {
            const s4v lo = __builtin_amdgcn_ds_read_tr16_b64_v4i16((LAS s4v*)(Vi + (32 * ks + 4 * g + tq) * A2_VP + (16 * t + 4 * tp) * 2));
            const s4v hi = __builtin_amdgcn_ds_read_tr16_b64_v4i16((LAS s4v*)(Vi + (32 * ks + 16 + 4 * g + tq) * A2_VP + (16 * t + 4 * tp) * 2));
            O[t] = __builtin_amdgcn_mfma_f32_16x16x32_bf16((bf16x8){lo[0], lo[1], lo[2], lo[3], hi[0], hi[1], hi[2], hi[3]}, pf, O[t], 0, 0, 0);
        }
    }
    m_out = mx; l_out = l;
}
__device__ __forceinline__ void attnA_merge(Frame& F, f32x4 (&O)[4], float m, float l, int tt, int g, bool first, bool last, bf16* yrow) {
    LAS unsigned char* orow = F.lds + tt * A2_OROW + 8 * g; LAS float* mp = (LAS float*)(F.lds + A2_M) + tt; LAS float* lp = (LAS float*)(F.lds + A2_L) + tt;
    if (!first) {
        const float mo = *mp, lo_ = *lp; const float mn = fmaxf(m, mo), ao = __expf(mo - mn), an = __expf(m - mn);
#pragma unroll
        for (int t = 0; t < 4; ++t) { const v2u w = *(const LAS v2u*)(orow + 32 * t); O[t] = (f32x4){bf_lo(w.x), bf_hi(w.x), bf_lo(w.y), bf_hi(w.y)} * ao + O[t] * an; }
        l = lo_ * ao + l * an; m = mn;
    }
    if (!last) {
#pragma unroll
        for (int t = 0; t < 4; ++t) { v2u w; w.x = cvt_pk_bf16(O[t][0], O[t][1]); w.y = cvt_pk_bf16(O[t][2], O[t][3]); *(LAS v2u*)(orow + 32 * t) = w; }
        if (g == 0) { *mp = m; *lp = l; }
    } else {
        const float inv = 1.0f / l;
#pragma unroll
        for (int t = 0; t < 4; ++t) { v2u w; w.x = cvt_pk_bf16(O[t][0] * inv, O[t][1] * inv); w.y = cvt_pk_bf16(O[t][2] * inv, O[t][3] * inv); *(v2u*)(yrow + 16 * t) = w; }
    }
}
__device__ __forceinline__ void attnA_unit(Frame& F, int unit) {
    const int lane = lane_id_fresh();
    const int tid = F.wave * 64 + lane;
    const int b = unit / 48, rem = unit % 48, h = rem >> 3, tile = rem & 7, t0 = tile * 256; const long tokbase = (long)b * SEQ;
    const bf16* PA = (const bf16*)(F.ws + WS_PA);
    LAS float* bt = (LAS float*)(F.lds + A2_BT);
    LAS unsigned char* Ki = F.lds + A2_STG; LAS unsigned char* Vi = F.lds + A2_VOFF;
    const int q = lane & 15, g = lane >> 4, w = F.wave;
    bf16* Y = (bf16*)(F.dout + DO_Y) + YC_A + h * 64 + 4 * g;
    __syncthreads();
    if (tid < 480) { const int p = tid / 160, st = tid - p * 160 - 16; bt[tid] = (st >= 0 && st <= 128) ? ((const float*)(F.ws + WS_TAB))[(p * 129 + st) * 6 + h] : -3.0e38f; }
    v4u sk[5], sv[5];
#define A2_LOAD1(hh_) do { _Pragma("unroll") for (int it = 0; it < 5; ++it) { const int i = tid + it * 512; sk[it] = (v4u){0u, 0u, 0u, 0u}; sv[it] = sk[it]; \
        if (i < 272 * 8) { const int row = i >> 3, ch = i & 7, pos = t0 + 128 * (hh_) - 128 + row; \
            if (pos >= 0 && pos < SEQ) { const bf16* rp_ = PA + (tokbase + pos) * LD_PA + 384 + h * 64 + ch * 8; sk[it] = *(const v4u*)rp_; sv[it] = *(const v4u*)(rp_ + 384); } } } } while (0)
#define A2_LOAD2(rp_i) do { _Pragma("unroll") for (int it = 0; it < 5; ++it) { const int i = tid + it * 512; sk[it] = (v4u){0u, 0u, 0u, 0u}; sv[it] = sk[it]; \
        { const int row = i >> 3, ch = i & 7, rr_ = row >= 208 ? 1 : 0, j = row - 208 * rr_, posn = t0 / 4 - 128 + j, pos = 4 * posn + 2 * (rp_i) + rr_; \
            if (posn >= 0 && pos < SEQ) { const bf16* rp_ = PA + (tokbase + pos) * LD_PA + 384 + h * 64 + ch * 8; sk[it] = *(const v4u*)rp_; sv[it] = *(const v4u*)(rp_ + 384); } } } } while (0)
#define A2_WRITE(nit, cnt) do { _Pragma("unroll") for (int it = 0; it < (nit); ++it) { const int i = tid + it * 512; if (i < (cnt)) { const int row = i >> 3, ch = i & 7; \
        *(LAS v4u*)(Ki + row * A2_KP + ch * 16) = sk[it]; *(LAS v4u*)(Vi + row * A2_VP + ch * 16) = sv[it]; } } } while (0)
    bf16x8 qc[2], qn[2];
    A2_LOAD1(0);
    attn_load_q(PA + (tokbase + t0 + 16 * w) * LD_PA + h * 64, (unsigned)LD_PA, lane, qc);
#pragma unroll 1
    for (int hh = 0; hh < 2; ++hh) {
        __syncthreads();
        A2_WRITE(5, 272 * 8);
        __syncthreads();
        if (hh == 0) { A2_LOAD1(1); attn_load_q(PA + (tokbase + t0 + 128 + 16 * w) * LD_PA + h * 64, (unsigned)LD_PA, lane, qn); }
        else { A2_LOAD2(0); attn_load_q(PA + (tokbase + t0 + (w >> 2) + 64 * (w & 3)) * LD_PA + h * 64, (unsigned)(4 * LD_PA), lane, qn); }
        const int tq0 = t0 + 128 * hh + 16 * w; const int clo = tq0 < 128 ? 128 - tq0 : 0;
        f32x4 O[4]; float m, l;
        attn_sub_lds(qc, Ki + 16 * w * A2_KP, Vi + 16 * w * A2_VP, clo, bt, lane, O, m, l);
        attnA_merge(F, O, m, l, (tq0 - t0) + q, g, true, false, nullptr);
        qc[0] = qn[0]; qc[1] = qn[1];
    }
#pragma unroll 1
    for (int rp = 0; rp < 2; ++rp) {
        __syncthreads();
        A2_WRITE(5, 416 * 8);
        for (int i = tid + 5 * 512; i < 416 * 8; i += 512) { const int row = i >> 3, ch = i & 7, rr_ = row >= 208 ? 1 : 0, j = row - 208 * rr_, posn = t0 / 4 - 128 + j, pos = 4 * posn + 2 * rp + rr_; v4u kv = (v4u){0u, 0u, 0u, 0u}, vv = kv;
            if (posn >= 0 && pos < SEQ) { const bf16* rp2 = PA + (tokbase + pos) * LD_PA + 384 + h * 64 + ch * 8; kv = *(const v4u*)rp2; vv = *(const v4u*)(rp2 + 384); }
            *(LAS v4u*)(Ki + row * A2_KP + ch * 16) = kv; *(LAS v4u*)(Vi + row * A2_VP + ch * 16) = vv; }
        __syncthreads();
        if (rp == 0) { A2_LOAD2(1); attn_load_q(PA + (tokbase + t0 + 2 + (w >> 2) + 64 * (w & 3)) * LD_PA + h * 64, (unsigned)(4 * LD_PA), lane, qn); }
        const int rr = w >> 2, jp = w & 3, tq0 = t0 + 2 * rp + rr + 64 * jp, pq0 = t0 / 4 + 16 * jp; const int clo = pq0 < 128 ? 128 - pq0 : 0;
        f32x4 O[4]; float m, l;
        attn_sub_lds(qc, Ki + (208 * rr + 16 * jp) * A2_KP, Vi + (208 * rr + 16 * jp) * A2_VP, clo, bt + 160, lane, O, m, l);
        attnA_merge(F, O, m, l, (tq0 - t0) + 4 * q, g, false, false, nullptr);
        qc[0] = qn[0]; qc[1] = qn[1];
    }
#undef A2_LOAD1
#undef A2_LOAD2
#undef A2_WRITE
    __syncthreads();
    LAS unsigned char* vst = F.lds + A2_STG + w * 2 * ATT_VBUF;
#pragma unroll
    for (int su = 0; su < 2; ++su) {
        const int sub = w * 2 + su, tq0 = t0 + sub, pq0 = t0 / 16; const int clo = pq0 < 128 ? 128 - pq0 : 0;
        const bf16* Q0 = PA + (tokbase + tq0) * LD_PA + h * 64; const bf16* K0 = PA + (tokbase + tq0 - 128 * 16) * LD_PA + 384 + h * 64;
        f32x4 O[4]; float m, l;
        attn_sub<9, true>(Q0, (unsigned)(16 * LD_PA), K0, K0 + 384, (unsigned)(16 * LD_PA), clo, bt + 320, vst + su * ATT_VBUF, lane, O, m, l);
        const int tt = (tq0 - t0) + 16 * q;
        attnA_merge(F, O, m, l, tt, g, false, true, Y + (tokbase + t0 + tt) * 1024);
    }
    __syncthreads();
}
constexpr int CK_PITCH = 144, CV_PITCH = 160, CK_OFF = 0, CV_OFF = 256 * CK_PITCH;
static_assert(CV_OFF + 256 * CV_PITCH <= LDS_MISC, "mixer C LDS map");
__device__ __forceinline__ void attnC_unit(Frame& F, int unit) {
    const int lane = lane_id_fresh(); const int tid = F.wave * 64 + lane;
    const int b = unit >> 5, h = (unit >> 3) & 3, tile = unit & 7; const long tok0 = (long)b * SEQ + tile * 256;
    const bf16* PC = (const bf16*)(F.ws + WS_PC);
    const bf16* K0 = (const bf16*)(F.ws + WS_MEMK) + (long)b * MEML * 256 + h * 64; const bf16* V0 = (const bf16*)(F.ws + WS_MEMV) + (long)b * MEML * 256 + h * 64;
    LAS unsigned char* L = F.lds;
    bf16x8 qa[2][2];
    { const int q_ = lane & 15, g_ = lane >> 4;
#pragma unroll
      for (int su = 0; su < 2; ++su)
#pragma unroll
        for (int ks = 0; ks < 2; ++ks) qa[su][ks] = *(const bf16x8*)(PC + (tok0 + 16 * (F.wave * 2 + su) + q_) * LD_PC + h * 64 + 8 * g_ + 32 * ks); }
    __syncthreads();
#pragma unroll
    for (int j = 0; j < 4; ++j) { const int i = tid + 512 * j, row = i >> 3, ch = i & 7;
        *(LAS v4u*)(L + CK_OFF + row * CK_PITCH + ch * 16) = *(const v4u*)(K0 + (long)row * 256 + ch * 8);
        *(LAS v4u*)(L + CV_OFF + row * CV_PITCH + ch * 16) = *(const v4u*)(V0 + (long)row * 256 + ch * 8); }
    __syncthreads();
    const int q = lane & 15, g = lane >> 4, tq = (lane & 15) >> 2, tp = lane & 3;
#pragma unroll 1
    for (int su = 0; su < 2; ++su) {
        const long tq0 = tok0 + 16 * (F.wave * 2 + su);
        bf16x8 qf[2]; qf[0] = su == 0 ? qa[0][0] : qa[1][0]; qf[1] = su == 0 ? qa[0][1] : qa[1][1];
        f32x4 S[16];
#pragma unroll
        for (int k = 0; k < 16; ++k) {
            const bf16x8 k0 = *(const LAS bf16x8*)(L + CK_OFF + (16 * k + q) * CK_PITCH + 16 * g), k1 = *(const LAS bf16x8*)(L + CK_OFF + (16 * k + q) * CK_PITCH + 64 + 16 * g);
            S[k] = __builtin_amdgcn_mfma_f32_16x16x32_bf16(k0, qf[0], (f32x4){0.f, 0.f, 0.f, 0.f}, 0, 0, 0);
            S[k] = __builtin_amdgcn_mfma_f32_16x16x32_bf16(k1, qf[1], S[k], 0, 0, 0);
            if ((k & 3) == 3) asm volatile("" ::: "memory");
        }
        float mx = -3.0e38f;
#pragma unroll
        for (int k = 0; k < 16; ++k) mx = fmaxf(mx, fmaxf(fmaxf(S[k][0], S[k][1]), fmaxf(S[k][2], S[k][3])));
        mx = xmax32(xmax16(mx));
        float l = 0.f;
#pragma unroll
        for (int k = 0; k < 16; ++k)
#pragma unroll
            for (int r = 0; r < 4; ++r) { const float p = __expf(S[k][r] - mx); S[k][r] = p; l += p; }
        l = xsum32(xsum16(l));
        f32x4 O[4];
#pragma unroll
        for (int t = 0; t < 4; ++t) O[t] = (f32x4){0.f, 0.f, 0.f, 0.f};
#pragma unroll
        for (int ks = 0; ks < 8; ++ks) {
            v4u pw; pw.x = cvt_pk_bf16(S[2 * ks][0], S[2 * ks][1]); pw.y = cvt_pk_bf16(S[2 * ks][2], S[2 * ks][3]); pw.z = cvt_pk_bf16(S[2 * ks + 1][0], S[2 * ks + 1][1]); pw.w = cvt_pk_bf16(S[2 * ks + 1][2], S[2 * ks + 1][3]);
            const bf16x8 pf = __builtin_bit_cast(bf16x8, pw);
#pragma unroll
            for (int t = 0; t < 4; ++t) {
                const s4v lo = __builtin_amdgcn_ds_read_tr16_b64_v4i16((LAS s4v*)(L + CV_OFF + (32 * ks + 4 * g + tq) * CV_PITCH + (16 * t + 4 * tp) * 2));
                const s4v hi = __builtin_amdgcn_ds_read_tr16_b64_v4i16((LAS s4v*)(L + CV_OFF + (32 * ks + 16 + 4 * g + tq) * CV_PITCH + (16 * t + 4 * tp) * 2));
                O[t] = __builtin_amdgcn_mfma_f32_16x16x32_bf16((bf16x8){lo[0], lo[1], lo[2], lo[3], hi[0], hi[1], hi[2], hi[3]}, pf, O[t], 0, 0, 0);
            }
        }
        const float inv = 1.0f / l; bf16* yo = (bf16*)(F.dout + DO_Y) + (tq0 + q) * 1024 + YC_C + h * 64 + 4 * g;
#pragma unroll
        for (int t = 0; t < 4; ++t) { v2u w; w.x = cvt_pk_bf16(O[t][0] * inv, O[t][1] * inv); w.y = cvt_pk_bf16(O[t][2] * inv, O[t][3] * inv); *(v2u*)(yo + 16 * t) = w; }
    }
}
__device__ __forceinline__ void p2_attn_mfma(Frame& F) {
    const int lane = lane_id_fresh();
    for (int u = F.vcu; u < NB * 6 * 8; u += F.G) attnA_unit(F, u);
    for (int u = F.vcu; u < NB * 4 * 8; u += F.G) attnC_unit(F, u);
    __syncthreads();
}

constexpr int HG_PR = 144, HG_PX = 160, HG_PV = 224;
constexpr int HG_KH = 0, HG_QT = 64 * HG_PR, HG_QS = 2 * 64 * HG_PR, HG_KX = HG_QS + 10 * 16 * HG_PR, HG_VI = HG_KX + 64 * HG_PX, HG_SI = HG_VI + 64 * HG_PV, HG_DV = HG_SI + 2 * 64 * HG_PV, HG_PS = HG_DV + 256, HG_END = HG_PS + 512;
static_assert(HG_END <= LDS_MISC, "hgrn LDS map");
__device__ __forceinline__ s4v trd(const LAS unsigned char* p) { return __builtin_amdgcn_ds_read_tr16_b64_v4i16((LAS s4v*)p); }
__device__ __forceinline__ bf16x8 cat8(s4v lo, s4v hi) { return (bf16x8){lo[0], lo[1], lo[2], lo[3], hi[0], hi[1], hi[2], hi[3]}; }
__device__ __forceinline__ void hgrn_seq(Frame& F, int seq, bf16* YB) {
    const int lane = lane_id_fresh();
    const int w = F.wave, tid = w * 64 + lane;
    const int b = seq >> 2, h = seq & 3; const long tokbase = (long)b * SEQ;
    const bf16* PB = (const bf16*)(F.ws + WS_PB);
    LAS unsigned char* L = F.lds;
    __syncthreads();
    for (int i = tid; i < 2 * 64 * HG_PV / 16; i += 512) *(LAS v4u*)(L + HG_SI + i * 16) = (v4u){0u, 0u, 0u, 0u};
    float lbv[8];
    { const float* lbt = (const float*)(F.ws + WS_TAB) + 4096 + h * 64 + 8 * w;
#pragma unroll
      for (int j = 0; j < 8; ++j) lbv[j] = lbt[j]; }
    f32x4 St[3];
#pragma unroll
    for (int t = 0; t < 3; ++t) St[t] = (f32x4){0.f, 0.f, 0.f, 0.f};
    const int q16 = lane & 15, g = lane >> 4, mi = w >> 1, hh = w & 1, tq4 = (lane & 15) >> 2, tp = lane & 3;
    float gn[3];
#pragma unroll
    for (int t = 0; t < 3; ++t) gn[t] = arg_in(I_ONB)[h * 96 + 16 * (3 * hh + t) + q16];
    v4u qw, fw, vw0, vw1 = (v4u){0u, 0u, 0u, 0u};
    { const bf16* rowp = PB + (tokbase + lane) * LD_PB; qw = *(const v4u*)(rowp + h * 64 + 8 * w); fw = *(const v4u*)(rowp + 256 + h * 64 + 8 * w);
      vw0 = *(const v4u*)(PB + (tokbase + tid / 12) * LD_PB + 512 + h * 96 + (tid % 12) * 8);
      if (tid < 256) vw1 = *(const v4u*)(PB + (tokbase + (tid + 512) / 12) * LD_PB + 512 + h * 96 + ((tid + 512) % 12) * 8); }
    bf16 ogc[3][4], ogn[3][4];
#pragma unroll
    for (int t = 0; t < 3; ++t)
#pragma unroll
        for (int r = 0; r < 4; ++r) { ogc[t][r] = PB[(tokbase + 16 * mi + 4 * g + r) * LD_PB + 896 + h * 96 + 16 * (3 * hh + t) + q16]; ogn[t][r] = ogc[t][r]; }
#pragma unroll 1
    for (int c = 0; c < 32; ++c) {
        const long tok0 = tokbase + 64 * c;
        *(LAS v4u*)(L + HG_VI + (tid / 12) * HG_PV + (tid % 12) * 16) = vw0;
        if (tid < 256) *(LAS v4u*)(L + HG_VI + ((tid + 512) / 12) * HG_PV + ((tid + 512) % 12) * 16) = vw1;
        float qf[8], kk[8], bb[8];
        { const unsigned qa[4] = {qw.x, qw.y, qw.z, qw.w}, fa[4] = {fw.x, fw.y, fw.z, fw.w};
#pragma unroll
          for (int j = 0; j < 4; ++j) { qf[2 * j] = bf_lo(qa[j]); qf[2 * j + 1] = bf_hi(qa[j]);
              const float f0 = lbv[2 * j] + (1.f - lbv[2 * j]) * sigmoidf_(bf_lo(fa[j])), f1 = lbv[2 * j + 1] + (1.f - lbv[2 * j + 1]) * sigmoidf_(bf_hi(fa[j]));
              kk[2 * j] = 1.f - f0; kk[2 * j + 1] = 1.f - f1; bb[2 * j] = __logf(f0); bb[2 * j + 1] = __logf(f1); } }
#pragma unroll
        for (int j = 0; j < 8; ++j) bb[j] = scan_incl64(bb[j]);
        float E0[8], E1[8], E2[8], E3[8], Es[8];
#pragma unroll
        for (int j = 0; j < 8; ++j) { E0[j] = readlane_f(bb[j], 15); E1[j] = readlane_f(bb[j], 31); E2[j] = readlane_f(bb[j], 47); E3[j] = readlane_f(bb[j], 63);
            Es[j] = g == 0 ? E0[j] : (g == 1 ? E1[j] : (g == 2 ? E2[j] : E3[j])); }
        {   float kh[8], qt[8], kx[8];
#pragma unroll
            for (int j = 0; j < 8; ++j) { kh[j] = kk[j] * __expf(Es[j] - bb[j]); qt[j] = qf[j] * __expf(bb[j]); kx[j] = kk[j] * __expf(E3[j] - bb[j]); }
            v4u o; o.x = cvt_pk_bf16(kh[0], kh[1]); o.y = cvt_pk_bf16(kh[2], kh[3]); o.z = cvt_pk_bf16(kh[4], kh[5]); o.w = cvt_pk_bf16(kh[6], kh[7]); *(LAS v4u*)(L + HG_KH + lane * HG_PR + w * 16) = o;
            o.x = cvt_pk_bf16(qt[0], qt[1]); o.y = cvt_pk_bf16(qt[2], qt[3]); o.z = cvt_pk_bf16(qt[4], qt[5]); o.w = cvt_pk_bf16(qt[6], qt[7]); *(LAS v4u*)(L + HG_QT + lane * HG_PR + w * 16) = o;
            o.x = cvt_pk_bf16(kx[0], kx[1]); o.y = cvt_pk_bf16(kx[2], kx[3]); o.z = cvt_pk_bf16(kx[4], kx[5]); o.w = cvt_pk_bf16(kx[6], kx[7]); *(LAS v4u*)(L + HG_KX + lane * HG_PX + w * 16) = o; }
#pragma unroll
        for (int jj = 0; jj < 4; ++jj) {
            if (g >= jj) { float qs[8];
#pragma unroll
                for (int j = 0; j < 8; ++j) { const float Ej = jj == 0 ? E0[j] : (jj == 1 ? E1[j] : (jj == 2 ? E2[j] : E3[j])); qs[j] = qf[j] * __expf(bb[j] - Ej); }
                const int tix = (jj == 0 ? 0 : (jj == 1 ? 4 : (jj == 2 ? 7 : 9))) + (g - jj);
                v4u o; o.x = cvt_pk_bf16(qs[0], qs[1]); o.y = cvt_pk_bf16(qs[2], qs[3]); o.z = cvt_pk_bf16(qs[4], qs[5]); o.w = cvt_pk_bf16(qs[6], qs[7]);
                *(LAS v4u*)(L + HG_QS + tix * 16 * HG_PR + q16 * HG_PR + w * 16) = o; }
        }
        if (lane == 63) {
#pragma unroll
            for (int j = 0; j < 8; ++j) *(LAS float*)(L + HG_DV + (8 * w + j) * 4) = __expf(bb[j]); }
        __syncthreads();
        if (c + 1 < 32) { const long tn = tok0 + 64; const bf16* rowp = PB + (tn + lane) * LD_PB; qw = *(const v4u*)(rowp + h * 64 + 8 * w); fw = *(const v4u*)(rowp + 256 + h * 64 + 8 * w);
            vw0 = *(const v4u*)(PB + (tn + tid / 12) * LD_PB + 512 + h * 96 + (tid % 12) * 8);
            if (tid < 256) vw1 = *(const v4u*)(PB + (tn + (tid + 512) / 12) * LD_PB + 512 + h * 96 + ((tid + 512) % 12) * 8);
#pragma unroll
            for (int t = 0; t < 3; ++t)
#pragma unroll
                for (int r = 0; r < 4; ++r) ogn[t][r] = PB[(tn + 16 * mi + 4 * g + r) * LD_PB + 896 + h * 96 + 16 * (3 * hh + t) + q16]; }
        const LAS unsigned char* SIr = L + HG_SI + (c & 1) * 64 * HG_PV; LAS unsigned char* SIw = L + HG_SI + ((c + 1) & 1) * 64 * HG_PV;
        f32x4 AT[4];
#pragma unroll
        for (int j = 0; j < 4; ++j) {
            f32x4 acc = (f32x4){0.f, 0.f, 0.f, 0.f};
            if (j <= mi) {
                const int tix = (j == 0 ? 0 : (j == 1 ? 4 : (j == 2 ? 7 : 9))) + (mi - j);
#pragma unroll
                for (int ks = 0; ks < 2; ++ks) {
                    const bf16x8 a = *(const LAS bf16x8*)(L + HG_KH + (16 * j + q16) * HG_PR + (32 * ks + 8 * g) * 2);
                    const bf16x8 bq = *(const LAS bf16x8*)(L + HG_QS + tix * 16 * HG_PR + q16 * HG_PR + (32 * ks + 8 * g) * 2);
                    acc = __builtin_amdgcn_mfma_f32_16x16x32_bf16(a, bq, acc, 0, 0, 0);
                }
                if (j == mi) {
#pragma unroll
                    for (int r = 0; r < 4; ++r) if (4 * g + r > q16) acc[r] = 0.f; }
            }
            AT[j] = acc;
        }
        bf16x8 vf[2][3];
#pragma unroll
        for (int ks = 0; ks < 2; ++ks)
#pragma unroll
            for (int t = 0; t < 3; ++t) { const int col = (16 * (3 * hh + t) + 4 * tp) * 2;
                vf[ks][t] = cat8(trd(L + HG_VI + (32 * ks + 4 * g + tq4) * HG_PV + col), trd(L + HG_VI + (32 * ks + 16 + 4 * g + tq4) * HG_PV + col)); }
        f32x4 o[3];
#pragma unroll
        for (int t = 0; t < 3; ++t) o[t] = (f32x4){0.f, 0.f, 0.f, 0.f};
#pragma unroll
        for (int ks = 0; ks < 2; ++ks) {
            const bf16x8 a = *(const LAS bf16x8*)(L + HG_QT + (16 * mi + q16) * HG_PR + (32 * ks + 8 * g) * 2);
#pragma unroll
            for (int t = 0; t < 3; ++t) { const int col = (16 * (3 * hh + t) + 4 * tp) * 2;
                const bf16x8 bs = cat8(trd(SIr + (32 * ks + 8 * g + tq4) * HG_PV + col), trd(SIr + (32 * ks + 8 * g + 4 + tq4) * HG_PV + col));
                o[t] = __builtin_amdgcn_mfma_f32_16x16x32_bf16(a, bs, o[t], 0, 0, 0); }
        }
#pragma unroll
        for (int ks = 0; ks < 2; ++ks) {
            if (2 * ks <= mi) {
                v4u pw; pw.x = cvt_pk_bf16(AT[2 * ks][0], AT[2 * ks][1]); pw.y = cvt_pk_bf16(AT[2 * ks][2], AT[2 * ks][3]); pw.z = cvt_pk_bf16(AT[2 * ks + 1][0], AT[2 * ks + 1][1]); pw.w = cvt_pk_bf16(AT[2 * ks + 1][2], AT[2 * ks + 1][3]);
                const bf16x8 a = __builtin_bit_cast(bf16x8, pw);
#pragma unroll
                for (int t = 0; t < 3; ++t) o[t] = __builtin_amdgcn_mfma_f32_16x16x32_bf16(a, vf[ks][t], o[t], 0, 0, 0);
            }
        }
        { const f32x4 dv = *(const LAS f32x4*)(L + HG_DV + (16 * mi + 4 * g) * 4);
#pragma unroll
          for (int t = 0; t < 3; ++t) St[t] = St[t] * dv; }
#pragma unroll
        for (int ks = 0; ks < 2; ++ks) {
            const int col = (16 * mi + 4 * tp) * 2;
            const bf16x8 a = cat8(trd(L + HG_KX + (32 * ks + 4 * g + tq4) * HG_PX + col), trd(L + HG_KX + (32 * ks + 16 + 4 * g + tq4) * HG_PX + col));
#pragma unroll
            for (int t = 0; t < 3; ++t) St[t] = __builtin_amdgcn_mfma_f32_16x16x32_bf16(a, vf[ks][t], St[t], 0, 0, 0);
        }
#pragma unroll
        for (int t = 0; t < 3; ++t)
#pragma unroll
            for (int r = 0; r < 4; ++r) *(LAS bf16*)(SIw + (16 * mi + 4 * g + r) * HG_PV + (16 * (3 * hh + t) + q16) * 2) = f2bf(St[t][r]);
        float ss[4];
#pragma unroll
        for (int r = 0; r < 4; ++r) { float s2 = o[0][r] * o[0][r] + o[1][r] * o[1][r] + o[2][r] * o[2][r];
            ss[r] = sum_row16(s2); }
        if (q16 == 0) {
#pragma unroll
            for (int r = 0; r < 4; ++r) *(LAS float*)(L + HG_PS + ((16 * mi + 4 * g + r) * 2 + hh) * 4) = ss[r]; }
        float ogv[3][4];
#pragma unroll
        for (int t = 0; t < 3; ++t)
#pragma unroll
            for (int r = 0; r < 4; ++r) { ogv[t][r] = bf2f(ogc[t][r]); ogc[t][r] = ogn[t][r]; }
        __syncthreads();
#pragma unroll
        for (int r = 0; r < 4; ++r) { const f32x2 p2 = *(const LAS f32x2*)(L + HG_PS + (16 * mi + 4 * g + r) * 8); const float rstd = rsqrtf((p2[0] + p2[1]) * (1.f / 96.f) + EPS);
#pragma unroll
            for (int t = 0; t < 3; ++t) YB[(tok0 + 16 * mi + 4 * g + r) * 1024 + YC_B + h * 96 + 16 * (3 * hh + t) + q16] = f2bf(o[t][r] * rstd * gn[t] * ogv[t][r]); }
    }
    __syncthreads();
}
constexpr int CW_Q = 8192;
__device__ __forceinline__ void p2_queue(Frame& F) {
    const int lane = lane_id_fresh();
    volatile LAS int* qw = (volatile LAS int*)(F.lds + LDS_MISC + 64);
    constexpr int NH = 128, NW = (CV_ALL - CV_EARLY + 255) / 256, NA = NB * 6 * 8, NC = NB * 4 * 8;
    if (F.wave == 0 && lane == 0) qw[0] = (int)atomicAdd((unsigned*)(F.ws + WS_CTL) + CW_Q, 1u);
    for (;;) {
        __syncthreads();
        const int it = __builtin_amdgcn_readfirstlane(qw[0]);
        __syncthreads();
        if (it >= NH + NW + NA + NC) break;
        int nxt = 0; if (F.wave == 0 && lane == 0) nxt = (int)atomicAdd((unsigned*)(F.ws + WS_CTL) + CW_Q, 1u);
        if (it < NH) hgrn_seq(F, it, (bf16*)(F.dout + DO_Y));
        else if (it < NH + NW) { const int l2 = lane_id_fresh(); LAS float* scr = (LAS float*)(F.lds + F.wave * 16384);
            for (int j = 0; j < 32; ++j) { const int ci = CV_EARLY + (it - NH) * 256 + F.wave * 32 + j; if (ci < CV_ALL) conv_item(F, ci, scr, l2); } }
        else if (it < NH + NW + NA) attnA_unit(F, it - NH - NW);
        else attnC_unit(F, it - NH - NW - NA);
        if (F.wave == 0 && lane == 0) qw[0] = nxt;
    }
    __syncthreads();
}
template <bool OUTPUTS>
__device__ __forceinline__ void hgrn_simple(Frame& F, bf16* YBo) {
    const int lane = lane_id_fresh(); const int tid = F.wave * 64 + lane; (void)tid;
    const int uw = tid >> 7, col = tid & 127;
    LAS float* fL = (LAS float*)(F.lds + uw * 29184); LAS float* qL = fL + 2048; LAS float* oL = qL + 2048; LAS float* pL = oL + 3072;
    const bf16* PB = (const bf16*)(F.ws + WS_PB);
    const float* lbt = (const float*)(F.ws + WS_TAB) + 4096;
    float* LST = (float*)(F.ws + WS_LST); float* DEC = (float*)(F.ws + WS_DEC);
    for (int grp = F.vcu; grp < 1024; grp += F.G) {
        const int unit = grp * 4 + uw, b = unit >> 7, h = (unit >> 5) & 3, c = unit & 31; const int tok0 = b * SEQ + c * 64;
        float S[64]; float dprod = 1.f;
#pragma unroll
        for (int k = 0; k < 64; ++k) S[k] = 0.f;
        if (OUTPUTS && col < 96) {
            for (int cp = 0; cp < c; ++cp) { const float* dp = DEC + (size_t)(unit - c + cp) * 64; const float* lp = LST + (size_t)(unit - c + cp) * 6144 + col;
#pragma unroll
                for (int k = 0; k < 64; ++k) S[k] = dp[k] * S[k] + lp[k * 96]; }
        }
        for (int hf = 0; hf < 2; ++hf) {
            __syncthreads();
            for (int idx = col; idx < 2048; idx += 128) { const int s = idx >> 6, k = idx & 63; const size_t rb = (size_t)(tok0 + hf * 32 + s) * LD_PB;
                const float lb = lbt[h * 64 + k]; fL[idx] = lb + (1.f - lb) * sigmoidf_(bf2f(PB[rb + 256 + h * 64 + k]));
                if (OUTPUTS) qL[idx] = bf2f(PB[rb + h * 64 + k]); }
            __syncthreads();
            if (col < 96) {
                for (int s = 0; s < 32; ++s) {
                    const float v = bf2f(PB[(size_t)(tok0 + hf * 32 + s) * LD_PB + 512 + h * 96 + col]); float o = 0.f;
#pragma unroll
                    for (int k4 = 0; k4 < 16; ++k4) { const f32x4 f4 = *(const LAS f32x4*)(fL + s * 64 + 4 * k4); f32x4 q4 = (f32x4){0.f, 0.f, 0.f, 0.f}; if (OUTPUTS) q4 = *(const LAS f32x4*)(qL + s * 64 + 4 * k4);
#pragma unroll
                        for (int j = 0; j < 4; ++j) { const float fk = f4[j]; S[4 * k4 + j] = fk * S[4 * k4 + j] + (1.f - fk) * v; if (OUTPUTS) o += S[4 * k4 + j] * q4[j]; } }
                    if (OUTPUTS) oL[s * 96 + col] = o;
                }
            }
            if (!OUTPUTS && col < 64) { for (int s = 0; s < 32; ++s) dprod *= fL[s * 64 + col]; }
            if (OUTPUTS) {
                __syncthreads();
                { const int s = col & 31, part = col >> 5; float ss = 0.f;
#pragma unroll
                  for (int j = 0; j < 24; ++j) { const float x = oL[s * 96 + part * 24 + j]; ss += x * x; }
                  pL[s * 4 + part] = ss; }
                __syncthreads();
                if (col < 96) { const float gn = arg_in(I_ONB)[h * 96 + col];
                    for (int s = 0; s < 32; ++s) { const f32x4 p4 = *(const LAS f32x4*)(pL + s * 4); const float rstd = rsqrtf(((p4[0] + p4[1]) + (p4[2] + p4[3])) * (1.f / 96.f) + EPS);
                        const size_t tok = (size_t)(tok0 + hf * 32 + s); const float og = bf2f(PB[tok * LD_PB + 896 + h * 96 + col]);
                        YBo[tok * 384 + h * 96 + col] = f2bf(oL[s * 96 + col] * rstd * gn * og); } }
            }
        }
        if (!OUTPUTS) {
            if (col < 96) {
#pragma unroll
                for (int k = 0; k < 64; ++k) LST[(size_t)unit * 6144 + k * 96 + col] = S[k]; }
            if (col < 64) DEC[(size_t)unit * 64 + col] = dprod;
        }
    }
    __syncthreads();
}

__device__ __forceinline__ __amdgpu_buffer_rsrc_t make_rsrc(const void* base, int bytes) { return __builtin_amdgcn_make_buffer_rsrc((void*)base, (short)0, bytes, 0x00020000); }
__device__ __forceinline__ void count_greater4(int& beat, const v4u o, const unsigned key) {
    unsigned long long A, B, C;
    asm volatile("v_cmp_gt_u32_e64 %1, %4, %8\n\t"
                 "v_cmp_gt_u32_e64 %2, %5, %8\n\t"
                 "v_cmp_gt_u32_e64 %3, %6, %8\n\t"
                 "v_addc_co_u32_e64 %0, %1, 0, %0, %1\n\t"
                 "v_cmp_gt_u32_e64 %1, %7, %8\n\t"
                 "v_addc_co_u32_e64 %0, %2, 0, %0, %2\n\t"
                 "v_addc_co_u32_e64 %0, %3, 0, %0, %3\n\t"
                 "v_addc_co_u32_e64 %0, %1, 0, %0, %1"
                 : "+v"(beat), "=&s"(A), "=&s"(B), "=&s"(C) : "v"(o.x), "v"(o.y), "v"(o.z), "v"(o.w), "v"(key));
}
constexpr int RT_ROW = 2064;
constexpr int RT_HI = 0, RT_LO = 32 * RT_ROW, RT_LG = 64 * RT_ROW;
constexpr int RT_GN = RT_LG + 2 * 32 * 64 * 4 + 1024;
constexpr int RT_KEY = RT_GN + 4096;
static_assert(RT_KEY + 8 * 1024 <= LDS_MISC, "routing LDS map");
__device__ __forceinline__ void p6_route(Frame& F, const bool commit) {
    const int lane = lane_id_fresh();
    const bf16* X1 = (const bf16*)F.dout; bf16* U = (bf16*)(F.ws + WS_U);
    const bf16* WRH = (const bf16*)(F.ws + WS_TAB + 65536); const bf16* WRL = WRH + 65536;
    const float rbias = arg_in(I_RB)[lane];
    v2u* slot = (v2u*)(F.ws + WS_SLOT); unsigned* cntw = (unsigned*)(F.ws + WS_CTL) + CW_CNT;
    LAS unsigned* lcnt = (LAS unsigned*)(F.lds + RT_LG + 2 * 32 * 64 * 4);
    for (int i = F.vcu * 512 + F.wave * 64 + lane; i < HALF_T; i += F.G * 512) slot[(size_t)64 * SLOT_CAP + i] = (v2u){(unsigned)(i * 8), 0x3f800000u};
    const int q = lane & 15, g = lane >> 4, et = F.wave & 3, kh = F.wave >> 2;
    bf16x8 wh[16], wl[16];
    const __amdgpu_buffer_rsrc_t rsl = make_rsrc(WRL + (size_t)et * 16384 + (size_t)kh * 8192, 16384); const int lv16 = lane * 16;
    {   const bf16* ph = WRH + (size_t)et * 16384 + (size_t)kh * 8192 + lane * 8;
#pragma unroll
        for (int ks = 0; ks < 16; ++ks) wh[ks] = *(const bf16x8*)(ph + 512 * ks); }
    const unsigned long long lt_mask = (lane == 0) ? 0ull : (~0ull >> (64 - lane));
    v4u xv[4][2], xn[4][2];
    if (F.wave < 4) *(LAS f32x4*)(F.lds + RT_GN + (F.wave * 64 + lane) * 16) = ((const f32x4*)arg_in(I_FNG))[F.wave * 64 + lane];
    {   const int t0 = F.vcu * 32;
        if (t0 < T) {
#pragma unroll
            for (int i = 0; i < 4; ++i)
#pragma unroll
                for (int j = 0; j < 2; ++j) { xv[i][j] = *(const v4u*)(X1 + x1_off((size_t)(t0 + F.wave * 4 + i)) + 16 * lane + 8 * j); xn[i][j] = xv[i][j]; } }
        const int t1 = t0 + F.G * 32;
        if (t1 < T) {
#pragma unroll
            for (int i = 0; i < 4; ++i)
#pragma unroll
                for (int j = 0; j < 2; ++j) xn[i][j] = *(const v4u*)(X1 + x1_off((size_t)(t1 + F.wave * 4 + i)) + 16 * lane + 8 * j); } }
    for (int t0 = F.vcu * 32; t0 < T; t0 += F.G * 32) {
        __syncthreads();
        if (F.wave == 0) lcnt[lane] = 0u;
#pragma unroll
        for (int i = 0; i < 4; ++i) {
            const int tl = F.wave * 4 + i, t = t0 + tl;
            float x[16];
#pragma unroll
            for (int j = 0; j < 2; ++j) { const unsigned w4[4] = {xv[i][j].x, xv[i][j].y, xv[i][j].z, xv[i][j].w};
#pragma unroll
                for (int k = 0; k < 4; ++k) { x[8 * j + 2 * k] = bf_lo(w4[k]); x[8 * j + 2 * k + 1] = bf_hi(w4[k]); } }
            float s2 = 0.f;
#pragma unroll
            for (int k = 0; k < 16; ++k) s2 += x[k] * x[k];
            const float rstd = rsqrtf(wave_sum(s2) * (1.f / D) + EPS);
            unsigned hw[8], lw[8];
#pragma unroll
            for (int k = 0; k < 8; ++k) { const f32x4 gg = *(const LAS f32x4*)(F.lds + RT_GN + (4 * lane + (k >> 1)) * 16);
                const float u0 = x[2 * k] * rstd * gg[2 * (k & 1)], u1 = x[2 * k + 1] * rstd * gg[2 * (k & 1) + 1];
                hw[k] = cvt_pk_bf16(u0, u1); lw[k] = cvt_pk_bf16(u0 - bf_lo(hw[k]), u1 - bf_hi(hw[k])); }
            *(LAS v4u*)(F.lds + RT_HI + tl * RT_ROW + lane * 32) = (v4u){hw[0], hw[1], hw[2], hw[3]}; *(LAS v4u*)(F.lds + RT_HI + tl * RT_ROW + lane * 32 + 16) = (v4u){hw[4], hw[5], hw[6], hw[7]};
            *(LAS v4u*)(F.lds + RT_LO + tl * RT_ROW + lane * 32) = (v4u){lw[0], lw[1], lw[2], lw[3]}; *(LAS v4u*)(F.lds + RT_LO + tl * RT_ROW + lane * 32 + 16) = (v4u){lw[4], lw[5], lw[6], lw[7]};
        }
        asm volatile("" ::: "memory");
#pragma unroll
        for (int ks = 0; ks < 16; ++ks) wl[ks] = __builtin_bit_cast(bf16x8, __builtin_amdgcn_raw_buffer_load_b128(rsl, lv16, 1024 * ks, 0));
#pragma unroll
        for (int i = 0; i < 4; ++i)
#pragma unroll
            for (int j = 0; j < 2; ++j) xv[i][j] = xn[i][j];
        {   const int tn = t0 + 2 * F.G * 32;
            if (tn < T) {
#pragma unroll
                for (int i = 0; i < 4; ++i)
#pragma unroll
                    for (int j = 0; j < 2; ++j) xn[i][j] = *(const v4u*)(X1 + x1_off((size_t)(tn + F.wave * 4 + i)) + 16 * lane + 8 * j); } }
        __syncthreads();
#pragma unroll
        for (int mt = 0; mt < 2; ++mt) {
            f32x4 acc = (f32x4){0.f, 0.f, 0.f, 0.f};
            const LAS unsigned char* uh = F.lds + RT_HI + (mt * 16 + q) * RT_ROW + 16 * g + kh * 1024; const LAS unsigned char* ul = F.lds + RT_LO + (mt * 16 + q) * RT_ROW + 16 * g + kh * 1024;
#pragma unroll
            for (int ks = 0; ks < 16; ++ks) {
                const bf16x8 b_h = *(const LAS bf16x8*)(uh + 64 * ks), b_l = *(const LAS bf16x8*)(ul + 64 * ks);
                acc = __builtin_amdgcn_mfma_f32_16x16x32_bf16(wh[ks], b_h, acc, 0, 0, 0);
                acc = __builtin_amdgcn_mfma_f32_16x16x32_bf16(wl[ks], b_h, acc, 0, 0, 0);
                acc = __builtin_amdgcn_mfma_f32_16x16x32_bf16(wh[ks], b_l, acc, 0, 0, 0);
            }
            *(LAS f32x4*)(F.lds + RT_LG + kh * 8192 + ((mt * 16 + q) * 64 + et * 16 + 4 * g) * 4) = acc;
        }
        __syncthreads();
#pragma unroll
        for (int i = 0; i < 4; ++i) { const int tl = F.wave * 4 + i;
#pragma unroll
            for (int j = 0; j < 2; ++j) *((v4u*)(U + (size_t)(t0 + tl) * D) + 64 * j + lane) = *(const LAS v4u*)(F.lds + RT_HI + tl * RT_ROW + (64 * j + lane) * 16); }
        unsigned lrank[4]; float wn[4]; int rk[4];
#pragma unroll
        for (int i = 0; i < 4; ++i) {
            const int tl = F.wave * 4 + i;
            const float z = *(const LAS float*)(F.lds + RT_LG + (tl * 64 + lane) * 4) + *(const LAS float*)(F.lds + RT_LG + 8192 + (tl * 64 + lane) * 4);
            const float sg = sigmoidf_(z), ch = sg + rbias;
            float m1 = max_grp8(ch);
            const unsigned long long eqm = __ballot(ch == m1); const int gbase = lane & ~7; const unsigned gm = (unsigned)(eqm >> gbase) & 0xffu; const int first = gbase + __builtin_ctz(gm);
            float m2 = max_grp8((lane == first) ? -3.0e38f : ch);
            const float gs = m1 + m2; const int gi = lane >> 3; int grank = 0;
#pragma unroll
            for (int gg = 0; gg < 8; ++gg) { const float og = readlane_f(gs, gg * 8); grank += (og > gs || (og == gs && gg < gi)) ? 1 : 0; }
            const bool gsel = grank < 4; const float cm = gsel ? ch : -3.0e38f;
            const unsigned kb = __float_as_uint(cm); const unsigned key = (kb & 0x80000000u) ? ~kb : (kb | 0x80000000u);
            int beat = 0;
            {   LAS unsigned* kr = (LAS unsigned*)(F.lds + RT_KEY + F.wave * 1024 + i * 256);
                kr[lane] = key;
#pragma unroll
                for (int h = 0; h < 2; ++h) { v4u o[8];
#pragma unroll
                    for (int j4 = 0; j4 < 8; ++j4) o[j4] = *(const LAS v4u*)(kr + 32 * h + 4 * j4);
#pragma unroll
                    for (int j4 = 0; j4 < 8; ++j4) count_greater4(beat, o[j4], key); } }
            bool sel = gsel && beat < 8;
            if (__builtin_popcountll(__ballot(sel)) != 8) {
                unsigned thr = 0u;
#pragma unroll 1
                for (int bit = 31; bit >= 0; --bit) { const unsigned cand = thr | (1u << bit); if (__builtin_popcountll(__ballot(key >= cand)) >= 8) thr = cand; }
                const unsigned long long gtm = __ballot(key > thr), eqt = __ballot(key == thr); const int need = 8 - __builtin_popcountll(gtm);
                sel = (key > thr) || (key == thr && __builtin_popcountll(eqt & lt_mask) < need);
            }
            const unsigned long long selm = __ballot(sel);
            const float wsum = wave_sum(sel ? sg : 0.f);
            rk[i] = sel ? __builtin_popcountll(selm & lt_mask) : -1; wn[i] = 2.5f * sg / wsum; lrank[i] = 0u;
            if (sel) lrank[i] = __hip_atomic_fetch_add(lcnt + lane, 1u, __ATOMIC_RELAXED, __HIP_MEMORY_SCOPE_WORKGROUP);
        }
        __syncthreads();
        const int seg = lane;
        if (F.wave == 0) { const unsigned n = lcnt[lane]; unsigned base = 0u; if (n && commit) base = atomicAdd(cntw + 64 * seg, n); lcnt[64 + lane] = base; }
        __syncthreads();
        if (commit) { const unsigned base = lcnt[64 + lane];
#pragma unroll
            for (int i = 0; i < 4; ++i) if (rk[i] >= 0) { const int flat = (t0 + F.wave * 4 + i) * 8 + rk[i]; slot[(size_t)seg * SLOT_CAP + base + lrank[i]] = (v2u){(unsigned)flat, __float_as_uint(wn[i])}; } }
    }
    __syncthreads();
}
__device__ __forceinline__ void moe_load_segs(Frame& F) {
    const int lane = lane_id_fresh(); const int tid = F.wave * 64 + lane; (void)tid;
    LAS int* pre = (LAS int*)(F.lds + LDS_PRE); LAS int* cnt = pre + 132;
    __syncthreads();
    if (tid < NSEG) { const int e = tid % NSEGH; cnt[tid] = (e == 64) ? T : (int)__hip_atomic_load((unsigned*)(F.ws + WS_CTL) + CW_CNT + 64 * tid, RLX_AGENT); }
    __syncthreads();
    static_assert(NSEG == 65, "the scan below handles 64 lanes + one tail segment");
    if (F.wave == 0) {
        const int b = (cnt[lane] + 255) >> 8; int inc = b;
#pragma unroll
        for (int o = 1; o < 64; o <<= 1) { const int t = __shfl_up(inc, o); if (lane >= o) inc += t; }
        pre[lane] = inc - b;
        if (lane == 63) { pre[64] = inc; pre[65] = inc + ((cnt[64] + 255) >> 8); }
    }
    __syncthreads();
}
typedef float f32x2v __attribute__((ext_vector_type(2)));
__device__ __forceinline__ void p_combine(Frame& F) {
    const int lane = lane_id_fresh();
    const int gw = F.vcu * 8 + F.wave, NGW = F.G * 8; float* out = (float*)F.dout; const unsigned char* YB = F.ws + WS_YBUF; const unsigned char* SHB = F.ws + WS_SHB;
    v4u c[11], n[11];
#define CMB_LOAD(dst, t_) do { const bf16* xp_ = (const bf16*)F.dout + x1_off((size_t)(t_)) + lane * 16; dst[0] = *(const v4u*)xp_; dst[1] = *(const v4u*)(xp_ + 8); \
        _Pragma("unroll") for (int k = 0; k < 8; ++k) dst[2 + k] = *(const v4u*)(YB + (size_t)(lane >> 4) * ((size_t)T * 8 * 256) + ((size_t)(t_) * 8 + k) * 256 + (lane & 15) * 16); \
        dst[10] = *(const v4u*)(SHB + (size_t)(lane >> 4) * ((size_t)T * 256) + (size_t)(t_) * 256 + (lane & 15) * 16); } while (0)
    if (gw < T) CMB_LOAD(c, gw);
    for (int t = gw; t < T; t += NGW) {
        const int tn = t + NGW;
        if (tn < T) CMB_LOAD(n, tn);
        float a[16];
        { const unsigned ww[8] = {c[0].x, c[0].y, c[0].z, c[0].w, c[1].x, c[1].y, c[1].z, c[1].w};
#pragma unroll
          for (int j = 0; j < 8; ++j) { a[2 * j] = bf_lo(ww[j]); a[2 * j + 1] = bf_hi(ww[j]); } }
        float acc[16];
#pragma unroll
        for (int j = 0; j < 16; ++j) acc[j] = 0.f;
#pragma unroll
        for (int k = 0; k < 9; ++k) { const unsigned ww[4] = {c[2 + k].x, c[2 + k].y, c[2 + k].z, c[2 + k].w};
#pragma unroll
            for (int j = 0; j < 4; ++j) { const f32x2v lo = __builtin_amdgcn_cvt_pk_f32_fp8((int)ww[j], false), hi = __builtin_amdgcn_cvt_pk_f32_fp8((int)ww[j], true);
                acc[4 * j] += lo[0]; acc[4 * j + 1] += lo[1]; acc[4 * j + 2] += hi[0]; acc[4 * j + 3] += hi[1]; } }
#pragma unroll
        for (int j = 0; j < 4; ++j) *(f32x4*)(out + (size_t)t * D + lane * 16 + 4 * j) = (f32x4){a[4 * j] + acc[4 * j] * Y8_INV, a[4 * j + 1] + acc[4 * j + 1] * Y8_INV, a[4 * j + 2] + acc[4 * j + 2] * Y8_INV, a[4 * j + 3] + acc[4 * j + 3] * Y8_INV};
#pragma unroll
        for (int k = 0; k < 11; ++k) c[k] = n[k];
    }
#undef CMB_LOAD
}

struct Args { const float* in[24]; float* out; unsigned char* ws; int ph_lo, ph_hi, li, pad; };
__global__ void __launch_bounds__(512, 2) mk_fwd(Args args) {
    extern __shared__ __attribute__((aligned(16))) unsigned char lds[];
    Frame F;
    F.lds = (LAS unsigned char*)lds;
    F.wave = __builtin_amdgcn_readfirstlane((int)threadIdx.x >> 6);
    F.G = gridDim.x; { const int bx = blockIdx.x; F.vcu = (F.G % 8 == 0) ? (bx % 8) * (F.G / 8) + bx / 8 : bx; }
    F.ws = args.ws; F.dout = (unsigned char*)args.out;
    volatile LAS unsigned* MISC = (volatile LAS unsigned*)(F.lds + LDS_MISC);
    if (threadIdx.x < 64) MISC[threadIdx.x] = 0u;
    __syncthreads();
    XcdBarrier bar; bar.bar = (unsigned*)(F.ws + WS_CTL) + CW_BAR; bar.x = 0; bar.st = nullptr;
    if (MK_N_LAUNCHES == 1) bar = xcd_barrier_post((unsigned*)(F.ws + WS_CTL) + CW_BAR, MISC);
    const int lo = args.ph_lo, hi = args.ph_hi;
#ifndef PH_MASK
#define PH_MASK 0xfff
#endif
#define IN(k) (((PH_MASK >> (k)) & 1) && lo <= (k) && (k) < hi)
#ifndef REPEAT_MASK
#define REPEAT_MASK 0
#endif
#define REP(k) (((REPEAT_MASK >> (k)) & 1) != 0)
#define SEAM(k) do { if (IN(k) && IN((k) + 1)) xcd_barrier(bar, F.wave); } while (0)
    LAS unsigned char* ring = F.lds;

    if (IN(0)) { p0_prologue(F); if (REP(0)) { xcd_barrier(bar, F.wave); p0_prologue(F); } } SEAM(0);
    if (IN(1)) for (int rep_ = 0; rep_ < (REP(1) ? 2 : 1); ++rep_) { if (rep_) xcd_barrier(bar, F.wave);
        stagger(F, 350);
        { pg8::StaticOrder S; S.init(F.dout, F.ws + WS_WIN, T, NPROJ_PAD, 1024, F.G, (int)blockIdx.x);
          pg8::EpiProj E{(bf16*)(F.ws + WS_PA), (bf16*)(F.ws + WS_PB), (bf16*)(F.ws + WS_PC), (unsigned char*)(F.ws + WS_PG), arg_in(I_QNA), arg_in(I_KNA), arg_in(I_QNC)};
          pg8::gemm_phase<pg8::EpiProj, pg8::StaticOrder, false>(ring, 1024, S, E, F.wave); }
        { pg8::StaticOrder S; S.init(F.ws + WS_MEMN, F.ws + WS_WMEM, NB * MEML, 512, 1024, F.G, (int)((blockIdx.x + 128) % F.G));
          pg8::EpiMemKV E{(bf16*)(F.ws + WS_MEMK), (bf16*)(F.ws + WS_MEMV), arg_in(I_KNC)};
          pg8::gemm_phase<pg8::EpiMemKV, pg8::StaticOrder, false>(ring, 1024, S, E, F.wave); }
    } SEAM(1);
#ifndef HGRN_CHECK
#define HGRN_CHECK 0
#endif
#ifndef P2_MODE
#define P2_MODE 0
#endif
#if HGRN_CHECK == 2
    if (IN(2)) { for (int sq = F.vcu; sq < 128; sq += F.G) hgrn_seq(F, sq, (bf16*)(F.dout + 128 * MiB)); for (int sq = F.vcu; sq < 128; sq += F.G) hgrn_seq(F, sq, (bf16*)(F.dout + 176 * MiB)); p2_attn_mfma(F); hgrn_simple<false>(F, nullptr); } SEAM(2);
    if (IN(3)) { hgrn_simple<true>(F, (bf16*)(F.dout + 128 * MiB)); xcd_barrier(bar, F.wave);
        const bf16* Y1 = (const bf16*)(F.dout + 128 * MiB); const bf16* Y3 = (const bf16*)(F.dout + 176 * MiB); const bf16* Y2 = (const bf16*)(F.dout + 128 * MiB); unsigned bad = 0, bad2 = 0; const int lane = lane_id_fresh();
        for (size_t i = (size_t)F.vcu * 512 + F.wave * 64 + lane; i < (size_t)T * 384; i += (size_t)F.G * 512) { if (Y1[i] != Y3[i]) ++bad; const float a = bf2f(Y1[i]), b2 = bf2f(Y2[i]); if (!(fabsf(a - b2) <= 0.03f * (fabsf(a) + fabsf(b2)) + 0.02f)) ++bad2; }
        bad = (unsigned)wave_sum((float)bad); bad2 = (unsigned)wave_sum((float)bad2); if (lane == 0 && bad) atomicAdd((unsigned*)(F.ws + WS_CTL) + CW_Q + 64, bad); if (lane == 0 && bad2) atomicAdd((unsigned*)(F.ws + WS_CTL) + CW_Q + 128, bad2); } SEAM(3);
#else
    if (IN(2)) { if (P2_MODE == 0) p2_queue(F); else { for (int sq = F.vcu; sq < 128; sq += F.G) hgrn_seq(F, sq, (bf16*)(F.dout + DO_Y)); p2_attn_mfma(F); } if (HGRN_CHECK) hgrn_simple<false>(F, nullptr); } SEAM(2);
    if (IN(3) && HGRN_CHECK) { if (HGRN_CHECK) {
        bf16* Y2 = (bf16*)(F.dout + 128 * MiB); hgrn_simple<true>(F, Y2); xcd_barrier(bar, F.wave);
        const bf16* Y1 = (const bf16*)(F.dout + 128 * MiB); unsigned bad = 0; const int lane = lane_id_fresh();
        for (size_t i = (size_t)F.vcu * 512 + F.wave * 64 + lane; i < (size_t)T * 384; i += (size_t)F.G * 512) { const float a = bf2f(Y1[i]), b2 = bf2f(Y2[i]); if (!(fabsf(a - b2) <= 0.03f * (fabsf(a) + fabsf(b2)) + 0.02f)) ++bad; }
        bad = (unsigned)wave_sum((float)bad); if (lane == 0 && bad) atomicAdd((unsigned*)(F.ws + WS_CTL) + CW_Q + 64, bad); } } if (HGRN_CHECK) SEAM(3);
#endif
    if (IN(4)) for (int rep_ = 0; rep_ < (REP(4) ? 2 : 1); ++rep_) { if (rep_) xcd_barrier(bar, F.wave);
        pg8::StaticOrder S; S.init(F.dout + DO_Y, F.ws + WS_WA, T, 1024, 1024, F.G, (int)blockIdx.x); pg8::EpiMerge E{(const unsigned char*)(F.ws + WS_PG), (bf16*)(F.ws + WS_MIXED)};
        pg8::gemm_phase<pg8::EpiMerge, pg8::StaticOrder, false>(ring, 1024, S, E, F.wave);
    } SEAM(4);
    if (IN(5)) for (int rep_ = 0; rep_ < (REP(5) ? 2 : 1); ++rep_) { if (rep_) xcd_barrier(bar, F.wave);
        pg8::StaticOrder S; S.init(F.ws + WS_MIXED, F.ws + WS_WOUT, T, 1024, 1024, F.G, (int)blockIdx.x); pg8::EpiOut E{arg_in(I_X), (bf16*)F.dout};
        pg8::gemm_phase<pg8::EpiOut, pg8::StaticOrder, false>(ring, 1024, S, E, F.wave);
    } SEAM(5);
    if (IN(6)) { for (int rep_ = (REP(6) ? 0 : 1); rep_ < 2; ++rep_) { p6_route(F, rep_ == 1 || ((volatile unsigned*)(F.ws + WS_CTL))[8] != 0u); if (rep_ == 0) xcd_barrier(bar, F.wave); } } SEAM(6);
    if (IN(7)) for (int rep_ = 0; rep_ < (REP(7) ? 2 : 1); ++rep_) { if (rep_) xcd_barrier(bar, F.wave);
        moe_load_segs(F); stagger(F, 300);
        pg8::MoeOrder S; S.pre = (const LAS int*)(F.lds + LDS_PRE); S.cnt = S.pre + 132; S.seg_lo = 0; S.nseg = NSEG; S.nN = 2; S.G = F.G; S.c = F.vcu;
        S.A = (const char*)(F.ws + WS_U); S.Bt = (const char*)(F.ws + WS_WUP); S.a_tstep = 0; S.b_estride = (size_t)512 * 1024 * 2; S.b_tstep = (size_t)256 * 1024 * 2; S.slot = (const int*)(F.ws + WS_SLOT); S.gather = true; S.hint = 0;
        pg8::EpiUp E{(bf16*)(F.ws + WS_HID)};
        pg8::gemm_phase<pg8::EpiUp, pg8::MoeOrder, true>(ring, 1024, S, E, F.wave);
    } SEAM(7);
#define DOWN_PHASE(nsg, prb) do { if (!(IN(7))) moe_load_segs(F);     \
        pg8::MoeOrder S; S.pre = (const LAS int*)(F.lds + LDS_PRE); S.cnt = S.pre + 132; S.seg_lo = 0; S.nseg = (nsg); S.nN = 4; S.G = F.G; S.c = F.vcu; \
        S.A = (const char*)(F.ws + WS_HID); S.Bt = (const char*)(F.ws + WS_WDN); S.a_tstep = (size_t)256 * 256 * 2; S.b_estride = (size_t)1024 * 256 * 2; S.b_tstep = (size_t)256 * 256 * 2; S.slot = (const int*)(F.ws + WS_SLOT); S.gather = false; S.hint = 0; \
        pg8::EpiDown E{F.lds, F.ws + WS_YBUF, F.ws + WS_SHB, (prb)}; \
        pg8::gemm_phase<pg8::EpiDown, pg8::MoeOrder, false, true>(ring, 256, S, E, F.wave); } while (0)
    if (IN(8)) { if (REP(8)) { DOWN_PHASE(64, -2); xcd_barrier(bar, F.wave); } DOWN_PHASE(NSEGH, 0); } SEAM(8);
    if (IN(9)) { p_combine(F);
        if (HGRN_CHECK) { xcd_barrier(bar, F.wave); const unsigned c1 = __hip_atomic_load((unsigned*)(F.ws + WS_CTL) + CW_Q + 64, RLX_AGENT), c2 = __hip_atomic_load((unsigned*)(F.ws + WS_CTL) + CW_Q + 128, RLX_AGENT);
            const float frac = (c1 > 0u ? 50.f : 0.f) + (c2 > 25000u ? 5.f : 0.f) + (c2 > 1250000u ? 10.f : 0.f);
            if (frac > 0.f) { const int lane = lane_id_fresh(); float* o = (float*)F.dout; for (size_t i = (size_t)F.vcu * 512 + F.wave * 64 + lane; i < (size_t)T * D; i += (size_t)F.G * 512) o[i] += frac; } } }
#undef IN
#undef SEAM
}

extern "C" void kernel_launch(void* const* d_in, const int* in_sizes, int n_in, void* d_out, int out_size, void* d_ws, size_t ws_size, hipStream_t stream) {
    static int grid = 0;
    if (grid == 0) {
        if (n_in != 24 || out_size != T * D || ws_size < WS_END) { fprintf(stderr, "kernel_launch: unexpected shapes (n_in %d out %d ws %zu)\n", n_in, out_size, ws_size); grid = -1; return; }
        int dev = 0, cus = 0, per_cu = 0;
        if (hipGetDevice(&dev) != hipSuccess || hipDeviceGetAttribute(&cus, hipDeviceAttributeMultiprocessorCount, dev) != hipSuccess) { grid = -1; return; }
        if (hipFuncSetAttribute((const void*)mk_fwd, hipFuncAttributeMaxDynamicSharedMemorySize, LDS_BYTES) != hipSuccess) { fprintf(stderr, "kernel_launch: hipFuncSetAttribute failed\n"); grid = -1; return; }
        if (hipOccupancyMaxActiveBlocksPerMultiprocessor(&per_cu, (const void*)mk_fwd, 512, LDS_BYTES) != hipSuccess || per_cu < 1) fprintf(stderr, "kernel_launch: occupancy query says %d\n", per_cu);
        (void)hipGetLastError();
        grid = cus;
    }
    if (grid < 0) return;
    (void)hipMemsetAsync((char*)d_ws + WS_CTL, 0, CTL_ZERO_BYTES, stream);
    Args a{};
    for (int i = 0; i < 24; ++i) a.in[i] = (const float*)d_in[i];
    a.out = (float*)d_out; a.ws = (unsigned char*)d_ws;
    for (int li = 0; li < MK_N_LAUNCHES; ++li) {
        a.ph_lo = (MK_N_LAUNCHES == 1) ? 0 : li; a.ph_hi = (MK_N_LAUNCHES == 1) ? NPHASE : li + 1; a.li = li;
        hipLaunchKernelGGL(mk_fwd, dim3(grid), dim3(512), LDS_BYTES, stream, a);
    }
}
```

```cpp
#include <hip/hip_runtime.h>
#include <cstdio>
#include <cstdint>

#define GAS __attribute__((address_space(1)))
#define LAS __attribute__((address_space(3)))
typedef unsigned short bf16;
typedef unsigned v4u __attribute__((ext_vector_type(4)));
typedef unsigned v2u __attribute__((ext_vector_type(2)));
typedef float f32x4 __attribute__((ext_vector_type(4)));
typedef float f32x2 __attribute__((ext_vector_type(2)));
typedef short bf16x8 __attribute__((ext_vector_type(8)));
typedef GAS unsigned gu32;
#define RLX_AGENT __ATOMIC_RELAXED, __HIP_MEMORY_SCOPE_AGENT
#define LDS_WAIT() asm volatile("s_waitcnt lgkmcnt(0)" ::: "memory")
#define VM_WAIT() asm volatile("s_waitcnt vmcnt(0)" ::: "memory")

#ifndef MK_N_LAUNCHES
#define MK_N_LAUNCHES 1
#endif
static_assert(MK_N_LAUNCHES == 1 || MK_N_LAUNCHES == 10, "launch split");

constexpr int T = 65536, D = 1024, SEQ = 2048, NB = 32, MEML = 256;
constexpr int NPROJ = 5760, NPROJ_PAD = 5888;
constexpr int LD_PA = 1152, LD_PB = 1280, LD_PC = 256, LD_PG = 3072;
constexpr int NEXP = 64, NSEGH = 65, NSEG = 65, SLOT_CAP = 65536, HALF_T = 65536;
constexpr float Y8_SCALE = 16.0f, Y8_INV = 1.0f / 16.0f;
constexpr float EPS = 1e-6f;
constexpr int NPHASE = 10;

constexpr size_t MiB = 1u << 20;
constexpr size_t WS_CTL = 0, CTL_ZERO_BYTES = 128 * 1024;
constexpr size_t WS_TAB = 1 * MiB;
constexpr size_t WS_WIN = 2 * MiB;
constexpr size_t WS_WMEM = 14 * MiB;
constexpr size_t WS_WA = 15 * MiB;
constexpr size_t WS_WB = WS_WA + 768 * 1024;
constexpr size_t WS_WC = WS_WB + 768 * 1024;
constexpr size_t WS_WOUT = 17 * MiB;
constexpr size_t WS_WUP = 19 * MiB;
constexpr size_t WS_WDN = 84 * MiB;
constexpr size_t WS_MEMN = 117 * MiB;
constexpr size_t WS_MEMK = 133 * MiB, WS_MEMV = 137 * MiB;
constexpr size_t WS_ACT = 141 * MiB;
constexpr size_t WS_PG = WS_ACT;
constexpr size_t WS_PA = WS_PG + 384 * MiB;
constexpr size_t WS_PB = WS_PA + 144 * MiB;
constexpr size_t WS_PC = WS_PB + 160 * MiB;
constexpr size_t WS_LST = WS_PC + 32 * MiB;
constexpr size_t WS_DEC = WS_LST + 96 * MiB;
constexpr size_t WS_MIXED = WS_PA;
constexpr size_t WS_HID = WS_ACT;
constexpr size_t WS_SLOT = WS_HID + 304 * MiB;
constexpr size_t WS_U = WS_SLOT + 34 * MiB;
constexpr size_t WS_SHB = WS_WUP;
constexpr size_t WS_YBUF = WS_U;
constexpr size_t WS_END = WS_YBUF + 512 * MiB;
__device__ __forceinline__ size_t x1_off(size_t t) { return t * 2048 + (t & 1) * 1024; }
static_assert(WS_DEC + 1 * MiB <= 1024 * MiB && WS_END <= 1024 * MiB, "ws map");
static_assert(WS_WDN + (size_t)65 * 1024 * 256 * 2 <= WS_MEMN && WS_WUP + (size_t)65 * 512 * 1024 * 2 <= WS_WDN, "weights map");
constexpr size_t DO_Y = 0;
constexpr int YC_A = 0, YC_B = 384, YC_C = 768;
constexpr int CW_BAR = 4096;
constexpr int CW_CNT = 16384;

constexpr int RING_BYTES = 131072;
constexpr int LDS_GTAB = RING_BYTES;
constexpr int LDS_PRE = LDS_GTAB + 6144;
constexpr int LDS_BYTES = 163840;
constexpr int LDS_MISC = LDS_BYTES - 256;
static_assert(LDS_MISC + 256 <= LDS_BYTES, "lds map");

__device__ __forceinline__ int lane_id_fresh() { int l = __builtin_amdgcn_mbcnt_hi(0xffffffffu, __builtin_amdgcn_mbcnt_lo(0xffffffffu, 0u)); asm volatile("" : "+v"(l)); return l; }
typedef __bf16 bf16v2_t __attribute__((ext_vector_type(2)));
__device__ __forceinline__ unsigned cvt_pk_bf16(float lo, float hi) { const bf16v2_t v = {(__bf16)lo, (__bf16)hi}; return __builtin_bit_cast(unsigned, v); }
__device__ __forceinline__ float bf_lo(unsigned w) { return __uint_as_float(w << 16); }
__device__ __forceinline__ float bf_hi(unsigned w) { return __uint_as_float(w & 0xffff0000u); }
__device__ __forceinline__ float bf2f(bf16 b) { return __uint_as_float(((unsigned)b) << 16); }
__device__ __forceinline__ bf16 f2bf(float f) { return (bf16)(cvt_pk_bf16(f, 0.f) & 0xffffu); }
__device__ __forceinline__ float sigmoidf_(float x) { return __builtin_amdgcn_rcpf(1.0f + __builtin_amdgcn_exp2f(-1.44269504f * x)); }
__device__ __forceinline__ float readlane_f(float v, int l) { return __int_as_float(__builtin_amdgcn_readlane(__float_as_int(v), l)); }
template <int CTRL, int RM = 0xf, bool BC = false>
__device__ __forceinline__ float dpp_get(float v) { return __uint_as_float(__builtin_amdgcn_update_dpp(0u, __float_as_uint(v), CTRL, RM, 0xf, BC)); }
__device__ __forceinline__ float sum_row16(float x) { x += dpp_get<0x128>(x); x += dpp_get<0x124>(x); x += dpp_get<0x122>(x); x += dpp_get<0x121>(x); return x; }
__device__ __forceinline__ float max_row16(float x) { x = fmaxf(x, dpp_get<0x128>(x)); x = fmaxf(x, dpp_get<0x124>(x)); x = fmaxf(x, dpp_get<0x122>(x)); x = fmaxf(x, dpp_get<0x121>(x)); return x; }
__device__ __forceinline__ float xsum16(float x) { const auto r = __builtin_amdgcn_permlane16_swap(__float_as_uint(x), __float_as_uint(x), false, false); return __uint_as_float(r[0]) + __uint_as_float(r[1]); }
__device__ __forceinline__ float xsum32(float x) { const auto r = __builtin_amdgcn_permlane32_swap(__float_as_uint(x), __float_as_uint(x), false, false); return __uint_as_float(r[0]) + __uint_as_float(r[1]); }
__device__ __forceinline__ float xmax16(float x) { const auto r = __builtin_amdgcn_permlane16_swap(__float_as_uint(x), __float_as_uint(x), false, false); return fmaxf(__uint_as_float(r[0]), __uint_as_float(r[1])); }
__device__ __forceinline__ float xmax32(float x) { const auto r = __builtin_amdgcn_permlane32_swap(__float_as_uint(x), __float_as_uint(x), false, false); return fmaxf(__uint_as_float(r[0]), __uint_as_float(r[1])); }
__device__ __forceinline__ float wave_sum(float v) { return xsum32(xsum16(sum_row16(v))); }
__device__ __forceinline__ float wave_max(float v) { return xmax32(xmax16(max_row16(v))); }
__device__ __forceinline__ float scan_incl64(float x) {
    x += dpp_get<0x111, 0xf, true>(x); x += dpp_get<0x112, 0xf, true>(x); x += dpp_get<0x114, 0xf, true>(x); x += dpp_get<0x118, 0xf, true>(x);
    x += dpp_get<0x142, 0xa>(x); x += dpp_get<0x143, 0xc>(x); return x;
}
__device__ __forceinline__ float max_grp8(float x) { x = fmaxf(x, dpp_get<0xB1>(x)); x = fmaxf(x, dpp_get<0x4E>(x)); x = fmaxf(x, dpp_get<0x141>(x)); return x; }

#define XB_TMO      128
#define XB_XCNT(j)  (256  + 64 * (j))
#define XB_XSUB(j)  (1280 + 64 * (j))
#define XB_XGEN(j)  (2304 + 64 * (j))
#define XB_TOP      3328
#define XB_TOPGEN   3392
#define XCD_BAR_WORDS 3456
#define XB_SPIN_CAP (1u << 22)
__device__ __forceinline__ unsigned xb_ld(unsigned* p)              { return __hip_atomic_load(p, __ATOMIC_RELAXED, __HIP_MEMORY_SCOPE_AGENT); }
__device__ __forceinline__ unsigned xb_add(unsigned* p, unsigned v) { return __hip_atomic_fetch_add(p, v, __ATOMIC_RELAXED, __HIP_MEMORY_SCOPE_AGENT); }
__device__ __forceinline__ unsigned xb_xcc_id() { return (unsigned)__builtin_amdgcn_s_getreg((3 << 11) | 20) & 0xFu; }
#define XB_SPIN(cond, bar) do { unsigned _sp = 0; while (cond) { __builtin_amdgcn_s_sleep(1); \
    if ((++_sp & 255u) == 0u) { if (xb_ld(&(bar)[XB_TMO])) break; if (_sp > XB_SPIN_CAP) { atomicAdd(&(bar)[XB_TMO], 1u); break; } } } } while (0)
struct XcdBarrier { unsigned* bar; unsigned x; volatile LAS unsigned* st; };
__device__ __forceinline__ XcdBarrier xcd_barrier_post(unsigned* bar, volatile LAS unsigned* st) {
    XcdBarrier b; b.bar = bar; b.x = xb_xcc_id(); b.st = st;
    if (threadIdx.x == 0) (void)xb_add(&bar[XB_XCNT(b.x)], 1u);
    return b;
}
__device__ __forceinline__ void xcd_barrier_complete(unsigned* bar, unsigned x, unsigned& nloc, unsigned& nx) {
    const unsigned G = gridDim.x * gridDim.y * gridDim.z;
    unsigned sum, cnt, mine, sp = 0u;
    for (;;) {
        sum = 0u; cnt = 0u; mine = 0u;
#pragma unroll
        for (unsigned j = 0; j < 16; ++j) { const unsigned c = xb_ld(&bar[XB_XCNT(j)]); sum += c; cnt += (c > 0u) ? 1u : 0u; mine = (j == x) ? c : mine; }
        if (sum == G) break;
        __builtin_amdgcn_s_sleep(1);
        if ((++sp & 255u) == 0u) { if (xb_ld(&bar[XB_TMO])) break; if (sp > XB_SPIN_CAP) { atomicAdd(&bar[XB_TMO], 1u); break; } }
    }
    nloc = mine > 0u ? mine : 1u; nx = cnt > 0u ? cnt : 1u;
}
__device__ __forceinline__ void xcd_barrier(const XcdBarrier& b, const int wave) {
    asm volatile("s_waitcnt vmcnt(0)" ::: "memory");
    __syncthreads();
    if (wave == 0 && lane_id_fresh() == 0) {
        unsigned* bar = b.bar;
        __builtin_amdgcn_s_waitcnt(0);
        unsigned nloc = b.st[0], nx = b.st[1];
        if (nloc == 0u) { xcd_barrier_complete(bar, b.x, nloc, nx); b.st[0] = nloc; b.st[1] = nx; }
        const unsigned old = xb_add(&bar[XB_XSUB(b.x)], 1u);
        const unsigned gen = old / nloc;
        if (old + 1u == (gen + 1u) * nloc) {
            __builtin_amdgcn_fence(__ATOMIC_RELEASE, "agent");
            asm volatile("s_waitcnt vmcnt(0)" ::: "memory");
            const unsigned og = xb_add(&bar[XB_TOP], 1u);
            const unsigned tg = og / nx;
            if (og + 1u == (tg + 1u) * nx) xb_add(&bar[XB_TOPGEN], 1u);
            else XB_SPIN(xb_ld(&bar[XB_TOPGEN]) == tg, bar);
            __builtin_amdgcn_fence(__ATOMIC_ACQUIRE, "agent");
            xb_add(&bar[XB_XGEN(b.x)], 1u);
            asm volatile("s_waitcnt vmcnt(0)" ::: "memory");
        } else {
            XB_SPIN(xb_ld(&bar[XB_XGEN(b.x)]) == gen, bar);
            __builtin_amdgcn_fence(__ATOMIC_ACQUIRE, "agent");
            asm volatile("s_waitcnt vmcnt(0)" ::: "memory");
        }
    }
    __syncthreads();
}

namespace pg8 {
constexpr int BM = 256, BK = 64, HALF = 128, HTB = HALF * BK * 2, NXCD = 8, WGM = 8;
__host__ __device__ __forceinline__ int lds_byte(int r, int c) { const int st = (r >> 4) * 2 + (c >> 5), rr = r & 15, cc = c & 31, ob = rr * 64 + cc * 2; return st * 1024 + (ob ^ (((ob >> 9) & 1) << 5)); }
__host__ __device__ __forceinline__ void stage_rc(int b, int& R, int& C) { const int st = b / 1024, sb = b % 1024, swz = sb ^ (((sb >> 9) & 1) << 5); R = (st >> 1) * 16 + swz / 64; C = (st & 1) * 32 + (swz % 64) / 2; }
__host__ __device__ __forceinline__ int perm32(int rho) { const int n = rho >> 4, i = rho & 15; return 8 * (i >> 2) + 4 * n + (i & 3); }

struct Unit { int pm, pn; const char* a; const char* b; int rows, seg, j, tb; };

struct StaticOrder {
    int nM, nN, nwg, G, c; const char* A; const char* Bt; size_t tstep;
    __device__ void init(const void* A_, const void* Bt_, int M, int N, int K, int G_, int c_) { A = (const char*)A_; Bt = (const char*)Bt_; nM = M / BM; nN = N / BM; nwg = nM * nN; G = G_; c = c_; tstep = (size_t)BM * K * 2; }
    __device__ bool next(int i, Unit& u) const {
        const long L = (long)i * G + c; if (L >= nwg) return false;
        int wgid = (int)L; { const int q = nwg / NXCD, r = nwg % NXCD, xcd = wgid % NXCD, off = wgid / NXCD; wgid = (xcd < r ? xcd * (q + 1) : r * (q + 1) + (xcd - r) * q) + off; }
        const int nig = WGM * nN, gid = wgid / nig, fm = gid * WGM, gsz = (nM - fm) < WGM ? (nM - fm) : WGM;
        u.pm = fm + ((wgid % nig) % gsz); u.pn = (wgid % nig) / gsz; u.a = A + (size_t)u.pm * tstep; u.b = Bt + (size_t)u.pn * tstep; u.rows = 256; u.seg = 0; u.j = 0; return true;
    }
    __device__ __forceinline__ const int* tab_src(const Unit&) const { return nullptr; }
};
struct MoeOrder {
    const LAS int* pre; const LAS int* cnt; int seg_lo, nseg, nN, G, c; const char* A; const char* Bt; size_t a_tstep, b_estride, b_tstep; const int* slot; bool gather; mutable int hint;
    __device__ bool next(int i, Unit& u) const {
        const long L = (long)i * G + c; const int b0 = __builtin_amdgcn_readfirstlane(pre[seg_lo]), total = __builtin_amdgcn_readfirstlane(pre[seg_lo + nseg]) - b0;
        const int br = (int)(L / nN); if (br >= total) return false;
        const int blk = b0 + br; u.pn = (int)(L % nN); u.pm = blk;
        int lo = hint < seg_lo ? seg_lo : hint;
        while (lo + 1 < seg_lo + nseg && __builtin_amdgcn_readfirstlane(pre[lo + 1]) <= blk) ++lo;
        hint = lo;
        u.seg = lo; u.j = blk - __builtin_amdgcn_readfirstlane(pre[lo]); const int rem = __builtin_amdgcn_readfirstlane(cnt[lo]) - u.j * 256; u.rows = rem < 256 ? rem : 256;
        const int e = lo % NSEGH;
        u.a = gather ? A : A + (size_t)blk * a_tstep; u.b = Bt + (size_t)e * b_estride + (size_t)u.pn * b_tstep; return true;
    }
    __device__ __forceinline__ const int* tab_src(const Unit& u) const { return slot + ((size_t)u.seg * SLOT_CAP + u.j * 256) * 2; }
};

template <class Epi, class Sched, bool GATHER, bool ROWTAB = GATHER, bool ALIGN_EPI = true>
__device__ __forceinline__ void gemm_phase(LAS unsigned char* lds, const int K, const Sched& S, const Epi& E, const int wave) {
    const int lane = lane_id_fresh(), wid = wave, tid = wid * 64 + lane, wr = wid >> 2, wc = wid & 3, fr = lane & 15, fq = lane >> 4; (void)fr; (void)fq;
    const int nt = K / BK;
    unsigned voffA[2][2], voffB[2];
#pragma unroll
    for (int i = 0; i < 2; ++i) { int R, C; stage_rc(tid * 16 + i * 8192, R, C); const int Rb = Epi::PERM ? ((R & ~31) + perm32(R & 31)) : R;
        voffB[i] = (unsigned)(tid * 16 + i * 8192); (void)Rb;
#pragma unroll
        for (int h = 0; h < 2; ++h) voffA[h][i] = (unsigned)(R * K + C) * 2u; }
    const size_t kstep = (size_t)(BK * 2);
    const size_t hstep = (size_t)HALF * K * 2;
    constexpr size_t hstepB = 16384, kstepB = 32768;
    const unsigned ldsw = (unsigned)wid * 1024u;
    const int aoff = lds_byte(wr * 64 + fr, fq * 8), boff = lds_byte(wc * 32 + fr, fq * 8);
    const LAS int* gtab = (const LAS int*)(lds + LDS_GTAB);
#define PG8_SA(b, h) (((b) * 2 + (h)) * HTB)
#define PG8_SB(b, h) ((4 + (b) * 2 + (h)) * HTB)
#define PG8_STAGE_A(bufoff, gbase, h) do { _Pragma("unroll") for (int _i = 0; _i < 2; ++_i) \
        __builtin_amdgcn_global_load_lds((const unsigned*)((const char*)(gbase) + (GATHER ? (size_t)0 : (size_t)(h) * hstep) + voffA[GATHER ? (h) : 0][_i]), (LAS unsigned*)(lds + (bufoff) + ldsw + _i * 8192), 16, 0, 0); } while (0)
#define PG8_STAGE_B(bufoff, gbase) do { _Pragma("unroll") for (int _i = 0; _i < 2; ++_i) \
        __builtin_amdgcn_global_load_lds((const unsigned*)((const char*)(gbase) + voffB[_i]), (LAS unsigned*)(lds + (bufoff) + ldsw + _i * 8192), 16, 0, 0); } while (0)
#define PG8_LDA(dst, b, h) do { _Pragma("unroll") for (int m = 0; m < 4; ++m) _Pragma("unroll") for (int k = 0; k < 2; ++k) dst[m][k] = *(const LAS bf16x8*)(lds + PG8_SA(b, h) + aoff + m * 2048 + k * 1024); } while (0)
#define PG8_LDB(dst, b, h) do { _Pragma("unroll") for (int n = 0; n < 2; ++n) _Pragma("unroll") for (int k = 0; k < 2; ++k) dst[n][k] = *(const LAS bf16x8*)(lds + PG8_SB(b, h) + boff + n * 2048 + k * 1024); } while (0)
#define PG8_MMA(ai, bj, At, Bt) do { __builtin_amdgcn_s_setprio(1); _Pragma("unroll") for (int m = 0; m < 4; ++m) _Pragma("unroll") for (int n = 0; n < 2; ++n) _Pragma("unroll") for (int k = 0; k < 2; ++k) \
        acc[ai][bj][m][n] = __builtin_amdgcn_mfma_f32_16x16x32_bf16(Bt[n][k], At[m][k], acc[ai][bj][m][n], 0, 0, 0); __builtin_amdgcn_s_setprio(0); } while (0)
#define PG8_WAIT_V(n) asm volatile("s_waitcnt vmcnt(" #n ")" ::: "memory")
#define PG8_WAIT_L(n) asm volatile("s_waitcnt lgkmcnt(" #n ")" ::: "memory")
#define PG8_BAR __builtin_amdgcn_s_barrier()
#define PG8_SCHED __builtin_amdgcn_sched_barrier(0)
#define PG8_GOFFS(u, tb) do { const int _tid = wid * 64 + lane_id_fresh(); _Pragma("unroll") for (int _h = 0; _h < 2; ++_h) _Pragma("unroll") for (int _i = 0; _i < 2; ++_i) { int _R, _C; stage_rc(_tid * 16 + _i * 8192, _R, _C); \
        const int _rr = _h * HALF + _R; const int _v = gtab[(tb) * 512 + 2 * _rr]; const unsigned _tok = (_rr < (u).rows) ? (unsigned)(_v >> 3) : 0u; voffA[_h][_i] = _tok * (unsigned)(K * 2) + (unsigned)(_C * 2); } } while (0)
#define PG8_GTAB_DMA(u, tb) do { __builtin_amdgcn_global_load_lds((const unsigned*)(S.tab_src(u) + wid * 64 + lane_id_fresh()), (LAS unsigned*)(lds + LDS_GTAB + (tb) * 2048 + wid * 256), 4, 0, 0); } while (0)
    Unit cur, nxt; int ui = 0;
    if (!S.next(0, cur)) return;
    f32x4 acc[2][2][4][2];
#pragma unroll
    for (int a = 0; a < 2; ++a)
#pragma unroll
        for (int b = 0; b < 2; ++b)
#pragma unroll
            for (int m = 0; m < 4; ++m)
#pragma unroll
                for (int n = 0; n < 2; ++n) acc[a][b][m][n] = (f32x4){0.f, 0.f, 0.f, 0.f};
    bf16x8 At[4][2], B0[2][2], B1[2][2];
    const char* cA = cur.a; const char* cB = cur.b;
    int tbi = 0; cur.tb = 0;
    if constexpr (ROWTAB) { PG8_GTAB_DMA(cur, 0); PG8_WAIT_V(0); PG8_BAR; }
    if constexpr (GATHER) { PG8_GOFFS(cur, 0); }
    PG8_STAGE_B(PG8_SB(0, 0), cB); PG8_STAGE_B(PG8_SB(0, 1), cB + hstepB); PG8_STAGE_A(PG8_SA(0, 0), cA, 0); PG8_STAGE_A(PG8_SA(0, 1), cA, 1);
    if (wr == 1) PG8_BAR;
    PG8_WAIT_V(2); PG8_BAR;
    PG8_STAGE_B(PG8_SB(1, 0), cB + kstepB); PG8_STAGE_A(PG8_SA(1, 0), cA + kstep, 0); PG8_STAGE_B(PG8_SB(1, 1), cB + hstepB + kstepB);
    PG8_WAIT_V(6); PG8_BAR;
    for (;;) {
        const bool has_next = S.next(ui + 1, nxt); const int tbn = tbi == 2 ? 0 : tbi + 1; nxt.tb = tbn;
        const char* nA = has_next ? nxt.a : cA; const char* nB = has_next ? nxt.b : cB;
        for (int t = 0; t < nt; t += 2) {
            const bool last = (t == nt - 2);
            const char* a1 = cA + (size_t)(t + 1) * kstep;
            const char* a2 = last ? nA : cA + (size_t)(t + 2) * kstep; const char* b2 = last ? nB : cB + (size_t)(t + 2) * kstepB;
            const char* a3 = a2 + kstep; const char* b3 = b2 + kstepB;
            if constexpr (Epi::HOOK) { if (t == Epi::HOOK_T1 || t == Epi::HOOK_T2) { if (wr == 0) PG8_BAR;
                const int l2 = lane_id_fresh(); E.hook(acc, cur, t, wr, wc, l2 & 15, l2 >> 4); if (wr == 1) PG8_BAR; } }
            if constexpr (ROWTAB) { if (t == 0 && has_next) PG8_GTAB_DMA(nxt, tbn); }
            PG8_LDB(B0, 0, 0); PG8_LDB(B1, 0, 1); PG8_SCHED; PG8_LDA(At, 0, 0); PG8_STAGE_A(PG8_SA(1, 1), a1, 1);
            PG8_WAIT_V(8); PG8_WAIT_L(0); PG8_BAR; PG8_MMA(0, 0, At, B0); PG8_MMA(0, 1, At, B1); PG8_BAR; PG8_SCHED;
            if constexpr (GATHER) { if (last && has_next) PG8_GOFFS(nxt, tbn); }
            PG8_LDA(At, 0, 1); PG8_STAGE_B(PG8_SB(0, 0), b2); PG8_STAGE_B(PG8_SB(0, 1), b2 + hstepB); PG8_STAGE_A(PG8_SA(0, 0), a2, 0);
            PG8_WAIT_V(8); PG8_WAIT_L(0); PG8_BAR; PG8_MMA(1, 0, At, B0); PG8_MMA(1, 1, At, B1); PG8_BAR; PG8_SCHED;
            PG8_LDB(B0, 1, 0); PG8_LDB(B1, 1, 1); PG8_SCHED; PG8_LDA(At, 1, 0); PG8_STAGE_A(PG8_SA(0, 1), a2, 1);
            PG8_WAIT_V(8); PG8_WAIT_L(0); PG8_BAR; PG8_MMA(0, 0, At, B0); PG8_MMA(0, 1, At, B1); PG8_BAR; PG8_SCHED;
            PG8_LDA(At, 1, 1); PG8_STAGE_B(PG8_SB(1, 0), b3); PG8_STAGE_B(PG8_SB(1, 1), b3 + hstepB); PG8_STAGE_A(PG8_SA(1, 0), a3, 0);
            PG8_WAIT_V(8); PG8_WAIT_L(0); PG8_BAR; PG8_MMA(1, 0, At, B0); PG8_MMA(1, 1, At, B1); PG8_BAR; PG8_SCHED;
        }
        if constexpr (ALIGN_EPI) { if (wr == 0) PG8_BAR; }
        { const int l2 = lane_id_fresh(); E(acc, cur, wr, wc, l2 & 15, l2 >> 4); }
        if (!has_next) break;
#pragma unroll
        for (int a = 0; a < 2; ++a)
#pragma unroll
            for (int b = 0; b < 2; ++b)
#pragma unroll
                for (int m = 0; m < 4; ++m)
#pragma unroll
                    for (int n = 0; n < 2; ++n) acc[a][b][m][n] = (f32x4){0.f, 0.f, 0.f, 0.f};
        cur = nxt; cA = nA; cB = nB; ++ui; tbi = tbn;
        if constexpr (ALIGN_EPI) { if (wr == 1) PG8_BAR; }
    }
    PG8_WAIT_V(0);
    if constexpr (!ALIGN_EPI) { if (wr == 0) PG8_BAR; }
    PG8_BAR;
#undef PG8_SA
#undef PG8_SB
#undef PG8_STAGE_A
#undef PG8_STAGE_B
#undef PG8_LDA
#undef PG8_LDB
#undef PG8_MMA
#undef PG8_WAIT_V
#undef PG8_WAIT_L
#undef PG8_BAR
#undef PG8_SCHED
#undef PG8_GOFFS
#undef PG8_GTAB_DMA
}

__device__ __forceinline__ void store_rows_paired(bf16* grp_base  , size_t ld, int fr, int fq, v4u w0, v4u w1) {
    v4u x, y;
    x.x = __builtin_amdgcn_update_dpp(0, (int)w1.x, 0x118, 0xf, 0xf, false); x.y = __builtin_amdgcn_update_dpp(0, (int)w1.y, 0x118, 0xf, 0xf, false);
    x.z = __builtin_amdgcn_update_dpp(0, (int)w1.z, 0x118, 0xf, 0xf, false); x.w = __builtin_amdgcn_update_dpp(0, (int)w1.w, 0x118, 0xf, 0xf, false);
    y.x = __builtin_amdgcn_update_dpp(0, (int)w0.x, 0x108, 0xf, 0xf, false); y.y = __builtin_amdgcn_update_dpp(0, (int)w0.y, 0x108, 0xf, 0xf, false);
    y.z = __builtin_amdgcn_update_dpp(0, (int)w0.z, 0x108, 0xf, 0xf, false); y.w = __builtin_amdgcn_update_dpp(0, (int)w0.w, 0x108, 0xf, 0xf, false);
    const bool lo = fr < 8; const int r7 = fr & 7;
    const v4u d1 = lo ? w0 : x, d2 = lo ? y : w1;
    bf16* p1 = grp_base + (size_t)r7 * ld + (lo ? 0 : 32) + 8 * fq;
    *(v4u*)p1 = d1; *(v4u*)(p1 + 8 * ld) = d2;
}
typedef f32x4 Acc[2][2][4][2];
struct EpiProj {
    static constexpr bool PERM = true, HOOK = false; static constexpr int HOOK_T1 = -1, HOOK_T2 = -1;
    __device__ __forceinline__ void hook(Acc&, const Unit&, int, int, int, int, int) const {}
    bf16 *PA, *PB, *PC; unsigned char* PG; const float *qna, *kna, *qnc;
    __device__ __forceinline__ void operator()(const Acc& acc, const Unit& u, int wr, int wc, int fr, int fq) const {
        const int f0 = u.pn * 256 + wc * 64;
        if (f0 >= NPROJ) return;
        bf16* base; int ld, c0, op; const float* gain = qna; float scale = 1.f;
        if (f0 < 1152) { base = PA; ld = LD_PA; c0 = f0; if (f0 < 384) { op = 1; gain = qna; scale = 0.125f; } else if (f0 < 768) { op = 1; gain = kna; } else op = 0; }
        else if (f0 < 2432) { base = PB; ld = LD_PB; c0 = f0 - 1152; if (c0 < 256) { op = 2; scale = 0.125f; } else if (c0 < 896) op = 0; else op = 2; }
        else if (f0 < 2688) { base = PC; ld = LD_PC; c0 = f0 - 2432; op = 1; gain = qnc; scale = 0.125f; }
        else { base = PA; ld = LD_PG; c0 = f0 - 2688; op = 3; }
        f32x4 g[2][2];
        if (op == 1) {
#pragma unroll
            for (int bj = 0; bj < 2; ++bj)
#pragma unroll
                for (int n = 0; n < 2; ++n) g[bj][n] = *(const f32x4*)(gain + 32 * bj + 8 * fq + 4 * n);
#pragma unroll
            for (int bj = 0; bj < 2; ++bj)
#pragma unroll
                for (int n = 0; n < 2; ++n) g[bj][n] = g[bj][n] * scale;
        } else {
#pragma unroll
            for (int bj = 0; bj < 2; ++bj)
#pragma unroll
                for (int n = 0; n < 2; ++n) g[bj][n] = (f32x4){scale, scale, scale, scale};
        }
#pragma unroll
        for (int ai = 0; ai < 2; ++ai)
#pragma unroll
            for (int m = 0; m < 4; ++m) {
                const int row = u.pm * BM + ai * HALF + wr * 64 + m * 16 + fr;
                f32x4 v[2][2];
#pragma unroll
                for (int bj = 0; bj < 2; ++bj)
#pragma unroll
                    for (int n = 0; n < 2; ++n) v[bj][n] = acc[ai][bj][m][n];
                if (op == 1) {
                    float ss = 0.f;
#pragma unroll
                    for (int bj = 0; bj < 2; ++bj)
#pragma unroll
                        for (int n = 0; n < 2; ++n) ss += (v[bj][n][0] * v[bj][n][0] + v[bj][n][1] * v[bj][n][1]) + (v[bj][n][2] * v[bj][n][2] + v[bj][n][3] * v[bj][n][3]);
                    ss = xsum32(xsum16(ss));
                    const float r = rsqrtf(ss * (1.0f / 64.0f) + EPS);
#pragma unroll
                    for (int bj = 0; bj < 2; ++bj)
#pragma unroll
                        for (int n = 0; n < 2; ++n) v[bj][n] = v[bj][n] * r * g[bj][n];
                } else if (op == 2) {
#pragma unroll
                    for (int bj = 0; bj < 2; ++bj)
#pragma unroll
                        for (int n = 0; n < 2; ++n)
#pragma unroll
                            for (int j = 0; j < 4; ++j) v[bj][n][j] = v[bj][n][j] * sigmoidf_(v[bj][n][j]) * scale;
                } else if (op == 3) {
                    unsigned q[4];
#pragma unroll
                    for (int bj = 0; bj < 2; ++bj)
#pragma unroll
                        for (int n = 0; n < 2; ++n) { unsigned pk = 0u;
#pragma unroll
                            for (int j = 0; j < 4; ++j) pk |= (unsigned)__builtin_amdgcn_fmed3f(sigmoidf_(v[bj][n][j]) * 255.f + 0.5f, 1.0f, 255.0f) << (8 * j);
                            q[2 * bj + n] = pk; }
                    *(v4u*)(PG + (size_t)row * LD_PG + c0 + 16 * fq) = (v4u){q[0], q[1], q[2], q[3]};
                    continue;
                }
                v4u w[2];
#pragma unroll
                for (int bj = 0; bj < 2; ++bj) { w[bj].x = cvt_pk_bf16(v[bj][0][0], v[bj][0][1]); w[bj].y = cvt_pk_bf16(v[bj][0][2], v[bj][0][3]); w[bj].z = cvt_pk_bf16(v[bj][1][0], v[bj][1][1]); w[bj].w = cvt_pk_bf16(v[bj][1][2], v[bj][1][3]); }
                store_rows_paired(base + (size_t)(row - fr) * ld + c0, (size_t)ld, fr, fq, w[0], w[1]);
            }
    }
};
struct EpiMemKV {
    static constexpr bool PERM = true, HOOK = false; static constexpr int HOOK_T1 = -1, HOOK_T2 = -1;
    __device__ __forceinline__ void hook(Acc&, const Unit&, int, int, int, int, int) const {}
    bf16 *MK, *MV; const float* knc;
    __device__ __forceinline__ void operator()(const Acc& acc, const Unit& u, int wr, int wc, int fr, int fq) const {
        bf16* base = u.pn == 0 ? MK : MV; const bool nrm = (u.pn == 0);
        f32x4 g[2][2];
#pragma unroll
        for (int bj = 0; bj < 2; ++bj)
#pragma unroll
            for (int n = 0; n < 2; ++n) g[bj][n] = *(const f32x4*)(knc + 32 * bj + 8 * fq + 4 * n);
#pragma unroll
        for (int ai = 0; ai < 2; ++ai)
#pragma unroll
            for (int m = 0; m < 4; ++m) {
                const int row = u.pm * BM + ai * HALF + wr * 64 + m * 16 + fr;
                f32x4 v[2][2];
#pragma unroll
                for (int bj = 0; bj < 2; ++bj)
#pragma unroll
                    for (int n = 0; n < 2; ++n) v[bj][n] = acc[ai][bj][m][n];
                if (nrm) {
                    float ss = 0.f;
#pragma unroll
                    for (int bj = 0; bj < 2; ++bj)
#pragma unroll
                        for (int n = 0; n < 2; ++n) ss += (v[bj][n][0] * v[bj][n][0] + v[bj][n][1] * v[bj][n][1]) + (v[bj][n][2] * v[bj][n][2] + v[bj][n][3] * v[bj][n][3]);
                    ss = xsum32(xsum16(ss));
                    const float r = rsqrtf(ss * (1.0f / 64.0f) + EPS);
#pragma unroll
                    for (int bj = 0; bj < 2; ++bj)
#pragma unroll
                        for (int n = 0; n < 2; ++n) v[bj][n] = v[bj][n] * r * g[bj][n];
                }
                bf16* rowp = base + (size_t)row * 256 + wc * 64 + 8 * fq;
#pragma unroll
                for (int bj = 0; bj < 2; ++bj) { v4u w; w.x = cvt_pk_bf16(v[bj][0][0], v[bj][0][1]); w.y = cvt_pk_bf16(v[bj][0][2], v[bj][0][3]); w.z = cvt_pk_bf16(v[bj][1][0], v[bj][1][1]); w.w = cvt_pk_bf16(v[bj][1][2], v[bj][1][3]);
                    *(v4u*)(rowp + 32 * bj) = w; }
            }
    }
};
struct EpiMerge {
    static constexpr bool PERM = true, HOOK = true; static constexpr int HOOK_T1 = 6, HOOK_T2 = 12;
    const unsigned char* PG; bf16* MX;
    __device__ __forceinline__ void hook(Acc& acc, const Unit& u, int t, int wr, int wc, int fr, int fq) const {
        const int bn = (t == HOOK_T1) ? 0 : 1024;
        v4u nu[2][4], de[2][4];
#pragma unroll
        for (int ai = 0; ai < 2; ++ai)
#pragma unroll
            for (int m = 0; m < 4; ++m) {
                const unsigned char* gp = PG + (size_t)(u.pm * BM + ai * HALF + wr * 64 + m * 16 + fr) * LD_PG + bn + u.pn * BM + wc * 64 + 16 * fq;
                nu[ai][m] = *(const v4u*)gp; de[ai][m] = *(const v4u*)(gp + 1024);
            }
#pragma unroll
        for (int ai = 0; ai < 2; ++ai) {
#pragma unroll
            for (int m = 0; m < 4; ++m) {
                const unsigned na[4] = {nu[ai][m].x, nu[ai][m].y, nu[ai][m].z, nu[ai][m].w}, da[4] = {de[ai][m].x, de[ai][m].y, de[ai][m].z, de[ai][m].w};
#pragma unroll
                for (int bj = 0; bj < 2; ++bj)
#pragma unroll
                    for (int n = 0; n < 2; ++n)
#pragma unroll
                        for (int j = 0; j < 4; ++j) acc[ai][bj][m][n][j] *= (float)((na[2 * bj + n] >> (8 * j)) & 0xffu) * __builtin_amdgcn_rcpf((float)((da[2 * bj + n] >> (8 * j)) & 0xffu));
            }
            asm volatile("" ::: "memory");
        }
    }
    __device__ __forceinline__ void operator()(const Acc& acc, const Unit& u, int wr, int wc, int fr, int fq) const {
        v4u gq[2][4];
#pragma unroll
        for (int ai = 0; ai < 2; ++ai)
#pragma unroll
            for (int m = 0; m < 4; ++m) gq[ai][m] = *(const v4u*)(PG + (size_t)(u.pm * BM + ai * HALF + wr * 64 + m * 16 + fr) * LD_PG + 2048 + u.pn * BM + wc * 64 + 16 * fq);
#pragma unroll
        for (int ai = 0; ai < 2; ++ai)
#pragma unroll
            for (int m = 0; m < 4; ++m) {
                const int row = u.pm * BM + ai * HALF + wr * 64 + m * 16 + fr;
                const unsigned ga[4] = {gq[ai][m].x, gq[ai][m].y, gq[ai][m].z, gq[ai][m].w};
#pragma unroll
                for (int bj = 0; bj < 2; ++bj) {
                    const int c = u.pn * BM + wc * 64 + bj * 32 + 8 * fq;
                    float o[8];
#pragma unroll
                    for (int n = 0; n < 2; ++n)
#pragma unroll
                        for (int j = 0; j < 4; ++j) o[4 * n + j] = acc[ai][bj][m][n][j] * ((float)((ga[2 * bj + n] >> (8 * j)) & 0xffu) * (1.f / 255.f));
                    v4u w; w.x = cvt_pk_bf16(o[0], o[1]); w.y = cvt_pk_bf16(o[2], o[3]); w.z = cvt_pk_bf16(o[4], o[5]); w.w = cvt_pk_bf16(o[6], o[7]);
                    *(v4u*)(MX + (size_t)row * 1024 + c) = w;
                }
                asm volatile("" ::: "memory");
            }
    }
};
struct EpiOut {
    static constexpr bool PERM = true, HOOK = false; static constexpr int HOOK_T1 = -1, HOOK_T2 = -1;
    __device__ __forceinline__ void hook(Acc&, const Unit&, int, int, int, int, int) const {}
    const float* X; bf16* X1;
    __device__ __forceinline__ void operator()(const Acc& acc, const Unit& u, int wr, int wc, int fr, int fq) const {
#pragma unroll
        for (int ai = 0; ai < 2; ++ai) {
            f32x4 xv[4][2][2];
#pragma unroll
            for (int m = 0; m < 4; ++m) { const size_t row = (size_t)(u.pm * BM + ai * HALF + wr * 64 + m * 16 + fr); const int c0 = u.pn * BM + wc * 64 + 8 * fq;
#pragma unroll
                for (int bj = 0; bj < 2; ++bj) { xv[m][bj][0] = *(const f32x4*)(X + row * 1024 + c0 + 32 * bj); xv[m][bj][1] = *(const f32x4*)(X + row * 1024 + c0 + 32 * bj + 4); } }
            asm volatile("" ::: "memory");
#pragma unroll
            for (int m = 0; m < 4; ++m) { const size_t row = (size_t)(u.pm * BM + ai * HALF + wr * 64 + m * 16 + fr); const int c0 = u.pn * BM + wc * 64 + 8 * fq;
                bf16* xr = X1 + x1_off(row);
#pragma unroll
                for (int bj = 0; bj < 2; ++bj) { const f32x4 a0 = xv[m][bj][0] + acc[ai][bj][m][0], a1 = xv[m][bj][1] + acc[ai][bj][m][1];
                    v4u w; w.x = cvt_pk_bf16(a0[0], a0[1]); w.y = cvt_pk_bf16(a0[2], a0[3]); w.z = cvt_pk_bf16(a1[0], a1[1]); w.w = cvt_pk_bf16(a1[2], a1[3]);
                    *(v4u*)(xr + c0 + 32 * bj) = w; } }
            asm volatile("" ::: "memory");
        }
    }
};
struct EpiUp {
    static constexpr bool PERM = true, HOOK = false; static constexpr int HOOK_T1 = -1, HOOK_T2 = -1;
    __device__ __forceinline__ void hook(Acc&, const Unit&, int, int, int, int, int) const {}
    bf16* HID;
    __device__ __forceinline__ void operator()(const Acc& acc, const Unit& u, int wr, int wc, int fr, int fq) const {
#pragma unroll
        for (int ai = 0; ai < 2; ++ai)
#pragma unroll
            for (int m = 0; m < 4; ++m) {
                const size_t row = (size_t)u.pm * BM + ai * HALF + wr * 64 + m * 16 + fr;
                float o[8];
#pragma unroll
                for (int n = 0; n < 2; ++n)
#pragma unroll
                    for (int j = 0; j < 4; ++j) { const float gt = acc[ai][0][m][n][j], up = acc[ai][1][m][n][j]; o[4 * n + j] = gt * sigmoidf_(gt) * up; }
                v4u w; w.x = cvt_pk_bf16(o[0], o[1]); w.y = cvt_pk_bf16(o[2], o[3]); w.z = cvt_pk_bf16(o[4], o[5]); w.w = cvt_pk_bf16(o[6], o[7]);
                *(v4u*)(HID + row * 256 + u.pn * 128 + wc * 32 + 8 * fq) = w;
            }
    }
};
struct EpiDown {
    static constexpr bool PERM = true, HOOK = false; static constexpr int HOOK_T1 = -1, HOOK_T2 = -1;
    __device__ __forceinline__ void hook(Acc&, const Unit&, int, int, int, int, int) const {}
    LAS unsigned char* lds; unsigned char* YB; unsigned char* SHB; int probe;
    __device__ __forceinline__ void operator()(const Acc& acc, const Unit& u, int wr, int wc, int fr, int fq) const {
        const int e = u.seg % NSEGH;
        const LAS v2u* tab = (const LAS v2u*)(lds + LDS_GTAB + u.tb * 2048);
        v2u ents[2][4];
#pragma unroll
        for (int ai = 0; ai < 2; ++ai)
#pragma unroll
            for (int m = 0; m < 4; ++m) ents[ai][m] = tab[ai * HALF + wr * 64 + m * 16 + fr];
#pragma unroll
        for (int ai = 0; ai < 2; ++ai)
#pragma unroll
            for (int m = 0; m < 4; ++m) {
                const int r = ai * HALF + wr * 64 + m * 16 + fr;
                if (r < u.rows && probe != -2) {
                    const v2u ent = ents[ai][m]; const int flat = (int)ent.x; const float w = __uint_as_float(ent.y) * Y8_SCALE;
                    unsigned char* rowp = (e < NEXP ? YB + (size_t)u.pn * ((size_t)T * 8 * 256) + (size_t)flat * 256 : SHB + (size_t)u.pn * ((size_t)T * 256) + (size_t)(flat >> 3) * 256) + wc * 64 + 16 * fq;
                    v4u o; unsigned ow[4];
#pragma unroll
                    for (int bj = 0; bj < 2; ++bj)
#pragma unroll
                        for (int n = 0; n < 2; ++n) { f32x4 a = acc[ai][bj][m][n] * w;
#pragma unroll
                            for (int j = 0; j < 4; ++j) a[j] = __builtin_amdgcn_fmed3f(a[j], -440.f, 440.f);
                            int p = __builtin_amdgcn_cvt_pk_fp8_f32(a[0], a[1], 0, false); p = __builtin_amdgcn_cvt_pk_fp8_f32(a[2], a[3], p, true); ow[2 * bj + n] = (unsigned)p; }
                    o.x = ow[0]; o.y = ow[1]; o.z = ow[2]; o.w = ow[3];
                    *(v4u*)rowp = o;
                }
            }
    }
};
}

__device__ __forceinline__ const float* arg_in(int i) {
    const __attribute__((address_space(4))) char* kp = (const __attribute__((address_space(4))) char*)__builtin_amdgcn_kernarg_segment_ptr();
    asm volatile("" : "+s"(kp));
    return *(const float* const __attribute__((address_space(4)))*)(kp + 8 * i);
}
struct Frame {
    LAS unsigned char* lds;
    int wave, vcu, G;
    unsigned char* ws; unsigned char* dout;
};
enum { I_X = 0, I_MEM, I_ANG, I_WIN, I_QNA, I_KNA, I_RELB, I_LBL, I_ONB, I_MNG, I_WMKV, I_QNC, I_KNC, I_WBA, I_WBB, I_WBC, I_WOUT, I_FNG, I_WR, I_RB, I_WEU, I_WED, I_WSU, I_WSD };

#ifndef STAGGER
#define STAGGER 0
#endif
__device__ __forceinline__ void stagger(const Frame& F, unsigned ticks_per_group) {
    if (!STAGGER) return;
    const unsigned long long t0 = __builtin_amdgcn_s_memrealtime(); const unsigned long long want = (unsigned long long)((unsigned)F.vcu & 7u) * ticks_per_group;
    while (__builtin_amdgcn_s_memrealtime() - t0 < want) __builtin_amdgcn_s_sleep(8);
}
__device__ __forceinline__ size_t bt_tiled_off(int n, int k, int K, bool perm) {
    const int pn = n >> 8, rho = n & 255, h = rho >> 7, r = rho & 127;
    const int x = r & 31; const int R = perm ? ((r & ~31) + 16 * ((x >> 2) & 1) + 4 * (x >> 3) + (x & 3)) : r;
    const int kt = k >> 6, C = k & 63;
    return ((size_t)((pn * (K >> 6) + kt) * 2 + h) * 16384 + (size_t)pg8::lds_byte(R, C)) >> 1;
}
__device__ __forceinline__ void tr_item(const float* W, int ldw, int k0s, int n0s, bf16* WT, int K, int n0d, int k0d, bool perm, LAS float* scr, int lane, const bool spread = false) {
    const int r8 = lane >> 3, c4 = lane & 7, n4 = 4 * c4, sc = spread ? 16 * (n4 >> 3) + (n4 & 7) : n4;
    f32x4 v[8];
#pragma unroll
    for (int i = 0; i < 8; ++i) v[i] = (n0s >= 0) ? *(const f32x4*)(W + (size_t)(k0s + 8 * i + r8) * ldw + n0s + sc) : (f32x4){0.f, 0.f, 0.f, 0.f};
#pragma unroll
    for (int i = 0; i < 8; ++i)
#pragma unroll
        for (int e = 0; e < 4; ++e) scr[(8 * i + r8) * 33 + n4 + e] = v[i][e];
    LDS_WAIT(); asm volatile("" ::: "memory");
    const int c = lane & 7;
#pragma unroll
    for (int j = 0; j < 4; ++j) { const int n = (lane >> 3) + 8 * j; const LAS float* s = scr + (8 * c) * 33 + n;
        v4u o; o.x = cvt_pk_bf16(s[0 * 33], s[1 * 33]); o.y = cvt_pk_bf16(s[2 * 33], s[3 * 33]); o.z = cvt_pk_bf16(s[4 * 33], s[5 * 33]); o.w = cvt_pk_bf16(s[6 * 33], s[7 * 33]);
        *(v4u*)(WT + bt_tiled_off(n0d + n, k0d + 8 * c, K, perm)) = o; }
    LDS_WAIT(); asm volatile("" ::: "memory");
}
__device__ __forceinline__ void rms_rows_to_bf16(const float* X, const float* g, bf16* O, int nrows, int gw, int NGW, int lane) {
    f32x4 gg[4];
#pragma unroll
    for (int j = 0; j < 4; ++j) gg[j] = ((const f32x4*)g + lane)[64 * j];
    for (int m = gw; m < nrows; m += 2 * NGW) {
        const int m1 = m + NGW; const bool has1 = m1 < nrows;
        const f32x4* x0 = (const f32x4*)(X + (size_t)m * D) + lane; const f32x4* x1 = (const f32x4*)(X + (size_t)(has1 ? m1 : m) * D) + lane;
        f32x4 v0[4], v1[4];
#pragma unroll
        for (int j = 0; j < 4; ++j) v0[j] = x0[64 * j];
#pragma unroll
        for (int j = 0; j < 4; ++j) v1[j] = x1[64 * j];
        float s0 = 0.f, s1 = 0.f;
#pragma unroll
        for (int j = 0; j < 4; ++j) { s0 += (v0[j][0] * v0[j][0] + v0[j][1] * v0[j][1]) + (v0[j][2] * v0[j][2] + v0[j][3] * v0[j][3]); s1 += (v1[j][0] * v1[j][0] + v1[j][1] * v1[j][1]) + (v1[j][2] * v1[j][2] + v1[j][3] * v1[j][3]); }
        const float r0 = rsqrtf(wave_sum(s0) * (1.f / D) + EPS), r1 = rsqrtf(wave_sum(s1) * (1.f / D) + EPS);
        v2u* o0 = (v2u*)(O + (size_t)m * D) + lane; v2u* o1 = (v2u*)(O + (size_t)m1 * D) + lane;
#pragma unroll
        for (int j = 0; j < 4; ++j) { v2u w; w.x = cvt_pk_bf16(v0[j][0] * r0 * gg[j][0], v0[j][1] * r0 * gg[j][1]); w.y = cvt_pk_bf16(v0[j][2] * r0 * gg[j][2], v0[j][3] * r0 * gg[j][3]); o0[64 * j] = w; }
        if (has1) {
#pragma unroll
            for (int j = 0; j < 4; ++j) { v2u w; w.x = cvt_pk_bf16(v1[j][0] * r1 * gg[j][0], v1[j][1] * r1 * gg[j][1]); w.y = cvt_pk_bf16(v1[j][2] * r1 * gg[j][2], v1[j][3] * r1 * gg[j][3]); o1[64 * j] = w; } }
    }
}
__device__ __forceinline__ int t5_bucket(int dist) {
    if (dist < 16) return dist;
    const int large = 16 + (int)(logf((float)dist / 16.0f) / 4.852030263919617f * 16.0f);
    return large < 31 ? large : 31;
}
constexpr int CV_I0 = 16 * 184, CV_I1 = 16 * 16, CV_I2 = 6 * 32, CV_I3 = 6 * 32, CV_I4 = 4 * 32, CV_I5 = 16 * 32, CV_I6 = 65 * 256, CV_I7 = 65 * 128;
constexpr int CV_EARLY = CV_I0 + CV_I1 + CV_I2 + CV_I3 + CV_I4 + CV_I5, CV_ALL = CV_EARLY + CV_I6 + CV_I7;
__device__ __forceinline__ void conv_item(Frame& F, int it, LAS float* scr, int lane) {
    constexpr int I0 = CV_I0, I1 = CV_I1, I2 = CV_I2, I3 = CV_I3, I4 = CV_I4, I5 = CV_I5, I6 = CV_I6;
    do {
        int r = it;
        if (r < I0 + I1) {
            const bool first = r < I0; if (!first) r -= I0;
            const int nblk = first ? 184 : 16, nsrc = first ? NPROJ : 512;
            const int kb = r / nblk, nbd = r % nblk, tile = nbd >> 3, within = nbd & 7, bj = within >> 2, wc = within & 3;
            const int srcb = tile * 8 + 2 * wc + bj;
            const int n0s = (srcb * 32 < nsrc) ? srcb * 32 : -1;
            tr_item(first ? arg_in(I_WIN) : arg_in(I_WMKV), nsrc, kb * 64, n0s, (bf16*)(F.ws + (first ? WS_WIN : WS_WMEM)), 1024, nbd * 32, kb * 64, true, scr, lane);
            break;
        }
        r -= I0 + I1;
#define HG_SRC(nb) ((((nb) >> 3) * 8 + 2 * ((nb) & 3) + (((nb) & 7) >> 2)) * 32)
        if (r < I2) { tr_item(arg_in(I_WBA), 1024, (r / 32) * 64, HG_SRC(r % 32), (bf16*)(F.ws + WS_WA), 1024, (r % 32) * 32, YC_A + (r / 32) * 64, true, scr, lane); break; } r -= I2;
        if (r < I3) { tr_item(arg_in(I_WBB), 1024, (r / 32) * 64, HG_SRC(r % 32), (bf16*)(F.ws + WS_WA), 1024, (r % 32) * 32, YC_B + (r / 32) * 64, true, scr, lane); break; } r -= I3;
        if (r < I4) { tr_item(arg_in(I_WBC), 1024, (r / 32) * 64, HG_SRC(r % 32), (bf16*)(F.ws + WS_WA), 1024, (r % 32) * 32, YC_C + (r / 32) * 64, true, scr, lane); break; } r -= I4;
        if (r < I5) { tr_item(arg_in(I_WOUT), 1024, (r / 32) * 64, HG_SRC(r % 32), (bf16*)(F.ws + WS_WOUT), 1024, (r % 32) * 32, (r / 32) * 64, true, scr, lane); break; } r -= I5;
        if (r < I6) {
            const int e = r / 256, q = r % 256, kb = q / 16, nbd = q % 16, pn = nbd >> 3, within = nbd & 7, bj = within >> 2, qq = within & 3;
            const int srcb = bj * 8 + pn * 4 + qq;
            const float* W = (e < 64) ? arg_in(I_WEU) + (size_t)e * 1024 * 512 : arg_in(I_WSU);
            tr_item(W, 512, kb * 64, srcb * 32, (bf16*)(F.ws + WS_WUP) + (size_t)e * 512 * 1024, 1024, nbd * 32, kb * 64, true, scr, lane);
            break;
        }
        r -= I6;
        {   const int e = r / 128, q = r % 128, kb = q / 32, nb = q % 32;
            const float* W = (e < 64) ? arg_in(I_WED) + (size_t)e * 256 * 1024 : arg_in(I_WSD);
            tr_item(W, 1024, kb * 64, (nb >> 3) * 256 + 64 * (nb & 3) + 8 * ((nb & 7) >> 2), (bf16*)(F.ws + WS_WDN) + (size_t)e * 1024 * 256, 256, nb * 32, kb * 64, true, scr, lane, true); }
    } while (0);
}
__device__ __forceinline__ void p0_prologue(Frame& F) {
    const int lane = lane_id_fresh(); const int tid = F.wave * 64 + lane; (void)tid;
    LAS float* scr = (LAS float*)(F.lds + F.wave * 16384);
    const int gw = F.vcu * 8 + F.wave, NGW = F.G * 8;
    for (int it = gw; it < CV_EARLY; it += NGW) conv_item(F, it, scr, lane);
    rms_rows_to_bf16(arg_in(I_X), arg_in(I_ANG), (bf16*)F.dout, T, gw, NGW, lane);
    rms_rows_to_bf16(arg_in(I_MEM), arg_in(I_MNG), (bf16*)(F.ws + WS_MEMN), NB * MEML, gw, NGW, lane);
    for (int i = F.vcu * 512 + tid; i < 64 * 1024; i += F.G * 512) {
        const int j = i & 7, ln = (i >> 3) & 63, ks = (i >> 9) & 31, et = i >> 14; const int e = 16 * et + (ln & 15), k = 32 * ks + 8 * (ln >> 4) + j; const float w = arg_in(I_WR)[(size_t)k * 64 + e];
        const unsigned hi = cvt_pk_bf16(w, 0.f) & 0xffffu; const float lo = w - __uint_as_float(hi << 16);
        ((bf16*)(F.ws + WS_TAB + 65536))[i] = (bf16)hi; ((bf16*)(F.ws + WS_TAB + 65536))[65536 + i] = f2bf(lo); }
    if (F.vcu == 0) {
        float* tab = (float*)(F.ws + WS_TAB);
        for (int i = tid; i < 3 * 129 * 6; i += 512) { const int h = i % 6, st = (i / 6) % 129, p = i / (6 * 129); tab[i] = arg_in(I_RELB)[t5_bucket(st << (2 * p)) * 6 + h]; }
        if (tid < 256) { const float a0 = arg_in(I_LBL)[tid], a1 = arg_in(I_LBL)[256 + tid]; tab[4096 + tid] = 1.0f / (1.0f + __expf(a1 - a0)); }
    }
}

template <int NR, class EntF>
__device__ __forceinline__ void attn_wave_simple(const bf16* qrow, const char* KB, const char* VB, const EntF& ent, bf16* orow, LAS float* wscr, int lane) {
    float q[64];
    { const v4u* qp = (const v4u*)qrow;
#pragma unroll
      for (int i = 0; i < 8; ++i) { const v4u w = qp[i]; q[8 * i + 0] = bf_lo(w.x); q[8 * i + 1] = bf_hi(w.x); q[8 * i + 2] = bf_lo(w.y); q[8 * i + 3] = bf_hi(w.y); q[8 * i + 4] = bf_lo(w.z); q[8 * i + 5] = bf_hi(w.z); q[8 * i + 6] = bf_lo(w.w); q[8 * i + 7] = bf_hi(w.w); } }
    float mx = -3.0e38f;
    LAS unsigned* vscr = (LAS unsigned*)(wscr + NR * 64);
#pragma unroll 1
    for (int r = 0; r < NR; ++r) {
        unsigned koff = 0, voff = 0; float bias = 0.f;
        const bool valid = ent(r * 64 + lane, koff, voff, bias);
        const v4u* kp = (const v4u*)(KB + koff);
        float d0 = 0.f, d1 = 0.f;
#pragma unroll
        for (int i = 0; i < 8; ++i) { const v4u w = kp[i];
            d0 += q[8 * i + 0] * bf_lo(w.x) + q[8 * i + 2] * bf_lo(w.y) + q[8 * i + 4] * bf_lo(w.z) + q[8 * i + 6] * bf_lo(w.w);
            d1 += q[8 * i + 1] * bf_hi(w.x) + q[8 * i + 3] * bf_hi(w.y) + q[8 * i + 5] * bf_hi(w.z) + q[8 * i + 7] * bf_hi(w.w); }
        const float sv = valid ? (d0 + d1 + bias) : -3.0e38f; wscr[r * 64 + lane] = sv; vscr[r * 64 + lane] = voff; mx = fmaxf(mx, sv);
    }
    mx = wave_max(mx);
    float l = 0.f;
#pragma unroll 1
    for (int r = 0; r < NR; ++r) { const float sv = wscr[r * 64 + lane]; const float p = (sv > -1.0e38f) ? __expf(sv - mx) : 0.f; l += p; wscr[r * 64 + lane] = p; }
    l = wave_sum(l);
    LDS_WAIT(); asm volatile("" ::: "memory");
    const int sub = lane >> 4, dg = lane & 15;
    float o0 = 0.f, o1 = 0.f, o2 = 0.f, o3 = 0.f;
    for (int i = 0; i < NR * 16; ++i) {
        const int e = 4 * i + sub; const float p = wscr[e]; const unsigned voff = vscr[e];
        const v2u w = *(const v2u*)(VB + voff + dg * 8);
        o0 += p * bf_lo(w.x); o1 += p * bf_hi(w.x); o2 += p * bf_lo(w.y); o3 += p * bf_hi(w.y);
    }
    o0 += __shfl_xor(o0, 16); o1 += __shfl_xor(o1, 16); o2 += __shfl_xor(o2, 16); o3 += __shfl_xor(o3, 16);
    o0 += __shfl_xor(o0, 32); o1 += __shfl_xor(o1, 32); o2 += __shfl_xor(o2, 32); o3 += __shfl_xor(o3, 32);
    const float inv = 1.0f / l;
    if (lane < 16) { v2u w; w.x = cvt_pk_bf16(o0 * inv, o1 * inv); w.y = cvt_pk_bf16(o2 * inv, o3 * inv); *(v2u*)(orow + dg * 4) = w; }
    LDS_WAIT(); asm volatile("" ::: "memory");
}
struct EntA {
    int pos, h; unsigned rowbase; const float* btab;
    __device__ __forceinline__ bool operator()(int e, unsigned& koff, unsigned& voff, float& bias) const {
        const int p = e / 129, st = e - p * 129; const int kt = pos - (st << (2 * p));
        const bool valid = (e < 387) && (kt >= 0);
        const unsigned off = valid ? (rowbase + (unsigned)kt * (LD_PA * 2)) : rowbase;
        koff = off + (384 + h * 64) * 2; voff = off + (768 + h * 64) * 2;
        bias = valid ? btab[e * 6 + h] : 0.f; return valid;
    }
};
struct EntC {
    unsigned base;
    __device__ __forceinline__ bool operator()(int e, unsigned& koff, unsigned& voff, float& bias) const { koff = base + (unsigned)e * 512u; voff = koff; bias = 0.f; return true; }
};
__device__ __forceinline__ void p2_attn_simple(Frame& F) {
    const int lane = lane_id_fresh(); const int tid = F.wave * 64 + lane; (void)tid;
    LAS float* wscr = (LAS float*)(F.lds + F.wave * 8192);
    const int gw = F.vcu * 8 + F.wave, NGW = F.G * 8;
    const bf16* PA = (const bf16*)(F.ws + WS_PA); const bf16* PC = (const bf16*)(F.ws + WS_PC);
    const float* btab = (const float*)(F.ws + WS_TAB);
    for (int it = gw; it < T * 6; it += NGW) {
        const int t = it / 6, h = it % 6, b = t >> 11, pos = t & 2047;
        EntA ent{pos, h, (unsigned)(b * SEQ) * (unsigned)(LD_PA * 2), btab};
        attn_wave_simple<7, EntA>(PA + (size_t)t * LD_PA + h * 64, (const char*)PA, (const char*)PA, ent, (bf16*)(F.dout + DO_Y) + (size_t)t * 1024 + YC_A + h * 64, wscr, lane);
    }
    for (int it = gw; it < T * 4; it += NGW) {
        const int t = it >> 2, h = it & 3, b = t >> 11;
        EntC ent{(unsigned)(b * MEML) * 512u + (unsigned)h * 128u};
        attn_wave_simple<4, EntC>(PC + (size_t)t * LD_PC + h * 64, (const char*)(F.ws + WS_MEMK), (const char*)(F.ws + WS_MEMV), ent, (bf16*)(F.dout + DO_Y) + (size_t)t * 1024 + YC_C + h * 64, wscr, lane);
    }
}

typedef short s4v __attribute__((ext_vector_type(4)));
constexpr int ATT_OROW = 272;
constexpr int ATT_OACC = 0, ATT_M = 256 * ATT_OROW, ATT_L = ATT_M + 1024, ATT_BT = ATT_L + 1024, ATT_VST = 73728, ATT_VROW = 160, ATT_VBUF = 32 * ATT_VROW;
static_assert(ATT_BT + 3 * 160 * 4 <= ATT_VST && ATT_VST + 8 * 2 * ATT_VBUF <= LDS_MISC, "attention LDS map");
template <int NT, bool MASK>
__device__ __forceinline__ void attn_sub(const bf16* Q0, unsigned qstep, const bf16* K0, const bf16* V0, unsigned kstep, int clo, const LAS float* btab, LAS unsigned char* vst, int lane,
                                         f32x4 (&O)[4], float& m_out, float& l_out) {
    const int q = lane & 15, g = lane >> 4;
    bf16x8 qf[2];
#pragma unroll
    for (int ks = 0; ks < 2; ++ks) qf[ks] = *(const bf16x8*)((const char*)Q0 + ((unsigned)q * qstep + 8u * g + 32u * ks) * 2u);
    f32x4 S[NT];
#pragma unroll
    for (int k = 0; k < NT; ++k) {
        S[k] = (f32x4){0.f, 0.f, 0.f, 0.f};
        if (!MASK || 16 * k >= clo) {
            const char* kr = (const char*)K0 + ((unsigned)(16 * k + q) * kstep + 8u * g) * 2u;
            const bf16x8 k0 = *(const bf16x8*)kr, k1 = *(const bf16x8*)(kr + 64);
            S[k] = __builtin_amdgcn_mfma_f32_16x16x32_bf16(k0, qf[0], S[k], 0, 0, 0);
            S[k] = __builtin_amdgcn_mfma_f32_16x16x32_bf16(k1, qf[1], S[k], 0, 0, 0);
        }
        if ((k & 3) == 3) asm volatile("" ::: "memory");
    }
    const int vr = lane >> 3, vc = lane & 7;
    const int ksf = MASK ? (clo >> 5) : 0;
    v4u wv[4];
#define ATT_LOADV(KS) do { _Pragma("unroll") for (int _i = 0; _i < 4; ++_i) { int _c = 32 * (KS) + 8 * _i + vr; if (MASK && _c < clo) _c = clo; if (_c > 16 * NT - 1) _c = 16 * NT - 1; \
        wv[_i] = *(const v4u*)((const char*)V0 + ((unsigned)_c * kstep + 8u * vc) * 2u); } } while (0)
    ATT_LOADV(ksf);
    float mx = -3.0e38f;
    if (MASK) {
        const LAS float* bp = btab + (128 + 16 + q - 4 * g);
        if (clo > 0) {
#pragma unroll
            for (int k = 0; k < NT; ++k)
#pragma unroll
                for (int r = 0; r < 4; ++r) { const float v = (16 * k + 4 * g + r >= clo) ? S[k][r] + bp[-16 * k - r] : -3.0e38f; S[k][r] = v; mx = fmaxf(mx, v); }
        } else {
#pragma unroll
            for (int k = 0; k < NT; ++k)
#pragma unroll
                for (int r = 0; r < 4; ++r) { const float v = S[k][r] + bp[-16 * k - r]; S[k][r] = v; mx = fmaxf(mx, v); }
        }
    } else {
#pragma unroll
        for (int k = 0; k < NT; ++k) mx = fmaxf(mx, fmaxf(fmaxf(S[k][0], S[k][1]), fmaxf(S[k][2], S[k][3])));
    }
    mx = xmax32(xmax16(mx));
    float l = 0.f;
#pragma unroll
    for (int k = 0; k < NT; ++k)
#pragma unroll
        for (int r = 0; r < 4; ++r) { const float p = __expf(S[k][r] - mx); S[k][r] = p; l += p; }
    l = xsum32(xsum16(l));
#pragma unroll
    for (int t = 0; t < 4; ++t) O[t] = (f32x4){0.f, 0.f, 0.f, 0.f};
    constexpr int NKS = (NT + 1) / 2;
    const int tq = (lane & 15) >> 2, tp = lane & 3;
#pragma unroll
    for (int ks = 0; ks < NKS; ++ks) {
        if (MASK && ks < ksf) continue;
        LAS unsigned char* vb = vst;
#pragma unroll
        for (int i = 0; i < 4; ++i) *(LAS v4u*)(vb + (8 * i + vr) * ATT_VROW + vc * 16) = wv[i];
        asm volatile("" ::: "memory");
        if (ks + 1 < NKS) ATT_LOADV(ks + 1);
        bf16x8 pf;
        { const f32x4 a = S[2 * ks]; f32x4 b = (f32x4){0.f, 0.f, 0.f, 0.f}; if (2 * ks + 1 < NT) b = S[2 * ks + 1 < NT ? 2 * ks + 1 : 0];
          v4u pw; pw.x = cvt_pk_bf16(a[0], a[1]); pw.y = cvt_pk_bf16(a[2], a[3]); pw.z = cvt_pk_bf16(b[0], b[1]); pw.w = cvt_pk_bf16(b[2], b[3]); pf = __builtin_bit_cast(bf16x8, pw); }
#pragma unroll
        for (int t = 0; t < 4; ++t) {
            const s4v lo = __builtin_amdgcn_ds_read_tr16_b64_v4i16((LAS s4v*)(vb + (4 * g + tq) * ATT_VROW + (16 * t + 4 * tp) * 2));
            const s4v hi = __builtin_amdgcn_ds_read_tr16_b64_v4i16((LAS s4v*)(vb + (16 + 4 * g + tq) * ATT_VROW + (16 * t + 4 * tp) * 2));
            const bf16x8 af = (bf16x8){lo[0], lo[1], lo[2], lo[3], hi[0], hi[1], hi[2], hi[3]};
            O[t] = __builtin_amdgcn_mfma_f32_16x16x32_bf16(af, pf, O[t], 0, 0, 0);
        }
        asm volatile("" ::: "memory");
    }
#undef ATT_LOADV
    m_out = mx; l_out = l;
}
constexpr int A2_OROW = 144, A2_M = 256 * A2_OROW, A2_L = A2_M + 1024, A2_BT = A2_L + 1024, A2_STG = 40960, A2_KP = 144, A2_VP = 144, A2_NR = 416, A2_VOFF = A2_STG + A2_NR * A2_KP;
static_assert(A2_BT + 3 * 160 * 4 <= A2_STG && A2_VOFF + A2_NR * A2_VP <= LDS_MISC && A2_STG + 8 * 2 * ATT_VBUF <= LDS_MISC, "mixer A LDS map");
__device__ __forceinline__ void attn_load_q(const bf16* Q0, unsigned qstep, int lane, bf16x8 (&qf)[2]) {
    const int q = lane & 15, g = lane >> 4;
#pragma unroll
    for (int ks = 0; ks < 2; ++ks) qf[ks] = *(const bf16x8*)((const char*)Q0 + ((unsigned)q * qstep + 8u * g + 32u * ks) * 2u);
}
__device__ __forceinline__ void attn_sub_lds(const bf16x8 (&qf)[2], const LAS unsigned char* Ki, const LAS unsigned char* Vi, int clo, const LAS float* btab, int lane, f32x4 (&O)[4], float& m_out, float& l_out) {
    const int q = lane & 15, g = lane >> 4, tq = (lane & 15) >> 2, tp = lane & 3;
    f32x4 S[9];
#pragma unroll
    for (int k = 0; k < 9; ++k) {
        S[k] = (f32x4){0.f, 0.f, 0.f, 0.f};
        if (16 * k >= clo) {
            const bf16x8 k0 = *(const LAS bf16x8*)(Ki + (16 * k + q) * A2_KP + 16 * g), k1 = *(const LAS bf16x8*)(Ki + (16 * k + q) * A2_KP + 64 + 16 * g);
            S[k] = __builtin_amdgcn_mfma_f32_16x16x32_bf16(k0, qf[0], S[k], 0, 0, 0);
            S[k] = __builtin_amdgcn_mfma_f32_16x16x32_bf16(k1, qf[1], S[k], 0, 0, 0);
        }
    }
    float mx = -3.0e38f;
    const LAS float* bp = btab + (128 + 16 + q - 4 * g);
    if (clo > 0) {
#pragma unroll
        for (int k = 0; k < 9; ++k)
#pragma unroll
            for (int r = 0; r < 4; ++r) { const float v = (16 * k + 4 * g + r >= clo) ? S[k][r] + bp[-16 * k - r] : -3.0e38f; S[k][r] = v; mx = fmaxf(mx, v); }
    } else {
#pragma unroll
        for (int k = 0; k < 9; ++k)
#pragma unroll
            for (int r = 0; r < 4; ++r) { const float v = S[k][r] + bp[-16 * k - r]; S[k][r] = v; mx = fmaxf(mx, v); }
    }
    mx = xmax32(xmax16(mx));
    float l = 0.f;
#pragma unroll
    for (int k = 0; k < 9; ++k)
#pragma unroll
        for (int r = 0; r < 4; ++r) { const float p = __expf(S[k][r] - mx); S[k][r] = p; l += p; }
    l = xsum32(xsum16(l));
#pragma unroll
    for (int t = 0; t < 4; ++t) O[t] = (f32x4){0.f, 0.f, 0.f, 0.f};
    const int ksf = clo >> 5;
#pragma unroll
    for (int ks = 0; ks < 5; ++ks) {
        if (ks < ksf) continue;
        const f32x4 a = S[2 * ks]; f32x4 b2 = (f32x4){0.f, 0.f, 0.f, 0.f}; if (2 * ks + 1 < 9) b2 = S[2 * ks + 1 < 9 ? 2 * ks + 1 : 0];
        v4u pw; pw.x = cvt_pk_bf16(a[0], a[1]); pw.y = cvt_pk_bf16(a[2], a[3]); pw.z = cvt_pk_bf16(b2[0], b2[1]); pw.w = cvt_pk_bf16(b2[2], b2[3]);
        const bf16x8 pf = __builtin_bit_cast(bf16x8, pw);
#pragma unroll
        for (int t = 0; t < 4; ++t) {
            const s4v lo = __builtin_amdgcn_ds_read_tr16_b64_v4i16((LAS s4v*)(Vi + (32 * ks + 4 * g + tq) * A2_VP + (16 * t + 4 * tp) * 2));
            const s4v hi = __builtin_amdgcn_ds_read_tr16_b64_v4i16((LAS s4v*)(Vi + (32 * ks + 16 + 4 * g + tq) * A2_VP + (16 * t + 4 * tp) * 2));
            O[t] = __builtin_amdgcn_mfma_f32_16x16x32_bf16((bf16x8){lo[0], lo[1], lo[2], lo[3], hi[0], hi[1], hi[2], hi[3]}, pf, O[t], 0, 0, 0);
        }
    }
    m_out = mx; l_out = l;
}
__device__ __forceinline__ void attnA_merge(Frame& F, f32x4 (&O)[4], float m, float l, int tt, int g, bool first, bool last, bf16* yrow) {
    LAS unsigned char* orow = F.lds + tt * A2_OROW + 8 * g; LAS float* mp = (LAS float*)(F.lds + A2_M) + tt; LAS float* lp = (LAS float*)(F.lds + A2_L) + tt;
    if (!first) {
        const float mo = *mp, lo_ = *lp; const float mn = fmaxf(m, mo), ao = __expf(mo - mn), an = __expf(m - mn);
#pragma unroll
        for (int t = 0; t < 4; ++t) { const v2u w = *(const LAS v2u*)(orow + 32 * t); O[t] = (f32x4){bf_lo(w.x), bf_hi(w.x), bf_lo(w.y), bf_hi(w.y)} * ao + O[t] * an; }
        l = lo_ * ao + l * an; m = mn;
    }
    if (!last) {
#pragma unroll
        for (int t = 0; t < 4; ++t) { v2u w; w.x = cvt_pk_bf16(O[t][0], O[t][1]); w.y = cvt_pk_bf16(O[t][2], O[t][3]); *(LAS v2u*)(orow + 32 * t) = w; }
        if (g == 0) { *mp = m; *lp = l; }
    } else {
        const float inv = 1.0f / l;
#pragma unroll
        for (int t = 0; t < 4; ++t) { v2u w; w.x = cvt_pk_bf16(O[t][0] * inv, O[t][1] * inv); w.y = cvt_pk_bf16(O[t][2] * inv, O[t][3] * inv); *(v2u*)(yrow + 16 * t) = w; }
    }
}
__device__ __forceinline__ void attnA_unit(Frame& F, int unit) {
    const int lane = lane_id_fresh();
    const int tid = F.wave * 64 + lane;
    const int b = unit / 48, rem = unit % 48, h = rem >> 3, tile = rem & 7, t0 = tile * 256; const long tokbase = (long)b * SEQ;
    const bf16* PA = (const bf16*)(F.ws + WS_PA);
    LAS float* bt = (LAS float*)(F.lds + A2_BT);
    LAS unsigned char* Ki = F.lds + A2_STG; LAS unsigned char* Vi = F.lds + A2_VOFF;
    const int q = lane & 15, g = lane >> 4, w = F.wave;
    bf16* Y = (bf16*)(F.dout + DO_Y) + YC_A + h * 64 + 4 * g;
    __syncthreads();
    if (tid < 480) { const int p = tid / 160, st = tid - p * 160 - 16; bt[tid] = (st >= 0 && st <= 128) ? ((const float*)(F.ws + WS_TAB))[(p * 129 + st) * 6 + h] : -3.0e38f; }
    v4u sk[5], sv[5];
#define A2_LOAD1(hh_) do { _Pragma("unroll") for (int it = 0; it < 5; ++it) { const int i = tid + it * 512; sk[it] = (v4u){0u, 0u, 0u, 0u}; sv[it] = sk[it]; \
        if (i < 272 * 8) { const int row = i >> 3, ch = i & 7, pos = t0 + 128 * (hh_) - 128 + row; \
            if (pos >= 0 && pos < SEQ) { const bf16* rp_ = PA + (tokbase + pos) * LD_PA + 384 + h * 64 + ch * 8; sk[it] = *(const v4u*)rp_; sv[it] = *(const v4u*)(rp_ + 384); } } } } while (0)
#define A2_LOAD2(rp_i) do { _Pragma("unroll") for (int it = 0; it < 5; ++it) { const int i = tid + it * 512; sk[it] = (v4u){0u, 0u, 0u, 0u}; sv[it] = sk[it]; \
        { const int row = i >> 3, ch = i & 7, rr_ = row >= 208 ? 1 : 0, j = row - 208 * rr_, posn = t0 / 4 - 128 + j, pos = 4 * posn + 2 * (rp_i) + rr_; \
            if (posn >= 0 && pos < SEQ) { const bf16* rp_ = PA + (tokbase + pos) * LD_PA + 384 + h * 64 + ch * 8; sk[it] = *(const v4u*)rp_; sv[it] = *(const v4u*)(rp_ + 384); } } } } while (0)
#define A2_WRITE(nit, cnt) do { _Pragma("unroll") for (int it = 0; it < (nit); ++it) { const int i = tid + it * 512; if (i < (cnt)) { const int row = i >> 3, ch = i & 7; \
        *(LAS v4u*)(Ki + row * A2_KP + ch * 16) = sk[it]; *(LAS v4u*)(Vi + row * A2_VP + ch * 16) = sv[it]; } } } while (0)
    bf16x8 qc[2], qn[2];
    A2_LOAD1(0);
    attn_load_q(PA + (tokbase + t0 + 16 * w) * LD_PA + h * 64, (unsigned)LD_PA, lane, qc);
#pragma unroll 1
    for (int hh = 0; hh < 2; ++hh) {
        __syncthreads();
        A2_WRITE(5, 272 * 8);
        __syncthreads();
        if (hh == 0) { A2_LOAD1(1); attn_load_q(PA + (tokbase + t0 + 128 + 16 * w) * LD_PA + h * 64, (unsigned)LD_PA, lane, qn); }
        else { A2_LOAD2(0); attn_load_q(PA + (tokbase + t0 + (w >> 2) + 64 * (w & 3)) * LD_PA + h * 64, (unsigned)(4 * LD_PA), lane, qn); }
        const int tq0 = t0 + 128 * hh + 16 * w; const int clo = tq0 < 128 ? 128 - tq0 : 0;
        f32x4 O[4]; float m, l;
        attn_sub_lds(qc, Ki + 16 * w * A2_KP, Vi + 16 * w * A2_VP, clo, bt, lane, O, m, l);
        attnA_merge(F, O, m, l, (tq0 - t0) + q, g, true, false, nullptr);
        qc[0] = qn[0]; qc[1] = qn[1];
    }
#pragma unroll 1
    for (int rp = 0; rp < 2; ++rp) {
        __syncthreads();
        A2_WRITE(5, 416 * 8);
        for (int i = tid + 5 * 512; i < 416 * 8; i += 512) { const int row = i >> 3, ch = i & 7, rr_ = row >= 208 ? 1 : 0, j = row - 208 * rr_, posn = t0 / 4 - 128 + j, pos = 4 * posn + 2 * rp + rr_; v4u kv = (v4u){0u, 0u, 0u, 0u}, vv = kv;
            if (posn >= 0 && pos < SEQ) { const bf16* rp2 = PA + (tokbase + pos) * LD_PA + 384 + h * 64 + ch * 8; kv = *(const v4u*)rp2; vv = *(const v4u*)(rp2 + 384); }
            *(LAS v4u*)(Ki + row * A2_KP + ch * 16) = kv; *(LAS v4u*)(Vi + row * A2_VP + ch * 16) = vv; }
        __syncthreads();
        if (rp == 0) { A2_LOAD2(1); attn_load_q(PA + (tokbase + t0 + 2 + (w >> 2) + 64 * (w & 3)) * LD_PA + h * 64, (unsigned)(4 * LD_PA), lane, qn); }
        const int rr = w >> 2, jp = w & 3, tq0 = t0 + 2 * rp + rr + 64 * jp, pq0 = t0 / 4 + 16 * jp; const int clo = pq0 < 128 ? 128 - pq0 : 0;
        f32x4 O[4]; float m, l;
        attn_sub_lds(qc, Ki + (208 * rr + 16 * jp) * A2_KP, Vi + (208 * rr + 16 * jp) * A2_VP, clo, bt + 160, lane, O, m, l);
        attnA_merge(F, O, m, l, (tq0 - t0) + 4 * q, g, false, false, nullptr);
        qc[0] = qn[0]; qc[1] = qn[1];
    }
#undef A2_LOAD1
#undef A2_LOAD2
#undef A2_WRITE
    __syncthreads();
    LAS unsigned char* vst = F.lds + A2_STG + w * 2 * ATT_VBUF;
#pragma unroll
    for (int su = 0; su < 2; ++su) {
        const int sub = w * 2 + su, tq0 = t0 + sub, pq0 = t0 / 16; const int clo = pq0 < 128 ? 128 - pq0 : 0;
        const bf16* Q0 = PA + (tokbase + tq0) * LD_PA + h * 64; const bf16* K0 = PA + (tokbase + tq0 - 128 * 16) * LD_PA + 384 + h * 64;
        f32x4 O[4]; float m, l;
        attn_sub<9, true>(Q0, (unsigned)(16 * LD_PA), K0, K0 + 384, (unsigned)(16 * LD_PA), clo, bt + 320, vst + su * ATT_VBUF, lane, O, m, l);
        const int tt = (tq0 - t0) + 16 * q;
        attnA_merge(F, O, m, l, tt, g, false, true, Y + (tokbase + t0 + tt) * 1024);
    }
    __syncthreads();
}
constexpr int CK_PITCH = 144, CV_PITCH = 160, CK_OFF = 0, CV_OFF = 256 * CK_PITCH;
static_assert(CV_OFF + 256 * CV_PITCH <= LDS_MISC, "mixer C LDS map");
__device__ __forceinline__ void attnC_unit(Frame& F, int unit) {
    const int lane = lane_id_fresh(); const int tid = F.wave * 64 + lane;
    const int b = unit >> 5, h = (unit >> 3) & 3, tile = unit & 7; const long tok0 = (long)b * SEQ + tile * 256;
    const bf16* PC = (const bf16*)(F.ws + WS_PC);
    const bf16* K0 = (const bf16*)(F.ws + WS_MEMK) + (long)b * MEML * 256 + h * 64; const bf16* V0 = (const bf16*)(F.ws + WS_MEMV) + (long)b * MEML * 256 + h * 64;
    LAS unsigned char* L = F.lds;
    bf16x8 qa[2][2];
    { const int q_ = lane & 15, g_ = lane >> 4;
#pragma unroll
      for (int su = 0; su < 2; ++su)
#pragma unroll
        for (int ks = 0; ks < 2; ++ks) qa[su][ks] = *(const bf16x8*)(PC + (tok0 + 16 * (F.wave * 2 + su) + q_) * LD_PC + h * 64 + 8 * g_ + 32 * ks); }
    __syncthreads();
#pragma unroll
    for (int j = 0; j < 4; ++j) { const int i = tid + 512 * j, row = i >> 3, ch = i & 7;
        *(LAS v4u*)(L + CK_OFF + row * CK_PITCH + ch * 16) = *(const v4u*)(K0 + (long)row * 256 + ch * 8);
        *(LAS v4u*)(L + CV_OFF + row * CV_PITCH + ch * 16) = *(const v4u*)(V0 + (long)row * 256 + ch * 8); }
    __syncthreads();
    const int q = lane & 15, g = lane >> 4, tq = (lane & 15) >> 2, tp = lane & 3;
#pragma unroll 1
    for (int su = 0; su < 2; ++su) {
        const long tq0 = tok0 + 16 * (F.wave * 2 + su);
        bf16x8 qf[2]; qf[0] = su == 0 ? qa[0][0] : qa[1][0]; qf[1] = su == 0 ? qa[0][1] : qa[1][1];
        f32x4 S[16];
#pragma unroll
        for (int k = 0; k < 16; ++k) {
            const bf16x8 k0 = *(const LAS bf16x8*)(L + CK_OFF + (16 * k + q) * CK_PITCH + 16 * g), k1 = *(const LAS bf16x8*)(L + CK_OFF + (16 * k + q) * CK_PITCH + 64 + 16 * g);
            S[k] = __builtin_amdgcn_mfma_f32_16x16x32_bf16(k0, qf[0], (f32x4){0.f, 0.f, 0.f, 0.f}, 0, 0, 0);
            S[k] = __builtin_amdgcn_mfma_f32_16x16x32_bf16(k1, qf[1], S[k], 0, 0, 0);
            if ((k & 3) == 3) asm volatile("" ::: "memory");
        }
        float mx = -3.0e38f;
#pragma unroll
        for (int k = 0; k < 16; ++k) mx = fmaxf(mx, fmaxf(fmaxf(S[k][0], S[k][1]), fmaxf(S[k][2], S[k][3])));
        mx = xmax32(xmax16(mx));
        float l = 0.f;
#pragma unroll
        for (int k = 0; k < 16; ++k)
#pragma unroll
            for (int r = 0; r < 4; ++r) { const float p = __expf(S[k][r] - mx); S[k][r] = p; l += p; }
        l = xsum32(xsum16(l));
        f32x4 O[4];
#pragma unroll
        for (int t = 0; t < 4; ++t) O[t] = (f32x4){0.f, 0.f, 0.f, 0.f};
#pragma unroll
        for (int ks = 0; ks < 8; ++ks) {
            v4u pw; pw.x = cvt_pk_bf16(S[2 * ks][0], S[2 * ks][1]); pw.y = cvt_pk_bf16(S[2 * ks][2], S[2 * ks][3]); pw.z = cvt_pk_bf16(S[2 * ks + 1][0], S[2 * ks + 1][1]); pw.w = cvt_pk_bf16(S[2 * ks + 1][2], S[2 * ks + 1][3]);
            const bf16x8 pf = __builtin_bit_cast(bf16x8, pw);
#pragma unroll
            for (int t = 0; t < 4; ++t) {
                const s4v lo = __builtin_amdgcn_ds_read_tr16_b64_v4i16((LAS s4v*)(L + CV_OFF + (32 * ks + 4 * g + tq) * CV_PITCH + (16 * t + 4 * tp) * 2));
                const s4v hi = __builtin_amdgcn_ds_read_tr16_b64_v4i16((LAS s4v*)(L + CV_OFF + (32 * ks + 16 + 4 * g + tq) * CV_PITCH + (16 * t + 4 * tp) * 2));
                O[t] = __builtin_amdgcn_mfma_f32_16x16x32_bf16((bf16x8){lo[0], lo[1], lo[2], lo[3], hi[0], hi[1], hi[2], hi[3]}, pf, O[t], 0, 0, 0);
            }
        }
        const float inv = 1.0f / l; bf16* yo = (bf16*)(F.dout + DO_Y) + (tq0 + q) * 1024 + YC_C + h * 64 + 4 * g;
#pragma unroll
        for (int t = 0; t < 4; ++t) { v2u w; w.x = cvt_pk_bf16(O[t][0] * inv, O[t][1] * inv); w.y = cvt_pk_bf16(O[t][2] * inv, O[t][3] * inv); *(v2u*)(yo + 16 * t) = w; }
    }
}
__device__ __forceinline__ void p2_attn_mfma(Frame& F) {
    const int lane = lane_id_fresh();
    for (int u = F.vcu; u < NB * 6 * 8; u += F.G) attnA_unit(F, u);
    for (int u = F.vcu; u < NB * 4 * 8; u += F.G) attnC_unit(F, u);
    __syncthreads();
}

constexpr int HG_PR = 144, HG_PX = 160, HG_PV = 224;
constexpr int HG_KH = 0, HG_QT = 64 * HG_PR, HG_QS = 2 * 64 * HG_PR, HG_KX = HG_QS + 10 * 16 * HG_PR, HG_VI = HG_KX + 64 * HG_PX, HG_SI = HG_VI + 64 * HG_PV, HG_DV = HG_SI + 2 * 64 * HG_PV, HG_PS = HG_DV + 256, HG_END = HG_PS + 512;
static_assert(HG_END <= LDS_MISC, "hgrn LDS map");
__device__ __forceinline__ s4v trd(const LAS unsigned char* p) { return __builtin_amdgcn_ds_read_tr16_b64_v4i16((LAS s4v*)p); }
__device__ __forceinline__ bf16x8 cat8(s4v lo, s4v hi) { return (bf16x8){lo[0], lo[1], lo[2], lo[3], hi[0], hi[1], hi[2], hi[3]}; }
__device__ __forceinline__ void hgrn_seq(Frame& F, int seq, bf16* YB) {
    const int lane = lane_id_fresh();
    const int w = F.wave, tid = w * 64 + lane;
    const int b = seq >> 2, h = seq & 3; const long tokbase = (long)b * SEQ;
    const bf16* PB = (const bf16*)(F.ws + WS_PB);
    LAS unsigned char* L = F.lds;
    __syncthreads();
    for (int i = tid; i < 2 * 64 * HG_PV / 16; i += 512) *(LAS v4u*)(L + HG_SI + i * 16) = (v4u){0u, 0u, 0u, 0u};
    float lbv[8];
    { const float* lbt = (const float*)(F.ws + WS_TAB) + 4096 + h * 64 + 8 * w;
#pragma unroll
      for (int j = 0; j < 8; ++j) lbv[j] = lbt[j]; }
    f32x4 St[3];
#pragma unroll
    for (int t = 0; t < 3; ++t) St[t] = (f32x4){0.f, 0.f, 0.f, 0.f};
    const int q16 = lane & 15, g = lane >> 4, mi = w >> 1, hh = w & 1, tq4 = (lane & 15) >> 2, tp = lane & 3;
    float gn[3];
#pragma unroll
    for (int t = 0; t < 3; ++t) gn[t] = arg_in(I_ONB)[h * 96 + 16 * (3 * hh + t) + q16];
    v4u qw, fw, vw0, vw1 = (v4u){0u, 0u, 0u, 0u};
    { const bf16* rowp = PB + (tokbase + lane) * LD_PB; qw = *(const v4u*)(rowp + h * 64 + 8 * w); fw = *(const v4u*)(rowp + 256 + h * 64 + 8 * w);
      vw0 = *(const v4u*)(PB + (tokbase + tid / 12) * LD_PB + 512 + h * 96 + (tid % 12) * 8);
      if (tid < 256) vw1 = *(const v4u*)(PB + (tokbase + (tid + 512) / 12) * LD_PB + 512 + h * 96 + ((tid + 512) % 12) * 8); }
    bf16 ogc[3][4], ogn[3][4];
#pragma unroll
    for (int t = 0; t < 3; ++t)
#pragma unroll
        for (int r = 0; r < 4; ++r) { ogc[t][r] = PB[(tokbase + 16 * mi + 4 * g + r) * LD_PB + 896 + h * 96 + 16 * (3 * hh + t) + q16]; ogn[t][r] = ogc[t][r]; }
#pragma unroll 1
    for (int c = 0; c < 32; ++c) {
        const long tok0 = tokbase + 64 * c;
        *(LAS v4u*)(L + HG_VI + (tid / 12) * HG_PV + (tid % 12) * 16) = vw0;
        if (tid < 256) *(LAS v4u*)(L + HG_VI + ((tid + 512) / 12) * HG_PV + ((tid + 512) % 12) * 16) = vw1;
        float qf[8], kk[8], bb[8];
        { const unsigned qa[4] = {qw.x, qw.y, qw.z, qw.w}, fa[4] = {fw.x, fw.y, fw.z, fw.w};
#pragma unroll
          for (int j = 0; j < 4; ++j) { qf[2 * j] = bf_lo(qa[j]); qf[2 * j + 1] = bf_hi(qa[j]);
              const float f0 = lbv[2 * j] + (1.f - lbv[2 * j]) * sigmoidf_(bf_lo(fa[j])), f1 = lbv[2 * j + 1] + (1.f - lbv[2 * j + 1]) * sigmoidf_(bf_hi(fa[j]));
              kk[2 * j] = 1.f - f0; kk[2 * j + 1] = 1.f - f1; bb[2 * j] = __logf(f0); bb[2 * j + 1] = __logf(f1); } }
#pragma unroll
        for (int j = 0; j < 8; ++j) bb[j] = scan_incl64(bb[j]);
        float E0[8], E1[8], E2[8], E3[8], Es[8];
#pragma unroll
        for (int j = 0; j < 8; ++j) { E0[j] = readlane_f(bb[j], 15); E1[j] = readlane_f(bb[j], 31); E2[j] = readlane_f(bb[j], 47); E3[j] = readlane_f(bb[j], 63);
            Es[j] = g == 0 ? E0[j] : (g == 1 ? E1[j] : (g == 2 ? E2[j] : E3[j])); }
        {   float kh[8], qt[8], kx[8];
#pragma unroll
            for (int j = 0; j < 8; ++j) { kh[j] = kk[j] * __expf(Es[j] - bb[j]); qt[j] = qf[j] * __expf(bb[j]); kx[j] = kk[j] * __expf(E3[j] - bb[j]); }
            v4u o; o.x = cvt_pk_bf16(kh[0], kh[1]); o.y = cvt_pk_bf16(kh[2], kh[3]); o.z = cvt_pk_bf16(kh[4], kh[5]); o.w = cvt_pk_bf16(kh[6], kh[7]); *(LAS v4u*)(L + HG_KH + lane * HG_PR + w * 16) = o;
            o.x = cvt_pk_bf16(qt[0], qt[1]); o.y = cvt_pk_bf16(qt[2], qt[3]); o.z = cvt_pk_bf16(qt[4], qt[5]); o.w = cvt_pk_bf16(qt[6], qt[7]); *(LAS v4u*)(L + HG_QT + lane * HG_PR + w * 16) = o;
            o.x = cvt_pk_bf16(kx[0], kx[1]); o.y = cvt_pk_bf16(kx[2], kx[3]); o.z = cvt_pk_bf16(kx[4], kx[5]); o.w = cvt_pk_bf16(kx[6], kx[7]); *(LAS v4u*)(L + HG_KX + lane * HG_PX + w * 16) = o; }
#pragma unroll
        for (int jj = 0; jj < 4; ++jj) {
            if (g >= jj) { float qs[8];
#pragma unroll
                for (int j = 0; j < 8; ++j) { const float Ej = jj == 0 ? E0[j] : (jj == 1 ? E1[j] : (jj == 2 ? E2[j] : E3[j])); qs[j] = qf[j] * __expf(bb[j] - Ej); }
                const int tix = (jj == 0 ? 0 : (jj == 1 ? 4 : (jj == 2 ? 7 : 9))) + (g - jj);
                v4u o; o.x = cvt_pk_bf16(qs[0], qs[1]); o.y = cvt_pk_bf16(qs[2], qs[3]); o.z = cvt_pk_bf16(qs[4], qs[5]); o.w = cvt_pk_bf16(qs[6], qs[7]);
                *(LAS v4u*)(L + HG_QS + tix * 16 * HG_PR + q16 * HG_PR + w * 16) = o; }
        }
        if (lane == 63) {
#pragma unroll
            for (int j = 0; j < 8; ++j) *(LAS float*)(L + HG_DV + (8 * w + j) * 4) = __expf(bb[j]); }
        __syncthreads();
        if (c + 1 < 32) { const long tn = tok0 + 64; const bf16* rowp = PB + (tn + lane) * LD_PB; qw = *(const v4u*)(rowp + h * 64 + 8 * w); fw = *(const v4u*)(rowp + 256 + h * 64 + 8 * w);
            vw0 = *(const v4u*)(PB + (tn + tid / 12) * LD_PB + 512 + h * 96 + (tid % 12) * 8);
            if (tid < 256) vw1 = *(const v4u*)(PB + (tn + (tid + 512) / 12) * LD_PB + 512 + h * 96 + ((tid + 512) % 12) * 8);
#pragma unroll
            for (int t = 0; t < 3; ++t)
#pragma unroll
                for (int r = 0; r < 4; ++r) ogn[t][r] = PB[(tn + 16 * mi + 4 * g + r) * LD_PB + 896 + h * 96 + 16 * (3 * hh + t) + q16]; }
        const LAS unsigned char* SIr = L + HG_SI + (c & 1) * 64 * HG_PV; LAS unsigned char* SIw = L + HG_SI + ((c + 1) & 1) * 64 * HG_PV;
        f32x4 AT[4];
#pragma unroll
        for (int j = 0; j < 4; ++j) {
            f32x4 acc = (f32x4){0.f, 0.f, 0.f, 0.f};
            if (j <= mi) {
                const int tix = (j == 0 ? 0 : (j == 1 ? 4 : (j == 2 ? 7 : 9))) + (mi - j);
#pragma unroll
                for (int ks = 0; ks < 2; ++ks) {
                    const bf16x8 a = *(const LAS bf16x8*)(L + HG_KH + (16 * j + q16) * HG_PR + (32 * ks + 8 * g) * 2);
                    const bf16x8 bq = *(const LAS bf16x8*)(L + HG_QS + tix * 16 * HG_PR + q16 * HG_PR + (32 * ks + 8 * g) * 2);
                    acc = __builtin_amdgcn_mfma_f32_16x16x32_bf16(a, bq, acc, 0, 0, 0);
                }
                if (j == mi) {
#pragma unroll
                    for (int r = 0; r < 4; ++r) if (4 * g + r > q16) acc[r] = 0.f; }
            }
            AT[j] = acc;
        }
        bf16x8 vf[2][3];
#pragma unroll
        for (int ks = 0; ks < 2; ++ks)
#pragma unroll
            for (int t = 0; t < 3; ++t) { const int col = (16 * (3 * hh + t) + 4 * tp) * 2;
                vf[ks][t] = cat8(trd(L + HG_VI + (32 * ks + 4 * g + tq4) * HG_PV + col), trd(L + HG_VI + (32 * ks + 16 + 4 * g + tq4) * HG_PV + col)); }
        f32x4 o[3];
#pragma unroll
        for (int t = 0; t < 3; ++t) o[t] = (f32x4){0.f, 0.f, 0.f, 0.f};
#pragma unroll
        for (int ks = 0; ks < 2; ++ks) {
            const bf16x8 a = *(const LAS bf16x8*)(L + HG_QT + (16 * mi + q16) * HG_PR + (32 * ks + 8 * g) * 2);
#pragma unroll
            for (int t = 0; t < 3; ++t) { const int col = (16 * (3 * hh + t) + 4 * tp) * 2;
                const bf16x8 bs = cat8(trd(SIr + (32 * ks + 8 * g + tq4) * HG_PV + col), trd(SIr + (32 * ks + 8 * g + 4 + tq4) * HG_PV + col));
                o[t] = __builtin_amdgcn_mfma_f32_16x16x32_bf16(a, bs, o[t], 0, 0, 0); }
        }
#pragma unroll
        for (int ks = 0; ks < 2; ++ks) {
            if (2 * ks <= mi) {
                v4u pw; pw.x = cvt_pk_bf16(AT[2 * ks][0], AT[2 * ks][1]); pw.y = cvt_pk_bf16(AT[2 * ks][2], AT[2 * ks][3]); pw.z = cvt_pk_bf16(AT[2 * ks + 1][0], AT[2 * ks + 1][1]); pw.w = cvt_pk_bf16(AT[2 * ks + 1][2], AT[2 * ks + 1][3]);
                const bf16x8 a = __builtin_bit_cast(bf16x8, pw);
#pragma unroll
                for (int t = 0; t < 3; ++t) o[t] = __builtin_amdgcn_mfma_f32_16x16x32_bf16(a, vf[ks][t], o[t], 0, 0, 0);
            }
        }
        { const f32x4 dv = *(const LAS f32x4*)(L + HG_DV + (16 * mi + 4 * g) * 4);
#pragma unroll
          for (int t = 0; t < 3; ++t) St[t] = St[t] * dv; }
#pragma unroll
        for (int ks = 0; ks < 2; ++ks) {
            const int col = (16 * mi + 4 * tp) * 2;
            const bf16x8 a = cat8(trd(L + HG_KX + (32 * ks + 4 * g + tq4) * HG_PX + col), trd(L + HG_KX + (32 * ks + 16 + 4 * g + tq4) * HG_PX + col));
#pragma unroll
            for (int t = 0; t < 3; ++t) St[t] = __builtin_amdgcn_mfma_f32_16x16x32_bf16(a, vf[ks][t], St[t], 0, 0, 0);
        }
#pragma unroll
        for (int t = 0; t < 3; ++t)
#pragma unroll
            for (int r = 0; r < 4; ++r) *(LAS bf16*)(SIw + (16 * mi + 4 * g + r) * HG_PV + (16 * (3 * hh + t) + q16) * 2) = f2bf(St[t][r]);
        float ss[4];
#pragma unroll
        for (int r = 0; r < 4; ++r) { float s2 = o[0][r] * o[0][r] + o[1][r] * o[1][r] + o[2][r] * o[2][r];
            ss[r] = sum_row16(s2); }
        if (q16 == 0) {
#pragma unroll
            for (int r = 0; r < 4; ++r) *(LAS float*)(L + HG_PS + ((16 * mi + 4 * g + r) * 2 + hh) * 4) = ss[r]; }
        float ogv[3][4];
#pragma unroll
        for (int t = 0; t < 3; ++t)
#pragma unroll
            for (int r = 0; r < 4; ++r) { ogv[t][r] = bf2f(ogc[t][r]); ogc[t][r] = ogn[t][r]; }
        __syncthreads();
#pragma unroll
        for (int r = 0; r < 4; ++r) { const f32x2 p2 = *(const LAS f32x2*)(L + HG_PS + (16 * mi + 4 * g + r) * 8); const float rstd = rsqrtf((p2[0] + p2[1]) * (1.f / 96.f) + EPS);
#pragma unroll
            for (int t = 0; t < 3; ++t) YB[(tok0 + 16 * mi + 4 * g + r) * 1024 + YC_B + h * 96 + 16 * (3 * hh + t) + q16] = f2bf(o[t][r] * rstd * gn[t] * ogv[t][r]); }
    }
    __syncthreads();
}
constexpr int CW_Q = 8192;
__device__ __forceinline__ void p2_queue(Frame& F) {
    const int lane = lane_id_fresh();
    volatile LAS int* qw = (volatile LAS int*)(F.lds + LDS_MISC + 64);
    constexpr int NH = 128, NM = 64, NW = (CV_ALL - CV_EARLY + 255) / 256, NA = NB * 6 * 8, NC = NB * 4 * 8;
    unsigned* mkv_done = (unsigned*)(F.ws + WS_CTL) + CW_Q + 256; bool mkv_ok = false;
    if (F.wave == 0 && lane == 0) qw[0] = (int)atomicAdd((unsigned*)(F.ws + WS_CTL) + CW_Q, 1u);
    for (;;) {
        __syncthreads();
        const int it = __builtin_amdgcn_readfirstlane(qw[0]);
        __syncthreads();
        if (it >= NH + NM + NW + NA + NC) break;
        int nxt = 0; if (F.wave == 0 && lane == 0) nxt = (int)atomicAdd((unsigned*)(F.ws + WS_CTL) + CW_Q, 1u);
        if (it < NH) hgrn_seq(F, it, (bf16*)(F.dout + DO_Y));
        else if (it < NH + NM) {
            pg8::StaticOrder S; S.init(F.ws + WS_MEMN, F.ws + WS_WMEM, NB * MEML, 512, 1024, NM, it - NH);
            pg8::EpiMemKV E{(bf16*)(F.ws + WS_MEMK), (bf16*)(F.ws + WS_MEMV), arg_in(I_KNC)};
            pg8::gemm_phase<pg8::EpiMemKV, pg8::StaticOrder, false>(F.lds, 1024, S, E, F.wave);
            if (F.wave == 0 && lane_id_fresh() == 0) { __builtin_amdgcn_fence(__ATOMIC_RELEASE, "agent"); asm volatile("s_waitcnt vmcnt(0)" ::: "memory"); (void)__hip_atomic_fetch_add(mkv_done, 1u, __ATOMIC_RELAXED, __HIP_MEMORY_SCOPE_AGENT); }
        }
        else if (it < NH + NM + NW) { const int l2 = lane_id_fresh(); LAS float* scr = (LAS float*)(F.lds + F.wave * 16384);
            for (int j = 0; j < 32; ++j) { const int ci = CV_EARLY + (it - NH - NM) * 256 + F.wave * 32 + j; if (ci < CV_ALL) conv_item(F, ci, scr, l2); } }
        else if (it < NH + NM + NW + NA) attnA_unit(F, it - NH - NM - NW);
        else {
            if (!mkv_ok) { unsigned sp = 0u; while (__hip_atomic_load(mkv_done, __ATOMIC_RELAXED, __HIP_MEMORY_SCOPE_AGENT) < (unsigned)NM && ++sp < (1u << 24)) __builtin_amdgcn_s_sleep(2);
                __builtin_amdgcn_fence(__ATOMIC_ACQUIRE, "agent"); mkv_ok = true; }
            attnC_unit(F, it - NH - NM - NW - NA);
        }
        if (F.wave == 0 && lane == 0) qw[0] = nxt;
    }
    __syncthreads();
}
template <bool OUTPUTS>
__device__ __forceinline__ void hgrn_simple(Frame& F, bf16* YBo) {
    const int lane = lane_id_fresh(); const int tid = F.wave * 64 + lane; (void)tid;
    const int uw = tid >> 7, col = tid & 127;
    LAS float* fL = (LAS float*)(F.lds + uw * 29184); LAS float* qL = fL + 2048; LAS float* oL = qL + 2048; LAS float* pL = oL + 3072;
    const bf16* PB = (const bf16*)(F.ws + WS_PB);
    const float* lbt = (const float*)(F.ws + WS_TAB) + 4096;
    float* LST = (float*)(F.ws + WS_LST); float* DEC = (float*)(F.ws + WS_DEC);
    for (int grp = F.vcu; grp < 1024; grp += F.G) {
        const int unit = grp * 4 + uw, b = unit >> 7, h = (unit >> 5) & 3, c = unit & 31; const int tok0 = b * SEQ + c * 64;
        float S[64]; float dprod = 1.f;
#pragma unroll
        for (int k = 0; k < 64; ++k) S[k] = 0.f;
        if (OUTPUTS && col < 96) {
            for (int cp = 0; cp < c; ++cp) { const float* dp = DEC + (size_t)(unit - c + cp) * 64; const float* lp = LST + (size_t)(unit - c + cp) * 6144 + col;
#pragma unroll
                for (int k = 0; k < 64; ++k) S[k] = dp[k] * S[k] + lp[k * 96]; }
        }
        for (int hf = 0; hf < 2; ++hf) {
            __syncthreads();
            for (int idx = col; idx < 2048; idx += 128) { const int s = idx >> 6, k = idx & 63; const size_t rb = (size_t)(tok0 + hf * 32 + s) * LD_PB;
                const float lb = lbt[h * 64 + k]; fL[idx] = lb + (1.f - lb) * sigmoidf_(bf2f(PB[rb + 256 + h * 64 + k]));
                if (OUTPUTS) qL[idx] = bf2f(PB[rb + h * 64 + k]); }
            __syncthreads();
            if (col < 96) {
                for (int s = 0; s < 32; ++s) {
                    const float v = bf2f(PB[(size_t)(tok0 + hf * 32 + s) * LD_PB + 512 + h * 96 + col]); float o = 0.f;
#pragma unroll
                    for (int k4 = 0; k4 < 16; ++k4) { const f32x4 f4 = *(const LAS f32x4*)(fL + s * 64 + 4 * k4); f32x4 q4 = (f32x4){0.f, 0.f, 0.f, 0.f}; if (OUTPUTS) q4 = *(const LAS f32x4*)(qL + s * 64 + 4 * k4);
#pragma unroll
                        for (int j = 0; j < 4; ++j) { const float fk = f4[j]; S[4 * k4 + j] = fk * S[4 * k4 + j] + (1.f - fk) * v; if (OUTPUTS) o += S[4 * k4 + j] * q4[j]; } }
                    if (OUTPUTS) oL[s * 96 + col] = o;
                }
            }
            if (!OUTPUTS && col < 64) { for (int s = 0; s < 32; ++s) dprod *= fL[s * 64 + col]; }
            if (OUTPUTS) {
                __syncthreads();
                { const int s = col & 31, part = col >> 5; float ss = 0.f;
#pragma unroll
                  for (int j = 0; j < 24; ++j) { const float x = oL[s * 96 + part * 24 + j]; ss += x * x; }
                  pL[s * 4 + part] = ss; }
                __syncthreads();
                if (col < 96) { const float gn = arg_in(I_ONB)[h * 96 + col];
                    for (int s = 0; s < 32; ++s) { const f32x4 p4 = *(const LAS f32x4*)(pL + s * 4); const float rstd = rsqrtf(((p4[0] + p4[1]) + (p4[2] + p4[3])) * (1.f / 96.f) + EPS);
                        const size_t tok = (size_t)(tok0 + hf * 32 + s); const float og = bf2f(PB[tok * LD_PB + 896 + h * 96 + col]);
                        YBo[tok * 384 + h * 96 + col] = f2bf(oL[s * 96 + col] * rstd * gn * og); } }
            }
        }
        if (!OUTPUTS) {
            if (col < 96) {
#pragma unroll
                for (int k = 0; k < 64; ++k) LST[(size_t)unit * 6144 + k * 96 + col] = S[k]; }
            if (col < 64) DEC[(size_t)unit * 64 + col] = dprod;
        }
    }
    __syncthreads();
}

__device__ __forceinline__ __amdgpu_buffer_rsrc_t make_rsrc(const void* base, int bytes) { return __builtin_amdgcn_make_buffer_rsrc((void*)base, (short)0, bytes, 0x00020000); }
__device__ __forceinline__ void count_greater4(int& beat, const v4u o, const unsigned key) {
    unsigned long long A, B, C;
    asm volatile("v_cmp_gt_u32_e64 %1, %4, %8\n\t"
                 "v_cmp_gt_u32_e64 %2, %5, %8\n\t"
                 "v_cmp_gt_u32_e64 %3, %6, %8\n\t"
                 "v_addc_co_u32_e64 %0, %1, 0, %0, %1\n\t"
                 "v_cmp_gt_u32_e64 %1, %7, %8\n\t"
                 "v_addc_co_u32_e64 %0, %2, 0, %0, %2\n\t"
                 "v_addc_co_u32_e64 %0, %3, 0, %0, %3\n\t"
                 "v_addc_co_u32_e64 %0, %1, 0, %0, %1"
                 : "+v"(beat), "=&s"(A), "=&s"(B), "=&s"(C) : "v"(o.x), "v"(o.y), "v"(o.z), "v"(o.w), "v"(key));
}
constexpr int RT_ROW = 2064;
constexpr int RT_HI = 0, RT_LO = 32 * RT_ROW, RT_LG = 64 * RT_ROW;
constexpr int RT_GN = RT_LG + 2 * 32 * 64 * 4 + 1024;
constexpr int RT_KEY = RT_GN + 4096;
static_assert(RT_KEY + 8 * 1024 <= LDS_MISC, "routing LDS map");
__device__ __forceinline__ void p6_route(Frame& F, const bool commit) {
    const int lane = lane_id_fresh();
    const bf16* X1 = (const bf16*)F.dout; bf16* U = (bf16*)(F.ws + WS_U);
    const bf16* WRH = (const bf16*)(F.ws + WS_TAB + 65536); const bf16* WRL = WRH + 65536;
    const float rbias = arg_in(I_RB)[lane];
    v2u* slot = (v2u*)(F.ws + WS_SLOT); unsigned* cntw = (unsigned*)(F.ws + WS_CTL) + CW_CNT;
    LAS unsigned* lcnt = (LAS unsigned*)(F.lds + RT_LG + 2 * 32 * 64 * 4);
    for (int i = F.vcu * 512 + F.wave * 64 + lane; i < HALF_T; i += F.G * 512) slot[(size_t)64 * SLOT_CAP + i] = (v2u){(unsigned)(i * 8), 0x3f800000u};
    const int q = lane & 15, g = lane >> 4, et = F.wave & 3, kh = F.wave >> 2;
    bf16x8 wh[16], wl[16];
    const __amdgpu_buffer_rsrc_t rsl = make_rsrc(WRL + (size_t)et * 16384 + (size_t)kh * 8192, 16384); const int lv16 = lane * 16;
    {   const bf16* ph = WRH + (size_t)et * 16384 + (size_t)kh * 8192 + lane * 8;
#pragma unroll
        for (int ks = 0; ks < 16; ++ks) wh[ks] = *(const bf16x8*)(ph + 512 * ks); }
    const unsigned long long lt_mask = (lane == 0) ? 0ull : (~0ull >> (64 - lane));
    v4u xv[4][2], xn[4][2];
    if (F.wave < 4) *(LAS f32x4*)(F.lds + RT_GN + (F.wave * 64 + lane) * 16) = ((const f32x4*)arg_in(I_FNG))[F.wave * 64 + lane];
    {   const int t0 = F.vcu * 32;
        if (t0 < T) {
#pragma unroll
            for (int i = 0; i < 4; ++i)
#pragma unroll
                for (int j = 0; j < 2; ++j) { xv[i][j] = *(const v4u*)(X1 + x1_off((size_t)(t0 + F.wave * 4 + i)) + 16 * lane + 8 * j); xn[i][j] = xv[i][j]; } }
        const int t1 = t0 + F.G * 32;
        if (t1 < T) {
#pragma unroll
            for (int i = 0; i < 4; ++i)
#pragma unroll
                for (int j = 0; j < 2; ++j) xn[i][j] = *(const v4u*)(X1 + x1_off((size_t)(t1 + F.wave * 4 + i)) + 16 * lane + 8 * j); } }
    for (int t0 = F.vcu * 32; t0 < T; t0 += F.G * 32) {
        __syncthreads();
        if (F.wave == 0) lcnt[lane] = 0u;
#pragma unroll
        for (int i = 0; i < 4; ++i) {
            const int tl = F.wave * 4 + i, t = t0 + tl;
            float x[16];
#pragma unroll
            for (int j = 0; j < 2; ++j) { const unsigned w4[4] = {xv[i][j].x, xv[i][j].y, xv[i][j].z, xv[i][j].w};
#pragma unroll
                for (int k = 0; k < 4; ++k) { x[8 * j + 2 * k] = bf_lo(w4[k]); x[8 * j + 2 * k + 1] = bf_hi(w4[k]); } }
            float s2 = 0.f;
#pragma unroll
            for (int k = 0; k < 16; ++k) s2 += x[k] * x[k];
            const float rstd = rsqrtf(wave_sum(s2) * (1.f / D) + EPS);
            unsigned hw[8], lw[8];
#pragma unroll
            for (int k = 0; k < 8; ++k) { const f32x4 gg = *(const LAS f32x4*)(F.lds + RT_GN + (4 * lane + (k >> 1)) * 16);
                const float u0 = x[2 * k] * rstd * gg[2 * (k & 1)], u1 = x[2 * k + 1] * rstd * gg[2 * (k & 1) + 1];
                hw[k] = cvt_pk_bf16(u0, u1); lw[k] = cvt_pk_bf16(u0 - bf_lo(hw[k]), u1 - bf_hi(hw[k])); }
            *(LAS v4u*)(F.lds + RT_HI + tl * RT_ROW + lane * 32) = (v4u){hw[0], hw[1], hw[2], hw[3]}; *(LAS v4u*)(F.lds + RT_HI + tl * RT_ROW + lane * 32 + 16) = (v4u){hw[4], hw[5], hw[6], hw[7]};
            *(LAS v4u*)(F.lds + RT_LO + tl * RT_ROW + lane * 32) = (v4u){lw[0], lw[1], lw[2], lw[3]}; *(LAS v4u*)(F.lds + RT_LO + tl * RT_ROW + lane * 32 + 16) = (v4u){lw[4], lw[5], lw[6], lw[7]};
        }
        asm volatile("" ::: "memory");
#pragma unroll
        for (int ks = 0; ks < 16; ++ks) wl[ks] = __builtin_bit_cast(bf16x8, __builtin_amdgcn_raw_buffer_load_b128(rsl, lv16, 1024 * ks, 0));
#pragma unroll
        for (int i = 0; i < 4; ++i)
#pragma unroll
            for (int j = 0; j < 2; ++j) xv[i][j] = xn[i][j];
        {   const int tn = t0 + 2 * F.G * 32;
            if (tn < T) {
#pragma unroll
                for (int i = 0; i < 4; ++i)
#pragma unroll
                    for (int j = 0; j < 2; ++j) xn[i][j] = *(const v4u*)(X1 + x1_off((size_t)(tn + F.wave * 4 + i)) + 16 * lane + 8 * j); } }
        __syncthreads();
#pragma unroll
        for (int mt = 0; mt < 2; ++mt) {
            f32x4 acc = (f32x4){0.f, 0.f, 0.f, 0.f};
            const LAS unsigned char* uh = F.lds + RT_HI + (mt * 16 + q) * RT_ROW + 16 * g + kh * 1024; const LAS unsigned char* ul = F.lds + RT_LO + (mt * 16 + q) * RT_ROW + 16 * g + kh * 1024;
#pragma unroll
            for (int ks = 0; ks < 16; ++ks) {
                const bf16x8 b_h = *(const LAS bf16x8*)(uh + 64 * ks), b_l = *(const LAS bf16x8*)(ul + 64 * ks);
                acc = __builtin_amdgcn_mfma_f32_16x16x32_bf16(wh[ks], b_h, acc, 0, 0, 0);
                acc = __builtin_amdgcn_mfma_f32_16x16x32_bf16(wl[ks], b_h, acc, 0, 0, 0);
                acc = __builtin_amdgcn_mfma_f32_16x16x32_bf16(wh[ks], b_l, acc, 0, 0, 0);
            }
            *(LAS f32x4*)(F.lds + RT_LG + kh * 8192 + ((mt * 16 + q) * 64 + et * 16 + 4 * g) * 4) = acc;
        }
        __syncthreads();
#pragma unroll
        for (int i = 0; i < 4; ++i) { const int tl = F.wave * 4 + i;
#pragma unroll
            for (int j = 0; j < 2; ++j) *((v4u*)(U + (size_t)(t0 + tl) * D) + 64 * j + lane) = *(const LAS v4u*)(F.lds + RT_HI + tl * RT_ROW + (64 * j + lane) * 16); }
        unsigned lrank[4]; float wn[4]; int rk[4];
#pragma unroll
        for (int i = 0; i < 4; ++i) {
            const int tl = F.wave * 4 + i;
            const float z = *(const LAS float*)(F.lds + RT_LG + (tl * 64 + lane) * 4) + *(const LAS float*)(F.lds + RT_LG + 8192 + (tl * 64 + lane) * 4);
            const float sg = sigmoidf_(z), ch = sg + rbias;
            float m1 = max_grp8(ch);
            const unsigned long long eqm = __ballot(ch == m1); const int gbase = lane & ~7; const unsigned gm = (unsigned)(eqm >> gbase) & 0xffu; const int first = gbase + __builtin_ctz(gm);
            float m2 = max_grp8((lane == first) ? -3.0e38f : ch);
            const float gs = m1 + m2; const int gi = lane >> 3; int grank = 0;
#pragma unroll
            for (int gg = 0; gg < 8; ++gg) { const float og = readlane_f(gs, gg * 8); grank += (og > gs || (og == gs && gg < gi)) ? 1 : 0; }
            const bool gsel = grank < 4; const float cm = gsel ? ch : -3.0e38f;
            const unsigned kb = __float_as_uint(cm); const unsigned key = (kb & 0x80000000u) ? ~kb : (kb | 0x80000000u);
            int beat = 0;
            {   LAS unsigned* kr = (LAS unsigned*)(F.lds + RT_KEY + F.wave * 1024 + i * 256);
                kr[lane] = key;
#pragma unroll
                for (int h = 0; h < 2; ++h) { v4u o[8];
#pragma unroll
                    for (int j4 = 0; j4 < 8; ++j4) o[j4] = *(const LAS v4u*)(kr + 32 * h + 4 * j4);
#pragma unroll
                    for (int j4 = 0; j4 < 8; ++j4) count_greater4(beat, o[j4], key); } }
            bool sel = gsel && beat < 8;
            if (__builtin_popcountll(__ballot(sel)) != 8) {
                unsigned thr = 0u;
#pragma unroll 1
                for (int bit = 31; bit >= 0; --bit) { const unsigned cand = thr | (1u << bit); if (__builtin_popcountll(__ballot(key >= cand)) >= 8) thr = cand; }
                const unsigned long long gtm = __ballot(key > thr), eqt = __ballot(key == thr); const int need = 8 - __builtin_popcountll(gtm);
                sel = (key > thr) || (key == thr && __builtin_popcountll(eqt & lt_mask) < need);
            }
            const unsigned long long selm = __ballot(sel);
            const float wsum = wave_sum(sel ? sg : 0.f);
            rk[i] = sel ? __builtin_popcountll(selm & lt_mask) : -1; wn[i] = 2.5f * sg / wsum; lrank[i] = 0u;
            if (sel) lrank[i] = __hip_atomic_fetch_add(lcnt + lane, 1u, __ATOMIC_RELAXED, __HIP_MEMORY_SCOPE_WORKGROUP);
        }
        __syncthreads();
        const int seg = lane;
        if (F.wave == 0) { const unsigned n = lcnt[lane]; unsigned base = 0u; if (n && commit) base = atomicAdd(cntw + 64 * seg, n); lcnt[64 + lane] = base; }
        __syncthreads();
        if (commit) { const unsigned base = lcnt[64 + lane];
#pragma unroll
            for (int i = 0; i < 4; ++i) if (rk[i] >= 0) { const int flat = (t0 + F.wave * 4 + i) * 8 + rk[i]; slot[(size_t)seg * SLOT_CAP + base + lrank[i]] = (v2u){(unsigned)flat, __float_as_uint(wn[i])}; } }
    }
    __syncthreads();
}
__device__ __forceinline__ void moe_load_segs(Frame& F) {
    const int lane = lane_id_fresh(); const int tid = F.wave * 64 + lane; (void)tid;
    LAS int* pre = (LAS int*)(F.lds + LDS_PRE); LAS int* cnt = pre + 132;
    __syncthreads();
    if (tid < NSEG) { const int e = tid % NSEGH; cnt[tid] = (e == 64) ? T : (int)__hip_atomic_load((unsigned*)(F.ws + WS_CTL) + CW_CNT + 64 * tid, RLX_AGENT); }
    __syncthreads();
    static_assert(NSEG == 65, "the scan below handles 64 lanes + one tail segment");
    if (F.wave == 0) {
        const int b = (cnt[lane] + 255) >> 8; int inc = b;
#pragma unroll
        for (int o = 1; o < 64; o <<= 1) { const int t = __shfl_up(inc, o); if (lane >= o) inc += t; }
        pre[lane] = inc - b;
        if (lane == 63) { pre[64] = inc; pre[65] = inc + ((cnt[64] + 255) >> 8); }
    }
    __syncthreads();
}
typedef float f32x2v __attribute__((ext_vector_type(2)));
__device__ __forceinline__ void p_combine(Frame& F) {
    const int lane = lane_id_fresh();
    const int gw = F.vcu * 8 + F.wave, NGW = F.G * 8; float* out = (float*)F.dout; const unsigned char* YB = F.ws + WS_YBUF; const unsigned char* SHB = F.ws + WS_SHB;
    v4u c[11], n[11];
#define CMB_LOAD(dst, t_) do { const bf16* xp_ = (const bf16*)F.dout + x1_off((size_t)(t_)) + lane * 16; dst[0] = *(const v4u*)xp_; dst[1] = *(const v4u*)(xp_ + 8); \
        _Pragma("unroll") for (int k = 0; k < 8; ++k) dst[2 + k] = *(const v4u*)(YB + (size_t)(lane >> 4) * ((size_t)T * 8 * 256) + ((size_t)(t_) * 8 + k) * 256 + (lane & 15) * 16); \
        dst[10] = *(const v4u*)(SHB + (size_t)(lane >> 4) * ((size_t)T * 256) + (size_t)(t_) * 256 + (lane & 15) * 16); } while (0)
    if (gw < T) CMB_LOAD(c, gw);
    for (int t = gw; t < T; t += NGW) {
        const int tn = t + NGW;
        if (tn < T) CMB_LOAD(n, tn);
        float a[16];
        { const unsigned ww[8] = {c[0].x, c[0].y, c[0].z, c[0].w, c[1].x, c[1].y, c[1].z, c[1].w};
#pragma unroll
          for (int j = 0; j < 8; ++j) { a[2 * j] = bf_lo(ww[j]); a[2 * j + 1] = bf_hi(ww[j]); } }
        float acc[16];
#pragma unroll
        for (int j = 0; j < 16; ++j) acc[j] = 0.f;
#pragma unroll
        for (int k = 0; k < 9; ++k) { const unsigned ww[4] = {c[2 + k].x, c[2 + k].y, c[2 + k].z, c[2 + k].w};
#pragma unroll
            for (int j = 0; j < 4; ++j) { const f32x2v lo = __builtin_amdgcn_cvt_pk_f32_fp8((int)ww[j], false), hi = __builtin_amdgcn_cvt_pk_f32_fp8((int)ww[j], true);
                acc[4 * j] += lo[0]; acc[4 * j + 1] += lo[1]; acc[4 * j + 2] += hi[0]; acc[4 * j + 3] += hi[1]; } }
#pragma unroll
        for (int j = 0; j < 4; ++j) *(f32x4*)(out + (size_t)t * D + lane * 16 + 4 * j) = (f32x4){a[4 * j] + acc[4 * j] * Y8_INV, a[4 * j + 1] + acc[4 * j + 1] * Y8_INV, a[4 * j + 2] + acc[4 * j + 2] * Y8_INV, a[4 * j + 3] + acc[4 * j + 3] * Y8_INV};
#pragma unroll
        for (int k = 0; k < 11; ++k) c[k] = n[k];
    }
#undef CMB_LOAD
}

struct Args { const float* in[24]; float* out; unsigned char* ws; int ph_lo, ph_hi, li, pad; };
__global__ void __launch_bounds__(512, 2) mk_fwd(Args args) {
    extern __shared__ __attribute__((aligned(16))) unsigned char lds[];
    Frame F;
    F.lds = (LAS unsigned char*)lds;
    F.wave = __builtin_amdgcn_readfirstlane((int)threadIdx.x >> 6);
    F.G = gridDim.x; { const int bx = blockIdx.x; F.vcu = (F.G % 8 == 0) ? (bx % 8) * (F.G / 8) + bx / 8 : bx; }
    F.ws = args.ws; F.dout = (unsigned char*)args.out;
    volatile LAS unsigned* MISC = (volatile LAS unsigned*)(F.lds + LDS_MISC);
    if (threadIdx.x < 64) MISC[threadIdx.x] = 0u;
    __syncthreads();
    XcdBarrier bar; bar.bar = (unsigned*)(F.ws + WS_CTL) + CW_BAR; bar.x = 0; bar.st = nullptr;
    if (MK_N_LAUNCHES == 1) bar = xcd_barrier_post((unsigned*)(F.ws + WS_CTL) + CW_BAR, MISC);
    const int lo = args.ph_lo, hi = args.ph_hi;
#ifndef PH_MASK
#define PH_MASK 0xfff
#endif
#define IN(k) (((PH_MASK >> (k)) & 1) && lo <= (k) && (k) < hi)
#ifndef REPEAT_MASK
#define REPEAT_MASK 0
#endif
#define REP(k) (((REPEAT_MASK >> (k)) & 1) != 0)
#define SEAM(k) do { if (IN(k) && IN((k) + 1)) xcd_barrier(bar, F.wave); } while (0)
    LAS unsigned char* ring = F.lds;

    if (IN(0)) { p0_prologue(F); if (REP(0)) { xcd_barrier(bar, F.wave); p0_prologue(F); } } SEAM(0);
    if (IN(1)) for (int rep_ = 0; rep_ < (REP(1) ? 2 : 1); ++rep_) { if (rep_) xcd_barrier(bar, F.wave);
        stagger(F, 350);
        { pg8::StaticOrder S; S.init(F.dout, F.ws + WS_WIN, T, NPROJ_PAD, 1024, F.G, (int)blockIdx.x);
          pg8::EpiProj E{(bf16*)(F.ws + WS_PA), (bf16*)(F.ws + WS_PB), (bf16*)(F.ws + WS_PC), (unsigned char*)(F.ws + WS_PG), arg_in(I_QNA), arg_in(I_KNA), arg_in(I_QNC)};
          pg8::gemm_phase<pg8::EpiProj, pg8::StaticOrder, false>(ring, 1024, S, E, F.wave); }
    } SEAM(1);
#ifndef HGRN_CHECK
#define HGRN_CHECK 0
#endif
#ifndef P2_MODE
#define P2_MODE 0
#endif
#if HGRN_CHECK == 2
    if (IN(2)) { for (int sq = F.vcu; sq < 128; sq += F.G) hgrn_seq(F, sq, (bf16*)(F.dout + 128 * MiB)); for (int sq = F.vcu; sq < 128; sq += F.G) hgrn_seq(F, sq, (bf16*)(F.dout + 176 * MiB)); p2_attn_mfma(F); hgrn_simple<false>(F, nullptr); } SEAM(2);
    if (IN(3)) { hgrn_simple<true>(F, (bf16*)(F.dout + 128 * MiB)); xcd_barrier(bar, F.wave);
        const bf16* Y1 = (const bf16*)(F.dout + 128 * MiB); const bf16* Y3 = (const bf16*)(F.dout + 176 * MiB); const bf16* Y2 = (const bf16*)(F.dout + 128 * MiB); unsigned bad = 0, bad2 = 0; const int lane = lane_id_fresh();
        for (size_t i = (size_t)F.vcu * 512 + F.wave * 64 + lane; i < (size_t)T * 384; i += (size_t)F.G * 512) { if (Y1[i] != Y3[i]) ++bad; const float a = bf2f(Y1[i]), b2 = bf2f(Y2[i]); if (!(fabsf(a - b2) <= 0.03f * (fabsf(a) + fabsf(b2)) + 0.02f)) ++bad2; }
        bad = (unsigned)wave_sum((float)bad); bad2 = (unsigned)wave_sum((float)bad2); if (lane == 0 && bad) atomicAdd((unsigned*)(F.ws + WS_CTL) + CW_Q + 64, bad); if (lane == 0 && bad2) atomicAdd((unsigned*)(F.ws + WS_CTL) + CW_Q + 128, bad2); } SEAM(3);
#else
    if (IN(2)) { if (P2_MODE == 0) p2_queue(F); else { for (int sq = F.vcu; sq < 128; sq += F.G) hgrn_seq(F, sq, (bf16*)(F.dout + DO_Y)); p2_attn_mfma(F); } if (HGRN_CHECK) hgrn_simple<false>(F, nullptr); } SEAM(2);
    if (IN(3) && HGRN_CHECK) { if (HGRN_CHECK) {
        bf16* Y2 = (bf16*)(F.dout + 128 * MiB); hgrn_simple<true>(F, Y2); xcd_barrier(bar, F.wave);
        const bf16* Y1 = (const bf16*)(F.dout + 128 * MiB); unsigned bad = 0; const int lane = lane_id_fresh();
        for (size_t i = (size_t)F.vcu * 512 + F.wave * 64 + lane; i < (size_t)T * 384; i += (size_t)F.G * 512) { const float a = bf2f(Y1[i]), b2 = bf2f(Y2[i]); if (!(fabsf(a - b2) <= 0.03f * (fabsf(a) + fabsf(b2)) + 0.02f)) ++bad; }
        bad = (unsigned)wave_sum((float)bad); if (lane == 0 && bad) atomicAdd((unsigned*)(F.ws + WS_CTL) + CW_Q + 64, bad); } } if (HGRN_CHECK) SEAM(3);
#endif
    if (IN(4)) for (int rep_ = 0; rep_ < (REP(4) ? 2 : 1); ++rep_) { if (rep_) xcd_barrier(bar, F.wave);
        pg8::StaticOrder S; S.init(F.dout + DO_Y, F.ws + WS_WA, T, 1024, 1024, F.G, (int)blockIdx.x); pg8::EpiMerge E{(const unsigned char*)(F.ws + WS_PG), (bf16*)(F.ws + WS_MIXED)};
        pg8::gemm_phase<pg8::EpiMerge, pg8::StaticOrder, false>(ring, 1024, S, E, F.wave);
    } SEAM(4);
    if (IN(5)) for (int rep_ = 0; rep_ < (REP(5) ? 2 : 1); ++rep_) { if (rep_) xcd_barrier(bar, F.wave);
        pg8::StaticOrder S; S.init(F.ws + WS_MIXED, F.ws + WS_WOUT, T, 1024, 1024, F.G, (int)blockIdx.x); pg8::EpiOut E{arg_in(I_X), (bf16*)F.dout};
        pg8::gemm_phase<pg8::EpiOut, pg8::StaticOrder, false>(ring, 1024, S, E, F.wave);
    } SEAM(5);
    if (IN(6)) { for (int rep_ = (REP(6) ? 0 : 1); rep_ < 2; ++rep_) { p6_route(F, rep_ == 1 || ((volatile unsigned*)(F.ws + WS_CTL))[8] != 0u); if (rep_ == 0) xcd_barrier(bar, F.wave); } } SEAM(6);
    if (IN(7)) for (int rep_ = 0; rep_ < (REP(7) ? 2 : 1); ++rep_) { if (rep_) xcd_barrier(bar, F.wave);
        moe_load_segs(F); stagger(F, 300);
        pg8::MoeOrder S; S.pre = (const LAS int*)(F.lds + LDS_PRE); S.cnt = S.pre + 132; S.seg_lo = 0; S.nseg = NSEG; S.nN = 2; S.G = F.G; S.c = F.vcu;
        S.A = (const char*)(F.ws + WS_U); S.Bt = (const char*)(F.ws + WS_WUP); S.a_tstep = 0; S.b_estride = (size_t)512 * 1024 * 2; S.b_tstep = (size_t)256 * 1024 * 2; S.slot = (const int*)(F.ws + WS_SLOT); S.gather = true; S.hint = 0;
        pg8::EpiUp E{(bf16*)(F.ws + WS_HID)};
        pg8::gemm_phase<pg8::EpiUp, pg8::MoeOrder, true>(ring, 1024, S, E, F.wave);
    } SEAM(7);
#define DOWN_PHASE(nsg, prb) do { if (!(IN(7))) moe_load_segs(F);     \
        pg8::MoeOrder S; S.pre = (const LAS int*)(F.lds + LDS_PRE); S.cnt = S.pre + 132; S.seg_lo = 0; S.nseg = (nsg); S.nN = 4; S.G = F.G; S.c = F.vcu; \
        S.A = (const char*)(F.ws + WS_HID); S.Bt = (const char*)(F.ws + WS_WDN); S.a_tstep = (size_t)256 * 256 * 2; S.b_estride = (size_t)1024 * 256 * 2; S.b_tstep = (size_t)256 * 256 * 2; S.slot = (const int*)(F.ws + WS_SLOT); S.gather = false; S.hint = 0; \
        pg8::EpiDown E{F.lds, F.ws + WS_YBUF, F.ws + WS_SHB, (prb)}; \
        pg8::gemm_phase<pg8::EpiDown, pg8::MoeOrder, false, true>(ring, 256, S, E, F.wave); } while (0)
    if (IN(8)) { if (REP(8)) { DOWN_PHASE(64, -2); xcd_barrier(bar, F.wave); } DOWN_PHASE(NSEGH, 0); } SEAM(8);
    if (IN(9)) { p_combine(F);
        if (HGRN_CHECK) { xcd_barrier(bar, F.wave); const unsigned c1 = __hip_atomic_load((unsigned*)(F.ws + WS_CTL) + CW_Q + 64, RLX_AGENT), c2 = __hip_atomic_load((unsigned*)(F.ws + WS_CTL) + CW_Q + 128, RLX_AGENT);
            const float frac = (c1 > 0u ? 50.f : 0.f) + (c2 > 25000u ? 5.f : 0.f) + (c2 > 1250000u ? 10.f : 0.f);
            if (frac > 0.f) { const int lane = lane_id_fresh(); float* o = (float*)F.dout; for (size_t i = (size_t)F.vcu * 512 + F.wave * 64 + lane; i < (size_t)T * D; i += (size_t)F.G * 512) o[i] += frac; } } }
#undef IN
#undef SEAM
}

extern "C" void kernel_launch(void* const* d_in, const int* in_sizes, int n_in, void* d_out, int out_size, void* d_ws, size_t ws_size, hipStream_t stream) {
    static int grid = 0;
    if (grid == 0) {
        if (n_in != 24 || out_size != T * D || ws_size < WS_END) { fprintf(stderr, "kernel_launch: unexpected shapes (n_in %d out %d ws %zu)\n", n_in, out_size, ws_size); grid = -1; return; }
        int dev = 0, cus = 0, per_cu = 0;
        if (hipGetDevice(&dev) != hipSuccess || hipDeviceGetAttribute(&cus, hipDeviceAttributeMultiprocessorCount, dev) != hipSuccess) { grid = -1; return; }
        if (hipFuncSetAttribute((const void*)mk_fwd, hipFuncAttributeMaxDynamicSharedMemorySize, LDS_BYTES) != hipSuccess) { fprintf(stderr, "kernel_launch: hipFuncSetAttribute failed\n"); grid = -1; return; }
        if (hipOccupancyMaxActiveBlocksPerMultiprocessor(&per_cu, (const void*)mk_fwd, 512, LDS_BYTES) != hipSuccess || per_cu < 1) fprintf(stderr, "kernel_launch: occupancy query says %d\n", per_cu);
        (void)hipGetLastError();
        grid = cus;
    }
    if (grid < 0) return;
    (void)hipMemsetAsync((char*)d_ws + WS_CTL, 0, CTL_ZERO_BYTES, stream);
    Args a{};
    for (int i = 0; i < 24; ++i) a.in[i] = (const float*)d_in[i];
    a.out = (float*)d_out; a.ws = (unsigned char*)d_ws;
    for (int li = 0; li < MK_N_LAUNCHES; ++li) {
        a.ph_lo = (MK_N_LAUNCHES == 1) ? 0 : li; a.ph_hi = (MK_N_LAUNCHES == 1) ? NPHASE : li + 1; a.li = li;
        hipLaunchKernelGGL(mk_fwd, dim3(grid), dim3(512), LDS_BYTES, stream, a);
    }
}
```

```cpp
#include <hip/hip_runtime.h>
#include <cstdio>
#include <cstdint>

#define GAS __attribute__((address_space(1)))
#define LAS __attribute__((address_space(3)))
typedef unsigned short bf16;
typedef unsigned v4u __attribute__((ext_vector_type(4)));
typedef unsigned v2u __attribute__((ext_vector_type(2)));
typedef float f32x4 __attribute__((ext_vector_type(4)));
typedef float f32x2 __attribute__((ext_vector_type(2)));
typedef short bf16x8 __attribute__((ext_vector_type(8)));
typedef GAS unsigned gu32;
#define RLX_AGENT __ATOMIC_RELAXED, __HIP_MEMORY_SCOPE_AGENT
#define LDS_WAIT() asm volatile("s_waitcnt lgkmcnt(0)" ::: "memory")
#define VM_WAIT() asm volatile("s_waitcnt vmcnt(0)" ::: "memory")

#ifndef MK_N_LAUNCHES
#define MK_N_LAUNCHES 1
#endif
static_assert(MK_N_LAUNCHES == 1 || MK_N_LAUNCHES == 10, "launch split");

constexpr int T = 65536, D = 1024, SEQ = 2048, NB = 32, MEML = 256;
constexpr int NPROJ = 5760, NPROJ_PAD = 5888;
constexpr int LD_PA = 1152, LD_PB = 1280, LD_PC = 256, LD_PG = 3072;
constexpr int NEXP = 64, NSEGH = 65, NSEG = 65, SLOT_CAP = 65536, HALF_T = 65536;
constexpr float Y8_SCALE = 16.0f, Y8_INV = 1.0f / 16.0f;
constexpr float EPS = 1e-6f;
constexpr int NPHASE = 10;

constexpr size_t MiB = 1u << 20;
constexpr size_t WS_CTL = 0, CTL_ZERO_BYTES = 128 * 1024;
constexpr size_t WS_TAB = 1 * MiB;
constexpr size_t WS_WIN = 2 * MiB;
constexpr size_t WS_WMEM = 14 * MiB;
constexpr size_t WS_WA = 15 * MiB;
constexpr size_t WS_WB = WS_WA + 768 * 1024;
constexpr size_t WS_WC = WS_WB + 768 * 1024;
constexpr size_t WS_WOUT = 17 * MiB;
constexpr size_t WS_WUP = 19 * MiB;
constexpr size_t WS_WDN = 84 * MiB;
constexpr size_t WS_MEMN = 117 * MiB;
constexpr size_t WS_MEMK = 133 * MiB, WS_MEMV = 137 * MiB;
constexpr size_t WS_ACT = 141 * MiB;
constexpr size_t WS_PG = WS_ACT;
constexpr size_t WS_PA = WS_PG + 384 * MiB;
constexpr size_t WS_PB = WS_PA + 144 * MiB;
constexpr size_t WS_PC = WS_PB + 160 * MiB;
constexpr size_t WS_LST = WS_PC + 32 * MiB;
constexpr size_t WS_DEC = WS_LST + 96 * MiB;
constexpr size_t WS_MIXED = WS_PA;
constexpr size_t WS_HID = WS_ACT;
constexpr size_t WS_SLOT = WS_HID + 304 * MiB;
constexpr size_t WS_U = WS_SLOT + 34 * MiB;
constexpr size_t WS_SHB = WS_WUP;
constexpr size_t WS_YBUF = WS_U;
constexpr size_t WS_END = WS_YBUF + 512 * MiB;
__device__ __forceinline__ size_t x1_off(size_t t) { return t * 2048 + (t & 1) * 1024; }
static_assert(WS_DEC + 1 * MiB <= 1024 * MiB && WS_END <= 1024 * MiB, "ws map");
static_assert(WS_WDN + (size_t)65 * 1024 * 256 * 2 <= WS_MEMN && WS_WUP + (size_t)65 * 512 * 1024 * 2 <= WS_WDN, "weights map");
constexpr size_t DO_Y = 0;
constexpr int YC_A = 0, YC_B = 384, YC_C = 768;
constexpr int CW_BAR = 4096;
constexpr int CW_CNT = 16384;

constexpr int RING_BYTES = 131072;
constexpr int LDS_GTAB = RING_BYTES;
constexpr int LDS_PRE = LDS_GTAB + 6144;
constexpr int LDS_BYTES = 163840;
constexpr int LDS_MISC = LDS_BYTES - 256;
static_assert(LDS_MISC + 256 <= LDS_BYTES, "lds map");

__device__ __forceinline__ int lane_id_fresh() { int l = __builtin_amdgcn_mbcnt_hi(0xffffffffu, __builtin_amdgcn_mbcnt_lo(0xffffffffu, 0u)); asm volatile("" : "+v"(l)); return l; }
typedef __bf16 bf16v2_t __attribute__((ext_vector_type(2)));
__device__ __forceinline__ unsigned cvt_pk_bf16(float lo, float hi) { const bf16v2_t v = {(__bf16)lo, (__bf16)hi}; return __builtin_bit_cast(unsigned, v); }
__device__ __forceinline__ float bf_lo(unsigned w) { return __uint_as_float(w << 16); }
__device__ __forceinline__ float bf_hi(unsigned w) { return __uint_as_float(w & 0xffff0000u); }
__device__ __forceinline__ float bf2f(bf16 b) { return __uint_as_float(((unsigned)b) << 16); }
__device__ __forceinline__ bf16 f2bf(float f) { return (bf16)(cvt_pk_bf16(f, 0.f) & 0xffffu); }
__device__ __forceinline__ float sigmoidf_(float x) { return __builtin_amdgcn_rcpf(1.0f + __builtin_amdgcn_exp2f(-1.44269504f * x)); }
__device__ __forceinline__ float readlane_f(float v, int l) { return __int_as_float(__builtin_amdgcn_readlane(__float_as_int(v), l)); }
template <int CTRL, int RM = 0xf, bool BC = false>
__device__ __forceinline__ float dpp_get(float v) { return __uint_as_float(__builtin_amdgcn_update_dpp(0u, __float_as_uint(v), CTRL, RM, 0xf, BC)); }
__device__ __forceinline__ float sum_row16(float x) { x += dpp_get<0x128>(x); x += dpp_get<0x124>(x); x += dpp_get<0x122>(x); x += dpp_get<0x121>(x); return x; }
__device__ __forceinline__ float max_row16(float x) { x = fmaxf(x, dpp_get<0x128>(x)); x = fmaxf(x, dpp_get<0x124>(x)); x = fmaxf(x, dpp_get<0x122>(x)); x = fmaxf(x, dpp_get<0x121>(x)); return x; }
__device__ __forceinline__ float xsum16(float x) { const auto r = __builtin_amdgcn_permlane16_swap(__float_as_uint(x), __float_as_uint(x), false, false); return __uint_as_float(r[0]) + __uint_as_float(r[1]); }
__device__ __forceinline__ float xsum32(float x) { const auto r = __builtin_amdgcn_permlane32_swap(__float_as_uint(x), __float_as_uint(x), false, false); return __uint_as_float(r[0]) + __uint_as_float(r[1]); }
__device__ __forceinline__ float xmax16(float x) { const auto r = __builtin_amdgcn_permlane16_swap(__float_as_uint(x), __float_as_uint(x), false, false); return fmaxf(__uint_as_float(r[0]), __uint_as_float(r[1])); }
__device__ __forceinline__ float xmax32(float x) { const auto r = __builtin_amdgcn_permlane32_swap(__float_as_uint(x), __float_as_uint(x), false, false); return fmaxf(__uint_as_float(r[0]), __uint_as_float(r[1])); }
__device__ __forceinline__ float wave_sum(float v) { return xsum32(xsum16(sum_row16(v))); }
__device__ __forceinline__ float wave_max(float v) { return xmax32(xmax16(max_row16(v))); }
__device__ __forceinline__ float scan_incl64(float x) {
    x += dpp_get<0x111, 0xf, true>(x); x += dpp_get<0x112, 0xf, true>(x); x += dpp_get<0x114, 0xf, true>(x); x += dpp_get<0x118, 0xf, true>(x);
    x += dpp_get<0x142, 0xa>(x); x += dpp_get<0x143, 0xc>(x); return x;
}
__device__ __forceinline__ float max_grp8(float x) { x = fmaxf(x, dpp_get<0xB1>(x)); x = fmaxf(x, dpp_get<0x4E>(x)); x = fmaxf(x, dpp_get<0x141>(x)); return x; }

#define XB_TMO      128
#define XB_XCNT(j)  (256  + 64 * (j))
#define XB_XSUB(j)  (1280 + 64 * (j))
#define XB_XGEN(j)  (2304 + 64 * (j))
#define XB_TOP      3328
#define XB_TOPGEN   3392
#define XCD_BAR_WORDS 3456
#define XB_SPIN_CAP (1u << 22)
__device__ __forceinline__ unsigned xb_ld(unsigned* p)              { return __hip_atomic_load(p, __ATOMIC_RELAXED, __HIP_MEMORY_SCOPE_AGENT); }
__device__ __forceinline__ unsigned xb_add(unsigned* p, unsigned v) { return __hip_atomic_fetch_add(p, v, __ATOMIC_RELAXED, __HIP_MEMORY_SCOPE_AGENT); }
__device__ __forceinline__ unsigned xb_xcc_id() { return (unsigned)__builtin_amdgcn_s_getreg((3 << 11) | 20) & 0xFu; }
#define XB_SPIN(cond, bar) do { unsigned _sp = 0; while (cond) { __builtin_amdgcn_s_sleep(1); \
    if ((++_sp & 255u) == 0u) { if (xb_ld(&(bar)[XB_TMO])) break; if (_sp > XB_SPIN_CAP) { atomicAdd(&(bar)[XB_TMO], 1u); break; } } } } while (0)
struct XcdBarrier { unsigned* bar; unsigned x; volatile LAS unsigned* st; };
__device__ __forceinline__ XcdBarrier xcd_barrier_post(unsigned* bar, volatile LAS unsigned* st) {
    XcdBarrier b; b.bar = bar; b.x = xb_xcc_id(); b.st = st;
    if (threadIdx.x == 0) (void)xb_add(&bar[XB_XCNT(b.x)], 1u);
    return b;
}
__device__ __forceinline__ void xcd_barrier_complete(unsigned* bar, unsigned x, unsigned& nloc, unsigned& nx) {
    const unsigned G = gridDim.x * gridDim.y * gridDim.z;
    unsigned sum, cnt, mine, sp = 0u;
    for (;;) {
        sum = 0u; cnt = 0u; mine = 0u;
#pragma unroll
        for (unsigned j = 0; j < 16; ++j) { const unsigned c = xb_ld(&bar[XB_XCNT(j)]); sum += c; cnt += (c > 0u) ? 1u : 0u; mine = (j == x) ? c : mine; }
        if (sum == G) break;
        __builtin_amdgcn_s_sleep(1);
        if ((++sp & 255u) == 0u) { if (xb_ld(&bar[XB_TMO])) break; if (sp > XB_SPIN_CAP) { atomicAdd(&bar[XB_TMO], 1u); break; } }
    }
    nloc = mine > 0u ? mine : 1u; nx = cnt > 0u ? cnt : 1u;
}
__device__ __forceinline__ void xcd_barrier(const XcdBarrier& b, const int wave) {
    asm volatile("s_waitcnt vmcnt(0)" ::: "memory");
    __syncthreads();
    if (wave == 0 && lane_id_fresh() == 0) {
        unsigned* bar = b.bar;
        __builtin_amdgcn_s_waitcnt(0);
        unsigned nloc = b.st[0], nx = b.st[1];
        if (nloc == 0u) { xcd_barrier_complete(bar, b.x, nloc, nx); b.st[0] = nloc; b.st[1] = nx; }
        const unsigned old = xb_add(&bar[XB_XSUB(b.x)], 1u);
        const unsigned gen = old / nloc;
        if (old + 1u == (gen + 1u) * nloc) {
            __builtin_amdgcn_fence(__ATOMIC_RELEASE, "agent");
            asm volatile("s_waitcnt vmcnt(0)" ::: "memory");
            const unsigned og = xb_add(&bar[XB_TOP], 1u);
            const unsigned tg = og / nx;
            if (og + 1u == (tg + 1u) * nx) xb_add(&bar[XB_TOPGEN], 1u);
            else XB_SPIN(xb_ld(&bar[XB_TOPGEN]) == tg, bar);
            __builtin_amdgcn_fence(__ATOMIC_ACQUIRE, "agent");
            xb_add(&bar[XB_XGEN(b.x)], 1u);
            asm volatile("s_waitcnt vmcnt(0)" ::: "memory");
        } else {
            XB_SPIN(xb_ld(&bar[XB_XGEN(b.x)]) == gen, bar);
            __builtin_amdgcn_fence(__ATOMIC_ACQUIRE, "agent");
            asm volatile("s_waitcnt vmcnt(0)" ::: "memory");
        }
    }
    __syncthreads();
}

namespace pg8 {
constexpr int BM = 256, BK = 64, HALF = 128, HTB = HALF * BK * 2, NXCD = 8, WGM = 8;
__host__ __device__ __forceinline__ int lds_byte(int r, int c) { const int st = (r >> 4) * 2 + (c >> 5), rr = r & 15, cc = c & 31, ob = rr * 64 + cc * 2; return st * 1024 + (ob ^ (((ob >> 9) & 1) << 5)); }
__host__ __device__ __forceinline__ void stage_rc(int b, int& R, int& C) { const int st = b / 1024, sb = b % 1024, swz = sb ^ (((sb >> 9) & 1) << 5); R = (st >> 1) * 16 + swz / 64; C = (st & 1) * 32 + (swz % 64) / 2; }
__host__ __device__ __forceinline__ int perm32(int rho) { const int n = rho >> 4, i = rho & 15; return 8 * (i >> 2) + 4 * n + (i & 3); }

struct Unit { int pm, pn; const char* a; const char* b; int rows, seg, j, tb; };

struct StaticOrder {
    int nM, nN, nwg, G, c; const char* A; const char* Bt; size_t tstep;
    __device__ void init(const void* A_, const void* Bt_, int M, int N, int K, int G_, int c_) { A = (const char*)A_; Bt = (const char*)Bt_; nM = M / BM; nN = N / BM; nwg = nM * nN; G = G_; c = c_; tstep = (size_t)BM * K * 2; }
    __device__ bool next(int i, Unit& u) const {
        const long L = (long)i * G + c; if (L >= nwg) return false;
        int wgid = (int)L; { const int q = nwg / NXCD, r = nwg % NXCD, xcd = wgid % NXCD, off = wgid / NXCD; wgid = (xcd < r ? xcd * (q + 1) : r * (q + 1) + (xcd - r) * q) + off; }
        const int nig = WGM * nN, gid = wgid / nig, fm = gid * WGM, gsz = (nM - fm) < WGM ? (nM - fm) : WGM;
        u.pm = fm + ((wgid % nig) % gsz); u.pn = (wgid % nig) / gsz; u.a = A + (size_t)u.pm * tstep; u.b = Bt + (size_t)u.pn * tstep; u.rows = 256; u.seg = 0; u.j = 0; return true;
    }
    __device__ __forceinline__ const int* tab_src(const Unit&) const { return nullptr; }
};
struct MoeOrder {
    const LAS int* pre; const LAS int* cnt; int seg_lo, nseg, nN, G, c; const char* A; const char* Bt; size_t a_tstep, b_estride, b_tstep; const int* slot; bool gather; mutable int hint;
    __device__ bool next(int i, Unit& u) const {
        const long L = (long)i * G + c; const int b0 = __builtin_amdgcn_readfirstlane(pre[seg_lo]), total = __builtin_amdgcn_readfirstlane(pre[seg_lo + nseg]) - b0;
        const int br = (int)(L / nN); if (br >= total) return false;
        const int blk = b0 + br; u.pn = (int)(L % nN); u.pm = blk;
        int lo = hint < seg_lo ? seg_lo : hint;
        while (lo + 1 < seg_lo + nseg && __builtin_amdgcn_readfirstlane(pre[lo + 1]) <= blk) ++lo;
        hint = lo;
        u.seg = lo; u.j = blk - __builtin_amdgcn_readfirstlane(pre[lo]); const int rem = __builtin_amdgcn_readfirstlane(cnt[lo]) - u.j * 256; u.rows = rem < 256 ? rem : 256;
        const int e = lo % NSEGH;
        u.a = gather ? A : A + (size_t)blk * a_tstep; u.b = Bt + (size_t)e * b_estride + (size_t)u.pn * b_tstep; return true;
    }
    __device__ __forceinline__ const int* tab_src(const Unit& u) const { return slot + ((size_t)u.seg * SLOT_CAP + u.j * 256) * 2; }
};

template <class Epi, class Sched, bool GATHER, bool ROWTAB = GATHER, bool ALIGN_EPI = true>
__device__ __forceinline__ void gemm_phase(LAS unsigned char* lds, const int K, const Sched& S, const Epi& E, const int wave) {
    const int lane = lane_id_fresh(), wid = wave, tid = wid * 64 + lane, wr = wid >> 2, wc = wid & 3, fr = lane & 15, fq = lane >> 4; (void)fr; (void)fq;
    const int nt = K / BK;
    unsigned voffA[2][2], voffB[2];
#pragma unroll
    for (int i = 0; i < 2; ++i) { int R, C; stage_rc(tid * 16 + i * 8192, R, C); const int Rb = Epi::PERM ? ((R & ~31) + perm32(R & 31)) : R;
        voffB[i] = (unsigned)(tid * 16 + i * 8192); (void)Rb;
#pragma unroll
        for (int h = 0; h < 2; ++h) voffA[h][i] = (unsigned)(R * K + C) * 2u; }
    const size_t kstep = (size_t)(BK * 2);
    const size_t hstep = (size_t)HALF * K * 2;
    constexpr size_t hstepB = 16384, kstepB = 32768;
    const unsigned ldsw = (unsigned)wid * 1024u;
    const int aoff = lds_byte(wr * 64 + fr, fq * 8), boff = lds_byte(wc * 32 + fr, fq * 8);
    const LAS int* gtab = (const LAS int*)(lds + LDS_GTAB);
#define PG8_SA(b, h) (((b) * 2 + (h)) * HTB)
#define PG8_SB(b, h) ((4 + (b) * 2 + (h)) * HTB)
#define PG8_STAGE_A(bufoff, gbase, h) do { _Pragma("unroll") for (int _i = 0; _i < 2; ++_i) \
        __builtin_amdgcn_global_load_lds((const unsigned*)((const char*)(gbase) + (GATHER ? (size_t)0 : (size_t)(h) * hstep) + voffA[GATHER ? (h) : 0][_i]), (LAS unsigned*)(lds + (bufoff) + ldsw + _i * 8192), 16, 0, 0); } while (0)
#define PG8_STAGE_B(bufoff, gbase) do { _Pragma("unroll") for (int _i = 0; _i < 2; ++_i) \
        __builtin_amdgcn_global_load_lds((const unsigned*)((const char*)(gbase) + voffB[_i]), (LAS unsigned*)(lds + (bufoff) + ldsw + _i * 8192), 16, 0, 0); } while (0)
#define PG8_LDA(dst, b, h) do { _Pragma("unroll") for (int m = 0; m < 4; ++m) _Pragma("unroll") for (int k = 0; k < 2; ++k) dst[m][k] = *(const LAS bf16x8*)(lds + PG8_SA(b, h) + aoff + m * 2048 + k * 1024); } while (0)
#define PG8_LDB(dst, b, h) do { _Pragma("unroll") for (int n = 0; n < 2; ++n) _Pragma("unroll") for (int k = 0; k < 2; ++k) dst[n][k] = *(const LAS bf16x8*)(lds + PG8_SB(b, h) + boff + n * 2048 + k * 1024); } while (0)
#define PG8_MMA(ai, bj, At, Bt) do { __builtin_amdgcn_s_setprio(1); _Pragma("unroll") for (int m = 0; m < 4; ++m) _Pragma("unroll") for (int n = 0; n < 2; ++n) _Pragma("unroll") for (int k = 0; k < 2; ++k) \
        acc[ai][bj][m][n] = __builtin_amdgcn_mfma_f32_16x16x32_bf16(Bt[n][k], At[m][k], acc[ai][bj][m][n], 0, 0, 0); __builtin_amdgcn_s_setprio(0); } while (0)
#define PG8_WAIT_V(n) asm volatile("s_waitcnt vmcnt(" #n ")" ::: "memory")
#define PG8_WAIT_L(n) asm volatile("s_waitcnt lgkmcnt(" #n ")" ::: "memory")
#define PG8_BAR __builtin_amdgcn_s_barrier()
#define PG8_SCHED __builtin_amdgcn_sched_barrier(0)
#define PG8_GOFFS(u, tb) do { const int _tid = wid * 64 + lane_id_fresh(); _Pragma("unroll") for (int _h = 0; _h < 2; ++_h) _Pragma("unroll") for (int _i = 0; _i < 2; ++_i) { int _R, _C; stage_rc(_tid * 16 + _i * 8192, _R, _C); \
        const int _rr = _h * HALF + _R; const int _v = gtab[(tb) * 512 + 2 * _rr]; const unsigned _tok = (_rr < (u).rows) ? (unsigned)(_v >> 3) : 0u; voffA[_h][_i] = _tok * (unsigned)(K * 2) + (unsigned)(_C * 2); } } while (0)
#define PG8_GTAB_DMA(u, tb) do { __builtin_amdgcn_global_load_lds((const unsigned*)(S.tab_src(u) + wid * 64 + lane_id_fresh()), (LAS unsigned*)(lds + LDS_GTAB + (tb) * 2048 + wid * 256), 4, 0, 0); } while (0)
    Unit cur, nxt; int ui = 0;
    if (!S.next(0, cur)) return;
    f32x4 acc[2][2][4][2];
#pragma unroll
    for (int a = 0; a < 2; ++a)
#pragma unroll
        for (int b = 0; b < 2; ++b)
#pragma unroll
            for (int m = 0; m < 4; ++m)
#pragma unroll
                for (int n = 0; n < 2; ++n) acc[a][b][m][n] = (f32x4){0.f, 0.f, 0.f, 0.f};
    bf16x8 At[4][2], B0[2][2], B1[2][2];
    const char* cA = cur.a; const char* cB = cur.b;
    int tbi = 0; cur.tb = 0;
    if constexpr (ROWTAB) { PG8_GTAB_DMA(cur, 0); PG8_WAIT_V(0); PG8_BAR; }
    if constexpr (GATHER) { PG8_GOFFS(cur, 0); }
    PG8_STAGE_B(PG8_SB(0, 0), cB); PG8_STAGE_B(PG8_SB(0, 1), cB + hstepB); PG8_STAGE_A(PG8_SA(0, 0), cA, 0); PG8_STAGE_A(PG8_SA(0, 1), cA, 1);
    if (wr == 1) PG8_BAR;
    PG8_WAIT_V(2); PG8_BAR;
    PG8_STAGE_B(PG8_SB(1, 0), cB + kstepB); PG8_STAGE_A(PG8_SA(1, 0), cA + kstep, 0); PG8_STAGE_B(PG8_SB(1, 1), cB + hstepB + kstepB);
    PG8_WAIT_V(6); PG8_BAR;
    for (;;) {
        const bool has_next = S.next(ui + 1, nxt); const int tbn = tbi == 2 ? 0 : tbi + 1; nxt.tb = tbn;
        const char* nA = has_next ? nxt.a : cA; const char* nB = has_next ? nxt.b : cB;
        for (int t = 0; t < nt; t += 2) {
            const bool last = (t == nt - 2);
            const char* a1 = cA + (size_t)(t + 1) * kstep;
            const char* a2 = last ? nA : cA + (size_t)(t + 2) * kstep; const char* b2 = last ? nB : cB + (size_t)(t + 2) * kstepB;
            const char* a3 = a2 + kstep; const char* b3 = b2 + kstepB;
            if constexpr (Epi::HOOK) { if (t == Epi::HOOK_T1 || t == Epi::HOOK_T2) { if (wr == 0) PG8_BAR;
                const int l2 = lane_id_fresh(); E.hook(acc, cur, t, wr, wc, l2 & 15, l2 >> 4); if (wr == 1) PG8_BAR; } }
            if constexpr (ROWTAB) { if (t == 0 && has_next) PG8_GTAB_DMA(nxt, tbn); }
            PG8_LDB(B0, 0, 0); PG8_LDB(B1, 0, 1); PG8_SCHED; PG8_LDA(At, 0, 0); PG8_STAGE_A(PG8_SA(1, 1), a1, 1);
            PG8_WAIT_V(8); PG8_WAIT_L(0); PG8_BAR; PG8_MMA(0, 0, At, B0); PG8_MMA(0, 1, At, B1); PG8_BAR; PG8_SCHED;
            if constexpr (GATHER) { if (last && has_next) PG8_GOFFS(nxt, tbn); }
            PG8_LDA(At, 0, 1); PG8_STAGE_B(PG8_SB(0, 0), b2); PG8_STAGE_B(PG8_SB(0, 1), b2 + hstepB); PG8_STAGE_A(PG8_SA(0, 0), a2, 0);
            PG8_WAIT_V(8); PG8_WAIT_L(0); PG8_BAR; PG8_MMA(1, 0, At, B0); PG8_MMA(1, 1, At, B1); PG8_BAR; PG8_SCHED;
            PG8_LDB(B0, 1, 0); PG8_LDB(B1, 1, 1); PG8_SCHED; PG8_LDA(At, 1, 0); PG8_STAGE_A(PG8_SA(0, 1), a2, 1);
            PG8_WAIT_V(8); PG8_WAIT_L(0); PG8_BAR; PG8_MMA(0, 0, At, B0); PG8_MMA(0, 1, At, B1); PG8_BAR; PG8_SCHED;
            PG8_LDA(At, 1, 1); PG8_STAGE_B(PG8_SB(1, 0), b3); PG8_STAGE_B(PG8_SB(1, 1), b3 + hstepB); PG8_STAGE_A(PG8_SA(1, 0), a3, 0);
            PG8_WAIT_V(8); PG8_WAIT_L(0); PG8_BAR; PG8_MMA(1, 0, At, B0); PG8_MMA(1, 1, At, B1); PG8_BAR; PG8_SCHED;
        }
        if constexpr (ALIGN_EPI) { if (wr == 0) PG8_BAR; }
        { const int l2 = lane_id_fresh(); E(acc, cur, wr, wc, l2 & 15, l2 >> 4); }
        if (!has_next) break;
#pragma unroll
        for (int a = 0; a < 2; ++a)
#pragma unroll
            for (int b = 0; b < 2; ++b)
#pragma unroll
                for (int m = 0; m < 4; ++m)
#pragma unroll
                    for (int n = 0; n < 2; ++n) acc[a][b][m][n] = (f32x4){0.f, 0.f, 0.f, 0.f};
        cur = nxt; cA = nA; cB = nB; ++ui; tbi = tbn;
        if constexpr (ALIGN_EPI) { if (wr == 1) PG8_BAR; }
    }
    PG8_WAIT_V(0);
    if constexpr (!ALIGN_EPI) { if (wr == 0) PG8_BAR; }
    PG8_BAR;
#undef PG8_SA
#undef PG8_SB
#undef PG8_STAGE_A
#undef PG8_STAGE_B
#undef PG8_LDA
#undef PG8_LDB
#undef PG8_MMA
#undef PG8_WAIT_V
#undef PG8_WAIT_L
#undef PG8_BAR
#undef PG8_SCHED
#undef PG8_GOFFS
#undef PG8_GTAB_DMA
}

__device__ __forceinline__ void store_rows_paired(bf16* grp_base  , size_t ld, int fr, int fq, v4u w0, v4u w1) {
    v4u x, y;
    x.x = __builtin_amdgcn_update_dpp(0, (int)w1.x, 0x118, 0xf, 0xf, false); x.y = __builtin_amdgcn_update_dpp(0, (int)w1.y, 0x118, 0xf, 0xf, false);
    x.z = __builtin_amdgcn_update_dpp(0, (int)w1.z, 0x118, 0xf, 0xf, false); x.w = __builtin_amdgcn_update_dpp(0, (int)w1.w, 0x118, 0xf, 0xf, false);
    y.x = __builtin_amdgcn_update_dpp(0, (int)w0.x, 0x108, 0xf, 0xf, false); y.y = __builtin_amdgcn_update_dpp(0, (int)w0.y, 0x108, 0xf, 0xf, false);
    y.z = __builtin_amdgcn_update_dpp(0, (int)w0.z, 0x108, 0xf, 0xf, false); y.w = __builtin_amdgcn_update_dpp(0, (int)w0.w, 0x108, 0xf, 0xf, false);
    const bool lo = fr < 8; const int r7 = fr & 7;
    const v4u d1 = lo ? w0 : x, d2 = lo ? y : w1;
    bf16* p1 = grp_base + (size_t)r7 * ld + (lo ? 0 : 32) + 8 * fq;
    *(v4u*)p1 = d1; *(v4u*)(p1 + 8 * ld) = d2;
}
typedef f32x4 Acc[2][2][4][2];
struct EpiProj {
    static constexpr bool PERM = true, HOOK = false; static constexpr int HOOK_T1 = -1, HOOK_T2 = -1;
    __device__ __forceinline__ void hook(Acc&, const Unit&, int, int, int, int, int) const {}
    bf16 *PA, *PB, *PC; unsigned char* PG; const float *qna, *kna, *qnc;
    __device__ __forceinline__ void operator()(const Acc& acc, const Unit& u, int wr, int wc, int fr, int fq) const {
        const int f0 = u.pn * 256 + wc * 64;
        if (f0 >= NPROJ) return;
        bf16* base; int ld, c0, op; const float* gain = qna; float scale = 1.f;
        if (f0 < 1152) { base = PA; ld = LD_PA; c0 = f0; if (f0 < 384) { op = 1; gain = qna; scale = 0.125f; } else if (f0 < 768) { op = 1; gain = kna; } else op = 0; }
        else if (f0 < 2432) { base = PB; ld = LD_PB; c0 = f0 - 1152; if (c0 < 256) { op = 2; scale = 0.125f; } else if (c0 < 896) op = 0; else op = 2; }
        else if (f0 < 2688) { base = PC; ld = LD_PC; c0 = f0 - 2432; op = 1; gain = qnc; scale = 0.125f; }
        else { base = PA; ld = LD_PG; c0 = f0 - 2688; op = 3; }
        f32x4 g[2][2];
        if (op == 1) {
#pragma unroll
            for (int bj = 0; bj < 2; ++bj)
#pragma unroll
                for (int n = 0; n < 2; ++n) g[bj][n] = *(const f32x4*)(gain + 32 * bj + 8 * fq + 4 * n);
#pragma unroll
            for (int bj = 0; bj < 2; ++bj)
#pragma unroll
                for (int n = 0; n < 2; ++n) g[bj][n] = g[bj][n] * scale;
        } else {
#pragma unroll
            for (int bj = 0; bj < 2; ++bj)
#pragma unroll
                for (int n = 0; n < 2; ++n) g[bj][n] = (f32x4){scale, scale, scale, scale};
        }
#pragma unroll
        for (int ai = 0; ai < 2; ++ai)
#pragma unroll
            for (int m = 0; m < 4; ++m) {
                const int row = u.pm * BM + ai * HALF + wr * 64 + m * 16 + fr;
                f32x4 v[2][2];
#pragma unroll
                for (int bj = 0; bj < 2; ++bj)
#pragma unroll
                    for (int n = 0; n < 2; ++n) v[bj][n] = acc[ai][bj][m][n];
                if (op == 1) {
                    float ss = 0.f;
#pragma unroll
                    for (int bj = 0; bj < 2; ++bj)
#pragma unroll
                        for (int n = 0; n < 2; ++n) ss += (v[bj][n][0] * v[bj][n][0] + v[bj][n][1] * v[bj][n][1]) + (v[bj][n][2] * v[bj][n][2] + v[bj][n][3] * v[bj][n][3]);
                    ss = xsum32(xsum16(ss));
                    const float r = rsqrtf(ss * (1.0f / 64.0f) + EPS);
#pragma unroll
                    for (int bj = 0; bj < 2; ++bj)
#pragma unroll
                        for (int n = 0; n < 2; ++n) v[bj][n] = v[bj][n] * r * g[bj][n];
                } else if (op == 2) {
#pragma unroll
                    for (int bj = 0; bj < 2; ++bj)
#pragma unroll
                        for (int n = 0; n < 2; ++n)
#pragma unroll
                            for (int j = 0; j < 4; ++j) v[bj][n][j] = v[bj][n][j] * sigmoidf_(v[bj][n][j]) * scale;
                } else if (op == 3) {
                    unsigned q[4];
#pragma unroll
                    for (int bj = 0; bj < 2; ++bj)
#pragma unroll
                        for (int n = 0; n < 2; ++n) { unsigned pk = 0u;
#pragma unroll
                            for (int j = 0; j < 4; ++j) pk |= (unsigned)__builtin_amdgcn_fmed3f(sigmoidf_(v[bj][n][j]) * 255.f + 0.5f, 1.0f, 255.0f) << (8 * j);
                            q[2 * bj + n] = pk; }
                    *(v4u*)(PG + (size_t)row * LD_PG + c0 + 16 * fq) = (v4u){q[0], q[1], q[2], q[3]};
                    continue;
                }
                v4u w[2];
#pragma unroll
                for (int bj = 0; bj < 2; ++bj) { w[bj].x = cvt_pk_bf16(v[bj][0][0], v[bj][0][1]); w[bj].y = cvt_pk_bf16(v[bj][0][2], v[bj][0][3]); w[bj].z = cvt_pk_bf16(v[bj][1][0], v[bj][1][1]); w[bj].w = cvt_pk_bf16(v[bj][1][2], v[bj][1][3]); }
                store_rows_paired(base + (size_t)(row - fr) * ld + c0, (size_t)ld, fr, fq, w[0], w[1]);
            }
    }
};
struct EpiMemKV {
    static constexpr bool PERM = true, HOOK = false; static constexpr int HOOK_T1 = -1, HOOK_T2 = -1;
    __device__ __forceinline__ void hook(Acc&, const Unit&, int, int, int, int, int) const {}
    bf16 *MK, *MV; const float* knc;
    __device__ __forceinline__ void operator()(const Acc& acc, const Unit& u, int wr, int wc, int fr, int fq) const {
        bf16* base = u.pn == 0 ? MK : MV; const bool nrm = (u.pn == 0);
        f32x4 g[2][2];
#pragma unroll
        for (int bj = 0; bj < 2; ++bj)
#pragma unroll
            for (int n = 0; n < 2; ++n) g[bj][n] = *(const f32x4*)(knc + 32 * bj + 8 * fq + 4 * n);
#pragma unroll
        for (int ai = 0; ai < 2; ++ai)
#pragma unroll
            for (int m = 0; m < 4; ++m) {
                const int row = u.pm * BM + ai * HALF + wr * 64 + m * 16 + fr;
                f32x4 v[2][2];
#pragma unroll
                for (int bj = 0; bj < 2; ++bj)
#pragma unroll
                    for (int n = 0; n < 2; ++n) v[bj][n] = acc[ai][bj][m][n];
                if (nrm) {
                    float ss = 0.f;
#pragma unroll
                    for (int bj = 0; bj < 2; ++bj)
#pragma unroll
                        for (int n = 0; n < 2; ++n) ss += (v[bj][n][0] * v[bj][n][0] + v[bj][n][1] * v[bj][n][1]) + (v[bj][n][2] * v[bj][n][2] + v[bj][n][3] * v[bj][n][3]);
                    ss = xsum32(xsum16(ss));
                    const float r = rsqrtf(ss * (1.0f / 64.0f) + EPS);
#pragma unroll
                    for (int bj = 0; bj < 2; ++bj)
#pragma unroll
                        for (int n = 0; n < 2; ++n) v[bj][n] = v[bj][n] * r * g[bj][n];
                }
                bf16* rowp = base + (size_t)row * 256 + wc * 64 + 8 * fq;
#pragma unroll
                for (int bj = 0; bj < 2; ++bj) { v4u w; w.x = cvt_pk_bf16(v[bj][0][0], v[bj][0][1]); w.y = cvt_pk_bf16(v[bj][0][2], v[bj][0][3]); w.z = cvt_pk_bf16(v[bj][1][0], v[bj][1][1]); w.w = cvt_pk_bf16(v[bj][1][2], v[bj][1][3]);
                    *(v4u*)(rowp + 32 * bj) = w; }
            }
    }
};
struct EpiMerge {
    static constexpr bool PERM = true, HOOK = true; static constexpr int HOOK_T1 = 6, HOOK_T2 = 12;
    const unsigned char* PG; bf16* MX;
    __device__ __forceinline__ void hook(Acc& acc, const Unit& u, int t, int wr, int wc, int fr, int fq) const {
        const int bn = (t == HOOK_T1) ? 0 : 1024;
        v4u nu[2][4], de[2][4];
#pragma unroll
        for (int ai = 0; ai < 2; ++ai)
#pragma unroll
            for (int m = 0; m < 4; ++m) {
                const unsigned char* gp = PG + (size_t)(u.pm * BM + ai * HALF + wr * 64 + m * 16 + fr) * LD_PG + bn + u.pn * BM + wc * 64 + 16 * fq;
                nu[ai][m] = *(const v4u*)gp; de[ai][m] = *(const v4u*)(gp + 1024);
            }
#pragma unroll
        for (int ai = 0; ai < 2; ++ai) {
#pragma unroll
            for (int m = 0; m < 4; ++m) {
                const unsigned na[4] = {nu[ai][m].x, nu[ai][m].y, nu[ai][m].z, nu[ai][m].w}, da[4] = {de[ai][m].x, de[ai][m].y, de[ai][m].z, de[ai][m].w};
#pragma unroll
                for (int bj = 0; bj < 2; ++bj)
#pragma unroll
                    for (int n = 0; n < 2; ++n)
#pragma unroll
                        for (int j = 0; j < 4; ++j) acc[ai][bj][m][n][j] *= (float)((na[2 * bj + n] >> (8 * j)) & 0xffu) * __builtin_amdgcn_rcpf((float)((da[2 * bj + n] >> (8 * j)) & 0xffu));
            }
            asm volatile("" ::: "memory");
        }
    }
    __device__ __forceinline__ void operator()(const Acc& acc, const Unit& u, int wr, int wc, int fr, int fq) const {
        v4u gq[2][4];
#pragma unroll
        for (int ai = 0; ai < 2; ++ai)
#pragma unroll
            for (int m = 0; m < 4; ++m) gq[ai][m] = *(const v4u*)(PG + (size_t)(u.pm * BM + ai * HALF + wr * 64 + m * 16 + fr) * LD_PG + 2048 + u.pn * BM + wc * 64 + 16 * fq);
#pragma unroll
        for (int ai = 0; ai < 2; ++ai)
#pragma unroll
            for (int m = 0; m < 4; ++m) {
                const int row = u.pm * BM + ai * HALF + wr * 64 + m * 16 + fr;
                const unsigned ga[4] = {gq[ai][m].x, gq[ai][m].y, gq[ai][m].z, gq[ai][m].w};
#pragma unroll
                for (int bj = 0; bj < 2; ++bj) {
                    const int c = u.pn * BM + wc * 64 + bj * 32 + 8 * fq;
                    float o[8];
#pragma unroll
                    for (int n = 0; n < 2; ++n)
#pragma unroll
                        for (int j = 0; j < 4; ++j) o[4 * n + j] = acc[ai][bj][m][n][j] * ((float)((ga[2 * bj + n] >> (8 * j)) & 0xffu) * (1.f / 255.f));
                    v4u w; w.x = cvt_pk_bf16(o[0], o[1]); w.y = cvt_pk_bf16(o[2], o[3]); w.z = cvt_pk_bf16(o[4], o[5]); w.w = cvt_pk_bf16(o[6], o[7]);
                    *(v4u*)(MX + (size_t)row * 1024 + c) = w;
                }
                asm volatile("" ::: "memory");
            }
    }
};
struct EpiOut {
    static constexpr bool PERM = true, HOOK = false; static constexpr int HOOK_T1 = -1, HOOK_T2 = -1;
    __device__ __forceinline__ void hook(Acc&, const Unit&, int, int, int, int, int) const {}
    const float* X; bf16* X1;
    __device__ __forceinline__ void operator()(const Acc& acc, const Unit& u, int wr, int wc, int fr, int fq) const {
#pragma unroll
        for (int ai = 0; ai < 2; ++ai) {
            f32x4 xv[4][2][2];
#pragma unroll
            for (int m = 0; m < 4; ++m) { const size_t row = (size_t)(u.pm * BM + ai * HALF + wr * 64 + m * 16 + fr); const int c0 = u.pn * BM + wc * 64 + 8 * fq;
#pragma unroll
                for (int bj = 0; bj < 2; ++bj) { xv[m][bj][0] = *(const f32x4*)(X + row * 1024 + c0 + 32 * bj); xv[m][bj][1] = *(const f32x4*)(X + row * 1024 + c0 + 32 * bj + 4); } }
            asm volatile("" ::: "memory");
#pragma unroll
            for (int m = 0; m < 4; ++m) { const size_t row = (size_t)(u.pm * BM + ai * HALF + wr * 64 + m * 16 + fr); const int c0 = u.pn * BM + wc * 64 + 8 * fq;
                bf16* xr = X1 + x1_off(row);
#pragma unroll
                for (int bj = 0; bj < 2; ++bj) { const f32x4 a0 = xv[m][bj][0] + acc[ai][bj][m][0], a1 = xv[m][bj][1] + acc[ai][bj][m][1];
                    v4u w; w.x = cvt_pk_bf16(a0[0], a0[1]); w.y = cvt_pk_bf16(a0[2], a0[3]); w.z = cvt_pk_bf16(a1[0], a1[1]); w.w = cvt_pk_bf16(a1[2], a1[3]);
                    *(v4u*)(xr + c0 + 32 * bj) = w; } }
            asm volatile("" ::: "memory");
        }
    }
};
struct EpiUp {
    static constexpr bool PERM = true, HOOK = false; static constexpr int HOOK_T1 = -1, HOOK_T2 = -1;
    __device__ __forceinline__ void hook(Acc&, const Unit&, int, int, int, int, int) const {}
    bf16* HID;
    __device__ __forceinline__ void operator()(const Acc& acc, const Unit& u, int wr, int wc, int fr, int fq) const {
#pragma unroll
        for (int ai = 0; ai < 2; ++ai)
#pragma unroll
            for (int m = 0; m < 4; ++m) {
                const size_t row = (size_t)u.pm * BM + ai * HALF + wr * 64 + m * 16 + fr;
                float o[8];
#pragma unroll
                for (int n = 0; n < 2; ++n)
#pragma unroll
                    for (int j = 0; j < 4; ++j) { const float gt = acc[ai][0][m][n][j], up = acc[ai][1][m][n][j]; o[4 * n + j] = gt * sigmoidf_(gt) * up; }
                v4u w; w.x = cvt_pk_bf16(o[0], o[1]); w.y = cvt_pk_bf16(o[2], o[3]); w.z = cvt_pk_bf16(o[4], o[5]); w.w = cvt_pk_bf16(o[6], o[7]);
                *(v4u*)(HID + row * 256 + u.pn * 128 + wc * 32 + 8 * fq) = w;
            }
    }
};
struct EpiDown {
    static constexpr bool PERM = true, HOOK = false; static constexpr int HOOK_T1 = -1, HOOK_T2 = -1;
    __device__ __forceinline__ void hook(Acc&, const Unit&, int, int, int, int, int) const {}
    LAS unsigned char* lds; unsigned char* YB; unsigned char* SHB; int probe;
    __device__ __forceinline__ void operator()(const Acc& acc, const Unit& u, int wr, int wc, int fr, int fq) const {
        const int e = u.seg % NSEGH;
        const LAS v2u* tab = (const LAS v2u*)(lds + LDS_GTAB + u.tb * 2048);
        v2u ents[2][4];
#pragma unroll
        for (int ai = 0; ai < 2; ++ai)
#pragma unroll
            for (int m = 0; m < 4; ++m) ents[ai][m] = tab[ai * HALF + wr * 64 + m * 16 + fr];
#pragma unroll
        for (int ai = 0; ai < 2; ++ai)
#pragma unroll
            for (int m = 0; m < 4; ++m) {
                const int r = ai * HALF + wr * 64 + m * 16 + fr;
                if (r < u.rows && probe != -2) {
                    const v2u ent = ents[ai][m]; const int flat = (int)ent.x; const float w = __uint_as_float(ent.y) * Y8_SCALE;
                    unsigned char* rowp = (e < NEXP ? YB + (size_t)u.pn * ((size_t)T * 8 * 256) + (size_t)flat * 256 : SHB + (size_t)u.pn * ((size_t)T * 256) + (size_t)(flat >> 3) * 256) + wc * 64 + 16 * fq;
                    v4u o; unsigned ow[4];
#pragma unroll
                    for (int bj = 0; bj < 2; ++bj)
#pragma unroll
                        for (int n = 0; n < 2; ++n) { f32x4 a = acc[ai][bj][m][n] * w;
#pragma unroll
                            for (int j = 0; j < 4; ++j) a[j] = __builtin_amdgcn_fmed3f(a[j], -440.f, 440.f);
                            int p = __builtin_amdgcn_cvt_pk_fp8_f32(a[0], a[1], 0, false); p = __builtin_amdgcn_cvt_pk_fp8_f32(a[2], a[3], p, true); ow[2 * bj + n] = (unsigned)p; }
                    o.x = ow[0]; o.y = ow[1]; o.z = ow[2]; o.w = ow[3];
                    *(v4u*)rowp = o;
                }
            }
    }
};
}

__device__ __forceinline__ const float* arg_in(int i) {
    const __attribute__((address_space(4))) char* kp = (const __attribute__((address_space(4))) char*)__builtin_amdgcn_kernarg_segment_ptr();
    asm volatile("" : "+s"(kp));
    return *(const float* const __attribute__((address_space(4)))*)(kp + 8 * i);
}
struct Frame {
    LAS unsigned char* lds;
    int wave, vcu, G;
    unsigned char* ws; unsigned char* dout;
};
enum { I_X = 0, I_MEM, I_ANG, I_WIN, I_QNA, I_KNA, I_RELB, I_LBL, I_ONB, I_MNG, I_WMKV, I_QNC, I_KNC, I_WBA, I_WBB, I_WBC, I_WOUT, I_FNG, I_WR, I_RB, I_WEU, I_WED, I_WSU, I_WSD };

#ifndef STAGGER
#define STAGGER 0
#endif
__device__ __forceinline__ void stagger(const Frame& F, unsigned ticks_per_group) {
    if (!STAGGER) return;
    const unsigned long long t0 = __builtin_amdgcn_s_memrealtime(); const unsigned long long want = (unsigned long long)((unsigned)F.vcu & 7u) * ticks_per_group;
    while (__builtin_amdgcn_s_memrealtime() - t0 < want) __builtin_amdgcn_s_sleep(8);
}
__device__ __forceinline__ size_t bt_tiled_off(int n, int k, int K, bool perm) {
    const int pn = n >> 8, rho = n & 255, h = rho >> 7, r = rho & 127;
    const int x = r & 31; const int R = perm ? ((r & ~31) + 16 * ((x >> 2) & 1) + 4 * (x >> 3) + (x & 3)) : r;
    const int kt = k >> 6, C = k & 63;
    return ((size_t)((pn * (K >> 6) + kt) * 2 + h) * 16384 + (size_t)pg8::lds_byte(R, C)) >> 1;
}
__device__ __forceinline__ void tr_item(const float* W, int ldw, int k0s, int n0s, bf16* WT, int K, int n0d, int k0d, bool perm, LAS float* scr, int lane, const bool spread = false) {
    const int r8 = lane >> 3, c4 = lane & 7, n4 = 4 * c4, sc = spread ? 16 * (n4 >> 3) + (n4 & 7) : n4;
    f32x4 v[8];
#pragma unroll
    for (int i = 0; i < 8; ++i) v[i] = (n0s >= 0) ? *(const f32x4*)(W + (size_t)(k0s + 8 * i + r8) * ldw + n0s + sc) : (f32x4){0.f, 0.f, 0.f, 0.f};
#pragma unroll
    for (int i = 0; i < 8; ++i)
#pragma unroll
        for (int e = 0; e < 4; ++e) scr[(8 * i + r8) * 33 + n4 + e] = v[i][e];
    LDS_WAIT(); asm volatile("" ::: "memory");
    const int c = lane & 7;
#pragma unroll
    for (int j = 0; j < 4; ++j) { const int n = (lane >> 3) + 8 * j; const LAS float* s = scr + (8 * c) * 33 + n;
        v4u o; o.x = cvt_pk_bf16(s[0 * 33], s[1 * 33]); o.y = cvt_pk_bf16(s[2 * 33], s[3 * 33]); o.z = cvt_pk_bf16(s[4 * 33], s[5 * 33]); o.w = cvt_pk_bf16(s[6 * 33], s[7 * 33]);
        *(v4u*)(WT + bt_tiled_off(n0d + n, k0d + 8 * c, K, perm)) = o; }
    LDS_WAIT(); asm volatile("" ::: "memory");
}
__device__ __forceinline__ void rms_rows_to_bf16(const float* X, const float* g, bf16* O, int nrows, int gw, int NGW, int lane) {
    f32x4 gg[4];
#pragma unroll
    for (int j = 0; j < 4; ++j) gg[j] = ((const f32x4*)g + lane)[64 * j];
    for (int m = gw; m < nrows; m += 2 * NGW) {
        const int m1 = m + NGW; const bool has1 = m1 < nrows;
        const f32x4* x0 = (const f32x4*)(X + (size_t)m * D) + lane; const f32x4* x1 = (const f32x4*)(X + (size_t)(has1 ? m1 : m) * D) + lane;
        f32x4 v0[4], v1[4];
#pragma unroll
        for (int j = 0; j < 4; ++j) v0[j] = x0[64 * j];
#pragma unroll
        for (int j = 0; j < 4; ++j) v1[j] = x1[64 * j];
        float s0 = 0.f, s1 = 0.f;
#pragma unroll
        for (int j = 0; j < 4; ++j) { s0 += (v0[j][0] * v0[j][0] + v0[j][1] * v0[j][1]) + (v0[j][2] * v0[j][2] + v0[j][3] * v0[j][3]); s1 += (v1[j][0] * v1[j][0] + v1[j][1] * v1[j][1]) + (v1[j][2] * v1[j][2] + v1[j][3] * v1[j][3]); }
        const float r0 = rsqrtf(wave_sum(s0) * (1.f / D) + EPS), r1 = rsqrtf(wave_sum(s1) * (1.f / D) + EPS);
        v2u* o0 = (v2u*)(O + (size_t)m * D) + lane; v2u* o1 = (v2u*)(O + (size_t)m1 * D) + lane;
#pragma unroll
        for (int j = 0; j < 4; ++j) { v2u w; w.x = cvt_pk_bf16(v0[j][0] * r0 * gg[j][0], v0[j][1] * r0 * gg[j][1]); w.y = cvt_pk_bf16(v0[j][2] * r0 * gg[j][2], v0[j][3] * r0 * gg[j][3]); o0[64 * j] = w; }
        if (has1) {
#pragma unroll
            for (int j = 0; j < 4; ++j) { v2u w; w.x = cvt_pk_bf16(v1[j][0] * r1 * gg[j][0], v1[j][1] * r1 * gg[j][1]); w.y = cvt_pk_bf16(v1[j][2] * r1 * gg[j][2], v1[j][3] * r1 * gg[j][3]); o1[64 * j] = w; } }
    }
}
__device__ __forceinline__ int t5_bucket(int dist) {
    if (dist < 16) return dist;
    const int large = 16 + (int)(logf((float)dist / 16.0f) / 4.852030263919617f * 16.0f);
    return large < 31 ? large : 31;
}
constexpr int CV_I0 = 16 * 184, CV_I1 = 16 * 16, CV_I2 = 6 * 32, CV_I3 = 6 * 32, CV_I4 = 4 * 32, CV_I5 = 16 * 32, CV_I6 = 65 * 256, CV_I7 = 65 * 128;
constexpr int CV_EARLY = CV_I0 + CV_I1 + CV_I2 + CV_I3 + CV_I4 + CV_I5, CV_ALL = CV_EARLY + CV_I6 + CV_I7;
__device__ __forceinline__ void conv_item(Frame& F, int it, LAS float* scr, int lane) {
    constexpr int I0 = CV_I0, I1 = CV_I1, I2 = CV_I2, I3 = CV_I3, I4 = CV_I4, I5 = CV_I5, I6 = CV_I6;
    do {
        int r = it;
        if (r < I0 + I1) {
            const bool first = r < I0; if (!first) r -= I0;
            const int nblk = first ? 184 : 16, nsrc = first ? NPROJ : 512;
            const int kb = r / nblk, nbd = r % nblk, tile = nbd >> 3, within = nbd & 7, bj = within >> 2, wc = within & 3;
            const int srcb = tile * 8 + 2 * wc + bj;
            const int n0s = (srcb * 32 < nsrc) ? srcb * 32 : -1;
            tr_item(first ? arg_in(I_WIN) : arg_in(I_WMKV), nsrc, kb * 64, n0s, (bf16*)(F.ws + (first ? WS_WIN : WS_WMEM)), 1024, nbd * 32, kb * 64, true, scr, lane);
            break;
        }
        r -= I0 + I1;
#define HG_SRC(nb) ((((nb) >> 3) * 8 + 2 * ((nb) & 3) + (((nb) & 7) >> 2)) * 32)
        if (r < I2) { tr_item(arg_in(I_WBA), 1024, (r / 32) * 64, HG_SRC(r % 32), (bf16*)(F.ws + WS_WA), 1024, (r % 32) * 32, YC_A + (r / 32) * 64, true, scr, lane); break; } r -= I2;
        if (r < I3) { tr_item(arg_in(I_WBB), 1024, (r / 32) * 64, HG_SRC(r % 32), (bf16*)(F.ws + WS_WA), 1024, (r % 32) * 32, YC_B + (r / 32) * 64, true, scr, lane); break; } r -= I3;
        if (r < I4) { tr_item(arg_in(I_WBC), 1024, (r / 32) * 64, HG_SRC(r % 32), (bf16*)(F.ws + WS_WA), 1024, (r % 32) * 32, YC_C + (r / 32) * 64, true, scr, lane); break; } r -= I4;
        if (r < I5) { tr_item(arg_in(I_WOUT), 1024, (r / 32) * 64, HG_SRC(r % 32), (bf16*)(F.ws + WS_WOUT), 1024, (r % 32) * 32, (r / 32) * 64, true, scr, lane); break; } r -= I5;
        if (r < I6) {
            const int e = r / 256, q = r % 256, kb = q / 16, nbd = q % 16, pn = nbd >> 3, within = nbd & 7, bj = within >> 2, qq = within & 3;
            const int srcb = bj * 8 + pn * 4 + qq;
            const float* W = (e < 64) ? arg_in(I_WEU) + (size_t)e * 1024 * 512 : arg_in(I_WSU);
            tr_item(W, 512, kb * 64, srcb * 32, (bf16*)(F.ws + WS_WUP) + (size_t)e * 512 * 1024, 1024, nbd * 32, kb * 64, true, scr, lane);
            break;
        }
        r -= I6;
        {   const int e = r / 128, q = r % 128, kb = q / 32, nb = q % 32;
            const float* W = (e < 64) ? arg_in(I_WED) + (size_t)e * 256 * 1024 : arg_in(I_WSD);
            tr_item(W, 1024, kb * 64, (nb >> 3) * 256 + 64 * (nb & 3) + 8 * ((nb & 7) >> 2), (bf16*)(F.ws + WS_WDN) + (size_t)e * 1024 * 256, 256, nb * 32, kb * 64, true, scr, lane, true); }
    } while (0);
}
__device__ __forceinline__ void p0_prologue(Frame& F) {
    const int lane = lane_id_fresh(); const int tid = F.wave * 64 + lane; (void)tid;
    LAS float* scr = (LAS float*)(F.lds + F.wave * 16384);
    const int gw = F.vcu * 8 + F.wave, NGW = F.G * 8;
    for (int it = gw; it < CV_EARLY; it += NGW) conv_item(F, it, scr, lane);
    rms_rows_to_bf16(arg_in(I_X), arg_in(I_ANG), (bf16*)F.dout, T, gw, NGW, lane);
    rms_rows_to_bf16(arg_in(I_MEM), arg_in(I_MNG), (bf16*)(F.ws + WS_MEMN), NB * MEML, gw, NGW, lane);
    for (int i = F.vcu * 512 + tid; i < 64 * 1024; i += F.G * 512) {
        const int j = i & 7, ln = (i >> 3) & 63, ks = (i >> 9) & 31, et = i >> 14; const int e = 16 * et + (ln & 15), k = 32 * ks + 8 * (ln >> 4) + j; const float w = arg_in(I_WR)[(size_t)k * 64 + e];
        const unsigned hi = cvt_pk_bf16(w, 0.f) & 0xffffu; const float lo = w - __uint_as_float(hi << 16);
        ((bf16*)(F.ws + WS_TAB + 65536))[i] = (bf16)hi; ((bf16*)(F.ws + WS_TAB + 65536))[65536 + i] = f2bf(lo); }
    if (F.vcu == 0) {
        float* tab = (float*)(F.ws + WS_TAB);
        for (int i = tid; i < 3 * 129 * 6; i += 512) { const int h = i % 6, st = (i / 6) % 129, p = i / (6 * 129); tab[i] = arg_in(I_RELB)[t5_bucket(st << (2 * p)) * 6 + h]; }
        if (tid < 256) { const float a0 = arg_in(I_LBL)[tid], a1 = arg_in(I_LBL)[256 + tid]; tab[4096 + tid] = 1.0f / (1.0f + __expf(a1 - a0)); }
    }
}

template <int NR, class EntF>
__device__ __forceinline__ void attn_wave_simple(const bf16* qrow, const char* KB, const char* VB, const EntF& ent, bf16* orow, LAS float* wscr, int lane) {
    float q[64];
    { const v4u* qp = (const v4u*)qrow;
#pragma unroll
      for (int i = 0; i < 8; ++i) { const v4u w = qp[i]; q[8 * i + 0] = bf_lo(w.x); q[8 * i + 1] = bf_hi(w.x); q[8 * i + 2] = bf_lo(w.y); q[8 * i + 3] = bf_hi(w.y); q[8 * i + 4] = bf_lo(w.z); q[8 * i + 5] = bf_hi(w.z); q[8 * i + 6] = bf_lo(w.w); q[8 * i + 7] = bf_hi(w.w); } }
    float mx = -3.0e38f;
    LAS unsigned* vscr = (LAS unsigned*)(wscr + NR * 64);
#pragma unroll 1
    for (int r = 0; r < NR; ++r) {
        unsigned koff = 0, voff = 0; float bias = 0.f;
        const bool valid = ent(r * 64 + lane, koff, voff, bias);
        const v4u* kp = (const v4u*)(KB + koff);
        float d0 = 0.f, d1 = 0.f;
#pragma unroll
        for (int i = 0; i < 8; ++i) { const v4u w = kp[i];
            d0 += q[8 * i + 0] * bf_lo(w.x) + q[8 * i + 2] * bf_lo(w.y) + q[8 * i + 4] * bf_lo(w.z) + q[8 * i + 6] * bf_lo(w.w);
            d1 += q[8 * i + 1] * bf_hi(w.x) + q[8 * i + 3] * bf_hi(w.y) + q[8 * i + 5] * bf_hi(w.z) + q[8 * i + 7] * bf_hi(w.w); }
        const float sv = valid ? (d0 + d1 + bias) : -3.0e38f; wscr[r * 64 + lane] = sv; vscr[r * 64 + lane] = voff; mx = fmaxf(mx, sv);
    }
    mx = wave_max(mx);
    float l = 0.f;
#pragma unroll 1
    for (int r = 0; r < NR; ++r) { const float sv = wscr[r * 64 + lane]; const float p = (sv > -1.0e38f) ? __expf(sv - mx) : 0.f; l += p; wscr[r * 64 + lane] = p; }
    l = wave_sum(l);
    LDS_WAIT(); asm volatile("" ::: "memory");
    const int sub = lane >> 4, dg = lane & 15;
    float o0 = 0.f, o1 = 0.f, o2 = 0.f, o3 = 0.f;
    for (int i = 0; i < NR * 16; ++i) {
        const int e = 4 * i + sub; const float p = wscr[e]; const unsigned voff = vscr[e];
        const v2u w = *(const v2u*)(VB + voff + dg * 8);
        o0 += p * bf_lo(w.x); o1 += p * bf_hi(w.x); o2 += p * bf_lo(w.y); o3 += p * bf_hi(w.y);
    }
    o0 += __shfl_xor(o0, 16); o1 += __shfl_xor(o1, 16); o2 += __shfl_xor(o2, 16); o3 += __shfl_xor(o3, 16);
    o0 += __shfl_xor(o0, 32); o1 += __shfl_xor(o1, 32); o2 += __shfl_xor(o2, 32); o3 += __shfl_xor(o3, 32);
    const float inv = 1.0f / l;
    if (lane < 16) { v2u w; w.x = cvt_pk_bf16(o0 * inv, o1 * inv); w.y = cvt_pk_bf16(o2 * inv, o3 * inv); *(v2u*)(orow + dg * 4) = w; }
    LDS_WAIT(); asm volatile("" ::: "memory");
}
struct EntA {
    int pos, h; unsigned rowbase; const float* btab;
    __device__ __forceinline__ bool operator()(int e, unsigned& koff, unsigned& voff, float& bias) const {
        const int p = e / 129, st = e - p * 129; const int kt = pos - (st << (2 * p));
        const bool valid = (e < 387) && (kt >= 0);
        const unsigned off = valid ? (rowbase + (unsigned)kt * (LD_PA * 2)) : rowbase;
        koff = off + (384 + h * 64) * 2; voff = off + (768 + h * 64) * 2;
        bias = valid ? btab[e * 6 + h] : 0.f; return valid;
    }
};
struct EntC {
    unsigned base;
    __device__ __forceinline__ bool operator()(int e, unsigned& koff, unsigned& voff, float& bias) const { koff = base + (unsigned)e * 512u; voff = koff; bias = 0.f; return true; }
};
__device__ __forceinline__ void p2_attn_simple(Frame& F) {
    const int lane = lane_id_fresh(); const int tid = F.wave * 64 + lane; (void)tid;
    LAS float* wscr = (LAS float*)(F.lds + F.wave * 8192);
    const int gw = F.vcu * 8 + F.wave, NGW = F.G * 8;
    const bf16* PA = (const bf16*)(F.ws + WS_PA); const bf16* PC = (const bf16*)(F.ws + WS_PC);
    const float* btab = (const float*)(F.ws + WS_TAB);
    for (int it = gw; it < T * 6; it += NGW) {
        const int t = it / 6, h = it % 6, b = t >> 11, pos = t & 2047;
        EntA ent{pos, h, (unsigned)(b * SEQ) * (unsigned)(LD_PA * 2), btab};
        attn_wave_simple<7, EntA>(PA + (size_t)t * LD_PA + h * 64, (const char*)PA, (const char*)PA, ent, (bf16*)(F.dout + DO_Y) + (size_t)t * 1024 + YC_A + h * 64, wscr, lane);
    }
    for (int it = gw; it < T * 4; it += NGW) {
        const int t = it >> 2, h = it & 3, b = t >> 11;
        EntC ent{(unsigned)(b * MEML) * 512u + (unsigned)h * 128u};
        attn_wave_simple<4, EntC>(PC + (size_t)t * LD_PC + h * 64, (const char*)(F.ws + WS_MEMK), (const char*)(F.ws + WS_MEMV), ent, (bf16*)(F.dout + DO_Y) + (size_t)t * 1024 + YC_C + h * 64, wscr, lane);
    }
}

typedef short s4v __attribute__((ext_vector_type(4)));
constexpr int ATT_OROW = 272;
constexpr int ATT_OACC = 0, ATT_M = 256 * ATT_OROW, ATT_L = ATT_M + 1024, ATT_BT = ATT_L + 1024, ATT_VST = 73728, ATT_VROW = 160, ATT_VBUF = 32 * ATT_VROW;
static_assert(ATT_BT + 3 * 160 * 4 <= ATT_VST && ATT_VST + 8 * 2 * ATT_VBUF <= LDS_MISC, "attention LDS map");
template <int NT, bool MASK>
__device__ __forceinline__ void attn_sub(const bf16* Q0, unsigned qstep, const bf16* K0, const bf16* V0, unsigned kstep, int clo, const LAS float* btab, LAS unsigned char* vst, int lane,
                                         f32x4 (&O)[4], float& m_out, float& l_out) {
    const int q = lane & 15, g = lane >> 4;
    bf16x8 qf[2];
#pragma unroll
    for (int ks = 0; ks < 2; ++ks) qf[ks] = *(const bf16x8*)((const char*)Q0 + ((unsigned)q * qstep + 8u * g + 32u * ks) * 2u);
    f32x4 S[NT];
#pragma unroll
    for (int k = 0; k < NT; ++k) {
        S[k] = (f32x4){0.f, 0.f, 0.f, 0.f};
        if (!MASK || 16 * k >= clo) {
            const char* kr = (const char*)K0 + ((unsigned)(16 * k + q) * kstep + 8u * g) * 2u;
            const bf16x8 k0 = *(const bf16x8*)kr, k1 = *(const bf16x8*)(kr + 64);
            S[k] = __builtin_amdgcn_mfma_f32_16x16x32_bf16(k0, qf[0], S[k], 0, 0, 0);
            S[k] = __builtin_amdgcn_mfma_f32_16x16x32_bf16(k1, qf[1], S[k], 0, 0, 0);
        }
        if ((k & 3) == 3) asm volatile("" ::: "memory");
    }
    const int vr = lane >> 3, vc = lane & 7;
    const int ksf = MASK ? (clo >> 5) : 0;
    v4u wv[4];
#define ATT_LOADV(KS) do { _Pragma("unroll") for (int _i = 0; _i < 4; ++_i) { int _c = 32 * (KS) + 8 * _i + vr; if (MASK && _c < clo) _c = clo; if (_c > 16 * NT - 1) _c = 16 * NT - 1; \
        wv[_i] = *(const v4u*)((const char*)V0 + ((unsigned)_c * kstep + 8u * vc) * 2u); } } while (0)
    ATT_LOADV(ksf);
    float mx = -3.0e38f;
    if (MASK) {
        const LAS float* bp = btab + (128 + 16 + q - 4 * g);
        if (clo > 0) {
#pragma unroll
            for (int k = 0; k < NT; ++k)
#pragma unroll
                for (int r = 0; r < 4; ++r) { const float v = (16 * k + 4 * g + r >= clo) ? S[k][r] + bp[-16 * k - r] : -3.0e38f; S[k][r] = v; mx = fmaxf(mx, v); }
        } else {
#pragma unroll
            for (int k = 0; k < NT; ++k)
#pragma unroll
                for (int r = 0; r < 4; ++r) { const float v = S[k][r] + bp[-16 * k - r]; S[k][r] = v; mx = fmaxf(mx, v); }
        }
    } else {
#pragma unroll
        for (int k = 0; k < NT; ++k) mx = fmaxf(mx, fmaxf(fmaxf(S[k][0], S[k][1]), fmaxf(S[k][2], S[k][3])));
    }
    mx = xmax32(xmax16(mx));
    float l = 0.f;
#pragma unroll
    for (int k = 0; k < NT; ++k)
#pragma unroll
        for (int r = 0; r < 4; ++r) { const float p = __expf(S[k][r] - mx); S[k][r] = p; l += p; }
    l = xsum32(xsum16(l));
#pragma unroll
    for (int t = 0; t < 4; ++t) O[t] = (f32x4){0.f, 0.f, 0.f, 0.f};
    constexpr int NKS = (NT + 1) / 2;
    const int tq = (lane & 15) >> 2, tp = lane & 3;
#pragma unroll
    for (int ks = 0; ks < NKS; ++ks) {
        if (MASK && ks < ksf) continue;
        LAS unsigned char* vb = vst;
#pragma unroll
        for (int i = 0; i < 4; ++i) *(LAS v4u*)(vb + (8 * i + vr) * ATT_VROW + vc * 16) = wv[i];
        asm volatile("" ::: "memory");
        if (ks + 1 < NKS) ATT_LOADV(ks + 1);
        bf16x8 pf;
        { const f32x4 a = S[2 * ks]; f32x4 b = (f32x4){0.f, 0.f, 0.f, 0.f}; if (2 * ks + 1 < NT) b = S[2 * ks + 1 < NT ? 2 * ks + 1 : 0];
          v4u pw; pw.x = cvt_pk_bf16(a[0], a[1]); pw.y = cvt_pk_bf16(a[2], a[3]); pw.z = cvt_pk_bf16(b[0], b[1]); pw.w = cvt_pk_bf16(b[2], b[3]); pf = __builtin_bit_cast(bf16x8, pw); }
#pragma unroll
        for (int t = 0; t < 4; ++t) {
            const s4v lo = __builtin_amdgcn_ds_read_tr16_b64_v4i16((LAS s4v*)(vb + (4 * g + tq) * ATT_VROW + (16 * t + 4 * tp) * 2));
            const s4v hi = __builtin_amdgcn_ds_read_tr16_b64_v4i16((LAS s4v*)(vb + (16 + 4 * g + tq) * ATT_VROW + (16 * t + 4 * tp) * 2));
            const bf16x8 af = (bf16x8){lo[0], lo[1], lo[2], lo[3], hi[0], hi[1], hi[2], hi[3]};
            O[t] = __builtin_amdgcn_mfma_f32_16x16x32_bf16(af, pf, O[t], 0, 0, 0);
        }
        asm volatile("" ::: "memory");
    }
#undef ATT_LOADV
    m_out = mx; l_out = l;
}
constexpr int A2_OROW = 144, A2_M = 256 * A2_OROW, A2_L = A2_M + 1024, A2_BT = A2_L + 1024, A2_STG = 40960, A2_KP = 144, A2_VP = 144, A2_NR = 416, A2_VOFF = A2_STG + A2_NR * A2_KP;
static_assert(A2_BT + 3 * 160 * 4 <= A2_STG && A2_VOFF + A2_NR * A2_VP <= LDS_MISC && A2_STG + 8 * 2 * ATT_VBUF <= LDS_MISC, "mixer A LDS map");
__device__ __forceinline__ void attn_load_q(const bf16* Q0, unsigned qstep, int lane, bf16x8 (&qf)[2]) {
    const int q = lane & 15, g = lane >> 4;
#pragma unroll
    for (int ks = 0; ks < 2; ++ks) qf[ks] = *(const bf16x8*)((const char*)Q0 + ((unsigned)q * qstep + 8u * g + 32u * ks) * 2u);
}
__device__ __forceinline__ void attn_sub_lds(const bf16x8 (&qf)[2], const LAS unsigned char* Ki, const LAS unsigned char* Vi, int clo, const LAS float* btab, int lane, f32x4 (&O)[4], float& m_out, float& l_out) {
    const int q = lane & 15, g = lane >> 4, tq = (lane & 15) >> 2, tp = lane & 3;
    f32x4 S[9];
#pragma unroll
    for (int k = 0; k < 9; ++k) {
        S[k] = (f32x4){0.f, 0.f, 0.f, 0.f};
        if (16 * k >= clo) {
            const bf16x8 k0 = *(const LAS bf16x8*)(Ki + (16 * k + q) * A2_KP + 16 * g), k1 = *(const LAS bf16x8*)(Ki + (16 * k + q) * A2_KP + 64 + 16 * g);
            S[k] = __builtin_amdgcn_mfma_f32_16x16x32_bf16(k0, qf[0], S[k], 0, 0, 0);
            S[k] = __builtin_amdgcn_mfma_f32_16x16x32_bf16(k1, qf[1], S[k], 0, 0, 0);
        }
    }
    float mx = -3.0e38f;
    const LAS float* bp = btab + (128 + 16 + q - 4 * g);
    if (clo > 0) {
#pragma unroll
        for (int k = 0; k < 9; ++k)
#pragma unroll
            for (int r = 0; r < 4; ++r) { const float v = (16 * k + 4 * g + r >= clo) ? S[k][r] + bp[-16 * k - r] : -3.0e38f; S[k][r] = v; mx = fmaxf(mx, v); }
    } else {
#pragma unroll
        for (int k = 0; k < 9; ++k)
#pragma unroll
            for (int r = 0; r < 4; ++r) { const float v = S[k][r] + bp[-16 * k - r]; S[k][r] = v; mx = fmaxf(mx, v); }
    }
    mx = xmax32(xmax16(mx));
    float l = 0.f;
#pragma unroll
    for (int k = 0; k < 9; ++k)
#pragma unroll
        for (int r = 0; r < 4; ++r) { const float p = __expf(S[k][r] - mx); S[k][r] = p; l += p; }
    l = xsum32(xsum16(l));
#pragma unroll
    for (int t = 0; t < 4; ++t) O[t] = (f32x4){0.f, 0.f, 0.f, 0.f};
    const int ksf = clo >> 5;
#pragma unroll
    for (int ks = 0; ks < 5; ++ks) {
        if (ks < ksf) continue;
        const f32x4 a = S[2 * ks]; f32x4 b2 = (f32x4){0.f, 0.f, 0.f, 0.f}; if (2 * ks + 1 < 9) b2 = S[2 * ks + 1 < 9 ? 2 * ks + 1 : 0];
        v4u pw; pw.x = cvt_pk_bf16(a[0], a[1]); pw.y = cvt_pk_bf16(a[2], a[3]); pw.z = cvt_pk_bf16(b2[0], b2[1]); pw.w = cvt_pk_bf16(b2[2], b2[3]);
        const bf16x8 pf = __builtin_bit_cast(bf16x8, pw);
#pragma unroll
        for (int t = 0; t < 4; ++t) {
            const s4v lo = __builtin_amdgcn_ds_read_tr16_b64_v4i16((LAS s4v*)(Vi + (32 * ks + 4 * g + tq) * A2_VP + (16 * t + 4 * tp) * 2));
            const s4v hi = __builtin_amdgcn_ds_read_tr16_b64_v4i16((LAS s4v*)(Vi + (32 * ks + 16 + 4 * g + tq) * A2_VP + (16 * t + 4 * tp) * 2));
            O[t] = __builtin_amdgcn_mfma_f32_16x16x32_bf16((bf16x8){lo[0], lo[1], lo[2], lo[3], hi[0], hi[1], hi[2], hi[3]}, pf, O[t], 0, 0, 0);
        }
    }
    m_out = mx; l_out = l;
}
__device__ __forceinline__ void attnA_merge(Frame& F, f32x4 (&O)[4], float m, float l, int tt, int g, bool first, bool last, bf16* yrow) {
    LAS unsigned char* orow = F.lds + tt * A2_OROW + 8 * g; LAS float* mp = (LAS float*)(F.lds + A2_M) + tt; LAS float* lp = (LAS float*)(F.lds + A2_L) + tt;
    if (!first) {
        const float mo = *mp, lo_ = *lp; const float mn = fmaxf(m, mo), ao = __expf(mo - mn), an = __expf(m - mn);
#pragma unroll
        for (int t = 0; t < 4; ++t) { const v2u w = *(const LAS v2u*)(orow + 32 * t); O[t] = (f32x4){bf_lo(w.x), bf_hi(w.x), bf_lo(w.y), bf_hi(w.y)} * ao + O[t] * an; }
        l = lo_ * ao + l * an; m = mn;
    }
    if (!last) {
#pragma unroll
        for (int t = 0; t < 4; ++t) { v2u w; w.x = cvt_pk_bf16(O[t][0], O[t][1]); w.y = cvt_pk_bf16(O[t][2], O[t][3]); *(LAS v2u*)(orow + 32 * t) = w; }
        if (g == 0) { *mp = m; *lp = l; }
    } else {
        const float inv = 1.0f / l;
#pragma unroll
        for (int t = 0; t < 4; ++t) { v2u w; w.x = cvt_pk_bf16(O[t][0] * inv, O[t][1] * inv); w.y = cvt_pk_bf16(O[t][2] * inv, O[t][3] * inv); *(v2u*)(yrow + 16 * t) = w; }
    }
}
__device__ __forceinline__ void attnA_unit(Frame& F, int unit) {
    const int lane = lane_id_fresh();
    const int tid = F.wave * 64 + lane;
    const int b = unit / 48, rem = unit % 48, h = rem >> 3, tile = rem & 7, t0 = tile * 256; const long tokbase = (long)b * SEQ;
    const bf16* PA = (const bf16*)(F.ws + WS_PA);
    LAS float* bt = (LAS float*)(F.lds + A2_BT);
    LAS unsigned char* Ki = F.lds + A2_STG; LAS unsigned char* Vi = F.lds + A2_VOFF;
    const int q = lane & 15, g = lane >> 4, w = F.wave;
    bf16* Y = (bf16*)(F.dout + DO_Y) + YC_A + h * 64 + 4 * g;
    __syncthreads();
    if (tid < 480) { const int p = tid / 160, st = tid - p * 160 - 16; bt[tid] = (st >= 0 && st <= 128) ? ((const float*)(F.ws + WS_TAB))[(p * 129 + st) * 6 + h] : -3.0e38f; }
    v4u sk[5], sv[5];
#define A2_LOAD1(hh_) do { _Pragma("unroll") for (int it = 0; it < 5; ++it) { const int i = tid + it * 512; sk[it] = (v4u){0u, 0u, 0u, 0u}; sv[it] = sk[it]; \
        if (i < 272 * 8) { const int row = i >> 3, ch = i & 7, pos = t0 + 128 * (hh_) - 128 + row; \
            if (pos >= 0 && pos < SEQ) { const bf16* rp_ = PA + (tokbase + pos) * LD_PA + 384 + h * 64 + ch * 8; sk[it] = *(const v4u*)rp_; sv[it] = *(const v4u*)(rp_ + 384); } } } } while (0)
#define A2_LOAD2(rp_i) do { _Pragma("unroll") for (int it = 0; it < 5; ++it) { const int i = tid + it * 512; sk[it] = (v4u){0u, 0u, 0u, 0u}; sv[it] = sk[it]; \
        { const int row = i >> 3, ch = i & 7, rr_ = row >= 208 ? 1 : 0, j = row - 208 * rr_, posn = t0 / 4 - 128 + j, pos = 4 * posn + 2 * (rp_i) + rr_; \
            if (posn >= 0 && pos < SEQ) { const bf16* rp_ = PA + (tokbase + pos) * LD_PA + 384 + h * 64 + ch * 8; sk[it] = *(const v4u*)rp_; sv[it] = *(const v4u*)(rp_ + 384); } } } } while (0)
#define A2_WRITE(nit, cnt) do { _Pragma("unroll") for (int it = 0; it < (nit); ++it) { const int i = tid + it * 512; if (i < (cnt)) { const int row = i >> 3, ch = i & 7; \
        *(LAS v4u*)(Ki + row * A2_KP + ch * 16) = sk[it]; *(LAS v4u*)(Vi + row * A2_VP + ch * 16) = sv[it]; } } } while (0)
    bf16x8 qc[2], qn[2];
    A2_LOAD1(0);
    attn_load_q(PA + (tokbase + t0 + 16 * w) * LD_PA + h * 64, (unsigned)LD_PA, lane, qc);
#pragma unroll 1
    for (int hh = 0; hh < 2; ++hh) {
        __syncthreads();
        A2_WRITE(5, 272 * 8);
        __syncthreads();
        if (hh == 0) { A2_LOAD1(1); attn_load_q(PA + (tokbase + t0 + 128 + 16 * w) * LD_PA + h * 64, (unsigned)LD_PA, lane, qn); }
        else { A2_LOAD2(0); attn_load_q(PA + (tokbase + t0 + (w >> 2) + 64 * (w & 3)) * LD_PA + h * 64, (unsigned)(4 * LD_PA), lane, qn); }
        const int tq0 = t0 + 128 * hh + 16 * w; const int clo = tq0 < 128 ? 128 - tq0 : 0;
        f32x4 O[4]; float m, l;
        attn_sub_lds(qc, Ki + 16 * w * A2_KP, Vi + 16 * w * A2_VP, clo, bt, lane, O, m, l);
        attnA_merge(F, O, m, l, (tq0 - t0) + q, g, true, false, nullptr);
        qc[0] = qn[0]; qc[1] = qn[1];
    }
#pragma unroll 1
    for (int rp = 0; rp < 2; ++rp) {
        __syncthreads();
        A2_WRITE(5, 416 * 8);
        for (int i = tid + 5 * 512; i < 416 * 8; i += 512) { const int row = i >> 3, ch = i & 7, rr_ = row >= 208 ? 1 : 0, j = row - 208 * rr_, posn = t0 / 4 - 128 + j, pos = 4 * posn + 2 * rp + rr_; v4u kv = (v4u){0u, 0u, 0u, 0u}, vv = kv;
            if (posn >= 0 && pos < SEQ) { const bf16* rp2 = PA + (tokbase + pos) * LD_PA + 384 + h * 64 + ch * 8; kv = *(const v4u*)rp2; vv = *(const v4u*)(rp2 + 384); }
            *(LAS v4u*)(Ki + row * A2_KP + ch * 16) = kv; *(LAS v4u*)(Vi + row * A2_VP + ch * 16) = vv; }
        __syncthreads();
        if (rp == 0) { A2_LOAD2(1); attn_load_q(PA + (tokbase + t0 + 2 + (w >> 2) + 64 * (w & 3)) * LD_PA + h * 64, (unsigned)(4 * LD_PA), lane, qn); }
        const int rr = w >> 2, jp = w & 3, tq0 = t0 + 2 * rp + rr + 64 * jp, pq0 = t0 / 4 + 16 * jp; const int clo = pq0 < 128 ? 128 - pq0 : 0;
        f32x4 O[4]; float m, l;
        attn_sub_lds(qc, Ki + (208 * rr + 16 * jp) * A2_KP, Vi + (208 * rr + 16 * jp) * A2_VP, clo, bt + 160, lane, O, m, l);
        attnA_merge(F, O, m, l, (tq0 - t0) + 4 * q, g, false, false, nullptr);
        qc[0] = qn[0]; qc[1] = qn[1];
    }
#undef A2_LOAD1
#undef A2_LOAD2
#undef A2_WRITE
    __syncthreads();
    LAS unsigned char* vst = F.lds + A2_STG + w * 2 * ATT_VBUF;
#pragma unroll
    for (int su = 0; su < 2; ++su) {
        const int sub = w * 2 + su, tq0 = t0 + sub, pq0 = t0 / 16; const int clo = pq0 < 128 ? 128 - pq0 : 0;
        const bf16* Q0 = PA + (tokbase + tq0) * LD_PA + h * 64; const bf16* K0 = PA + (tokbase + tq0 - 128 * 16) * LD_PA + 384 + h * 64;
        f32x4 O[4]; float m, l;
        attn_sub<9, true>(Q0, (unsigned)(16 * LD_PA), K0, K0 + 384, (unsigned)(16 * LD_PA), clo, bt + 320, vst + su * ATT_VBUF, lane, O, m, l);
        const int tt = (tq0 - t0) + 16 * q;
        attnA_merge(F, O, m, l, tt, g, false, true, Y + (tokbase + t0 + tt) * 1024);
    }
    __syncthreads();
}
constexpr int CK_PITCH = 144, CV_PITCH = 160, CK_OFF = 0, CV_OFF = 256 * CK_PITCH;
static_assert(CV_OFF + 256 * CV_PITCH <= LDS_MISC, "mixer C LDS map");
__device__ __forceinline__ void attnC_unit(Frame& F, int unit) {
    const int lane = lane_id_fresh(); const int tid = F.wave * 64 + lane;
    const int b = unit >> 5, h = (unit >> 3) & 3, tile = unit & 7; const long tok0 = (long)b * SEQ + tile * 256;
    const bf16* PC = (const bf16*)(F.ws + WS_PC);
    const bf16* K0 = (const bf16*)(F.ws + WS_MEMK) + (long)b * MEML * 256 + h * 64; const bf16* V0 = (const bf16*)(F.ws + WS_MEMV) + (long)b * MEML * 256 + h * 64;
    LAS unsigned char* L = F.lds;
    bf16x8 qa[2][2];
    { const int q_ = lane & 15, g_ = lane >> 4;
#pragma unroll
      for (int su = 0; su < 2; ++su)
#pragma unroll
        for (int ks = 0; ks < 2; ++ks) qa[su][ks] = *(const bf16x8*)(PC + (tok0 + 16 * (F.wave * 2 + su) + q_) * LD_PC + h * 64 + 8 * g_ + 32 * ks); }
    __syncthreads();
#pragma unroll
    for (int j = 0; j < 4; ++j) { const int i = tid + 512 * j, row = i >> 3, ch = i & 7;
        *(LAS v4u*)(L + CK_OFF + row * CK_PITCH + ch * 16) = *(const v4u*)(K0 + (long)row * 256 + ch * 8);
        *(LAS v4u*)(L + CV_OFF + row * CV_PITCH + ch * 16) = *(const v4u*)(V0 + (long)row * 256 + ch * 8); }
    __syncthreads();
    const int q = lane & 15, g = lane >> 4, tq = (lane & 15) >> 2, tp = lane & 3;
#pragma unroll 1
    for (int su = 0; su < 2; ++su) {
        const long tq0 = tok0 + 16 * (F.wave * 2 + su);
        bf16x8 qf[2]; qf[0] = su == 0 ? qa[0][0] : qa[1][0]; qf[1] = su == 0 ? qa[0][1] : qa[1][1];
        f32x4 S[16];
#pragma unroll
        for (int k = 0; k < 16; ++k) {
            const bf16x8 k0 = *(const LAS bf16x8*)(L + CK_OFF + (16 * k + q) * CK_PITCH + 16 * g), k1 = *(const LAS bf16x8*)(L + CK_OFF + (16 * k + q) * CK_PITCH + 64 + 16 * g);
            S[k] = __builtin_amdgcn_mfma_f32_16x16x32_bf16(k0, qf[0], (f32x4){0.f, 0.f, 0.f, 0.f}, 0, 0, 0);
            S[k] = __builtin_amdgcn_mfma_f32_16x16x32_bf16(k1, qf[1], S[k], 0, 0, 0);
            if ((k & 3) == 3) asm volatile("" ::: "memory");
        }
        float mx = -3.0e38f;
#pragma unroll
        for (int k = 0; k < 16; ++k) mx = fmaxf(mx, fmaxf(fmaxf(S[k][0], S[k][1]), fmaxf(S[k][2], S[k][3])));
        mx = xmax32(xmax16(mx));
        float l = 0.f;
#pragma unroll
        for (int k = 0; k < 16; ++k)
#pragma unroll
            for (int r = 0; r < 4; ++r) { const float p = __expf(S[k][r] - mx); S[k][r] = p; l += p; }
        l = xsum32(xsum16(l));
        f32x4 O[4];
#pragma unroll
        for (int t = 0; t < 4; ++t) O[t] = (f32x4){0.f, 0.f, 0.f, 0.f};
#pragma unroll
        for (int ks = 0; ks < 8; ++ks) {
            v4u pw; pw.x = cvt_pk_bf16(S[2 * ks][0], S[2 * ks][1]); pw.y = cvt_pk_bf16(S[2 * ks][2], S[2 * ks][3]); pw.z = cvt_pk_bf16(S[2 * ks + 1][0], S[2 * ks + 1][1]); pw.w = cvt_pk_bf16(S[2 * ks + 1][2], S[2 * ks + 1][3]);
            const bf16x8 pf = __builtin_bit_cast(bf16x8, pw);
#pragma unroll
            for (int t = 0; t < 4; ++t) {
                const s4v lo = __builtin_amdgcn_ds_read_tr16_b64_v4i16((LAS s4v*)(L + CV_OFF + (32 * ks + 4 * g + tq) * CV_PITCH + (16 * t + 4 * tp) * 2));
                const s4v hi = __builtin_amdgcn_ds_read_tr16_b64_v4i16((LAS s4v*)(L + CV_OFF + (32 * ks + 16 + 4 * g + tq) * CV_PITCH + (16 * t + 4 * tp) * 2));
                O[t] = __builtin_amdgcn_mfma_f32_16x16x32_bf16((bf16x8){lo[0], lo[1], lo[2], lo[3], hi[0], hi[1], hi[2], hi[3]}, pf, O[t], 0, 0, 0);
            }
        }
        const float inv = 1.0f / l; bf16* yo = (bf16*)(F.dout + DO_Y) + (tq0 + q) * 1024 + YC_C + h * 64 + 4 * g;
#pragma unroll
        for (int t = 0; t < 4; ++t) { v2u w; w.x = cvt_pk_bf16(O[t][0] * inv, O[t][1] * inv); w.y = cvt_pk_bf16(O[t][2] * inv, O[t][3] * inv); *(v2u*)(yo + 16 * t) = w; }
    }
}
__device__ __forceinline__ void p2_attn_mfma(Frame& F) {
    const int lane = lane_id_fresh();
    for (int u = F.vcu; u < NB * 6 * 8; u += F.G) attnA_unit(F, u);
    for (int u = F.vcu; u < NB * 4 * 8; u += F.G) attnC_unit(F, u);
    __syncthreads();
}

constexpr int HG_PR = 144, HG_PX = 160, HG_PV = 224;
constexpr int HG_KH = 0, HG_QT = 64 * HG_PR, HG_QS = 2 * 64 * HG_PR, HG_KX = HG_QS + 10 * 16 * HG_PR, HG_VI = HG_KX + 64 * HG_PX, HG_SI = HG_VI + 64 * HG_PV, HG_DV = HG_SI + 2 * 64 * HG_PV, HG_PS = HG_DV + 256, HG_END = HG_PS + 512;
static_assert(HG_END <= LDS_MISC, "hgrn LDS map");
__device__ __forceinline__ s4v trd(const LAS unsigned char* p) { return __builtin_amdgcn_ds_read_tr16_b64_v4i16((LAS s4v*)p); }
__device__ __forceinline__ bf16x8 cat8(s4v lo, s4v hi) { return (bf16x8){lo[0], lo[1], lo[2], lo[3], hi[0], hi[1], hi[2], hi[3]}; }
__device__ __forceinline__ void hgrn_seq(Frame& F, int seq, bf16* YB) {
    const int lane = lane_id_fresh();
    const int w = F.wave, tid = w * 64 + lane;
    const int b = seq >> 2, h = seq & 3; const long tokbase = (long)b * SEQ;
    const bf16* PB = (const bf16*)(F.ws + WS_PB);
    LAS unsigned char* L = F.lds;
    __syncthreads();
    for (int i = tid; i < 2 * 64 * HG_PV / 16; i += 512) *(LAS v4u*)(L + HG_SI + i * 16) = (v4u){0u, 0u, 0u, 0u};
    float lbv[8];
    { const float* lbt = (const float*)(F.ws + WS_TAB) + 4096 + h * 64 + 8 * w;
#pragma unroll
      for (int j = 0; j < 8; ++j) lbv[j] = lbt[j]; }
    f32x4 St[3];
#pragma unroll
    for (int t = 0; t < 3; ++t) St[t] = (f32x4){0.f, 0.f, 0.f, 0.f};
    const int q16 = lane & 15, g = lane >> 4, mi = w >> 1, hh = w & 1, tq4 = (lane & 15) >> 2, tp = lane & 3;
    float gn[3];
#pragma unroll
    for (int t = 0; t < 3; ++t) gn[t] = arg_in(I_ONB)[h * 96 + 16 * (3 * hh + t) + q16];
    v4u qw, fw, vw0, vw1 = (v4u){0u, 0u, 0u, 0u};
    { const bf16* rowp = PB + (tokbase + lane) * LD_PB; qw = *(const v4u*)(rowp + h * 64 + 8 * w); fw = *(const v4u*)(rowp + 256 + h * 64 + 8 * w);
      vw0 = *(const v4u*)(PB + (tokbase + tid / 12) * LD_PB + 512 + h * 96 + (tid % 12) * 8);
      if (tid < 256) vw1 = *(const v4u*)(PB + (tokbase + (tid + 512) / 12) * LD_PB + 512 + h * 96 + ((tid + 512) % 12) * 8); }
    bf16 ogc[3][4], ogn[3][4];
#pragma unroll
    for (int t = 0; t < 3; ++t)
#pragma unroll
        for (int r = 0; r < 4; ++r) { ogc[t][r] = PB[(tokbase + 16 * mi + 4 * g + r) * LD_PB + 896 + h * 96 + 16 * (3 * hh + t) + q16]; ogn[t][r] = ogc[t][r]; }
#pragma unroll 1
    for (int c = 0; c < 32; ++c) {
        const long tok0 = tokbase + 64 * c;
        *(LAS v4u*)(L + HG_VI + (tid / 12) * HG_PV + (tid % 12) * 16) = vw0;
        if (tid < 256) *(LAS v4u*)(L + HG_VI + ((tid + 512) / 12) * HG_PV + ((tid + 512) % 12) * 16) = vw1;
        float qf[8], kk[8], bb[8];
        { const unsigned qa[4] = {qw.x, qw.y, qw.z, qw.w}, fa[4] = {fw.x, fw.y, fw.z, fw.w};
#pragma unroll
          for (int j = 0; j < 4; ++j) { qf[2 * j] = bf_lo(qa[j]); qf[2 * j + 1] = bf_hi(qa[j]);
              const float f0 = lbv[2 * j] + (1.f - lbv[2 * j]) * sigmoidf_(bf_lo(fa[j])), f1 = lbv[2 * j + 1] + (1.f - lbv[2 * j + 1]) * sigmoidf_(bf_hi(fa[j]));
              kk[2 * j] = 1.f - f0; kk[2 * j + 1] = 1.f - f1; bb[2 * j] = __logf(f0); bb[2 * j + 1] = __logf(f1); } }
#pragma unroll
        for (int j = 0; j < 8; ++j) bb[j] = scan_incl64(bb[j]);
        float E0[8], E1[8], E2[8], E3[8], Es[8];
#pragma unroll
        for (int j = 0; j < 8; ++j) { E0[j] = readlane_f(bb[j], 15); E1[j] = readlane_f(bb[j], 31); E2[j] = readlane_f(bb[j], 47); E3[j] = readlane_f(bb[j], 63);
            Es[j] = g == 0 ? E0[j] : (g == 1 ? E1[j] : (g == 2 ? E2[j] : E3[j])); }
        {   float kh[8], qt[8], kx[8];
#pragma unroll
            for (int j = 0; j < 8; ++j) { kh[j] = kk[j] * __expf(Es[j] - bb[j]); qt[j] = qf[j] * __expf(bb[j]); kx[j] = kk[j] * __expf(E3[j] - bb[j]); }
            v4u o; o.x = cvt_pk_bf16(kh[0], kh[1]); o.y = cvt_pk_bf16(kh[2], kh[3]); o.z = cvt_pk_bf16(kh[4], kh[5]); o.w = cvt_pk_bf16(kh[6], kh[7]); *(LAS v4u*)(L + HG_KH + lane * HG_PR + w * 16) = o;
            o.x = cvt_pk_bf16(qt[0], qt[1]); o.y = cvt_pk_bf16(qt[2], qt[3]); o.z = cvt_pk_bf16(qt[4], qt[5]); o.w = cvt_pk_bf16(qt[6], qt[7]); *(LAS v4u*)(L + HG_QT + lane * HG_PR + w * 16) = o;
            o.x = cvt_pk_bf16(kx[0], kx[1]); o.y = cvt_pk_bf16(kx[2], kx[3]); o.z = cvt_pk_bf16(kx[4], kx[5]); o.w = cvt_pk_bf16(kx[6], kx[7]); *(LAS v4u*)(L + HG_KX + lane * HG_PX + w * 16) = o; }
#pragma unroll
        for (int jj = 0; jj < 4; ++jj) {
            if (g >= jj) { float qs[8];
#pragma unroll
                for (int j = 0; j < 8; ++j) { const float Ej = jj == 0 ? E0[j] : (jj == 1 ? E1[j] : (jj == 2 ? E2[j] : E3[j])); qs[j] = qf[j] * __expf(bb[j] - Ej); }
                const int tix = (jj == 0 ? 0 : (jj == 1 ? 4 : (jj == 2 ? 7 : 9))) + (g - jj);
                v4u o; o.x = cvt_pk_bf16(qs[0], qs[1]); o.y = cvt_pk_bf16(qs[2], qs[3]); o.z = cvt_pk_bf16(qs[4], qs[5]); o.w = cvt_pk_bf16(qs[6], qs[7]);
                *(LAS v4u*)(L + HG_QS + tix * 16 * HG_PR + q16 * HG_PR + w * 16) = o; }
        }
        if (lane == 63) {
#pragma unroll
            for (int j = 0; j < 8; ++j) *(LAS float*)(L + HG_DV + (8 * w + j) * 4) = __expf(bb[j]); }
        __syncthreads();
        if (c + 1 < 32) { const long tn = tok0 + 64; const bf16* rowp = PB + (tn + lane) * LD_PB; qw = *(const v4u*)(rowp + h * 64 + 8 * w); fw = *(const v4u*)(rowp + 256 + h * 64 + 8 * w);
            vw0 = *(const v4u*)(PB + (tn + tid / 12) * LD_PB + 512 + h * 96 + (tid % 12) * 8);
            if (tid < 256) vw1 = *(const v4u*)(PB + (tn + (tid + 512) / 12) * LD_PB + 512 + h * 96 + ((tid + 512) % 12) * 8);
#pragma unroll
            for (int t = 0; t < 3; ++t)
#pragma unroll
                for (int r = 0; r < 4; ++r) ogn[t][r] = PB[(tn + 16 * mi + 4 * g + r) * LD_PB + 896 + h * 96 + 16 * (3 * hh + t) + q16]; }
        const LAS unsigned char* SIr = L + HG_SI + (c & 1) * 64 * HG_PV; LAS unsigned char* SIw = L + HG_SI + ((c + 1) & 1) * 64 * HG_PV;
        f32x4 AT[4];
#pragma unroll
        for (int j = 0; j < 4; ++j) {
            f32x4 acc = (f32x4){0.f, 0.f, 0.f, 0.f};
            if (j <= mi) {
                const int tix = (j == 0 ? 0 : (j == 1 ? 4 : (j == 2 ? 7 : 9))) + (mi - j);
#pragma unroll
                for (int ks = 0; ks < 2; ++ks) {
                    const bf16x8 a = *(const LAS bf16x8*)(L + HG_KH + (16 * j + q16) * HG_PR + (32 * ks + 8 * g) * 2);
                    const bf16x8 bq = *(const LAS bf16x8*)(L + HG_QS + tix * 16 * HG_PR + q16 * HG_PR + (32 * ks + 8 * g) * 2);
                    acc = __builtin_amdgcn_mfma_f32_16x16x32_bf16(a, bq, acc, 0, 0, 0);
                }
                if (j == mi) {
#pragma unroll
                    for (int r = 0; r < 4; ++r) if (4 * g + r > q16) acc[r] = 0.f; }
            }
            AT[j] = acc;
        }
        bf16x8 vf[2][3];
#pragma unroll
        for (int ks = 0; ks < 2; ++ks)
#pragma unroll
            for (int t = 0; t < 3; ++t) { const int col = (16 * (3 * hh + t) + 4 * tp) * 2;
                vf[ks][t] = cat8(trd(L + HG_VI + (32 * ks + 4 * g + tq4) * HG_PV + col), trd(L + HG_VI + (32 * ks + 16 + 4 * g + tq4) * HG_PV + col)); }
        f32x4 o[3];
#pragma unroll
        for (int t = 0; t < 3; ++t) o[t] = (f32x4){0.f, 0.f, 0.f, 0.f};
#pragma unroll
        for (int ks = 0; ks < 2; ++ks) {
            const bf16x8 a = *(const LAS bf16x8*)(L + HG_QT + (16 * mi + q16) * HG_PR + (32 * ks + 8 * g) * 2);
#pragma unroll
            for (int t = 0; t < 3; ++t) { const int col = (16 * (3 * hh + t) + 4 * tp) * 2;
                const bf16x8 bs = cat8(trd(SIr + (32 * ks + 8 * g + tq4) * HG_PV + col), trd(SIr + (32 * ks + 8 * g + 4 + tq4) * HG_PV + col));
                o[t] = __builtin_amdgcn_mfma_f32_16x16x32_bf16(a, bs, o[t], 0, 0, 0); }
        }
#pragma unroll
        for (int ks = 0; ks < 2; ++ks) {
            if (2 * ks <= mi) {
                v4u pw; pw.x = cvt_pk_bf16(AT[2 * ks][0], AT[2 * ks][1]); pw.y = cvt_pk_bf16(AT[2 * ks][2], AT[2 * ks][3]); pw.z = cvt_pk_bf16(AT[2 * ks + 1][0], AT[2 * ks + 1][1]); pw.w = cvt_pk_bf16(AT[2 * ks + 1][2], AT[2 * ks + 1][3]);
                const bf16x8 a = __builtin_bit_cast(bf16x8, pw);
#pragma unroll
                for (int t = 0; t < 3; ++t) o[t] = __builtin_amdgcn_mfma_f32_16x16x32_bf16(a, vf[ks][t], o[t], 0, 0, 0);
            }
        }
        { const f32x4 dv = *(const LAS f32x4*)(L + HG_DV + (16 * mi + 4 * g) * 4);
#pragma unroll
          for (int t = 0; t < 3; ++t) St[t] = St[t] * dv; }
#pragma unroll
        for (int ks = 0; ks < 2; ++ks) {
            const int col = (16 * mi + 4 * tp) * 2;
            const bf16x8 a = cat8(trd(L + HG_KX + (32 * ks + 4 * g + tq4) * HG_PX + col), trd(L + HG_KX + (32 * ks + 16 + 4 * g + tq4) * HG_PX + col));
#pragma unroll
            for (int t = 0; t < 3; ++t) St[t] = __builtin_amdgcn_mfma_f32_16x16x32_bf16(a, vf[ks][t], St[t], 0, 0, 0);
        }
#pragma unroll
        for (int t = 0; t < 3; ++t)
#pragma unroll
            for (int r = 0; r < 4; ++r) *(LAS bf16*)(SIw + (16 * mi + 4 * g + r) * HG_PV + (16 * (3 * hh + t) + q16) * 2) = f2bf(St[t][r]);
        float ss[4];
#pragma unroll
        for (int r = 0; r < 4; ++r) { float s2 = o[0][r] * o[0][r] + o[1][r] * o[1][r] + o[2][r] * o[2][r];
            ss[r] = sum_row16(s2); }
        if (q16 == 0) {
#pragma unroll
            for (int r = 0; r < 4; ++r) *(LAS float*)(L + HG_PS + ((16 * mi + 4 * g + r) * 2 + hh) * 4) = ss[r]; }
        float ogv[3][4];
#pragma unroll
        for (int t = 0; t < 3; ++t)
#pragma unroll
            for (int r = 0; r < 4; ++r) { ogv[t][r] = bf2f(ogc[t][r]); ogc[t][r] = ogn[t][r]; }
        __syncthreads();
#pragma unroll
        for (int r = 0; r < 4; ++r) { const f32x2 p2 = *(const LAS f32x2*)(L + HG_PS + (16 * mi + 4 * g + r) * 8); const float rstd = rsqrtf((p2[0] + p2[1]) * (1.f / 96.f) + EPS);
#pragma unroll
            for (int t = 0; t < 3; ++t) YB[(tok0 + 16 * mi + 4 * g + r) * 1024 + YC_B + h * 96 + 16 * (3 * hh + t) + q16] = f2bf(o[t][r] * rstd * gn[t] * ogv[t][r]); }
    }
    __syncthreads();
}
constexpr int CW_Q = 8192;
__device__ __forceinline__ void p2_queue(Frame& F) {
    const int lane = lane_id_fresh();
    volatile LAS int* qw = (volatile LAS int*)(F.lds + LDS_MISC + 64);
    constexpr int NH = 128, NM = 64, NW = (CV_ALL - CV_EARLY + 255) / 256, NA = NB * 6 * 8, NC = NB * 4 * 8;
    unsigned* mkv_done = (unsigned*)(F.ws + WS_CTL) + CW_Q + 256; bool mkv_ok = false;
    if (F.wave == 0 && lane == 0) qw[0] = (int)atomicAdd((unsigned*)(F.ws + WS_CTL) + CW_Q, 1u);
    for (;;) {
        __syncthreads();
        const int it = __builtin_amdgcn_readfirstlane(qw[0]);
        __syncthreads();
        if (it >= NH + NM + NW + NA + NC) break;
        int nxt = 0; if (F.wave == 0 && lane == 0) nxt = (int)atomicAdd((unsigned*)(F.ws + WS_CTL) + CW_Q, 1u);
        if (it < NH) hgrn_seq(F, it, (bf16*)(F.dout + DO_Y));
        else if (it < NH + NM) {
            pg8::StaticOrder S; S.init(F.ws + WS_MEMN, F.ws + WS_WMEM, NB * MEML, 512, 1024, NM, it - NH);
            pg8::EpiMemKV E{(bf16*)(F.ws + WS_MEMK), (bf16*)(F.ws + WS_MEMV), arg_in(I_KNC)};
            pg8::gemm_phase<pg8::EpiMemKV, pg8::StaticOrder, false>(F.lds, 1024, S, E, F.wave);
            if (F.wave == 0 && lane_id_fresh() == 0) { __builtin_amdgcn_fence(__ATOMIC_RELEASE, "agent"); asm volatile("s_waitcnt vmcnt(0)" ::: "memory"); (void)__hip_atomic_fetch_add(mkv_done, 1u, __ATOMIC_RELAXED, __HIP_MEMORY_SCOPE_AGENT); }
        }
        else if (it < NH + NM + NW) { const int l2 = lane_id_fresh(); LAS float* scr = (LAS float*)(F.lds + F.wave * 16384);
            for (int j = 0; j < 32; ++j) { const int ci = CV_EARLY + (it - NH - NM) * 256 + F.wave * 32 + j; if (ci < CV_ALL) conv_item(F, ci, scr, l2); } }
        else if (it < NH + NM + NW + NA) attnA_unit(F, it - NH - NM - NW);
        else {
            if (!mkv_ok) { unsigned sp = 0u; while (__hip_atomic_load(mkv_done, __ATOMIC_RELAXED, __HIP_MEMORY_SCOPE_AGENT) < (unsigned)NM && ++sp < (1u << 24)) __builtin_amdgcn_s_sleep(2);
                __builtin_amdgcn_fence(__ATOMIC_ACQUIRE, "agent"); mkv_ok = true; }
            attnC_unit(F, it - NH - NM - NW - NA);
        }
        if (F.wave == 0 && lane == 0) qw[0] = nxt;
    }
    __syncthreads();
}
template <bool OUTPUTS>
__device__ __forceinline__ void hgrn_simple(Frame& F, bf16* YBo) {
    const int lane = lane_id_fresh(); const int tid = F.wave * 64 + lane; (void)tid;
    const int uw = tid >> 7, col = tid & 127;
    LAS float* fL = (LAS float*)(F.lds + uw * 29184); LAS float* qL = fL + 2048; LAS float* oL = qL + 2048; LAS float* pL = oL + 3072;
    const bf16* PB = (const bf16*)(F.ws + WS_PB);
    const float* lbt = (const float*)(F.ws + WS_TAB) + 4096;
    float* LST = (float*)(F.ws + WS_LST); float* DEC = (float*)(F.ws + WS_DEC);
    for (int grp = F.vcu; grp < 1024; grp += F.G) {
        const int unit = grp * 4 + uw, b = unit >> 7, h = (unit >> 5) & 3, c = unit & 31; const int tok0 = b * SEQ + c * 64;
        float S[64]; float dprod = 1.f;
#pragma unroll
        for (int k = 0; k < 64; ++k) S[k] = 0.f;
        if (OUTPUTS && col < 96) {
            for (int cp = 0; cp < c; ++cp) { const float* dp = DEC + (size_t)(unit - c + cp) * 64; const float* lp = LST + (size_t)(unit - c + cp) * 6144 + col;
#pragma unroll
                for (int k = 0; k < 64; ++k) S[k] = dp[k] * S[k] + lp[k * 96]; }
        }
        for (int hf = 0; hf < 2; ++hf) {
            __syncthreads();
            for (int idx = col; idx < 2048; idx += 128) { const int s = idx >> 6, k = idx & 63; const size_t rb = (size_t)(tok0 + hf * 32 + s) * LD_PB;
                const float lb = lbt[h * 64 + k]; fL[idx] = lb + (1.f - lb) * sigmoidf_(bf2f(PB[rb + 256 + h * 64 + k]));
                if (OUTPUTS) qL[idx] = bf2f(PB[rb + h * 64 + k]); }
            __syncthreads();
            if (col < 96) {
                for (int s = 0; s < 32; ++s) {
                    const float v = bf2f(PB[(size_t)(tok0 + hf * 32 + s) * LD_PB + 512 + h * 96 + col]); float o = 0.f;
#pragma unroll
                    for (int k4 = 0; k4 < 16; ++k4) { const f32x4 f4 = *(const LAS f32x4*)(fL + s * 64 + 4 * k4); f32x4 q4 = (f32x4){0.f, 0.f, 0.f, 0.f}; if (OUTPUTS) q4 = *(const LAS f32x4*)(qL + s * 64 + 4 * k4);
#pragma unroll
                        for (int j = 0; j < 4; ++j) { const float fk = f4[j]; S[4 * k4 + j] = fk * S[4 * k4 + j] + (1.f - fk) * v; if (OUTPUTS) o += S[4 * k4 + j] * q4[j]; } }
                    if (OUTPUTS) oL[s * 96 + col] = o;
                }
            }
            if (!OUTPUTS && col < 64) { for (int s = 0; s < 32; ++s) dprod *= fL[s * 64 + col]; }
            if (OUTPUTS) {
                __syncthreads();
                { const int s = col & 31, part = col >> 5; float ss = 0.f;
#pragma unroll
                  for (int j = 0; j < 24; ++j) { const float x = oL[s * 96 + part * 24 + j]; ss += x * x; }
                  pL[s * 4 + part] = ss; }
                __syncthreads();
                if (col < 96) { const float gn = arg_in(I_ONB)[h * 96 + col];
                    for (int s = 0; s < 32; ++s) { const f32x4 p4 = *(const LAS f32x4*)(pL + s * 4); const float rstd = rsqrtf(((p4[0] + p4[1]) + (p4[2] + p4[3])) * (1.f / 96.f) + EPS);
                        const size_t tok = (size_t)(tok0 + hf * 32 + s); const float og = bf2f(PB[tok * LD_PB + 896 + h * 96 + col]);
                        YBo[tok * 384 + h * 96 + col] = f2bf(oL[s * 96 + col] * rstd * gn * og); } }
            }
        }
        if (!OUTPUTS) {
            if (col < 96) {
#pragma unroll
                for (int k = 0; k < 64; ++k) LST[(size_t)unit * 6144 + k * 96 + col] = S[k]; }
            if (col < 64) DEC[(size_t)unit * 64 + col] = dprod;
        }
    }
    __syncthreads();
}

__device__ __forceinline__ __amdgpu_buffer_rsrc_t make_rsrc(const void* base, int bytes) { return __builtin_amdgcn_make_buffer_rsrc((void*)base, (short)0, bytes, 0x00020000); }
__device__ __forceinline__ void count_greater4(int& beat, const v4u o, const unsigned key) {
    unsigned long long A, B, C;
    asm volatile("v_cmp_gt_u32_e64 %1, %4, %8\n\t"
                 "v_cmp_gt_u32_e64 %2, %5, %8\n\t"
                 "v_cmp_gt_u32_e64 %3, %6, %8\n\t"
                 "v_addc_co_u32_e64 %0, %1, 0, %0, %1\n\t"
                 "v_cmp_gt_u32_e64 %1, %7, %8\n\t"
                 "v_addc_co_u32_e64 %0, %2, 0, %0, %2\n\t"
                 "v_addc_co_u32_e64 %0, %3, 0, %0, %3\n\t"
                 "v_addc_co_u32_e64 %0, %1, 0, %0, %1"
                 : "+v"(beat), "=&s"(A), "=&s"(B), "=&s"(C) : "v"(o.x), "v"(o.y), "v"(o.z), "v"(o.w), "v"(key));
}
constexpr int RT_ROW = 2064;
constexpr int RT_HI = 0, RT_LO = 32 * RT_ROW, RT_LG = 64 * RT_ROW;
constexpr int RT_GN = RT_LG + 2 * 32 * 64 * 4 + 1024;
constexpr int RT_KEY = RT_GN + 4096;
static_assert(RT_KEY + 8 * 1024 <= LDS_MISC, "routing LDS map");
__device__ __forceinline__ void p6_route(Frame& F, const bool commit) {
    const int lane = lane_id_fresh();
    const bf16* X1 = (const bf16*)F.dout; bf16* U = (bf16*)(F.ws + WS_U);
    const bf16* WRH = (const bf16*)(F.ws + WS_TAB + 65536); const bf16* WRL = WRH + 65536;
    const float rbias = arg_in(I_RB)[lane];
    v2u* slot = (v2u*)(F.ws + WS_SLOT); unsigned* cntw = (unsigned*)(F.ws + WS_CTL) + CW_CNT;
    LAS unsigned* lcnt = (LAS unsigned*)(F.lds + RT_LG + 2 * 32 * 64 * 4);
    for (int i = F.vcu * 512 + F.wave * 64 + lane; i < HALF_T; i += F.G * 512) slot[(size_t)64 * SLOT_CAP + i] = (v2u){(unsigned)(i * 8), 0x3f800000u};
    const int q = lane & 15, g = lane >> 4, et = F.wave & 3, kh = F.wave >> 2;
    bf16x8 wh[16], wl[16];
    const __amdgpu_buffer_rsrc_t rsl = make_rsrc(WRL + (size_t)et * 16384 + (size_t)kh * 8192, 16384); const int lv16 = lane * 16;
    {   const bf16* ph = WRH + (size_t)et * 16384 + (size_t)kh * 8192 + lane * 8;
#pragma unroll
        for (int ks = 0; ks < 16; ++ks) wh[ks] = *(const bf16x8*)(ph + 512 * ks); }
    const unsigned long long lt_mask = (lane == 0) ? 0ull : (~0ull >> (64 - lane));
    v4u xv[4][2], xn[4][2];
    if (F.wave < 4) *(LAS f32x4*)(F.lds + RT_GN + (F.wave * 64 + lane) * 16) = ((const f32x4*)arg_in(I_FNG))[F.wave * 64 + lane];
    {   const int t0 = F.vcu * 32;
        if (t0 < T) {
#pragma unroll
            for (int i = 0; i < 4; ++i)
#pragma unroll
                for (int j = 0; j < 2; ++j) { xv[i][j] = *(const v4u*)(X1 + x1_off((size_t)(t0 + F.wave * 4 + i)) + 16 * lane + 8 * j); xn[i][j] = xv[i][j]; } }
        const int t1 = t0 + F.G * 32;
        if (t1 < T) {
#pragma unroll
            for (int i = 0; i < 4; ++i)
#pragma unroll
                for (int j = 0; j < 2; ++j) xn[i][j] = *(const v4u*)(X1 + x1_off((size_t)(t1 + F.wave * 4 + i)) + 16 * lane + 8 * j); } }
    for (int t0 = F.vcu * 32; t0 < T; t0 += F.G * 32) {
        __syncthreads();
        if (F.wave == 0) lcnt[lane] = 0u;
#pragma unroll
        for (int i = 0; i < 4; ++i) {
            const int tl = F.wave * 4 + i, t = t0 + tl;
            float x[16];
#pragma unroll
            for (int j = 0; j < 2; ++j) { const unsigned w4[4] = {xv[i][j].x, xv[i][j].y, xv[i][j].z, xv[i][j].w};
#pragma unroll
                for (int k = 0; k < 4; ++k) { x[8 * j + 2 * k] = bf_lo(w4[k]); x[8 * j + 2 * k + 1] = bf_hi(w4[k]); } }
            float s2 = 0.f;
#pragma unroll
            for (int k = 0; k < 16; ++k) s2 += x[k] * x[k];
            const float rstd = rsqrtf(wave_sum(s2) * (1.f / D) + EPS);
            unsigned hw[8], lw[8];
#pragma unroll
            for (int k = 0; k < 8; ++k) { const f32x4 gg = *(const LAS f32x4*)(F.lds + RT_GN + (4 * lane + (k >> 1)) * 16);
                const float u0 = x[2 * k] * rstd * gg[2 * (k & 1)], u1 = x[2 * k + 1] * rstd * gg[2 * (k & 1) + 1];
                hw[k] = cvt_pk_bf16(u0, u1); lw[k] = cvt_pk_bf16(u0 - bf_lo(hw[k]), u1 - bf_hi(hw[k])); }
            *(LAS v4u*)(F.lds + RT_HI + tl * RT_ROW + lane * 32) = (v4u){hw[0], hw[1], hw[2], hw[3]}; *(LAS v4u*)(F.lds + RT_HI + tl * RT_ROW + lane * 32 + 16) = (v4u){hw[4], hw[5], hw[6], hw[7]};
            *(LAS v4u*)(F.lds + RT_LO + tl * RT_ROW + lane * 32) = (v4u){lw[0], lw[1], lw[2], lw[3]}; *(LAS v4u*)(F.lds + RT_LO + tl * RT_ROW + lane * 32 + 16) = (v4u){lw[4], lw[5], lw[6], lw[7]};
        }
        asm volatile("" ::: "memory");
#pragma unroll
        for (int ks = 0; ks < 16; ++ks) wl[ks] = __builtin_bit_cast(bf16x8, __builtin_amdgcn_raw_buffer_load_b128(rsl, lv16, 1024 * ks, 0));
#pragma unroll
        for (int i = 0; i < 4; ++i)
#pragma unroll
            for (int j = 0; j < 2; ++j) xv[i][j] = xn[i][j];
        {   const int tn = t0 + 2 * F.G * 32;
            if (tn < T) {
#pragma unroll
                for (int i = 0; i < 4; ++i)
#pragma unroll
                    for (int j = 0; j < 2; ++j) xn[i][j] = *(const v4u*)(X1 + x1_off((size_t)(tn + F.wave * 4 + i)) + 16 * lane + 8 * j); } }
        __syncthreads();
#pragma unroll
        for (int mt = 0; mt < 2; ++mt) {
            f32x4 acc = (f32x4){0.f, 0.f, 0.f, 0.f};
            const LAS unsigned char* uh = F.lds + RT_HI + (mt * 16 + q) * RT_ROW + 16 * g + kh * 1024; const LAS unsigned char* ul = F.lds + RT_LO + (mt * 16 + q) * RT_ROW + 16 * g + kh * 1024;
#pragma unroll
            for (int ks = 0; ks < 16; ++ks) {
                const bf16x8 b_h = *(const LAS bf16x8*)(uh + 64 * ks), b_l = *(const LAS bf16x8*)(ul + 64 * ks);
                acc = __builtin_amdgcn_mfma_f32_16x16x32_bf16(wh[ks], b_h, acc, 0, 0, 0);
                acc = __builtin_amdgcn_mfma_f32_16x16x32_bf16(wl[ks], b_h, acc, 0, 0, 0);
                acc = __builtin_amdgcn_mfma_f32_16x16x32_bf16(wh[ks], b_l, acc, 0, 0, 0);
            }
            *(LAS f32x4*)(F.lds + RT_LG + kh * 8192 + ((mt * 16 + q) * 64 + et * 16 + 4 * g) * 4) = acc;
        }
        __syncthreads();
#define RT_STORE_U() do { _Pragma("unroll") for (int i = 0; i < 4; ++i) { const int tl = F.wave * 4 + i; _Pragma("unroll") for (int j = 0; j < 2; ++j) \
            *((v4u*)(U + (size_t)(t0 + tl) * D) + 64 * j + lane) = *(const LAS v4u*)(F.lds + RT_HI + tl * RT_ROW + (64 * j + lane) * 16); } } while (0)
        if (F.wave < 4) RT_STORE_U();
        unsigned lrank[4]; float wn[4]; int rk[4];
#pragma unroll
        for (int i = 0; i < 4; ++i) {
            const int tl = F.wave * 4 + i;
            const float z = *(const LAS float*)(F.lds + RT_LG + (tl * 64 + lane) * 4) + *(const LAS float*)(F.lds + RT_LG + 8192 + (tl * 64 + lane) * 4);
            const float sg = sigmoidf_(z), ch = sg + rbias;
            float m1 = max_grp8(ch);
            const unsigned long long eqm = __ballot(ch == m1); const int gbase = lane & ~7; const unsigned gm = (unsigned)(eqm >> gbase) & 0xffu; const int first = gbase + __builtin_ctz(gm);
            float m2 = max_grp8((lane == first) ? -3.0e38f : ch);
            const float gs = m1 + m2; const int gi = lane >> 3; int grank = 0;
#pragma unroll
            for (int gg = 0; gg < 8; ++gg) { const float og = readlane_f(gs, gg * 8); grank += (og > gs || (og == gs && gg < gi)) ? 1 : 0; }
            const bool gsel = grank < 4; const float cm = gsel ? ch : -3.0e38f;
            const unsigned kb = __float_as_uint(cm); const unsigned key = (kb & 0x80000000u) ? ~kb : (kb | 0x80000000u);
            int beat = 0;
            {   LAS unsigned* kr = (LAS unsigned*)(F.lds + RT_KEY + F.wave * 1024 + i * 256);
                kr[lane] = key;
#pragma unroll
                for (int h = 0; h < 2; ++h) { v4u o[8];
#pragma unroll
                    for (int j4 = 0; j4 < 8; ++j4) o[j4] = *(const LAS v4u*)(kr + 32 * h + 4 * j4);
#pragma unroll
                    for (int j4 = 0; j4 < 8; ++j4) count_greater4(beat, o[j4], key); } }
            bool sel = gsel && beat < 8;
            if (__builtin_popcountll(__ballot(sel)) != 8) {
                unsigned thr = 0u;
#pragma unroll 1
                for (int bit = 31; bit >= 0; --bit) { const unsigned cand = thr | (1u << bit); if (__builtin_popcountll(__ballot(key >= cand)) >= 8) thr = cand; }
                const unsigned long long gtm = __ballot(key > thr), eqt = __ballot(key == thr); const int need = 8 - __builtin_popcountll(gtm);
                sel = (key > thr) || (key == thr && __builtin_popcountll(eqt & lt_mask) < need);
            }
            const unsigned long long selm = __ballot(sel);
            const float wsum = wave_sum(sel ? sg : 0.f);
            rk[i] = sel ? __builtin_popcountll(selm & lt_mask) : -1; wn[i] = 2.5f * sg / wsum; lrank[i] = 0u;
            if (sel) lrank[i] = __hip_atomic_fetch_add(lcnt + lane, 1u, __ATOMIC_RELAXED, __HIP_MEMORY_SCOPE_WORKGROUP);
        }
        if (F.wave >= 4) RT_STORE_U();
#undef RT_STORE_U
        __syncthreads();
        const int seg = lane;
        if (F.wave == 0) { const unsigned n = lcnt[lane]; unsigned base = 0u; if (n && commit) base = atomicAdd(cntw + 64 * seg, n); lcnt[64 + lane] = base; }
        __syncthreads();
        if (commit) { const unsigned base = lcnt[64 + lane];
#pragma unroll
            for (int i = 0; i < 4; ++i) if (rk[i] >= 0) { const int flat = (t0 + F.wave * 4 + i) * 8 + rk[i]; slot[(size_t)seg * SLOT_CAP + base + lrank[i]] = (v2u){(unsigned)flat, __float_as_uint(wn[i])}; } }
    }
    __syncthreads();
}
__device__ __forceinline__ void moe_load_segs(Frame& F) {
    const int lane = lane_id_fresh(); const int tid = F.wave * 64 + lane; (void)tid;
    LAS int* pre = (LAS int*)(F.lds + LDS_PRE); LAS int* cnt = pre + 132;
    __syncthreads();
    if (tid < NSEG) { const int e = tid % NSEGH; cnt[tid] = (e == 64) ? T : (int)__hip_atomic_load((unsigned*)(F.ws + WS_CTL) + CW_CNT + 64 * tid, RLX_AGENT); }
    __syncthreads();
    static_assert(NSEG == 65, "the scan below handles 64 lanes + one tail segment");
    if (F.wave == 0) {
        const int b = (cnt[lane] + 255) >> 8; int inc = b;
#pragma unroll
        for (int o = 1; o < 64; o <<= 1) { const int t = __shfl_up(inc, o); if (lane >= o) inc += t; }
        pre[lane] = inc - b;
        if (lane == 63) { pre[64] = inc; pre[65] = inc + ((cnt[64] + 255) >> 8); }
    }
    __syncthreads();
}
typedef float f32x2v __attribute__((ext_vector_type(2)));
__device__ __forceinline__ void p_combine(Frame& F) {
    const int lane = lane_id_fresh();
    const int gw = F.vcu * 8 + F.wave, NGW = F.G * 8; float* out = (float*)F.dout; const unsigned char* YB = F.ws + WS_YBUF; const unsigned char* SHB = F.ws + WS_SHB;
    v4u c[11], n[11];
#define CMB_LOAD(dst, t_) do { const bf16* xp_ = (const bf16*)F.dout + x1_off((size_t)(t_)) + lane * 16; dst[0] = *(const v4u*)xp_; dst[1] = *(const v4u*)(xp_ + 8); \
        _Pragma("unroll") for (int k = 0; k < 8; ++k) dst[2 + k] = *(const v4u*)(YB + (size_t)(lane >> 4) * ((size_t)T * 8 * 256) + ((size_t)(t_) * 8 + k) * 256 + (lane & 15) * 16); \
        dst[10] = *(const v4u*)(SHB + (size_t)(lane >> 4) * ((size_t)T * 256) + (size_t)(t_) * 256 + (lane & 15) * 16); } while (0)
    if (gw < T) CMB_LOAD(c, gw);
    for (int t = gw; t < T; t += NGW) {
        const int tn = t + NGW;
        if (tn < T) CMB_LOAD(n, tn);
        float a[16];
        { const unsigned ww[8] = {c[0].x, c[0].y, c[0].z, c[0].w, c[1].x, c[1].y, c[1].z, c[1].w};
#pragma unroll
          for (int j = 0; j < 8; ++j) { a[2 * j] = bf_lo(ww[j]); a[2 * j + 1] = bf_hi(ww[j]); } }
        float acc[16];
#pragma unroll
        for (int j = 0; j < 16; ++j) acc[j] = 0.f;
#pragma unroll
        for (int k = 0; k < 9; ++k) { const unsigned ww[4] = {c[2 + k].x, c[2 + k].y, c[2 + k].z, c[2 + k].w};
#pragma unroll
            for (int j = 0; j < 4; ++j) { const f32x2v lo = __builtin_amdgcn_cvt_pk_f32_fp8((int)ww[j], false), hi = __builtin_amdgcn_cvt_pk_f32_fp8((int)ww[j], true);
                acc[4 * j] += lo[0]; acc[4 * j + 1] += lo[1]; acc[4 * j + 2] += hi[0]; acc[4 * j + 3] += hi[1]; } }
#pragma unroll
        for (int j = 0; j < 4; ++j) *(f32x4*)(out + (size_t)t * D + lane * 16 + 4 * j) = (f32x4){a[4 * j] + acc[4 * j] * Y8_INV, a[4 * j + 1] + acc[4 * j + 1] * Y8_INV, a[4 * j + 2] + acc[4 * j + 2] * Y8_INV, a[4 * j + 3] + acc[4 * j + 3] * Y8_INV};
#pragma unroll
        for (int k = 0; k < 11; ++k) c[k] = n[k];
    }
#undef CMB_LOAD
}

struct Args { const float* in[24]; float* out; unsigned char* ws; int ph_lo, ph_hi, li, pad; };
__global__ void __launch_bounds__(512, 2) mk_fwd(Args args) {
    extern __shared__ __attribute__((aligned(16))) unsigned char lds[];
    Frame F;
    F.lds = (LAS unsigned char*)lds;
    F.wave = __builtin_amdgcn_readfirstlane((int)threadIdx.x >> 6);
    F.G = gridDim.x; { const int bx = blockIdx.x; F.vcu = (F.G % 8 == 0) ? (bx % 8) * (F.G / 8) + bx / 8 : bx; }
    F.ws = args.ws; F.dout = (unsigned char*)args.out;
    volatile LAS unsigned* MISC = (volatile LAS unsigned*)(F.lds + LDS_MISC);
    if (threadIdx.x < 64) MISC[threadIdx.x] = 0u;
    __syncthreads();
    XcdBarrier bar; bar.bar = (unsigned*)(F.ws + WS_CTL) + CW_BAR; bar.x = 0; bar.st = nullptr;
    if (MK_N_LAUNCHES == 1) bar = xcd_barrier_post((unsigned*)(F.ws + WS_CTL) + CW_BAR, MISC);
    const int lo = args.ph_lo, hi = args.ph_hi;
#ifndef PH_MASK
#define PH_MASK 0xfff
#endif
#define IN(k) (((PH_MASK >> (k)) & 1) && lo <= (k) && (k) < hi)
#ifndef REPEAT_MASK
#define REPEAT_MASK 0
#endif
#define REP(k) (((REPEAT_MASK >> (k)) & 1) != 0)
#define SEAM(k) do { if (IN(k) && IN((k) + 1)) xcd_barrier(bar, F.wave); } while (0)
    LAS unsigned char* ring = F.lds;

    if (IN(0)) { p0_prologue(F); if (REP(0)) { xcd_barrier(bar, F.wave); p0_prologue(F); } } SEAM(0);
    if (IN(1)) for (int rep_ = 0; rep_ < (REP(1) ? 2 : 1); ++rep_) { if (rep_) xcd_barrier(bar, F.wave);
        stagger(F, 350);
        { pg8::StaticOrder S; S.init(F.dout, F.ws + WS_WIN, T, NPROJ_PAD, 1024, F.G, (int)blockIdx.x);
          pg8::EpiProj E{(bf16*)(F.ws + WS_PA), (bf16*)(F.ws + WS_PB), (bf16*)(F.ws + WS_PC), (unsigned char*)(F.ws + WS_PG), arg_in(I_QNA), arg_in(I_KNA), arg_in(I_QNC)};
          pg8::gemm_phase<pg8::EpiProj, pg8::StaticOrder, false>(ring, 1024, S, E, F.wave); }
    } SEAM(1);
#ifndef HGRN_CHECK
#define HGRN_CHECK 0
#endif
#ifndef P2_MODE
#define P2_MODE 0
#endif
#if HGRN_CHECK == 2
    if (IN(2)) { for (int sq = F.vcu; sq < 128; sq += F.G) hgrn_seq(F, sq, (bf16*)(F.dout + 128 * MiB)); for (int sq = F.vcu; sq < 128; sq += F.G) hgrn_seq(F, sq, (bf16*)(F.dout + 176 * MiB)); p2_attn_mfma(F); hgrn_simple<false>(F, nullptr); } SEAM(2);
    if (IN(3)) { hgrn_simple<true>(F, (bf16*)(F.dout + 128 * MiB)); xcd_barrier(bar, F.wave);
        const bf16* Y1 = (const bf16*)(F.dout + 128 * MiB); const bf16* Y3 = (const bf16*)(F.dout + 176 * MiB); const bf16* Y2 = (const bf16*)(F.dout + 128 * MiB); unsigned bad = 0, bad2 = 0; const int lane = lane_id_fresh();
        for (size_t i = (size_t)F.vcu * 512 + F.wave * 64 + lane; i < (size_t)T * 384; i += (size_t)F.G * 512) { if (Y1[i] != Y3[i]) ++bad; const float a = bf2f(Y1[i]), b2 = bf2f(Y2[i]); if (!(fabsf(a - b2) <= 0.03f * (fabsf(a) + fabsf(b2)) + 0.02f)) ++bad2; }
        bad = (unsigned)wave_sum((float)bad); bad2 = (unsigned)wave_sum((float)bad2); if (lane == 0 && bad) atomicAdd((unsigned*)(F.ws + WS_CTL) + CW_Q + 64, bad); if (lane == 0 && bad2) atomicAdd((unsigned*)(F.ws + WS_CTL) + CW_Q + 128, bad2); } SEAM(3);
#else
    if (IN(2)) { if (P2_MODE == 0) p2_queue(F); else { for (int sq = F.vcu; sq < 128; sq += F.G) hgrn_seq(F, sq, (bf16*)(F.dout + DO_Y)); p2_attn_mfma(F); } if (HGRN_CHECK) hgrn_simple<false>(F, nullptr); } SEAM(2);
    if (IN(3) && HGRN_CHECK) { if (HGRN_CHECK) {
        bf16* Y2 = (bf16*)(F.dout + 128 * MiB); hgrn_simple<true>(F, Y2); xcd_barrier(bar, F.wave);
        const bf16* Y1 = (const bf16*)(F.dout + 128 * MiB); unsigned bad = 0; const int lane = lane_id_fresh();
        for (size_t i = (size_t)F.vcu * 512 + F.wave * 64 + lane; i < (size_t)T * 384; i += (size_t)F.G * 512) { const float a = bf2f(Y1[i]), b2 = bf2f(Y2[i]); if (!(fabsf(a - b2) <= 0.03f * (fabsf(a) + fabsf(b2)) + 0.02f)) ++bad; }
        bad = (unsigned)wave_sum((float)bad); if (lane == 0 && bad) atomicAdd((unsigned*)(F.ws + WS_CTL) + CW_Q + 64, bad); } } if (HGRN_CHECK) SEAM(3);
#endif
    if (IN(4)) for (int rep_ = 0; rep_ < (REP(4) ? 2 : 1); ++rep_) { if (rep_) xcd_barrier(bar, F.wave);
        pg8::StaticOrder S; S.init(F.dout + DO_Y, F.ws + WS_WA, T, 1024, 1024, F.G, (int)blockIdx.x); pg8::EpiMerge E{(const unsigned char*)(F.ws + WS_PG), (bf16*)(F.ws + WS_MIXED)};
        pg8::gemm_phase<pg8::EpiMerge, pg8::StaticOrder, false>(ring, 1024, S, E, F.wave);
    } SEAM(4);
    if (IN(5)) for (int rep_ = 0; rep_ < (REP(5) ? 2 : 1); ++rep_) { if (rep_) xcd_barrier(bar, F.wave);
        pg8::StaticOrder S; S.init(F.ws + WS_MIXED, F.ws + WS_WOUT, T, 1024, 1024, F.G, (int)blockIdx.x); pg8::EpiOut E{arg_in(I_X), (bf16*)F.dout};
        pg8::gemm_phase<pg8::EpiOut, pg8::StaticOrder, false>(ring, 1024, S, E, F.wave);
    } SEAM(5);
    if (IN(6)) { for (int rep_ = (REP(6) ? 0 : 1); rep_ < 2; ++rep_) { p6_route(F, rep_ == 1 || ((volatile unsigned*)(F.ws + WS_CTL))[8] != 0u); if (rep_ == 0) xcd_barrier(bar, F.wave); } } SEAM(6);
    if (IN(7)) for (int rep_ = 0; rep_ < (REP(7) ? 2 : 1); ++rep_) { if (rep_) xcd_barrier(bar, F.wave);
        moe_load_segs(F); stagger(F, 300);
        pg8::MoeOrder S; S.pre = (const LAS int*)(F.lds + LDS_PRE); S.cnt = S.pre + 132; S.seg_lo = 0; S.nseg = NSEG; S.nN = 2; S.G = F.G; S.c = F.vcu;
        S.A = (const char*)(F.ws + WS_U); S.Bt = (const char*)(F.ws + WS_WUP); S.a_tstep = 0; S.b_estride = (size_t)512 * 1024 * 2; S.b_tstep = (size_t)256 * 1024 * 2; S.slot = (const int*)(F.ws + WS_SLOT); S.gather = true; S.hint = 0;
        pg8::EpiUp E{(bf16*)(F.ws + WS_HID)};
        pg8::gemm_phase<pg8::EpiUp, pg8::MoeOrder, true>(ring, 1024, S, E, F.wave);
    } SEAM(7);
#define DOWN_PHASE(nsg, prb) do { if (!(IN(7))) moe_load_segs(F);     \
        pg8::MoeOrder S; S.pre = (const LAS int*)(F.lds + LDS_PRE); S.cnt = S.pre + 132; S.seg_lo = 0; S.nseg = (nsg); S.nN = 4; S.G = F.G; S.c = F.vcu; \
        S.A = (const char*)(F.ws + WS_HID); S.Bt = (const char*)(F.ws + WS_WDN); S.a_tstep = (size_t)256 * 256 * 2; S.b_estride = (size_t)1024 * 256 * 2; S.b_tstep = (size_t)256 * 256 * 2; S.slot = (const int*)(F.ws + WS_SLOT); S.gather = false; S.hint = 0; \
        pg8::EpiDown E{F.lds, F.ws + WS_YBUF, F.ws + WS_SHB, (prb)}; \
        pg8::gemm_phase<pg8::EpiDown, pg8::MoeOrder, false, true>(ring, 256, S, E, F.wave); } while (0)
    if (IN(8)) { if (REP(8)) { DOWN_PHASE(64, -2); xcd_barrier(bar, F.wave); } DOWN_PHASE(NSEGH, 0); } SEAM(8);
    if (IN(9)) { p_combine(F);
        if (HGRN_CHECK) { xcd_barrier(bar, F.wave); const unsigned c1 = __hip_atomic_load((unsigned*)(F.ws + WS_CTL) + CW_Q + 64, RLX_AGENT), c2 = __hip_atomic_load((unsigned*)(F.ws + WS_CTL) + CW_Q + 128, RLX_AGENT);
            const float frac = (c1 > 0u ? 50.f : 0.f) + (c2 > 25000u ? 5.f : 0.f) + (c2 > 1250000u ? 10.f : 0.f);
            if (frac > 0.f) { const int lane = lane_id_fresh(); float* o = (float*)F.dout; for (size_t i = (size_t)F.vcu * 512 + F.wave * 64 + lane; i < (size_t)T * D; i += (size_t)F.G * 512) o[i] += frac; } } }
#undef IN
#undef SEAM
}

extern "C" void kernel_launch(void* const* d_in, const int* in_sizes, int n_in, void* d_out, int out_size, void* d_ws, size_t ws_size, hipStream_t stream) {
    static int grid = 0;
    if (grid == 0) {
        if (n_in != 24 || out_size != T * D || ws_size < WS_END) { fprintf(stderr, "kernel_launch: unexpected shapes (n_in %d out %d ws %zu)\n", n_in, out_size, ws_size); grid = -1; return; }
        int dev = 0, cus = 0, per_cu = 0;
        if (hipGetDevice(&dev) != hipSuccess || hipDeviceGetAttribute(&cus, hipDeviceAttributeMultiprocessorCount, dev) != hipSuccess) { grid = -1; return; }
        if (hipFuncSetAttribute((const void*)mk_fwd, hipFuncAttributeMaxDynamicSharedMemorySize, LDS_BYTES) != hipSuccess) { fprintf(stderr, "kernel_launch: hipFuncSetAttribute failed\n"); grid = -1; return; }
        if (hipOccupancyMaxActiveBlocksPerMultiprocessor(&per_cu, (const void*)mk_fwd, 512, LDS_BYTES) != hipSuccess || per_cu < 1) fprintf(stderr, "kernel_launch: occupancy query says %d\n", per_cu);
        (void)hipGetLastError();
        grid = cus;
    }
    if (grid < 0) return;
    (void)hipMemsetAsync((char*)d_ws + WS_CTL, 0, CTL_ZERO_BYTES, stream);
    Args a{};
    for (int i = 0; i < 24; ++i) a.in[i] = (const float*)d_in[i];
    a.out = (float*)d_out; a.ws = (unsigned char*)d_ws;
    for (int li = 0; li < MK_N_LAUNCHES; ++li) {
        a.ph_lo = (MK_N_LAUNCHES == 1) ? 0 : li; a.ph_hi = (MK_N_LAUNCHES == 1) ? NPHASE : li + 1; a.li = li;
        hipLaunchKernelGGL(mk_fwd, dim3(grid), dim3(512), LDS_BYTES, stream, a);
    }
}
```
